# Optimizing an MI355X kernel written in HIP

```python
import jax, jax.numpy as jnp
from jax import lax
import numpy as np

D_MODEL = 1024
BATCH = 4
SEQ = 4096
DEPTH = 2

CTX_LEN = 256
GRID_W = 64
CHUNK = 128
Q_BLOCK = 128
W_A = D_MODEL // 4
A_HEADS = 4
A_HEAD_DIM = W_A // A_HEADS
W_B = D_MODEL // 4
POOL_WINDOWS = (2, 4, 8, 16)
B_GROUP = W_B // len(POOL_WINDOWS)
V_DIM = 64
W_C = D_MODEL // 2
MLA_HEADS = W_C // V_DIM
QK_NOPE = 64
QK_ROPE = 32
QK_HEAD = QK_NOPE + QK_ROPE
Q_RANK = 256
KV_RANK = 128
D_MIX = W_A + W_B + W_C
SPLIT_POINTS = (2 * W_A, 2 * W_A + W_B, 2 * W_A + W_B + Q_RANK, 2 * W_A + W_B + Q_RANK + KV_RANK)
D_IN = 2 * W_A + W_B + Q_RANK + KV_RANK + QK_ROPE
D_FF = -(-8 * D_MODEL // (3 * 256)) * 256
ROPE_BASE = 10000.0
EPS = 1e-6
N_MOD = 6

kernel_name = "hybrid_parallel_groups_dit_block"


def rms_norm(x, g):
    xf = x.astype(jnp.float32)
    y = xf * lax.rsqrt(jnp.mean(xf * xf, axis=-1, keepdims=True) + EPS)
    return (y * g.astype(jnp.float32)).astype(x.dtype)


def axial_rope_tables(n_tokens):
    rows = n_tokens // GRID_W
    row = jnp.repeat(jnp.arange(rows), GRID_W).astype(jnp.float32)
    col = jnp.tile(jnp.arange(GRID_W), rows).astype(jnp.float32)
    n_freq = QK_ROPE // 4
    inv = ROPE_BASE ** (-jnp.arange(n_freq, dtype=jnp.float32) / n_freq)
    ang = jnp.concatenate([row[:, None] * inv, col[:, None] * inv], axis=-1)
    return jnp.cos(ang), jnp.sin(ang)


def apply_rope(x, cos, sin):
    shp = x.shape
    xp = x.astype(jnp.float32).reshape(shp[:-1] + (QK_ROPE // 2, 2))
    x1, x2 = xp[..., 0], xp[..., 1]
    c = cos[None, :, None, :]
    s = sin[None, :, None, :]
    out = jnp.stack([x1 * c - x2 * s, x1 * s + x2 * c], axis=-1)
    return out.reshape(shp).astype(x.dtype)


def chunk_mlp(z, norm_g, w_spatial, b_spatial):
    bn, n_tok = z.shape[0], z.shape[1]
    u, v = z[..., :W_A], z[..., W_A:]
    v = rms_norm(v, norm_g).reshape(bn, n_tok // CHUNK, CHUNK, A_HEADS, A_HEAD_DIM)
    mixed = jnp.einsum('hij,bnjhd->bnihd', w_spatial, v) + b_spatial.T[:, :, None]
    return u * mixed.reshape(bn, n_tok, W_A)


def multiscale_pool(z, w_pool, pool_scale):
    n_tok = z.shape[1]
    zf = z.astype(jnp.float32)
    cs = jnp.concatenate([jnp.zeros_like(zf[:, :1]), jnp.cumsum(zf, axis=1)], axis=1)
    t = jnp.arange(n_tok)
    outs = []
    for g, w in enumerate(POOL_WINDOWS):
        lo = jnp.clip(t - w // 2, 0, n_tok)
        hi = jnp.clip(t + w // 2, 0, n_tok)
        seg = cs[:, :, g * B_GROUP:(g + 1) * B_GROUP]
        mean = (jnp.take(seg, hi, axis=1) - jnp.take(seg, lo, axis=1)) / (hi - lo).astype(jnp.float32)[None, :, None]
        d = (mean - zf[:, :, g * B_GROUP:(g + 1) * B_GROUP]).astype(z.dtype)
        outs.append(jnp.einsum('blc,cd->bld', d, w_pool[g]))
    return jnp.concatenate(outs, axis=-1) * pool_scale


def mla_qkv(p_q, p_kv, p_kr, q_a_norm_g, w_q_b, kv_a_norm_g, w_kv_b, q_norm_g, k_norm_g, rope):
    bn, n_tok = p_q.shape[0], p_q.shape[1]
    q = (rms_norm(p_q, q_a_norm_g) @ w_q_b).reshape(bn, n_tok, MLA_HEADS, QK_HEAD)
    kv = (rms_norm(p_kv, kv_a_norm_g) @ w_kv_b).reshape(bn, n_tok, MLA_HEADS, QK_NOPE + V_DIM)
    k_nope, v = kv[..., :QK_NOPE], kv[..., QK_NOPE:]
    k_rope = jnp.broadcast_to(p_kr[:, :, None, :], (bn, n_tok, MLA_HEADS, QK_ROPE))
    k = jnp.concatenate([k_nope, k_rope], axis=-1)
    q = rms_norm(q, q_norm_g)
    k = rms_norm(k, k_norm_g)
    if rope is not None:
        cos, sin = rope
        q = jnp.concatenate([q[..., :QK_NOPE], apply_rope(q[..., QK_NOPE:], cos, sin)], axis=-1)
        k = jnp.concatenate([k[..., :QK_NOPE], apply_rope(k[..., QK_NOPE:], cos, sin)], axis=-1)
    return q, k, v


def attend_blocks(q, k, v):
    bn, n_tok = q.shape[0], q.shape[1]
    nb = n_tok // Q_BLOCK
    scale = QK_HEAD ** -0.5
    qb = q.reshape(bn, nb, Q_BLOCK, MLA_HEADS, QK_HEAD).transpose(1, 0, 2, 3, 4)

    def one_block(qblk):
        s = jnp.einsum('bqhd,bkhd->bhqk', qblk, k, preferred_element_type=jnp.float32) * scale
        p = jax.nn.softmax(s, axis=-1)
        return jnp.einsum('bhqk,bkhd->bqhd', p.astype(v.dtype), v)

    o = lax.map(one_block, qb)
    return o.transpose(1, 0, 2, 3, 4).reshape(bn, n_tok, MLA_HEADS * V_DIM)


def swiglu(h, w_gate_up, w_down):
    gu = h @ w_gate_up
    return (jax.nn.silu(gu[..., :D_FF]) * gu[..., D_FF:]) @ w_down


def hybrid_layer(x, xc, s_lat, s_ctx, rope, norm1_g, norm2_g, w_ada, b_ada, w_in,
                 sgu_norm_g, w_spatial, b_spatial, w_pool, pool_scale,
                 q_a_norm_g, w_q_b, kv_a_norm_g, w_kv_b, q_norm_g, k_norm_g,
                 w_out, w_gate_up, w_down, update_ctx):
    bn = x.shape[0]
    mod = (s_lat @ w_ada + b_ada).reshape(bn, N_MOD, 1, D_MODEL)
    modc = (s_ctx @ w_ada + b_ada).reshape(N_MOD, 1, 1, D_MODEL)
    sh1, sc1, g1, sh2, sc2, g2 = [mod[:, i] for i in range(N_MOD)]
    sh1c, sc1c, g1c, sh2c, sc2c, g2c = [modc[i] for i in range(N_MOD)]

    h = rms_norm(x, norm1_g) * (1 + sc1) + sh1
    hc = rms_norm(xc, norm1_g) * (1 + sc1c) + sh1c
    a, b, pq, pkv, pkr = jnp.split(h @ w_in, SPLIT_POINTS, axis=-1)
    ac, bc, pqc, pkvc, pkrc = jnp.split(hc @ w_in, SPLIT_POINTS, axis=-1)

    y_a = chunk_mlp(jax.nn.gelu(a, approximate=False), sgu_norm_g, w_spatial, b_spatial)
    y_b = multiscale_pool(b, w_pool, pool_scale)
    q, k, v = mla_qkv(pq, pkv, pkr, q_a_norm_g, w_q_b, kv_a_norm_g, w_kv_b, q_norm_g, k_norm_g, rope)
    qc, kc, vc = mla_qkv(pqc, pkvc, pkrc, q_a_norm_g, w_q_b, kv_a_norm_g, w_kv_b, q_norm_g, k_norm_g, None)
    y_c = attend_blocks(q, jnp.concatenate([kc, k], axis=1), jnp.concatenate([vc, v], axis=1))
    x = x + g1 * (jnp.concatenate([y_a, y_b, y_c], axis=-1) @ w_out)

    h2 = rms_norm(x, norm2_g) * (1 + sc2) + sh2
    x = x + g2 * swiglu(h2, w_gate_up, w_down)

    if update_ctx:
        y_ac = chunk_mlp(jax.nn.gelu(ac, approximate=False), sgu_norm_g, w_spatial, b_spatial)
        y_bc = multiscale_pool(bc, w_pool, pool_scale)
        y_cc = attend_blocks(qc, kc, vc)
        xc = xc + g1c * (jnp.concatenate([y_ac, y_bc, y_cc], axis=-1) @ w_out)
        h2c = rms_norm(xc, norm2_g) * (1 + sc2c) + sh2c
        xc = xc + g2c * swiglu(h2c, w_gate_up, w_down)
    return x, xc


def setup_inputs(seed: int = 0) -> dict:
    key = jax.random.key(seed)
    ks = jax.random.split(key, 28)
    f32 = jnp.float32

    def nrm(k, shape, scale):
        return jax.random.normal(k, shape, f32) * scale

    def gain(k, shape):
        return 1.0 + 0.02 * jax.random.normal(k, shape, f32)

    L = DEPTH
    return {
        "x": nrm(ks[0], (BATCH, SEQ, D_MODEL), 1.0),
        "c": nrm(ks[1], (BATCH, D_MODEL), 1.0),
        "ctx": nrm(ks[2], (BATCH, CTX_LEN, D_MODEL), 1.0),
        "c_ctx": nrm(ks[3], (D_MODEL,), 1.0),
        "norm1_g": gain(ks[4], (L, D_MODEL)),
        "norm2_g": gain(ks[5], (L, D_MODEL)),
        "w_ada": nrm(ks[6], (L, D_MODEL, N_MOD * D_MODEL), 0.5 * D_MODEL ** -0.5),
        "b_ada": nrm(ks[7], (L, N_MOD * D_MODEL), 0.02),
        "w_in": nrm(ks[8], (L, D_MODEL, D_IN), D_MODEL ** -0.5),
        "sgu_norm_g": gain(ks[9], (L, W_A)),
        "w_spatial": nrm(ks[10], (L, A_HEADS, CHUNK, CHUNK), CHUNK ** -0.5),
        "b_spatial": gain(ks[11], (L, A_HEADS, CHUNK)),
        "w_pool": nrm(ks[12], (L, len(POOL_WINDOWS), B_GROUP, B_GROUP), B_GROUP ** -0.5),
        "pool_scale": gain(ks[13], (L, W_B)),
        "q_a_norm_g": gain(ks[14], (L, Q_RANK)),
        "w_q_b": nrm(ks[15], (L, Q_RANK, MLA_HEADS * QK_HEAD), Q_RANK ** -0.5),
        "kv_a_norm_g": gain(ks[16], (L, KV_RANK)),
        "w_kv_b": nrm(ks[17], (L, KV_RANK, MLA_HEADS * (QK_NOPE + V_DIM)), KV_RANK ** -0.5),
        "q_norm_g": gain(ks[18], (L, QK_HEAD)),
        "k_norm_g": gain(ks[19], (L, QK_HEAD)),
        "w_out": nrm(ks[20], (L, D_MIX, D_MODEL), D_MIX ** -0.5),
        "w_gate_up": nrm(ks[21], (L, D_MODEL, 2 * D_FF), D_MODEL ** -0.5),
        "w_down": nrm(ks[22], (L, D_FF, D_MODEL), D_FF ** -0.5),
    }


def reference(x, c, ctx, c_ctx, norm1_g, norm2_g, w_ada, b_ada, w_in, sgu_norm_g,
              w_spatial, b_spatial, w_pool, pool_scale, q_a_norm_g, w_q_b,
              kv_a_norm_g, w_kv_b, q_norm_g, k_norm_g, w_out, w_gate_up, w_down):
    n_tok = x.shape[1]
    rope = axial_rope_tables(n_tok)
    s_lat = jax.nn.silu(c)
    s_ctx = jax.nn.silu(c_ctx)
    xc = ctx
    for i in range(DEPTH):
        x, xc = hybrid_layer(
            x, xc, s_lat, s_ctx, rope, norm1_g[i], norm2_g[i], w_ada[i], b_ada[i], w_in[i],
            sgu_norm_g[i], w_spatial[i], b_spatial[i], w_pool[i], pool_scale[i],
            q_a_norm_g[i], w_q_b[i], kv_a_norm_g[i], w_kv_b[i], q_norm_g[i], k_norm_g[i],
            w_out[i], w_gate_up[i], w_down[i], update_ctx=(i < DEPTH - 1))
    return x
```

```cpp
#include <hip/hip_runtime.h>
#include <cstdint>
#include <cstdio>

constexpr int DM = 1024, NB = 4, SEQ = 4096, CTXL = 256, DEPTH = 2;
constexpr int RL = NB * SEQ;
constexpr int RC = NB * CTXL;
constexpr int R = RL + RC;
constexpr int WA = 256, DIN = 1184, DFF = 2816, NMOD = 6;
constexpr int NH = 8, QKH = 96, QKN = 64, QKR = 32, VD = 64, QRANK = 256, KVRANK = 128;
constexpr int NKEY = CTXL + SEQ;
constexpr float EPS = 1e-6f;
constexpr float QSCALE = 0.10206207261596577f * 1.4426950408889634f;

typedef unsigned short bf16_t;
__device__ __forceinline__ float bf2f(bf16_t v) { return __uint_as_float(((unsigned)v) << 16); }
__device__ __forceinline__ bf16_t f2bf(float f) { unsigned u = __float_as_uint(f); return (bf16_t)((u + 0x7fffu + ((u >> 16) & 1u)) >> 16); }
__device__ __forceinline__ int mrow_of(int r) { return r < RL ? (r >> 12) : 4; }
__device__ __forceinline__ float wave_sum(float v) {
#pragma unroll
    for (int o = 1; o < 64; o <<= 1) v += __shfl_xor(v, o);
    return v;
}
__device__ __forceinline__ float silu_f(float x) { return x / (1.f + __expf(-x)); }
__device__ __forceinline__ float gelu_f(float x) { return 0.5f * x * (1.f + erff(x * 0.70710678118654752f)); }

constexpr size_t MiB = 1u << 20;
constexpr size_t WS_MOD = 1 * MiB;
constexpr size_t WS_BIAS1 = WS_MOD + 256 * 1024;
constexpr size_t WS_BIAS2 = WS_BIAS1 + 64 * 1024;
constexpr size_t WS_ROPE = WS_BIAS2 + 256 * 1024;
constexpr size_t WS_RSQ1 = 2 * MiB;
constexpr size_t WS_RSQ2 = 2 * MiB + 512 * 1024;
constexpr size_t WS_XC = 4 * MiB;
constexpr size_t WS_XG = 8 * MiB;
constexpr size_t WS_MIX = 42 * MiB;
constexpr size_t WS_W = 76 * MiB;
constexpr size_t WS_OV = 120 * MiB;
constexpr size_t WS_ACT = WS_OV;
constexpr size_t WS_U = WS_OV;
constexpr size_t WS_VT = WS_U + (size_t)R * 256 * 2;
constexpr size_t WS_BW = WS_VT + (size_t)R * 256 * 2;
constexpr size_t WS_QA = WS_BW + (size_t)R * 256 * 2;
constexpr size_t WS_KVA = WS_QA + (size_t)R * 256 * 2;
constexpr size_t WS_KR = WS_KVA + (size_t)R * 128 * 2;
constexpr size_t WS_Q = 161 * MiB;
constexpr size_t WS_K = WS_Q + (size_t)R * 768 * 2;
constexpr size_t WS_V = WS_K + (size_t)NB * NH * NKEY * QKH * 2;
constexpr size_t WS_P = 161 * MiB;
static_assert(WS_KR + (size_t)R * 32 * 4 <= WS_Q, "map");
static_assert(WS_V + (size_t)NB * NH * NKEY * VD * 2 <= 256 * MiB, "map");
static_assert(WS_P + (size_t)R * DIN * 4 <= 256 * MiB, "map");
static_assert(WS_ACT + (size_t)R * DFF * 2 <= 256 * MiB, "map");

__global__ void __launch_bounds__(256) n_mod(const float* __restrict__ c, const float* __restrict__ cctx, const float* __restrict__ w_ada, const float* __restrict__ b_ada, float* __restrict__ MOD) {
    __shared__ float s[5][DM];
    const int l = blockIdx.y, n = blockIdx.x * 256 + threadIdx.x;
    for (int i = threadIdx.x; i < 5 * DM; i += 256) { const int mr = i / DM, k = i % DM; const float v = mr < 4 ? c[mr * DM + k] : cctx[k]; s[mr][k] = silu_f(v); }
    __syncthreads();
    float acc[5] = {0.f, 0.f, 0.f, 0.f, 0.f};
    const float* w = w_ada + (size_t)l * DM * (NMOD * DM) + n;
    for (int k = 0; k < DM; ++k) { const float wv = w[(size_t)k * (NMOD * DM)];
#pragma unroll
        for (int m = 0; m < 5; ++m) acc[m] += s[m][k] * wv; }
    const float bb = b_ada[l * NMOD * DM + n];
#pragma unroll
    for (int m = 0; m < 5; ++m) MOD[((size_t)l * 5 + m) * (NMOD * DM) + n] = acc[m] + bb;
}
__global__ void __launch_bounds__(256) n_foldw(const float* __restrict__ w_in, const float* __restrict__ w_pool, float* __restrict__ WF) {
    const size_t idx = (size_t)blockIdx.x * 256 + threadIdx.x; if (idx >= (size_t)DEPTH * DM * DIN) return;
    const int n = idx % DIN; const size_t lk = idx / DIN; const int l = lk / DM;
    float v;
    if (n >= 512 && n < 768) { const int g = (n - 512) >> 6, d = (n - 512) & 63; const float* wr = w_in + lk * DIN + 512 + g * 64; const float* wp = w_pool + ((size_t)(l * 4 + g) * 64) * 64 + d;
        float a = 0.f; for (int cc = 0; cc < 64; ++cc) a += wr[cc] * wp[cc * 64]; v = a; }
    else v = w_in[idx];
    WF[idx] = v;
}
__global__ void __launch_bounds__(256) n_bias(const float* __restrict__ MOD, const float* __restrict__ W, float* __restrict__ BIAS, int shift_idx, int N, int ldo, int pad_) {
    const int l = blockIdx.y, n = blockIdx.x * 256 + threadIdx.x; if (n >= N) return;
    float acc[5] = {0.f, 0.f, 0.f, 0.f, 0.f};
    const float* w = W + (size_t)l * DM * N + n; const float* m = MOD + (size_t)l * 5 * (NMOD * DM) + shift_idx * DM;
    for (int k = 0; k < DM; ++k) { const float wv = w[(size_t)k * N];
#pragma unroll
        for (int r = 0; r < 5; ++r) acc[r] += m[(size_t)r * (NMOD * DM) + k] * wv; }
#pragma unroll
    for (int r = 0; r < 5; ++r) BIAS[((size_t)l * 5 + r) * ldo + n] = acc[r];
}
__device__ void sincos_d(double x, double& s, double& c) {
    const double k = rint(x * 0.63661977236758134308); const double r = fma(-k, 1.5707963267948966192, x) - k * 6.123233995736766e-17;
    const double r2 = r * r;
    double sp = -7.6471637318198164759e-13; sp = sp * r2 + 1.6059043836821614599e-10; sp = sp * r2 - 2.5052108385441718775e-08; sp = sp * r2 + 2.7557319223985890653e-06; sp = sp * r2 - 1.9841269841269841270e-04; sp = sp * r2 + 8.3333333333333333333e-03; sp = sp * r2 - 1.6666666666666666667e-01; sp = r + r * r2 * sp;
    double cp = 4.7794773323873852974e-14; cp = cp * r2 - 1.1470745597729724714e-11; cp = cp * r2 + 2.0876756987868098979e-09; cp = cp * r2 - 2.7557319223985890653e-07; cp = cp * r2 + 2.4801587301587301587e-05; cp = cp * r2 - 1.3888888888888888889e-03; cp = cp * r2 + 4.1666666666666666667e-02; cp = cp * r2 - 0.5; cp = 1.0 + r2 * cp;
    const int q = ((int)k) & 3;
    s = (q == 0) ? sp : (q == 1) ? cp : (q == 2) ? -sp : -cp;
    c = (q == 0) ? cp : (q == 1) ? -sp : (q == 2) ? -cp : sp;
}
__global__ void n_rope(float* __restrict__ ROPE) {
    const int t = threadIdx.x + blockIdx.x * blockDim.x; if (t >= 512) return;
    const int pos = t >> 3, i = t & 7;
    const float inv = (float)exp2(-(double)i / 8.0 * 13.287712379549449);
    const float ang = (float)pos * inv;
    double s, c; sincos_d((double)ang, s, c);
    ROPE[t * 2] = (float)c; ROPE[t * 2 + 1] = (float)s;
}
__global__ void __launch_bounds__(256) n_copy_in(const float* __restrict__ x, const float* __restrict__ ctx, float* __restrict__ XL, float* __restrict__ XC) {
    const size_t i = ((size_t)blockIdx.x * 256 + threadIdx.x) * 4;
    if (i < (size_t)RL * DM) *(float4*)(XL + i) = *(const float4*)(x + i);
    else if (i < (size_t)R * DM) *(float4*)(XC + (i - (size_t)RL * DM)) = *(const float4*)(ctx + (i - (size_t)RL * DM));
}
__global__ void __launch_bounds__(256) n_rowprep(const float* __restrict__ XL, const float* __restrict__ XC, const float* __restrict__ g, const float* __restrict__ sc  ,
                                                 float* __restrict__ RSQ, bf16_t* __restrict__ XG, int nrows, int pad_) {
    const int r = blockIdx.x * 4 + (threadIdx.x >> 6), lane = threadIdx.x & 63; if (r >= nrows) return;
    const float* xr = r < RL ? XL + (size_t)r * DM : XC + (size_t)(r - RL) * DM; const float* scr = sc + (size_t)mrow_of(r) * (NMOD * DM);
    float ssv[4];
#pragma unroll
    for (int j = 0; j < 4; ++j) { const int k = j * 256 + lane * 4; const float4 v = *(const float4*)(xr + k); const float4 gg = *(const float4*)(g + k); const float4 s4 = *(const float4*)(scr + k);
        ssv[j] = wave_sum(v.x * v.x + v.y * v.y + v.z * v.z + v.w * v.w);
        ushort4 o; o.x = f2bf(v.x * gg.x * (1.f + s4.x)); o.y = f2bf(v.y * gg.y * (1.f + s4.y)); o.z = f2bf(v.z * gg.z * (1.f + s4.z)); o.w = f2bf(v.w * gg.w * (1.f + s4.w));
        *(ushort4*)(XG + (size_t)r * DM + k) = o; }
    if (lane == 0) *(float4*)(RSQ + (size_t)r * 4) = make_float4(ssv[0], ssv[1], ssv[2], ssv[3]);
}
__device__ __forceinline__ float rstd_of(const float* RSQ, int r) { const float4 p = *(const float4*)(RSQ + (size_t)r * 4); return rsqrtf(((p.x + p.y) + (p.z + p.w)) * (1.f / DM) + EPS); }

struct EpiStoreF32 { float* C; int ldc; int pad;
    __device__ void operator()(int row, int col, float a, float) const { C[(size_t)row * ldc + col] = a; } };
struct EpiResid { float* XL; float* XC; const float* gate;
    __device__ void operator()(int row, int col, float a, float) const { float* p = row < RL ? XL + (size_t)row * DM + col : XC + (size_t)(row - RL) * DM + col; *p += gate[(size_t)mrow_of(row) * (NMOD * DM) + col] * a; } };
struct EpiAct { bf16_t* ACT; const float* RSQ; const float* BIAS;
    __device__ void operator()(int row, int col, float a, float b) const { const float rs = rstd_of(RSQ, row); const float* bb = BIAS + (size_t)mrow_of(row) * (2 * DFF);
        const float gq = rs * a + bb[col], up = rs * b + bb[col + DFF]; ACT[(size_t)row * DFF + col] = f2bf(silu_f(gq) * up); } };
template <bool DUAL, class Epi>
__global__ void __launch_bounds__(256) n_gemm(const bf16_t* __restrict__ A, const float* __restrict__ B, int lda, int ldb, int N, int K, int dual_off, int pad_, Epi epi) {
    __shared__ float As[16][68]; __shared__ float Bs[16][64]; __shared__ float Bs2[DUAL ? 16 : 1][64];
    const int tid = threadIdx.x, tx = tid & 15, ty = tid >> 4; const int m0 = blockIdx.y * 64, n0 = blockIdx.x * 64;
    float acc[4][4], acc2[4][4];
#pragma unroll
    for (int i = 0; i < 4; ++i)
#pragma unroll
        for (int j = 0; j < 4; ++j) { acc[i][j] = 0.f; acc2[i][j] = 0.f; }
    for (int k0 = 0; k0 < K; k0 += 16) {
        { const int m = tid >> 2, kk = (tid & 3) * 4; const ushort4 a = *(const ushort4*)(A + (size_t)(m0 + m) * lda + k0 + kk);
          As[kk][m] = bf2f(a.x); As[kk + 1][m] = bf2f(a.y); As[kk + 2][m] = bf2f(a.z); As[kk + 3][m] = bf2f(a.w); }
        { const int kk = tid >> 4, n = (tid & 15) * 4;
#pragma unroll
          for (int j = 0; j < 4; ++j) { const int col = n0 + n + j; Bs[kk][n + j] = col < N ? B[(size_t)(k0 + kk) * ldb + col] : 0.f; if (DUAL) Bs2[kk][n + j] = col < N ? B[(size_t)(k0 + kk) * ldb + col + dual_off] : 0.f; } }
        __syncthreads();
#pragma unroll
        for (int kk = 0; kk < 16; ++kk) { float a[4], b[4], b2[4];
#pragma unroll
            for (int i = 0; i < 4; ++i) a[i] = As[kk][ty * 4 + i];
#pragma unroll
            for (int j = 0; j < 4; ++j) { b[j] = Bs[kk][tx * 4 + j]; if (DUAL) b2[j] = Bs2[kk][tx * 4 + j]; }
#pragma unroll
            for (int i = 0; i < 4; ++i)
#pragma unroll
                for (int j = 0; j < 4; ++j) { acc[i][j] += a[i] * b[j]; if (DUAL) acc2[i][j] += a[i] * b2[j]; } }
        __syncthreads();
    }
#pragma unroll
    for (int i = 0; i < 4; ++i)
#pragma unroll
        for (int j = 0; j < 4; ++j) { const int row = m0 + ty * 4 + i, col = n0 + tx * 4 + j; if (col < N) epi(row, col, acc[i][j], acc2[i][j]); }
}

__global__ void __launch_bounds__(256) n_g1_epi(const float* __restrict__ P, const float* __restrict__ RSQ1, const float* __restrict__ BIAS  ,
                                                const float* __restrict__ sgu_g, const float* __restrict__ qa_g, const float* __restrict__ kva_g,
                                                bf16_t* __restrict__ U, bf16_t* __restrict__ VT, bf16_t* __restrict__ BW, bf16_t* __restrict__ QA, bf16_t* __restrict__ KVA, float* __restrict__ KR) {
    const int r = blockIdx.x * 4 + (threadIdx.x >> 6), lane = threadIdx.x & 63; if (r >= R) return;
    const float rs = rstd_of(RSQ1, r); const float* p = P + (size_t)r * DIN; const float* bb = BIAS + (size_t)mrow_of(r) * 1280;
    const int c = lane * 4;
    float v[4];
#pragma unroll
    for (int j = 0; j < 4; ++j) v[j] = gelu_f(rs * p[c + j] + bb[c + j]);
    { ushort4 o; o.x = f2bf(v[0]); o.y = f2bf(v[1]); o.z = f2bf(v[2]); o.w = f2bf(v[3]); *(ushort4*)(U + (size_t)r * 256 + c) = o; }
    float ss = 0.f;
#pragma unroll
    for (int j = 0; j < 4; ++j) { v[j] = gelu_f(rs * p[256 + c + j] + bb[256 + c + j]); ss += v[j] * v[j]; }
    ss = wave_sum(ss); float rn = rsqrtf(ss * (1.f / 256.f) + EPS);
    { const int chunk = r >> 7, jj = r & 127;
#pragma unroll
      for (int j = 0; j < 4; ++j) VT[((size_t)chunk * 256 + c + j) * 128 + jj] = f2bf(v[j] * rn * sgu_g[c + j]); }
#pragma unroll
    for (int j = 0; j < 4; ++j) v[j] = rs * p[512 + c + j] + bb[512 + c + j];
    { ushort4 o; o.x = f2bf(v[0]); o.y = f2bf(v[1]); o.z = f2bf(v[2]); o.w = f2bf(v[3]); *(ushort4*)(BW + (size_t)r * 256 + c) = o; }
    ss = 0.f;
#pragma unroll
    for (int j = 0; j < 4; ++j) { v[j] = rs * p[768 + c + j] + bb[768 + c + j]; ss += v[j] * v[j]; }
    ss = wave_sum(ss); rn = rsqrtf(ss * (1.f / 256.f) + EPS);
    { ushort4 o; o.x = f2bf(v[0] * rn * qa_g[c]); o.y = f2bf(v[1] * rn * qa_g[c + 1]); o.z = f2bf(v[2] * rn * qa_g[c + 2]); o.w = f2bf(v[3] * rn * qa_g[c + 3]); *(ushort4*)(QA + (size_t)r * 256 + c) = o; }
    { const int c2 = lane * 2; float a0 = rs * p[1024 + c2] + bb[1024 + c2], a1 = rs * p[1024 + c2 + 1] + bb[1024 + c2 + 1];
      ss = wave_sum(a0 * a0 + a1 * a1); rn = rsqrtf(ss * (1.f / 128.f) + EPS);
      ushort2 o; o.x = f2bf(a0 * rn * kva_g[c2]); o.y = f2bf(a1 * rn * kva_g[c2 + 1]); *(ushort2*)(KVA + (size_t)r * 128 + c2) = o; }
    if (lane < 32) KR[(size_t)r * 32 + lane] = rs * p[1152 + lane] + bb[1152 + lane];
}

__global__ void __launch_bounds__(256) n_spatial(const bf16_t* __restrict__ U, const bf16_t* __restrict__ VT, const float* __restrict__ wsp  , const float* __restrict__ bsp  , bf16_t* __restrict__ MIX) {
    const int r = blockIdx.x, c = threadIdx.x, h = c >> 6, i = r & 127, chunk = r >> 7;
    const float* w = wsp + ((size_t)h * 128 + i) * 128; const bf16_t* vt = VT + ((size_t)chunk * 256 + c) * 128;
    float a = 0.f;
    for (int j = 0; j < 128; ++j) a += w[j] * bf2f(vt[j]);
    a += bsp[h * 128 + i];
    MIX[(size_t)r * DM + c] = f2bf(bf2f(U[(size_t)r * 256 + c]) * a);
}
__global__ void __launch_bounds__(256) n_pool(const bf16_t* __restrict__ BW, const float* __restrict__ pscale, bf16_t* __restrict__ MIX) {
    const int r = blockIdx.x, n = threadIdx.x, g = n >> 6, hw = 1 << g;
    int t, ntok, base; if (r < RL) { t = r & 4095; ntok = SEQ; base = r - t; } else { t = (r - RL) & 255; ntok = CTXL; base = r - t; }
    const int lo = max(t - hw, 0), hi = min(t + hw, ntok);
    float s = 0.f; for (int q = lo; q < hi; ++q) s += bf2f(BW[(size_t)(base + q) * 256 + n]);
    const float mean = s / (float)(hi - lo);
    MIX[(size_t)r * DM + 256 + n] = f2bf(pscale[n] * (mean - bf2f(BW[(size_t)r * 256 + n])));
}
__global__ void __launch_bounds__(256) n_q(const bf16_t* __restrict__ QA, const float* __restrict__ wqb  , const float* __restrict__ qn_g, const float* __restrict__ ROPE, bf16_t* __restrict__ Q, int row0, int pad_) {
    __shared__ float a[8][256]; __shared__ float q[8][768];
    const int tid = threadIdx.x, r0 = row0 + blockIdx.x * 8;
    for (int i = tid; i < 8 * 256; i += 256) a[i >> 8][i & 255] = bf2f(QA[(size_t)(r0 + (i >> 8)) * 256 + (i & 255)]);
    __syncthreads();
    float acc[3][8];
#pragma unroll
    for (int i = 0; i < 3; ++i)
#pragma unroll
        for (int m = 0; m < 8; ++m) acc[i][m] = 0.f;
    for (int k = 0; k < 256; ++k) { float w[3];
#pragma unroll
        for (int i = 0; i < 3; ++i) w[i] = wqb[(size_t)k * 768 + tid + 256 * i];
#pragma unroll
        for (int m = 0; m < 8; ++m) { const float av = a[m][k];
#pragma unroll
            for (int i = 0; i < 3; ++i) acc[i][m] += av * w[i]; } }
#pragma unroll
    for (int i = 0; i < 3; ++i)
#pragma unroll
        for (int m = 0; m < 8; ++m) q[m][tid + 256 * i] = acc[i][m];
    __syncthreads();
    if (tid < 64) { const int m = tid >> 3, h = tid & 7, r = r0 + m; float* qq = &q[m][h * 96];
        float ss = 0.f; for (int i = 0; i < 96; ++i) ss += qq[i] * qq[i];
        const float rn = rsqrtf(ss * (1.f / 96.f) + EPS);
        bf16_t* o = Q + ((size_t)r * NH + h) * QKH;
        for (int i = 0; i < 64; ++i) o[i] = f2bf(qq[i] * rn * qn_g[i] * QSCALE);
        const bool lat = r < RL; const int t = r & 4095;
        for (int pp = 0; pp < 16; ++pp) { float x1 = qq[64 + 2 * pp] * rn * qn_g[64 + 2 * pp], x2 = qq[65 + 2 * pp] * rn * qn_g[65 + 2 * pp];
            if (lat) { const int pos = pp < 8 ? (t >> 6) : (t & 63); const float cs = ROPE[(pos * 8 + (pp & 7)) * 2], sn = ROPE[(pos * 8 + (pp & 7)) * 2 + 1];
                const float y1 = x1 * cs - x2 * sn, y2 = x1 * sn + x2 * cs; x1 = y1; x2 = y2; }
            o[64 + 2 * pp] = f2bf(x1 * QSCALE); o[65 + 2 * pp] = f2bf(x2 * QSCALE); } }
}
__global__ void __launch_bounds__(256) n_kv(const bf16_t* __restrict__ KVA, const float* __restrict__ KR, const float* __restrict__ wkvb  , const float* __restrict__ kn_g, const float* __restrict__ ROPE,
                                            bf16_t* __restrict__ Kb, bf16_t* __restrict__ Vb) {
    __shared__ float a[8][128]; __shared__ float kv[8][1024];
    const int tid = threadIdx.x, r0 = blockIdx.x * 8;
    for (int i = tid; i < 8 * 128; i += 256) a[i >> 7][i & 127] = bf2f(KVA[(size_t)(r0 + (i >> 7)) * 128 + (i & 127)]);
    __syncthreads();
    float acc[4][8];
#pragma unroll
    for (int i = 0; i < 4; ++i)
#pragma unroll
        for (int m = 0; m < 8; ++m) acc[i][m] = 0.f;
    for (int k = 0; k < 128; ++k) { float w[4];
#pragma unroll
        for (int i = 0; i < 4; ++i) w[i] = wkvb[(size_t)k * 1024 + tid + 256 * i];
#pragma unroll
        for (int m = 0; m < 8; ++m) { const float av = a[m][k];
#pragma unroll
            for (int i = 0; i < 4; ++i) acc[i][m] += av * w[i]; } }
#pragma unroll
    for (int i = 0; i < 4; ++i)
#pragma unroll
        for (int m = 0; m < 8; ++m) kv[m][tid + 256 * i] = acc[i][m];
    __syncthreads();
    if (tid < 64) { const int m = tid >> 3, h = tid & 7, r = r0 + m; const float* kk = &kv[m][h * 128]; const float* kr = KR + (size_t)r * 32;
        const bool lat = r < RL; const int b = lat ? (r >> 12) : ((r - RL) >> 8), t = lat ? (r & 4095) : ((r - RL) & 255), key = lat ? CTXL + t : t;
        float ss = 0.f; for (int i = 0; i < 64; ++i) ss += kk[i] * kk[i]; for (int i = 0; i < 32; ++i) ss += kr[i] * kr[i];
        const float rn = rsqrtf(ss * (1.f / 96.f) + EPS);
        bf16_t* ko = Kb + (((size_t)b * NH + h) * NKEY + key) * QKH; bf16_t* vo = Vb + (((size_t)b * NH + h) * NKEY + key) * VD;
        for (int i = 0; i < 64; ++i) ko[i] = f2bf(kk[i] * rn * kn_g[i]);
        for (int pp = 0; pp < 16; ++pp) { float x1 = kr[2 * pp] * rn * kn_g[64 + 2 * pp], x2 = kr[2 * pp + 1] * rn * kn_g[65 + 2 * pp];
            if (lat) { const int pos = pp < 8 ? (t >> 6) : (t & 63); const float cs = ROPE[(pos * 8 + (pp & 7)) * 2], sn = ROPE[(pos * 8 + (pp & 7)) * 2 + 1];
                const float y1 = x1 * cs - x2 * sn, y2 = x1 * sn + x2 * cs; x1 = y1; x2 = y2; }
            ko[64 + 2 * pp] = f2bf(x1); ko[65 + 2 * pp] = f2bf(x2); }
        for (int i = 0; i < 64; ++i) vo[i] = f2bf(kk[64 + i]); }
}
__global__ void __launch_bounds__(256) n_attn(const bf16_t* __restrict__ Q, const bf16_t* __restrict__ Kb, const bf16_t* __restrict__ Vb, bf16_t* __restrict__ MIX, int ctx_mode, int pad_) {
    __shared__ float Ks[32][96]; __shared__ float Vs[32][64];
    const int tid = threadIdx.x; int b, h, r, nkeys;
    if (!ctx_mode) { const int u = blockIdx.x; const int qb = u & 15; h = (u >> 4) & 7; b = u >> 7; r = b * SEQ + qb * 256 + tid; nkeys = NKEY; }
    else { const int u = blockIdx.x; h = u & 7; b = u >> 3; r = RL + b * CTXL + tid; nkeys = CTXL; }
    float q[96], o[64];
    { const bf16_t* qp = Q + ((size_t)r * NH + h) * QKH;
#pragma unroll
      for (int i = 0; i < 96; ++i) q[i] = bf2f(qp[i]); }
#pragma unroll
    for (int i = 0; i < 64; ++i) o[i] = 0.f;
    float m = -1e30f, l = 0.f;
    const bf16_t* kbase = Kb + ((size_t)b * NH + h) * NKEY * QKH; const bf16_t* vbase = Vb + ((size_t)b * NH + h) * NKEY * VD;
    for (int k0 = 0; k0 < nkeys; k0 += 32) {
        __syncthreads();
        for (int i = tid; i < 32 * 96; i += 256) Ks[i / 96][i % 96] = bf2f(kbase[(size_t)k0 * QKH + i]);
        for (int i = tid; i < 32 * 64; i += 256) Vs[i >> 6][i & 63] = bf2f(vbase[(size_t)k0 * VD + i]);
        __syncthreads();
        float s[32]; float mx = m;
#pragma unroll
        for (int j = 0; j < 32; ++j) { float a = 0.f;
#pragma unroll
            for (int i = 0; i < 96; ++i) a += q[i] * Ks[j][i];
            s[j] = a; mx = fmaxf(mx, a); }
        const float alpha = exp2f(m - mx); m = mx; l *= alpha;
#pragma unroll
        for (int i = 0; i < 64; ++i) o[i] *= alpha;
#pragma unroll
        for (int j = 0; j < 32; ++j) { const float p = exp2f(s[j] - m); l += p;
#pragma unroll
            for (int i = 0; i < 64; ++i) o[i] += p * Vs[j][i]; }
    }
    const float il = 1.f / l; bf16_t* op = MIX + (size_t)r * DM + 512 + h * 64;
#pragma unroll
    for (int i = 0; i < 64; ++i) op[i] = f2bf(o[i] * il);
}

extern "C" void kernel_launch(void* const* d_in, const int* in_sizes, int n_in, void* d_out, int out_size, void* d_ws, size_t ws_size, hipStream_t stream) {
    const float* x = (const float*)d_in[0]; const float* c = (const float*)d_in[1]; const float* ctx = (const float*)d_in[2]; const float* cctx = (const float*)d_in[3];
    const float* norm1_g = (const float*)d_in[4]; const float* norm2_g = (const float*)d_in[5]; const float* w_ada = (const float*)d_in[6]; const float* b_ada = (const float*)d_in[7];
    const float* w_in = (const float*)d_in[8]; const float* sgu_g = (const float*)d_in[9]; const float* w_sp = (const float*)d_in[10]; const float* b_sp = (const float*)d_in[11];
    const float* w_pool = (const float*)d_in[12]; const float* pscale = (const float*)d_in[13]; const float* qa_g = (const float*)d_in[14]; const float* w_qb = (const float*)d_in[15];
    const float* kva_g = (const float*)d_in[16]; const float* w_kvb = (const float*)d_in[17]; const float* qn_g = (const float*)d_in[18]; const float* kn_g = (const float*)d_in[19];
    const float* w_out = (const float*)d_in[20]; const float* w_gu = (const float*)d_in[21]; const float* w_dn = (const float*)d_in[22];
    if (ws_size < 256 * MiB) { fprintf(stderr, "ws too small: %zu\n", ws_size); return; }
    unsigned char* ws = (unsigned char*)d_ws;
    float* MOD = (float*)(ws + WS_MOD); float* BIAS1 = (float*)(ws + WS_BIAS1); float* BIAS2 = (float*)(ws + WS_BIAS2); float* ROPE = (float*)(ws + WS_ROPE);
    float* RSQ1 = (float*)(ws + WS_RSQ1); float* RSQ2 = (float*)(ws + WS_RSQ2); float* XL = (float*)d_out; float* XC = (float*)(ws + WS_XC);
    bf16_t* XG = (bf16_t*)(ws + WS_XG); bf16_t* MIX = (bf16_t*)(ws + WS_MIX); float* WF = (float*)(ws + WS_W);
    bf16_t* ACT = (bf16_t*)(ws + WS_ACT); bf16_t* U = (bf16_t*)(ws + WS_U); bf16_t* VT = (bf16_t*)(ws + WS_VT); bf16_t* BW = (bf16_t*)(ws + WS_BW); bf16_t* QA = (bf16_t*)(ws + WS_QA);
    bf16_t* KVA = (bf16_t*)(ws + WS_KVA); float* KR = (float*)(ws + WS_KR); bf16_t* Q = (bf16_t*)(ws + WS_Q); bf16_t* Kb = (bf16_t*)(ws + WS_K); bf16_t* Vb = (bf16_t*)(ws + WS_V); float* P = (float*)(ws + WS_P);

    n_mod<<<dim3(NMOD * DM / 256, DEPTH), 256, 0, stream>>>(c, cctx, w_ada, b_ada, MOD);
    n_foldw<<<(unsigned)(((size_t)DEPTH * DM * DIN + 255) / 256), 256, 0, stream>>>(w_in, w_pool, WF);
    n_rope<<<2, 256, 0, stream>>>(ROPE);
    n_copy_in<<<(unsigned)((size_t)R * DM / 4 / 256), 256, 0, stream>>>(x, ctx, XL, XC);
    n_bias<<<dim3((DIN + 255) / 256, DEPTH), 256, 0, stream>>>(MOD, WF, BIAS1, 0, DIN, 1280, 0);
    n_bias<<<dim3(2 * DFF / 256, DEPTH), 256, 0, stream>>>(MOD, w_gu, BIAS2, 3, 2 * DFF, 2 * DFF, 0);
    n_rowprep<<<R / 4, 256, 0, stream>>>(XL, XC, norm1_g, MOD + 1 * DM, RSQ1, XG, R, 0);
    for (int l = 0; l < DEPTH; ++l) {
        const float* modl = MOD + (size_t)l * 5 * NMOD * DM;
        const int Mrows = (l == 0) ? R : RL;
        n_gemm<false, EpiStoreF32><<<dim3((DIN + 63) / 64, R / 64), 256, 0, stream>>>(XG, WF + (size_t)l * DM * DIN, DM, DIN, DIN, DM, 0, 0, EpiStoreF32{P, DIN, 0});
        n_g1_epi<<<R / 4, 256, 0, stream>>>(P, RSQ1, BIAS1 + (size_t)l * 5 * 1280, sgu_g + l * 256, qa_g + l * 256, kva_g + l * 128, U, VT, BW, QA, KVA, KR);
        n_spatial<<<Mrows, 256, 0, stream>>>(U, VT, w_sp + (size_t)l * 4 * 128 * 128, b_sp + l * 4 * 128, MIX);
        n_pool<<<Mrows, 256, 0, stream>>>(BW, pscale + l * 256, MIX);
        n_q<<<Mrows / 8, 256, 0, stream>>>(QA, w_qb + (size_t)l * 256 * 768, qn_g + l * 96, ROPE, Q, 0, 0);
        n_kv<<<R / 8, 256, 0, stream>>>(KVA, KR, w_kvb + (size_t)l * 128 * 1024, kn_g + l * 96, ROPE, Kb, Vb);
        n_attn<<<NB * NH * 16, 256, 0, stream>>>(Q, Kb, Vb, MIX, 0, 0);
        if (l == 0) n_attn<<<NB * NH, 256, 0, stream>>>(Q, Kb, Vb, MIX, 1, 0);
        n_gemm<false, EpiResid><<<dim3(DM / 64, Mrows / 64), 256, 0, stream>>>(MIX, w_out + (size_t)l * DM * DM, DM, DM, DM, DM, 0, 0, EpiResid{XL, XC, modl + 2 * DM});
        n_rowprep<<<Mrows / 4, 256, 0, stream>>>(XL, XC, norm2_g + l * DM, modl + 4 * DM, RSQ2, XG, Mrows, 0);
        n_gemm<true, EpiAct><<<dim3(DFF / 64, Mrows / 64), 256, 0, stream>>>(XG, w_gu + (size_t)l * DM * 2 * DFF, DM, 2 * DFF, DFF, DM, DFF, 0, EpiAct{ACT, RSQ2, BIAS2 + (size_t)l * 5 * 2 * DFF});
        n_gemm<false, EpiResid><<<dim3(DM / 64, Mrows / 64), 256, 0, stream>>>(ACT, w_dn + (size_t)l * DFF * DM, DFF, DM, DM, DFF, 0, 0, EpiResid{XL, XC, modl + 5 * DM});
        if (l + 1 < DEPTH) n_rowprep<<<R / 4, 256, 0, stream>>>(XL, XC, norm1_g + (l + 1) * DM, MOD + (size_t)(l + 1) * 5 * NMOD * DM + 1 * DM, RSQ1, XG, R, 0);
    }
}
```

```cpp
#include <hip/hip_runtime.h>
#include <cstdint>
#include <cstdio>
#define FAST_G5 1
#define FAST_G3 1
#define FAST_G1 1
#define FAST_G4 1
#define FAST_G6 1

constexpr int DM = 1024, NB = 4, SEQ = 4096, CTXL = 256, DEPTH = 2;
constexpr int RL = NB * SEQ;
constexpr int RC = NB * CTXL;
constexpr int R = RL + RC;
constexpr int WA = 256, DIN = 1184, DFF = 2816, NMOD = 6;
constexpr int NH = 8, QKH = 96, QKN = 64, QKR = 32, VD = 64, QRANK = 256, KVRANK = 128;
constexpr int NKEY = CTXL + SEQ;
constexpr float EPS = 1e-6f;
constexpr float QSCALE = 0.10206207261596577f * 1.4426950408889634f;

typedef unsigned short bf16_t;
__device__ __forceinline__ float bf2f(bf16_t v) { return __uint_as_float(((unsigned)v) << 16); }
__device__ __forceinline__ bf16_t f2bf(float f) { unsigned u = __float_as_uint(f); return (bf16_t)((u + 0x7fffu + ((u >> 16) & 1u)) >> 16); }
__device__ __forceinline__ int mrow_of(int r) { return r < RL ? (r >> 12) : 4; }
__device__ __forceinline__ float wave_sum(float v) {
#pragma unroll
    for (int o = 1; o < 64; o <<= 1) v += __shfl_xor(v, o);
    return v;
}
__device__ __forceinline__ float silu_f(float x) { return x / (1.f + __expf(-x)); }
__device__ __forceinline__ float gelu_f(float x) { return 0.5f * x * (1.f + erff(x * 0.70710678118654752f)); }

constexpr size_t MiB = 1u << 20;
constexpr size_t WS_MOD = 1 * MiB;
constexpr size_t WS_BIAS1 = WS_MOD + 256 * 1024;
constexpr size_t WS_BIAS2 = WS_BIAS1 + 64 * 1024;
constexpr size_t WS_ROPE = WS_BIAS2 + 256 * 1024;
constexpr size_t WS_RSQ1 = 2 * MiB;
constexpr size_t WS_RSQ2 = 2 * MiB + 512 * 1024;
constexpr size_t WS_XC = 4 * MiB;
constexpr size_t WS_XG = 8 * MiB;
constexpr size_t WS_MIX = 42 * MiB;
constexpr size_t WS_W = 76 * MiB;
constexpr size_t WS_OV = 120 * MiB;
constexpr size_t WS_ACT = WS_OV;
constexpr size_t WS_U = WS_OV;
constexpr size_t WS_VT = WS_U + (size_t)R * 256 * 2;
constexpr size_t WS_BW = WS_VT + (size_t)R * 256 * 2;
constexpr size_t WS_QA = WS_BW + (size_t)R * 256 * 2;
constexpr size_t WS_KVA = WS_QA + (size_t)R * 256 * 2;
constexpr size_t WS_KR = WS_KVA + (size_t)R * 128 * 2;
constexpr size_t WS_Q = 161 * MiB;
constexpr size_t WS_K = WS_Q + (size_t)R * 768 * 2;
constexpr size_t WS_V = WS_K + (size_t)NB * NH * NKEY * QKH * 2;
constexpr size_t WS_P = 161 * MiB;
static_assert(WS_KR + (size_t)R * 32 * 4 <= WS_Q, "map");
static_assert(WS_V + (size_t)NB * NH * NKEY * VD * 2 <= 256 * MiB, "map");
static_assert(WS_P + (size_t)R * DIN * 4 <= 256 * MiB, "map");
static_assert(WS_ACT + (size_t)R * DFF * 2 <= 256 * MiB, "map");

__global__ void __launch_bounds__(256) n_mod(const float* __restrict__ c, const float* __restrict__ cctx, const float* __restrict__ w_ada, const float* __restrict__ b_ada, float* __restrict__ MOD) {
    __shared__ float s[5][DM];
    const int l = blockIdx.y, n = blockIdx.x * 256 + threadIdx.x;
    for (int i = threadIdx.x; i < 5 * DM; i += 256) { const int mr = i / DM, k = i % DM; const float v = mr < 4 ? c[mr * DM + k] : cctx[k]; s[mr][k] = silu_f(v); }
    __syncthreads();
    float acc[5] = {0.f, 0.f, 0.f, 0.f, 0.f};
    const float* w = w_ada + (size_t)l * DM * (NMOD * DM) + n;
    for (int k = 0; k < DM; ++k) { const float wv = w[(size_t)k * (NMOD * DM)];
#pragma unroll
        for (int m = 0; m < 5; ++m) acc[m] += s[m][k] * wv; }
    const float bb = b_ada[l * NMOD * DM + n];
#pragma unroll
    for (int m = 0; m < 5; ++m) MOD[((size_t)l * 5 + m) * (NMOD * DM) + n] = acc[m] + bb;
}
__global__ void __launch_bounds__(256) n_foldw(const float* __restrict__ w_in, const float* __restrict__ w_pool, float* __restrict__ WF) {
    const size_t idx = (size_t)blockIdx.x * 256 + threadIdx.x; if (idx >= (size_t)DEPTH * DM * DIN) return;
    const int n = idx % DIN; const size_t lk = idx / DIN; const int l = lk / DM;
    float v;
    if (n >= 512 && n < 768) { const int g = (n - 512) >> 6, d = (n - 512) & 63; const float* wr = w_in + lk * DIN + 512 + g * 64; const float* wp = w_pool + ((size_t)(l * 4 + g) * 64) * 64 + d;
        float a = 0.f; for (int cc = 0; cc < 64; ++cc) a += wr[cc] * wp[cc * 64]; v = a; }
    else v = w_in[idx];
    WF[idx] = v;
}
__global__ void __launch_bounds__(256) n_bias(const float* __restrict__ MOD, const float* __restrict__ W, float* __restrict__ BIAS, int shift_idx, int N, int ldo, int pad_) {
    const int l = blockIdx.y, n = blockIdx.x * 256 + threadIdx.x; if (n >= N) return;
    float acc[5] = {0.f, 0.f, 0.f, 0.f, 0.f};
    const float* w = W + (size_t)l * DM * N + n; const float* m = MOD + (size_t)l * 5 * (NMOD * DM) + shift_idx * DM;
    for (int k = 0; k < DM; ++k) { const float wv = w[(size_t)k * N];
#pragma unroll
        for (int r = 0; r < 5; ++r) acc[r] += m[(size_t)r * (NMOD * DM) + k] * wv; }
#pragma unroll
    for (int r = 0; r < 5; ++r) BIAS[((size_t)l * 5 + r) * ldo + n] = acc[r];
}
__device__ void sincos_d(double x, double& s, double& c) {
    const double k = rint(x * 0.63661977236758134308); const double r = fma(-k, 1.5707963267948966192, x) - k * 6.123233995736766e-17;
    const double r2 = r * r;
    double sp = -7.6471637318198164759e-13; sp = sp * r2 + 1.6059043836821614599e-10; sp = sp * r2 - 2.5052108385441718775e-08; sp = sp * r2 + 2.7557319223985890653e-06; sp = sp * r2 - 1.9841269841269841270e-04; sp = sp * r2 + 8.3333333333333333333e-03; sp = sp * r2 - 1.6666666666666666667e-01; sp = r + r * r2 * sp;
    double cp = 4.7794773323873852974e-14; cp = cp * r2 - 1.1470745597729724714e-11; cp = cp * r2 + 2.0876756987868098979e-09; cp = cp * r2 - 2.7557319223985890653e-07; cp = cp * r2 + 2.4801587301587301587e-05; cp = cp * r2 - 1.3888888888888888889e-03; cp = cp * r2 + 4.1666666666666666667e-02; cp = cp * r2 - 0.5; cp = 1.0 + r2 * cp;
    const int q = ((int)k) & 3;
    s = (q == 0) ? sp : (q == 1) ? cp : (q == 2) ? -sp : -cp;
    c = (q == 0) ? cp : (q == 1) ? -sp : (q == 2) ? -cp : sp;
}
__global__ void n_rope(float* __restrict__ ROPE) {
    const int t = threadIdx.x + blockIdx.x * blockDim.x; if (t >= 512) return;
    const int pos = t >> 3, i = t & 7;
    const float inv = (float)exp2(-(double)i / 8.0 * 13.287712379549449);
    const float ang = (float)pos * inv;
    double s, c; sincos_d((double)ang, s, c);
    ROPE[t * 2] = (float)c; ROPE[t * 2 + 1] = (float)s;
}
__global__ void __launch_bounds__(256) n_copy_in(const float* __restrict__ x, const float* __restrict__ ctx, float* __restrict__ XL, float* __restrict__ XC) {
    const size_t i = ((size_t)blockIdx.x * 256 + threadIdx.x) * 4;
    if (i < (size_t)RL * DM) *(float4*)(XL + i) = *(const float4*)(x + i);
    else if (i < (size_t)R * DM) *(float4*)(XC + (i - (size_t)RL * DM)) = *(const float4*)(ctx + (i - (size_t)RL * DM));
}
__global__ void __launch_bounds__(256) n_rowprep(const float* __restrict__ XL, const float* __restrict__ XC, const float* __restrict__ g, const float* __restrict__ sc  ,
                                                 float* __restrict__ RSQ, bf16_t* __restrict__ XG, int nrows, int pad_) {
    const int r = blockIdx.x * 4 + (threadIdx.x >> 6), lane = threadIdx.x & 63; if (r >= nrows) return;
    const float* xr = r < RL ? XL + (size_t)r * DM : XC + (size_t)(r - RL) * DM; const float* scr = sc + (size_t)mrow_of(r) * (NMOD * DM);
    float ssv[4];
#pragma unroll
    for (int j = 0; j < 4; ++j) { const int k = j * 256 + lane * 4; const float4 v = *(const float4*)(xr + k); const float4 gg = *(const float4*)(g + k); const float4 s4 = *(const float4*)(scr + k);
        ssv[j] = wave_sum(v.x * v.x + v.y * v.y + v.z * v.z + v.w * v.w);
        ushort4 o; o.x = f2bf(v.x * gg.x * (1.f + s4.x)); o.y = f2bf(v.y * gg.y * (1.f + s4.y)); o.z = f2bf(v.z * gg.z * (1.f + s4.z)); o.w = f2bf(v.w * gg.w * (1.f + s4.w));
        *(ushort4*)(XG + (size_t)r * DM + k) = o; }
    if (lane == 0) *(float4*)(RSQ + (size_t)r * 4) = make_float4(ssv[0], ssv[1], ssv[2], ssv[3]);
}
__device__ __forceinline__ float rstd_of(const float* RSQ, int r) { const float4 p = *(const float4*)(RSQ + (size_t)r * 4); return rsqrtf(((p.x + p.y) + (p.z + p.w)) * (1.f / DM) + EPS); }

struct EpiStoreF32 { float* C; int ldc; int pad;
    __device__ void operator()(int row, int col, float a, float) const { C[(size_t)row * ldc + col] = a; } };
struct EpiResid { float* XL; float* XC; const float* gate;
    __device__ void operator()(int row, int col, float a, float) const { float* p = row < RL ? XL + (size_t)row * DM + col : XC + (size_t)(row - RL) * DM + col; *p += gate[(size_t)mrow_of(row) * (NMOD * DM) + col] * a; } };
struct EpiAct { bf16_t* ACT; const float* RSQ; const float* BIAS;
    __device__ void operator()(int row, int col, float a, float b) const { const float rs = rstd_of(RSQ, row); const float* bb = BIAS + (size_t)mrow_of(row) * (2 * DFF);
        const float gq = rs * a + bb[col], up = rs * b + bb[col + DFF]; ACT[(size_t)row * DFF + col] = f2bf(silu_f(gq) * up); } };
template <bool DUAL, class Epi>
__global__ void __launch_bounds__(256) n_gemm(const bf16_t* __restrict__ A, const float* __restrict__ B, int lda, int ldb, int N, int K, int dual_off, int pad_, Epi epi) {
    __shared__ float As[16][68]; __shared__ float Bs[16][64]; __shared__ float Bs2[DUAL ? 16 : 1][64];
    const int tid = threadIdx.x, tx = tid & 15, ty = tid >> 4; const int m0 = blockIdx.y * 64, n0 = blockIdx.x * 64;
    float acc[4][4], acc2[4][4];
#pragma unroll
    for (int i = 0; i < 4; ++i)
#pragma unroll
        for (int j = 0; j < 4; ++j) { acc[i][j] = 0.f; acc2[i][j] = 0.f; }
    for (int k0 = 0; k0 < K; k0 += 16) {
        { const int m = tid >> 2, kk = (tid & 3) * 4; const ushort4 a = *(const ushort4*)(A + (size_t)(m0 + m) * lda + k0 + kk);
          As[kk][m] = bf2f(a.x); As[kk + 1][m] = bf2f(a.y); As[kk + 2][m] = bf2f(a.z); As[kk + 3][m] = bf2f(a.w); }
        { const int kk = tid >> 4, n = (tid & 15) * 4;
#pragma unroll
          for (int j = 0; j < 4; ++j) { const int col = n0 + n + j; Bs[kk][n + j] = col < N ? B[(size_t)(k0 + kk) * ldb + col] : 0.f; if (DUAL) Bs2[kk][n + j] = col < N ? B[(size_t)(k0 + kk) * ldb + col + dual_off] : 0.f; } }
        __syncthreads();
#pragma unroll
        for (int kk = 0; kk < 16; ++kk) { float a[4], b[4], b2[4];
#pragma unroll
            for (int i = 0; i < 4; ++i) a[i] = As[kk][ty * 4 + i];
#pragma unroll
            for (int j = 0; j < 4; ++j) { b[j] = Bs[kk][tx * 4 + j]; if (DUAL) b2[j] = Bs2[kk][tx * 4 + j]; }
#pragma unroll
            for (int i = 0; i < 4; ++i)
#pragma unroll
                for (int j = 0; j < 4; ++j) { acc[i][j] += a[i] * b[j]; if (DUAL) acc2[i][j] += a[i] * b2[j]; } }
        __syncthreads();
    }
#pragma unroll
    for (int i = 0; i < 4; ++i)
#pragma unroll
        for (int j = 0; j < 4; ++j) { const int row = m0 + ty * 4 + i, col = n0 + tx * 4 + j; if (col < N) epi(row, col, acc[i][j], acc2[i][j]); }
}

__global__ void __launch_bounds__(256) n_g1_epi(const float* __restrict__ P, const float* __restrict__ RSQ1, const float* __restrict__ BIAS  ,
                                                const float* __restrict__ sgu_g, const float* __restrict__ qa_g, const float* __restrict__ kva_g,
                                                bf16_t* __restrict__ U, bf16_t* __restrict__ VT, bf16_t* __restrict__ BW, bf16_t* __restrict__ QA, bf16_t* __restrict__ KVA, float* __restrict__ KR) {
    const int r = blockIdx.x * 4 + (threadIdx.x >> 6), lane = threadIdx.x & 63; if (r >= R) return;
    const float rs = rstd_of(RSQ1, r); const float* p = P + (size_t)r * DIN; const float* bb = BIAS + (size_t)mrow_of(r) * 1280;
    const int c = lane * 4;
    float v[4];
#pragma unroll
    for (int j = 0; j < 4; ++j) v[j] = gelu_f(rs * p[c + j] + bb[c + j]);
    { ushort4 o; o.x = f2bf(v[0]); o.y = f2bf(v[1]); o.z = f2bf(v[2]); o.w = f2bf(v[3]); *(ushort4*)(U + (size_t)r * 256 + c) = o; }
    float ss = 0.f;
#pragma unroll
    for (int j = 0; j < 4; ++j) { v[j] = gelu_f(rs * p[256 + c + j] + bb[256 + c + j]); ss += v[j] * v[j]; }
    ss = wave_sum(ss); float rn = rsqrtf(ss * (1.f / 256.f) + EPS);
    { const int chunk = r >> 7, jj = r & 127;
#pragma unroll
      for (int j = 0; j < 4; ++j) VT[((size_t)chunk * 256 + c + j) * 128 + jj] = f2bf(v[j] * rn * sgu_g[c + j]); }
#pragma unroll
    for (int j = 0; j < 4; ++j) v[j] = rs * p[512 + c + j] + bb[512 + c + j];
    { ushort4 o; o.x = f2bf(v[0]); o.y = f2bf(v[1]); o.z = f2bf(v[2]); o.w = f2bf(v[3]); *(ushort4*)(BW + (size_t)r * 256 + c) = o; }
    ss = 0.f;
#pragma unroll
    for (int j = 0; j < 4; ++j) { v[j] = rs * p[768 + c + j] + bb[768 + c + j]; ss += v[j] * v[j]; }
    ss = wave_sum(ss); rn = rsqrtf(ss * (1.f / 256.f) + EPS);
    { ushort4 o; o.x = f2bf(v[0] * rn * qa_g[c]); o.y = f2bf(v[1] * rn * qa_g[c + 1]); o.z = f2bf(v[2] * rn * qa_g[c + 2]); o.w = f2bf(v[3] * rn * qa_g[c + 3]); *(ushort4*)(QA + (size_t)r * 256 + c) = o; }
    { const int c2 = lane * 2; float a0 = rs * p[1024 + c2] + bb[1024 + c2], a1 = rs * p[1024 + c2 + 1] + bb[1024 + c2 + 1];
      ss = wave_sum(a0 * a0 + a1 * a1); rn = rsqrtf(ss * (1.f / 128.f) + EPS);
      ushort2 o; o.x = f2bf(a0 * rn * kva_g[c2]); o.y = f2bf(a1 * rn * kva_g[c2 + 1]); *(ushort2*)(KVA + (size_t)r * 128 + c2) = o; }
    if (lane < 32) KR[(size_t)r * 32 + lane] = rs * p[1152 + lane] + bb[1152 + lane];
}

__global__ void __launch_bounds__(256) n_spatial(const bf16_t* __restrict__ U, const bf16_t* __restrict__ VT, const float* __restrict__ wsp  , const float* __restrict__ bsp  , bf16_t* __restrict__ MIX) {
    const int r = blockIdx.x, c = threadIdx.x, h = c >> 6, i = r & 127, chunk = r >> 7;
    const float* w = wsp + ((size_t)h * 128 + i) * 128; const bf16_t* vt = VT + ((size_t)chunk * 256 + c) * 128;
    float a = 0.f;
    for (int j = 0; j < 128; ++j) a += w[j] * bf2f(vt[j]);
    a += bsp[h * 128 + i];
    MIX[(size_t)r * DM + c] = f2bf(bf2f(U[(size_t)r * 256 + c]) * a);
}
__global__ void __launch_bounds__(256) n_pool(const bf16_t* __restrict__ BW, const float* __restrict__ pscale, bf16_t* __restrict__ MIX) {
    const int r = blockIdx.x, n = threadIdx.x, g = n >> 6, hw = 1 << g;
    int t, ntok, base; if (r < RL) { t = r & 4095; ntok = SEQ; base = r - t; } else { t = (r - RL) & 255; ntok = CTXL; base = r - t; }
    const int lo = max(t - hw, 0), hi = min(t + hw, ntok);
    float s = 0.f; for (int q = lo; q < hi; ++q) s += bf2f(BW[(size_t)(base + q) * 256 + n]);
    const float mean = s / (float)(hi - lo);
    MIX[(size_t)r * DM + 256 + n] = f2bf(pscale[n] * (mean - bf2f(BW[(size_t)r * 256 + n])));
}
__global__ void __launch_bounds__(256) n_q(const bf16_t* __restrict__ QA, const float* __restrict__ wqb  , const float* __restrict__ qn_g, const float* __restrict__ ROPE, bf16_t* __restrict__ Q, int row0, int pad_) {
    __shared__ float a[8][256]; __shared__ float q[8][768];
    const int tid = threadIdx.x, r0 = row0 + blockIdx.x * 8;
    for (int i = tid; i < 8 * 256; i += 256) a[i >> 8][i & 255] = bf2f(QA[(size_t)(r0 + (i >> 8)) * 256 + (i & 255)]);
    __syncthreads();
    float acc[3][8];
#pragma unroll
    for (int i = 0; i < 3; ++i)
#pragma unroll
        for (int m = 0; m < 8; ++m) acc[i][m] = 0.f;
    for (int k = 0; k < 256; ++k) { float w[3];
#pragma unroll
        for (int i = 0; i < 3; ++i) w[i] = wqb[(size_t)k * 768 + tid + 256 * i];
#pragma unroll
        for (int m = 0; m < 8; ++m) { const float av = a[m][k];
#pragma unroll
            for (int i = 0; i < 3; ++i) acc[i][m] += av * w[i]; } }
#pragma unroll
    for (int i = 0; i < 3; ++i)
#pragma unroll
        for (int m = 0; m < 8; ++m) q[m][tid + 256 * i] = acc[i][m];
    __syncthreads();
    if (tid < 64) { const int m = tid >> 3, h = tid & 7, r = r0 + m; float* qq = &q[m][h * 96];
        float ss = 0.f; for (int i = 0; i < 96; ++i) ss += qq[i] * qq[i];
        const float rn = rsqrtf(ss * (1.f / 96.f) + EPS);
        bf16_t* o = Q + ((size_t)r * NH + h) * QKH;
        for (int i = 0; i < 64; ++i) o[i] = f2bf(qq[i] * rn * qn_g[i] * QSCALE);
        const bool lat = r < RL; const int t = r & 4095;
        for (int pp = 0; pp < 16; ++pp) { float x1 = qq[64 + 2 * pp] * rn * qn_g[64 + 2 * pp], x2 = qq[65 + 2 * pp] * rn * qn_g[65 + 2 * pp];
            if (lat) { const int pos = pp < 8 ? (t >> 6) : (t & 63); const float cs = ROPE[(pos * 8 + (pp & 7)) * 2], sn = ROPE[(pos * 8 + (pp & 7)) * 2 + 1];
                const float y1 = x1 * cs - x2 * sn, y2 = x1 * sn + x2 * cs; x1 = y1; x2 = y2; }
            o[64 + 2 * pp] = f2bf(x1 * QSCALE); o[65 + 2 * pp] = f2bf(x2 * QSCALE); } }
}
__global__ void __launch_bounds__(256) n_kv(const bf16_t* __restrict__ KVA, const float* __restrict__ KR, const float* __restrict__ wkvb  , const float* __restrict__ kn_g, const float* __restrict__ ROPE,
                                            bf16_t* __restrict__ Kb, bf16_t* __restrict__ Vb) {
    __shared__ float a[8][128]; __shared__ float kv[8][1024];
    const int tid = threadIdx.x, r0 = blockIdx.x * 8;
    for (int i = tid; i < 8 * 128; i += 256) a[i >> 7][i & 127] = bf2f(KVA[(size_t)(r0 + (i >> 7)) * 128 + (i & 127)]);
    __syncthreads();
    float acc[4][8];
#pragma unroll
    for (int i = 0; i < 4; ++i)
#pragma unroll
        for (int m = 0; m < 8; ++m) acc[i][m] = 0.f;
    for (int k = 0; k < 128; ++k) { float w[4];
#pragma unroll
        for (int i = 0; i < 4; ++i) w[i] = wkvb[(size_t)k * 1024 + tid + 256 * i];
#pragma unroll
        for (int m = 0; m < 8; ++m) { const float av = a[m][k];
#pragma unroll
            for (int i = 0; i < 4; ++i) acc[i][m] += av * w[i]; } }
#pragma unroll
    for (int i = 0; i < 4; ++i)
#pragma unroll
        for (int m = 0; m < 8; ++m) kv[m][tid + 256 * i] = acc[i][m];
    __syncthreads();
    if (tid < 64) { const int m = tid >> 3, h = tid & 7, r = r0 + m; const float* kk = &kv[m][h * 128]; const float* kr = KR + (size_t)r * 32;
        const bool lat = r < RL; const int b = lat ? (r >> 12) : ((r - RL) >> 8), t = lat ? (r & 4095) : ((r - RL) & 255), key = lat ? CTXL + t : t;
        float ss = 0.f; for (int i = 0; i < 64; ++i) ss += kk[i] * kk[i]; for (int i = 0; i < 32; ++i) ss += kr[i] * kr[i];
        const float rn = rsqrtf(ss * (1.f / 96.f) + EPS);
        bf16_t* ko = Kb + (((size_t)b * NH + h) * NKEY + key) * QKH; bf16_t* vo = Vb + (((size_t)b * NH + h) * NKEY + key) * VD;
        for (int i = 0; i < 64; ++i) ko[i] = f2bf(kk[i] * rn * kn_g[i]);
        for (int pp = 0; pp < 16; ++pp) { float x1 = kr[2 * pp] * rn * kn_g[64 + 2 * pp], x2 = kr[2 * pp + 1] * rn * kn_g[65 + 2 * pp];
            if (lat) { const int pos = pp < 8 ? (t >> 6) : (t & 63); const float cs = ROPE[(pos * 8 + (pp & 7)) * 2], sn = ROPE[(pos * 8 + (pp & 7)) * 2 + 1];
                const float y1 = x1 * cs - x2 * sn, y2 = x1 * sn + x2 * cs; x1 = y1; x2 = y2; }
            ko[64 + 2 * pp] = f2bf(x1); ko[65 + 2 * pp] = f2bf(x2); }
        for (int i = 0; i < 64; ++i) vo[i] = f2bf(kk[64 + i]); }
}
__global__ void __launch_bounds__(256) n_attn(const bf16_t* __restrict__ Q, const bf16_t* __restrict__ Kb, const bf16_t* __restrict__ Vb, bf16_t* __restrict__ MIX, int ctx_mode, int pad_) {
    __shared__ float Ks[32][96]; __shared__ float Vs[32][64];
    const int tid = threadIdx.x; int b, h, r, nkeys;
    if (!ctx_mode) { const int u = blockIdx.x; const int qb = u & 15; h = (u >> 4) & 7; b = u >> 7; r = b * SEQ + qb * 256 + tid; nkeys = NKEY; }
    else { const int u = blockIdx.x; h = u & 7; b = u >> 3; r = RL + b * CTXL + tid; nkeys = CTXL; }
    float q[96], o[64];
    { const bf16_t* qp = Q + ((size_t)r * NH + h) * QKH;
#pragma unroll
      for (int i = 0; i < 96; ++i) q[i] = bf2f(qp[i]); }
#pragma unroll
    for (int i = 0; i < 64; ++i) o[i] = 0.f;
    float m = -1e30f, l = 0.f;
    const bf16_t* kbase = Kb + ((size_t)b * NH + h) * NKEY * QKH; const bf16_t* vbase = Vb + ((size_t)b * NH + h) * NKEY * VD;
    for (int k0 = 0; k0 < nkeys; k0 += 32) {
        __syncthreads();
        for (int i = tid; i < 32 * 96; i += 256) Ks[i / 96][i % 96] = bf2f(kbase[(size_t)k0 * QKH + i]);
        for (int i = tid; i < 32 * 64; i += 256) Vs[i >> 6][i & 63] = bf2f(vbase[(size_t)k0 * VD + i]);
        __syncthreads();
        float s[32]; float mx = m;
#pragma unroll
        for (int j = 0; j < 32; ++j) { float a = 0.f;
#pragma unroll
            for (int i = 0; i < 96; ++i) a += q[i] * Ks[j][i];
            s[j] = a; mx = fmaxf(mx, a); }
        const float alpha = exp2f(m - mx); m = mx; l *= alpha;
#pragma unroll
        for (int i = 0; i < 64; ++i) o[i] *= alpha;
#pragma unroll
        for (int j = 0; j < 32; ++j) { const float p = exp2f(s[j] - m); l += p;
#pragma unroll
            for (int i = 0; i < 64; ++i) o[i] += p * Vs[j][i]; }
    }
    const float il = 1.f / l; bf16_t* op = MIX + (size_t)r * DM + 512 + h * 64;
#pragma unroll
    for (int i = 0; i < 64; ++i) op[i] = f2bf(o[i] * il);
}


#define LAS __attribute__((address_space(3)))
#define GAS __attribute__((address_space(1)))
typedef short bf16x8 __attribute__((ext_vector_type(8)));
typedef float f32x4 __attribute__((ext_vector_type(4)));
typedef float f32x2 __attribute__((ext_vector_type(2)));
typedef unsigned u32x4 __attribute__((ext_vector_type(4)));
typedef unsigned u32x2 __attribute__((ext_vector_type(2)));
__device__ __forceinline__ unsigned cvt_pk_bf16(float lo, float hi) { unsigned r; asm volatile("v_cvt_pk_bf16_f32 %0, %1, %2" : "=v"(r) : "v"(lo), "v"(hi)); return r; }
__device__ __forceinline__ float fast_silu(float x) { return x * __builtin_amdgcn_rcpf(1.f + __builtin_amdgcn_exp2f(-1.4426950408889634f * x)); }

constexpr size_t WL_IN = 0;
constexpr size_t WL_OUT = WL_IN + (size_t)1280 * 1024;
constexpr size_t WL_GU = WL_OUT + (size_t)1024 * 1024;
constexpr size_t WL_DN = WL_GU + (size_t)5632 * 1024;
constexpr size_t WL_QB = WL_DN + (size_t)1024 * 2816;
constexpr size_t WL_KVB = WL_QB + (size_t)768 * 256;
constexpr size_t WL_SP = WL_KVB + (size_t)1024 * 128;
constexpr size_t WL_END = WL_SP + (size_t)4 * 128 * 128;
static_assert(WL_END * 2 <= 22 * MiB, "weights per layer");
constexpr size_t WS_WB = WS_W;
constexpr size_t WS_BIAS2P = 3 * MiB;
constexpr size_t WS_BIAS1P = 3 * MiB + 256 * 1024;

namespace pg8 {
constexpr int BM = 256, BK = 64, HALF = 128, HTB = HALF * BK * 2, STAGE_BYTES = 8 * HTB, NXCD = 8, WGM = 8;
__host__ __device__ __forceinline__ int lds_byte(int r, int c) { const int st = (r >> 4) * 2 + (c >> 5), rr = r & 15, cc = c & 31, ob = rr * 64 + cc * 2; return st * 1024 + (ob ^ (((ob >> 9) & 1) << 5)); }
__host__ __device__ __forceinline__ void stage_rc(int b, int& Rr, int& C) { const int st = b / 1024, sb = b % 1024, swz = sb ^ (((sb >> 9) & 1) << 5); Rr = (st >> 1) * 16 + swz / 64; C = (st & 1) * 32 + (swz % 64) / 2; }
__host__ __device__ __forceinline__ int perm32(int rho) { const int n = rho >> 4, i = rho & 15; return 8 * (i >> 2) + 4 * n + (i & 3); }
struct Unit { int pm, pn; };
struct Gemm { const bf16_t* A; const bf16_t* Bt; int M, N, K; };
struct StaticOrder {
    int nM, nN, nwg, G, c;
    __device__ void init(int M, int N, int G_, int c_) { nM = M / BM; nN = N / BM; nwg = nM * nN; G = G_; c = c_; }
    __device__ bool next(int i, Unit& u) const {
        const long L = (long)i * G + c; if (L >= nwg) return false;
        int wgid = (int)L; { const int q = nwg / NXCD, r = nwg % NXCD, xcd = wgid % NXCD, off = wgid / NXCD; wgid = (xcd < r ? xcd * (q + 1) : r * (q + 1) + (xcd - r) * q) + off; }
        const int nig = WGM * nN, gid = wgid / nig, fm = gid * WGM, gsz = (nM - fm) < WGM ? (nM - fm) : WGM;
        u.pm = fm + ((wgid % nig) % gsz); u.pn = (wgid % nig) / gsz; return true;
    }
};
template <class Epi, class Sched>
__device__ __forceinline__ void gemm_phase(LAS unsigned char* lds, LAS unsigned char* xl, const Gemm g, const Sched& S, const Epi& E) {
    const int tid = threadIdx.x, wid = __builtin_amdgcn_readfirstlane(tid >> 6), lane = tid & 63, wr = wid >> 2, wc = wid & 3, fr = lane & 15, fq = lane >> 4;
    const int K = g.K, nt = K / BK;
    unsigned voffA[2], voffB[2];
#pragma unroll
    for (int i = 0; i < 2; ++i) { int Rr, C; stage_rc(tid * 16 + i * 8192, Rr, C); const int Rb = (Rr & ~31) + perm32(Rr & 31);
        voffA[i] = (unsigned)(Rr * K + C) * 2u; voffB[i] = (unsigned)(Rb * K + C) * 2u; }
    const size_t kstep = (size_t)(BK * 2);
    const size_t hstep = (size_t)HALF * K * 2;
    const size_t tstep = 2 * hstep;
    const unsigned ldsw = (unsigned)wid * 1024u;
    const int aoff = lds_byte(wr * 64 + fr, fq * 8), boff = lds_byte(wc * 32 + fr, fq * 8);
#define PG8_SA(b, h) (((b) * 2 + (h)) * HTB)
#define PG8_SB(b, h) ((4 + (b) * 2 + (h)) * HTB)
#define PG8_STAGE(bufoff, gbase, voff) do { _Pragma("unroll") for (int _i = 0; _i < 2; ++_i) \
        __builtin_amdgcn_global_load_lds((const unsigned*)((const char*)(gbase) + (voff)[_i]), (LAS unsigned*)(lds + (bufoff) + ldsw + _i * 8192), 16, 0, 0); } while (0)
#define PG8_LDA(dst, b, h) do { _Pragma("unroll") for (int m = 0; m < 4; ++m) _Pragma("unroll") for (int k = 0; k < 2; ++k) dst[m][k] = *(const LAS bf16x8*)(lds + PG8_SA(b, h) + aoff + m * 2048 + k * 1024); } while (0)
#define PG8_LDB(dst, b, h) do { _Pragma("unroll") for (int n = 0; n < 2; ++n) _Pragma("unroll") for (int k = 0; k < 2; ++k) dst[n][k] = *(const LAS bf16x8*)(lds + PG8_SB(b, h) + boff + n * 2048 + k * 1024); } while (0)
#define PG8_MMA(ai, bj, At, Bt) do { __builtin_amdgcn_s_setprio(1); _Pragma("unroll") for (int m = 0; m < 4; ++m) _Pragma("unroll") for (int n = 0; n < 2; ++n) _Pragma("unroll") for (int k = 0; k < 2; ++k) \
        acc[ai][bj][m][n] = __builtin_amdgcn_mfma_f32_16x16x32_bf16(Bt[n][k], At[m][k], acc[ai][bj][m][n], 0, 0, 0); __builtin_amdgcn_s_setprio(0); } while (0)
#define PG8_WAIT_V(n) asm volatile("s_waitcnt vmcnt(" #n ")" ::: "memory")
#define PG8_WAIT_L(n) asm volatile("s_waitcnt lgkmcnt(" #n ")" ::: "memory")
#define PG8_BAR __builtin_amdgcn_s_barrier()
#define PG8_SCHED __builtin_amdgcn_sched_barrier(0)
    Unit cur, nxt; int ui = 0;
    if (!S.next(0, cur)) return;
    f32x4 acc[2][2][4][2];
#pragma unroll
    for (int a = 0; a < 2; ++a)
#pragma unroll
        for (int b = 0; b < 2; ++b)
#pragma unroll
            for (int m = 0; m < 4; ++m)
#pragma unroll
                for (int n = 0; n < 2; ++n) acc[a][b][m][n] = (f32x4){0.f, 0.f, 0.f, 0.f};
    bf16x8 At[4][2], B0[2][2], B1[2][2];
    const char* cA = (const char*)g.A + (size_t)cur.pm * tstep; const char* cB = (const char*)g.Bt + (size_t)cur.pn * tstep;
    PG8_STAGE(PG8_SB(0, 0), cB, voffB); PG8_STAGE(PG8_SB(0, 1), cB + hstep, voffB); PG8_STAGE(PG8_SA(0, 0), cA, voffA); PG8_STAGE(PG8_SA(0, 1), cA + hstep, voffA);
    if (wr == 1) PG8_BAR;
    PG8_WAIT_V(2); PG8_BAR;
    PG8_STAGE(PG8_SB(1, 0), cB + kstep, voffB); PG8_STAGE(PG8_SA(1, 0), cA + kstep, voffA); PG8_STAGE(PG8_SB(1, 1), cB + hstep + kstep, voffB);
    PG8_WAIT_V(6); PG8_BAR;
    for (;;) {
        const bool has_next = S.next(ui + 1, nxt);
        const char* nA = has_next ? (const char*)g.A + (size_t)nxt.pm * tstep : cA; const char* nB = has_next ? (const char*)g.Bt + (size_t)nxt.pn * tstep : cB;
        for (int t = 0; t < nt; t += 2) {
            const bool last = (t == nt - 2);
            const char* a1 = cA + (size_t)(t + 1) * kstep;
            const char* a2 = last ? nA : cA + (size_t)(t + 2) * kstep; const char* b2 = last ? nB : cB + (size_t)(t + 2) * kstep;
            const char* a3 = a2 + kstep; const char* b3 = b2 + kstep;
            PG8_LDB(B0, 0, 0); PG8_LDB(B1, 0, 1); PG8_SCHED; PG8_LDA(At, 0, 0); PG8_STAGE(PG8_SA(1, 1), a1 + hstep, voffA);
            PG8_WAIT_V(8); PG8_WAIT_L(0); PG8_BAR; PG8_MMA(0, 0, At, B0); PG8_MMA(0, 1, At, B1); PG8_BAR; PG8_SCHED;
            PG8_LDA(At, 0, 1); PG8_STAGE(PG8_SB(0, 0), b2, voffB); PG8_STAGE(PG8_SB(0, 1), b2 + hstep, voffB); PG8_STAGE(PG8_SA(0, 0), a2, voffA);
            PG8_WAIT_V(8); PG8_WAIT_L(0); PG8_BAR; PG8_MMA(1, 0, At, B0); PG8_MMA(1, 1, At, B1); PG8_BAR; PG8_SCHED;
            PG8_LDB(B0, 1, 0); PG8_LDB(B1, 1, 1); PG8_SCHED; PG8_LDA(At, 1, 0); PG8_STAGE(PG8_SA(0, 1), a2 + hstep, voffA);
            PG8_WAIT_V(8); PG8_WAIT_L(0); PG8_BAR; PG8_MMA(0, 0, At, B0); PG8_MMA(0, 1, At, B1); PG8_BAR; PG8_SCHED;
            PG8_LDA(At, 1, 1); PG8_STAGE(PG8_SB(1, 0), b3, voffB); PG8_STAGE(PG8_SB(1, 1), b3 + hstep, voffB); PG8_STAGE(PG8_SA(1, 0), a3, voffA);
            PG8_WAIT_V(8); PG8_WAIT_L(0); PG8_BAR; PG8_MMA(1, 0, At, B0); PG8_MMA(1, 1, At, B1); PG8_BAR; PG8_SCHED;
        }
        if (wr == 0) PG8_BAR;
        { int fr_ = fr, fq_ = fq; asm volatile("" : "+v"(fr_), "+v"(fq_)); E(acc, cur, wr, wc, fr_, fq_, xl); }
        if (!has_next) break;
#pragma unroll
        for (int a = 0; a < 2; ++a)
#pragma unroll
            for (int b = 0; b < 2; ++b)
#pragma unroll
                for (int m = 0; m < 4; ++m)
#pragma unroll
                    for (int n = 0; n < 2; ++n) acc[a][b][m][n] = (f32x4){0.f, 0.f, 0.f, 0.f};
        cur = nxt; cA = nA; cB = nB; ++ui;
        if (wr == 1) PG8_BAR;
    }
    PG8_WAIT_V(0);
    PG8_BAR;
#undef PG8_SA
#undef PG8_SB
#undef PG8_STAGE
#undef PG8_LDA
#undef PG8_LDB
#undef PG8_MMA
}
}

__device__ __forceinline__ f32x4 ld4(const float* p) { return *(const f32x4*)p; }
struct EpiGU {
    bf16_t* ACT; const float* RSQ; const float* BIAS;
    __device__ __forceinline__ void operator()(f32x4 (&acc)[2][2][4][2], const pg8::Unit& u, int wr, int wc, int fr, int fq, LAS unsigned char*) const {
        const int row0 = u.pm * 256 + wr * 64 + fr; const int mr = mrow_of(u.pm * 256);
        const float* bb = BIAS + (size_t)mr * (2 * DFF) + u.pn * 256 + wc * 32 + 8 * fq;
        const f32x4 bg0 = ld4(bb), bg1 = ld4(bb + 4), bu0 = ld4(bb + 128), bu1 = ld4(bb + 132);
        bf16_t* ob = ACT + u.pn * 128 + wc * 32 + 8 * fq;
#pragma unroll
        for (int ai = 0; ai < 2; ++ai)
#pragma unroll
            for (int m = 0; m < 4; ++m) { const int row = row0 + ai * 128 + m * 16; const float rs = rstd_of(RSQ, row);
                const f32x4 g0 = acc[ai][0][m][0] * rs + bg0, g1 = acc[ai][0][m][1] * rs + bg1, u0 = acc[ai][1][m][0] * rs + bu0, u1 = acc[ai][1][m][1] * rs + bu1;
                u32x4 w; w.x = cvt_pk_bf16(fast_silu(g0[0]) * u0[0], fast_silu(g0[1]) * u0[1]); w.y = cvt_pk_bf16(fast_silu(g0[2]) * u0[2], fast_silu(g0[3]) * u0[3]);
                w.z = cvt_pk_bf16(fast_silu(g1[0]) * u1[0], fast_silu(g1[1]) * u1[1]); w.w = cvt_pk_bf16(fast_silu(g1[2]) * u1[2], fast_silu(g1[3]) * u1[3]);
                *(u32x4*)(ob + (size_t)row * DFF) = w; }
    }
};
struct EpiRes {
    float* XL; float* XC; const float* gate; float* RSQ; bf16_t* XG; const float* ng; const float* nsc; int do_next; int pad;
    __device__ __forceinline__ void operator()(f32x4 (&acc)[2][2][4][2], const pg8::Unit& u, int wr, int wc, int fr, int fq, LAS unsigned char* xl) const {
        const int mr = mrow_of(u.pm * 256); const int col0 = u.pn * 256 + wc * 32 + 8 * fq; const int rl0 = wr * 64 + fr;
        float* xbase = u.pm < 64 ? XL + (size_t)(u.pm * 256) * DM : XC + (size_t)(u.pm * 256 - RL) * DM;
        LAS float* P = (LAS float*)xl;
        float ss[8];
#pragma unroll
        for (int q = 0; q < 8; ++q) ss[q] = 0.f;
#pragma unroll
        for (int bj = 0; bj < 2; ++bj) {
            f32x4 gt[2], gm[2];
#pragma unroll
            for (int n = 0; n < 2; ++n) { const int c = col0 + bj * 128 + 4 * n; gt[n] = ld4(gate + (size_t)mr * (NMOD * DM) + c);
                if (do_next) gm[n] = ld4(ng + c) * (ld4(nsc + (size_t)mr * (NMOD * DM) + c) + 1.f); else gm[n] = (f32x4){0.f, 0.f, 0.f, 0.f}; }
#pragma unroll
            for (int ai = 0; ai < 2; ++ai)
#pragma unroll
                for (int m = 0; m < 4; ++m) { const int rl = rl0 + ai * 128 + m * 16; float* xp = xbase + (size_t)rl * DM + col0 + bj * 128;
                    const f32x4 y0 = ld4(xp) + gt[0] * acc[ai][bj][m][0], y1 = ld4(xp + 4) + gt[1] * acc[ai][bj][m][1];
                    *(f32x4*)(xp) = y0; *(f32x4*)(xp + 4) = y1;
                    if (do_next) { ss[ai * 4 + m] += (y0[0] * y0[0] + y0[1] * y0[1]) + (y0[2] * y0[2] + y0[3] * y0[3]) + (y1[0] * y1[0] + y1[1] * y1[1]) + (y1[2] * y1[2] + y1[3] * y1[3]);
                        const f32x4 z0 = y0 * gm[0], z1 = y1 * gm[1]; u32x4 w; w.x = cvt_pk_bf16(z0[0], z0[1]); w.y = cvt_pk_bf16(z0[2], z0[3]); w.z = cvt_pk_bf16(z1[0], z1[1]); w.w = cvt_pk_bf16(z1[2], z1[3]);
                        *(u32x4*)(XG + (size_t)(u.pm * 256 + rl) * DM + col0 + bj * 128) = w; }
                    if (m & 1) asm volatile("" ::: "memory"); }
        }
        if (do_next) {
#pragma unroll
            for (int q = 0; q < 8; ++q) { float t = ss[q]; t += __shfl_xor(t, 16); t += __shfl_xor(t, 32); if (fq == 0) P[(rl0 + (q >> 2) * 128 + (q & 3) * 16) * 4 + wc] = t; }
        }
        if (do_next) {
            asm volatile("s_waitcnt lgkmcnt(0)" ::: "memory"); __builtin_amdgcn_s_barrier(); asm volatile("" ::: "memory");
            const int tid = threadIdx.x;
            if (tid < 256) { const f32x4 p = *(const LAS f32x4*)(P + tid * 4); RSQ[(size_t)(u.pm * 256 + tid) * 4 + u.pn] = (p[0] + p[1]) + (p[2] + p[3]); }
        }
    }
};


__device__ __forceinline__ float gelu_fast(float v) {
    const float av = fabsf(v), d = av * 0.2316418882f + 1.0f, t = __builtin_amdgcn_rcpf(d);
    float q = t * 0.5307027145f + (-0.7265760135f); q = q * t + 0.7107068705f; q = q * t + (-0.142248368f); q = q * t + 0.127414796f; q = q * t;
    const float e = __builtin_amdgcn_exp2f((v * v) * (-0.72134752044f));
    const float m = v * (q * e), r = v - m; return v < 0.f ? m : r;
}
struct EpiG1 {
    const float* RSQ; const float* BIAS; const float* sgu_g; const float* qa_g; const float* kva_g;
    bf16_t* U; bf16_t* VT; bf16_t* BW; bf16_t* QA; bf16_t* KVA; float* KR;
#define G1_PACK(v0, v1) (u32x4){cvt_pk_bf16((v0)[0], (v0)[1]), cvt_pk_bf16((v0)[2], (v0)[3]), cvt_pk_bf16((v1)[0], (v1)[1]), cvt_pk_bf16((v1)[2], (v1)[3])}
#define G1_SS(v) (((v)[0] * (v)[0] + (v)[1] * (v)[1]) + ((v)[2] * (v)[2] + (v)[3] * (v)[3]))
    __device__ __forceinline__ void operator()(f32x4 (&acc)[2][2][4][2], const pg8::Unit& u, int wr, int wc, int fr, int fq, LAS unsigned char* xl) const {
        const int mr = mrow_of(u.pm * 256); const int cl = wc * 32 + 8 * fq; const int rl0 = wr * 64 + fr; const int pn = u.pn;
        LAS float* P = (LAS float*)xl;
        {   f32x4 bv[2][2];
#pragma unroll
            for (int bj = 0; bj < 2; ++bj)
#pragma unroll
                for (int n = 0; n < 2; ++n) bv[bj][n] = ld4(BIAS + (size_t)mr * 1280 + pn * 256 + bj * 128 + cl + 4 * n);
            const bool act = (pn <= 1);
#pragma unroll
            for (int ai = 0; ai < 2; ++ai)
#pragma unroll
                for (int m = 0; m < 4; ++m) { const float rs = rstd_of(RSQ, u.pm * 256 + rl0 + ai * 128 + m * 16);
#pragma unroll
                    for (int bj = 0; bj < 2; ++bj)
#pragma unroll
                        for (int n = 0; n < 2; ++n) { f32x4 v = acc[ai][bj][m][n] * rs + bv[bj][n];
                            if (act) v = (f32x4){gelu_fast(v[0]), gelu_fast(v[1]), gelu_fast(v[2]), gelu_fast(v[3])};
                            acc[ai][bj][m][n] = v; }
                    if (m & 1) asm volatile("" ::: "memory"); }
        }
        if (pn == 0) {
#pragma unroll
            for (int ai = 0; ai < 2; ++ai)
#pragma unroll
                for (int m = 0; m < 4; ++m) { const int row = u.pm * 256 + rl0 + ai * 128 + m * 16;
#pragma unroll
                    for (int bj = 0; bj < 2; ++bj) *(u32x4*)(U + (size_t)row * 256 + bj * 128 + cl) = G1_PACK(acc[ai][bj][m][0], acc[ai][bj][m][1]); }
            return;
        }
        if (pn == 2) {
#pragma unroll
            for (int ai = 0; ai < 2; ++ai)
#pragma unroll
                for (int m = 0; m < 4; ++m) { const int row = u.pm * 256 + rl0 + ai * 128 + m * 16;
#pragma unroll
                    for (int bj = 0; bj < 2; ++bj) *(u32x4*)(BW + (size_t)row * 256 + bj * 128 + cl) = G1_PACK(acc[ai][bj][m][0], acc[ai][bj][m][1]); }
            return;
        }
#pragma unroll
        for (int ai = 0; ai < 2; ++ai)
#pragma unroll
            for (int m = 0; m < 4; ++m) { float ss = G1_SS(acc[ai][0][m][0]) + G1_SS(acc[ai][0][m][1]);
                if (pn != 4) ss += G1_SS(acc[ai][1][m][0]) + G1_SS(acc[ai][1][m][1]);
                ss += __shfl_xor(ss, 16); ss += __shfl_xor(ss, 32);
                if (fq == 0) P[(rl0 + ai * 128 + m * 16) * 4 + wc] = ss; }
        asm volatile("s_waitcnt lgkmcnt(0)" ::: "memory"); __builtin_amdgcn_s_barrier(); asm volatile("" ::: "memory");
        if (pn == 1) {
#pragma unroll
            for (int bj = 0; bj < 2; ++bj) { const f32x4 g0 = ld4(sgu_g + bj * 128 + cl), g1 = ld4(sgu_g + bj * 128 + cl + 4);
#pragma unroll
                for (int ai = 0; ai < 2; ++ai)
#pragma unroll
                    for (int m = 0; m < 4; ++m) { const int rl = rl0 + ai * 128 + m * 16; const int row = u.pm * 256 + rl;
                        const f32x4 p = *(const LAS f32x4*)(P + rl * 4); const float rn = rsqrtf(((p[0] + p[1]) + (p[2] + p[3])) * (1.f / 256.f) + EPS);
                        const f32x4 v0 = acc[ai][bj][m][0] * rn * g0, v1 = acc[ai][bj][m][1] * rn * g1;
                        bf16_t* vt = VT + ((size_t)(row >> 7) * 256 + bj * 128 + cl) * 128 + (row & 127);
#pragma unroll
                        for (int i = 0; i < 4; ++i) { vt[(size_t)i * 128] = (bf16_t)(cvt_pk_bf16(v0[i], 0.f) & 0xffffu); vt[(size_t)(4 + i) * 128] = (bf16_t)(cvt_pk_bf16(v1[i], 0.f) & 0xffffu); } } }
        } else if (pn == 3) {
#pragma unroll
            for (int bj = 0; bj < 2; ++bj) { const f32x4 g0 = ld4(qa_g + bj * 128 + cl), g1 = ld4(qa_g + bj * 128 + cl + 4);
#pragma unroll
                for (int ai = 0; ai < 2; ++ai)
#pragma unroll
                    for (int m = 0; m < 4; ++m) { const int rl = rl0 + ai * 128 + m * 16; const int row = u.pm * 256 + rl;
                        const f32x4 p = *(const LAS f32x4*)(P + rl * 4); const float rn = rsqrtf(((p[0] + p[1]) + (p[2] + p[3])) * (1.f / 256.f) + EPS);
                        const f32x4 v0 = acc[ai][bj][m][0] * rn * g0, v1 = acc[ai][bj][m][1] * rn * g1;
                        *(u32x4*)(QA + (size_t)row * 256 + bj * 128 + cl) = G1_PACK(v0, v1); } }
        } else {
            const f32x4 g0 = ld4(kva_g + cl), g1 = ld4(kva_g + cl + 4);
#pragma unroll
            for (int ai = 0; ai < 2; ++ai)
#pragma unroll
                for (int m = 0; m < 4; ++m) { const int rl = rl0 + ai * 128 + m * 16; const int row = u.pm * 256 + rl;
                    const f32x4 p = *(const LAS f32x4*)(P + rl * 4); const float rn = rsqrtf(((p[0] + p[1]) + (p[2] + p[3])) * (1.f / 128.f) + EPS);
                    const f32x4 v0 = acc[ai][0][m][0] * rn * g0, v1 = acc[ai][0][m][1] * rn * g1;
                    *(u32x4*)(KVA + (size_t)row * 128 + cl) = G1_PACK(v0, v1);
                    if (wc == 0) { *(f32x4*)(KR + (size_t)row * 32 + 8 * fq) = acc[ai][1][m][0]; *(f32x4*)(KR + (size_t)row * 32 + 8 * fq + 4) = acc[ai][1][m][1]; } }
        }
    }
#undef G1_PACK
#undef G1_SS
};


namespace att {
using s16x4 = __attribute__((ext_vector_type(4))) short;
using f32x16 = __attribute__((ext_vector_type(16))) float;
constexpr int KROW = 208;
constexpr int SHM_V = 64 * 64 * 2, SHM_K = 64 * KROW, OFF_K = 2 * SHM_V, OFF_WS = OFF_K + 2 * SHM_K, SHM_ATTN = OFF_WS + 8 * 64 * 4;
constexpr float THRL = 8.f;
#define ASBAR() __builtin_amdgcn_sched_barrier(0)
__device__ __forceinline__ int crow(int r, int hi) { return (r & 3) + 8 * (r >> 2) + 4 * hi; }
__device__ __forceinline__ int v_st(int k, int c) { const int kk = (k & ~0xC) | ((k & 4) << 1) | ((k & 8) >> 1); return ((kk >> 3) * 2 + (c >> 5)) * 512 + ((kk & 7) * 32 + (c & 31)) * 2; }
__device__ __forceinline__ int v_rd_base(int lane) { return ((lane & 3) << 3) | (((lane >> 2) & 3) << 6) | (((lane >> 4) & 1) << 5) | (((lane >> 5) & 1) << 8); }
constexpr int v_rd_off(int d0, int ks, int half) { return d0 * 512 + ks * 2048 + half * 1024; }
template <int OFF> __device__ __forceinline__ s16x4 tr_read(int vb) { s16x4 r; asm volatile("ds_read_b64_tr_b16 %0, %1 offset:%2" : "=&v"(r) : "v"(vb), "i"(OFF) : "memory"); return r; }
__device__ __forceinline__ void partialSM(f32x16& p0, f32x16& p1, float& m_reg, float& mn, float& alpha) {
    float pmax = p0[0];
#pragma unroll
    for (int r = 1; r < 16; ++r) pmax = fmaxf(pmax, p0[r]);
#pragma unroll
    for (int r = 0; r < 16; ++r) pmax = fmaxf(pmax, p1[r]);
    { auto rr = __builtin_amdgcn_permlane32_swap(__float_as_uint(pmax), __float_as_uint(pmax), false, false); pmax = fmaxf(__uint_as_float(rr[0]), __uint_as_float(rr[1])); }
    if (__builtin_expect(__all(pmax - m_reg <= THRL), 1)) { mn = m_reg; alpha = 1.f; }
    else { mn = fmaxf(m_reg, pmax); alpha = __builtin_amdgcn_exp2f(m_reg - mn); m_reg = mn; }
#pragma unroll
    for (int r = 0; r < 16; ++r) p0[r] = p0[r] - mn;
#pragma unroll
    for (int r = 0; r < 16; ++r) p1[r] = p1[r] - mn;
#pragma unroll
    for (int r = 0; r < 16; ++r) p0[r] = __builtin_amdgcn_exp2f(p0[r]);
}
__device__ __forceinline__ void finishSM(f32x16& p0, f32x16& p1, float alpha, float& l_reg, bf16x8& pa0, bf16x8& pa1, bf16x8& pa2, bf16x8& pa3) {
#pragma unroll
    for (int r = 0; r < 16; ++r) p1[r] = __builtin_amdgcn_exp2f(p1[r]);
    float ps = 0;
#pragma unroll
    for (int r = 0; r < 16; ++r) ps += p0[r];
#pragma unroll
    for (int r = 0; r < 16; ++r) ps += p1[r];
    { auto rr = __builtin_amdgcn_permlane32_swap(__float_as_uint(ps), __float_as_uint(ps), false, false); ps = __uint_as_float(rr[0]) + __uint_as_float(rr[1]); }
    l_reg = l_reg * alpha + ps;
#define PK4(P, BASE, OUT) do { unsigned a0 = cvt_pk_bf16(P[BASE + 0], P[BASE + 1]), a1 = cvt_pk_bf16(P[BASE + 2], P[BASE + 3]);   \
    unsigned b0 = cvt_pk_bf16(P[BASE + 4], P[BASE + 5]), b1 = cvt_pk_bf16(P[BASE + 6], P[BASE + 7]);                              \
    auto r0 = __builtin_amdgcn_permlane32_swap(a0, b0, false, false); auto r1 = __builtin_amdgcn_permlane32_swap(a1, b1, false, false); \
    u32x4 w = {r0[0], r1[0], r0[1], r1[1]}; OUT = *reinterpret_cast<bf16x8*>(&w); } while (0)
    PK4(p0, 0, pa0); PK4(p0, 8, pa1); PK4(p1, 0, pa2); PK4(p1, 8, pa3);
#undef PK4
}
__device__ __forceinline__ void qkt(f32x16& p0, f32x16& p1, LAS const unsigned char* Ks, const bf16x8 (&qr)[6], int r32, int hi) {
    p0 = f32x16{}; p1 = f32x16{};
#pragma unroll
    for (int d0 = 0; d0 < 6; ++d0) {
        const bf16x8 b0 = *(LAS const bf16x8*)(Ks + r32 * KROW + d0 * 32 + hi * 16);
        const bf16x8 b1 = *(LAS const bf16x8*)(Ks + (32 + r32) * KROW + d0 * 32 + hi * 16);
        p0 = __builtin_amdgcn_mfma_f32_32x32x16_bf16(b0, qr[d0], p0, 0, 0, 0);
        p1 = __builtin_amdgcn_mfma_f32_32x32x16_bf16(b1, qr[d0], p1, 0, 0, 0); }
}
template <int D0> __device__ __forceinline__ void pv_one(f32x16& od, int vb, bf16x8 pa0, bf16x8 pa1, bf16x8 pa2, bf16x8 pa3) {
    const s16x4 l0 = tr_read<v_rd_off(D0, 0, 0)>(vb), h0 = tr_read<v_rd_off(D0, 0, 1)>(vb), l1 = tr_read<v_rd_off(D0, 1, 0)>(vb), h1 = tr_read<v_rd_off(D0, 1, 1)>(vb);
    const s16x4 l2 = tr_read<v_rd_off(D0, 2, 0)>(vb), h2 = tr_read<v_rd_off(D0, 2, 1)>(vb), l3 = tr_read<v_rd_off(D0, 3, 0)>(vb), h3 = tr_read<v_rd_off(D0, 3, 1)>(vb);
    asm volatile("s_waitcnt lgkmcnt(0)" ::: "memory"); ASBAR();
#define PK(L, H) (bf16x8){L[0], L[1], L[2], L[3], H[0], H[1], H[2], H[3]}
    od = __builtin_amdgcn_mfma_f32_32x32x16_bf16(pa0, PK(l0, h0), od, 0, 0, 0);
    od = __builtin_amdgcn_mfma_f32_32x32x16_bf16(pa1, PK(l1, h1), od, 0, 0, 0);
    od = __builtin_amdgcn_mfma_f32_32x32x16_bf16(pa2, PK(l2, h2), od, 0, 0, 0);
    od = __builtin_amdgcn_mfma_f32_32x32x16_bf16(pa3, PK(l3, h3), od, 0, 0, 0);
#undef PK
}
__device__ __forceinline__ void attn_unit(const bf16_t* __restrict__ Qb, const bf16_t* __restrict__ Kh, const bf16_t* __restrict__ Vh, bf16_t* __restrict__ Ob, int seq, LAS unsigned char* lds) {
    int tid = threadIdx.x; asm volatile("" : "+v"(tid));
    const int wid = __builtin_amdgcn_readfirstlane(tid >> 6), lane = tid & 63, r32 = lane & 31, hi = lane >> 5;
    LAS float* wsf = (LAS float*)(lds + OFF_WS) + wid * 64; LAS float* li_l = wsf; LAS float* al_l = wsf + 32;
    float m_reg = -1e30f, l_reg = 0; f32x16 o[2] = {}; bf16x8 qr[6];
    const bf16_t* Qw = Qb + (size_t)(wid * 32 + r32) * 768 + hi * 8;
#pragma unroll
    for (int d0 = 0; d0 < 6; ++d0) qr[d0] = *(const bf16x8*)(Qw + d0 * 16);
    const bool isK = wid < 4; const int t = tid & 255;
    const unsigned char* gbase = isK ? (const unsigned char*)Kh : (const unsigned char*)Vh; const int tstride = isK ? 64 * 96 * 2 : 64 * 64 * 2;
    int loff0, loff1, loff2;
    { const int c0 = t, c1 = t + 256, c2 = t + 512;
      loff0 = isK ? (c0 / 12) * KROW + (c0 % 12) * 16 : v_st(c0 >> 3, (c0 & 7) * 8);
      loff1 = isK ? (c1 / 12) * KROW + (c1 % 12) * 16 : v_st(c1 >> 3, (c1 & 7) * 8);
      loff2 = (c2 / 12) * KROW + (c2 % 12) * 16; }
    const int vb0 = (int)(uintptr_t)(lds) + v_rd_base(lane);
    bf16x8 sA0, sA1, sA2, sB0, sB1, sB2;
#define SLOAD(S, tile) do { const unsigned char* p_ = gbase + (size_t)(tile) * tstride + t * 16; S##0 = *(const bf16x8*)(p_); S##1 = *(const bf16x8*)(p_ + 4096); if (isK) S##2 = *(const bf16x8*)(p_ + 8192); } while (0)
#define SWRITE(b, S) do { LAS unsigned char* d_ = lds + (isK ? OFF_K + (b) * SHM_K : (b) * SHM_V); *(LAS bf16x8*)(d_ + loff0) = S##0; *(LAS bf16x8*)(d_ + loff1) = S##1; if (isK) *(LAS bf16x8*)(d_ + loff2) = S##2; } while (0)
#define RESC(a) do { if (__any((a) < 1.f)) { if (hi == 0) al_l[r32] = (a); asm volatile("s_waitcnt lgkmcnt(0)" ::: "memory"); \
    _Pragma("unroll") for (int d = 0; d < 2; ++d) _Pragma("unroll") for (int r = 0; r < 16; ++r) o[d][r] *= al_l[crow(r, hi)]; } } while (0)
    f32x16 pA0, pA1, pB0, pB1; float mnA, mnB, alA, alB; bf16x8 pa0, pa1, pa2, pa3; const int NT = seq / 64;
    LAS const unsigned char* K0 = lds + OFF_K; LAS const unsigned char* K1 = lds + OFF_K + SHM_K;
    SLOAD(sA, 0); SWRITE(0, sA); __syncthreads();
    qkt(pA0, pA1, K0, qr, r32, hi); partialSM(pA0, pA1, m_reg, mnA, alA);
    SLOAD(sB, 1); if (2 < NT) SLOAD(sA, 2);
    SWRITE(1, sB); __syncthreads();
    for (int j = 1; j + 1 < NT; j += 2) {
        ASBAR(); qkt(pB0, pB1, K1, qr, r32, hi);
        finishSM(pA0, pA1, alA, l_reg, pa0, pa1, pa2, pa3); ASBAR();
        SLOAD(sB, j + 2); ASBAR();
        pv_one<0>(o[0], vb0, pa0, pa1, pa2, pa3); pv_one<1>(o[1], vb0, pa0, pa1, pa2, pa3); partialSM(pB0, pB1, m_reg, mnB, alB);
        __syncthreads(); SWRITE(0, sA);
        RESC(alB); __syncthreads();
        ASBAR(); qkt(pA0, pA1, K0, qr, r32, hi);
        finishSM(pB0, pB1, alB, l_reg, pa0, pa1, pa2, pa3); ASBAR();
        if (j + 3 < NT) SLOAD(sA, j + 3); ASBAR();
        pv_one<0>(o[0], vb0 + SHM_V, pa0, pa1, pa2, pa3); pv_one<1>(o[1], vb0 + SHM_V, pa0, pa1, pa2, pa3); partialSM(pA0, pA1, m_reg, mnA, alA);
        __syncthreads(); SWRITE(1, sB);
        RESC(alA); __syncthreads();
    }
    ASBAR(); qkt(pB0, pB1, K1, qr, r32, hi);
    finishSM(pA0, pA1, alA, l_reg, pa0, pa1, pa2, pa3); ASBAR();
    pv_one<0>(o[0], vb0, pa0, pa1, pa2, pa3); pv_one<1>(o[1], vb0, pa0, pa1, pa2, pa3); partialSM(pB0, pB1, m_reg, mnB, alB);
    __syncthreads(); RESC(alB);
    finishSM(pB0, pB1, alB, l_reg, pa0, pa1, pa2, pa3); ASBAR();
    pv_one<0>(o[0], vb0 + SHM_V, pa0, pa1, pa2, pa3); pv_one<1>(o[1], vb0 + SHM_V, pa0, pa1, pa2, pa3);
    if (hi == 0) li_l[r32] = l_reg; asm volatile("s_waitcnt lgkmcnt(0)" ::: "memory");
    int hi_e = hi, r32_e = r32; asm volatile("" : "+v"(hi_e), "+v"(r32_e));
    bf16_t* Ow = Ob + (size_t)(wid * 32 + 4 * hi_e) * DM + r32_e;
#pragma unroll
    for (int r = 0; r < 16; ++r) { const int orow = (r & 3) + 8 * (r >> 2); const float rl = __builtin_amdgcn_rcpf(li_l[orow + 4 * hi_e]);
#pragma unroll
        for (int d0 = 0; d0 < 2; ++d0) Ow[(size_t)orow * DM + d0 * 32] = (bf16_t)(cvt_pk_bf16(o[d0][r] * rl, 0.f) & 0xffffu); }
    __syncthreads();
#undef SLOAD
#undef SWRITE
#undef RESC
}
#undef ASBAR
}

__device__ __forceinline__ void transpose_item(const float* W, int ldw, int K, bf16_t* WT, int k0, int n0, int dst_row0, LAS float* scr, int lane) {
#pragma unroll 8
    for (int i = 0; i < 32; ++i) { const int kk = 2 * i + (lane >> 5); scr[kk * 33 + (lane & 31)] = W[(size_t)(k0 + kk) * ldw + n0 + (lane & 31)]; }
    asm volatile("s_waitcnt lgkmcnt(0)" ::: "memory");
    const int c = lane & 7;
#pragma unroll
    for (int j = 0; j < 4; ++j) { const int n = (lane >> 3) + 8 * j; const LAS float* sp = scr + (8 * c) * 33 + n;
        u32x4 o; o.x = cvt_pk_bf16(sp[0 * 33], sp[1 * 33]); o.y = cvt_pk_bf16(sp[2 * 33], sp[3 * 33]); o.z = cvt_pk_bf16(sp[4 * 33], sp[5 * 33]); o.w = cvt_pk_bf16(sp[6 * 33], sp[7 * 33]);
        *(u32x4*)(WT + (size_t)(dst_row0 + n) * K + k0 + 8 * c) = o; }
    asm volatile("s_waitcnt lgkmcnt(0)" ::: "memory");
}


__device__ __forceinline__ void fold_item(const float* w_in_l, const float* w_pool_l, bf16_t* WT, int k0, int g, int dh, LAS float* scr, int lane) {
    float acc[32];
#pragma unroll
    for (int d = 0; d < 32; ++d) acc[d] = 0.f;
    const float* ar = w_in_l + (size_t)(k0 + lane) * DIN + 512 + 64 * g; const float* wp = w_pool_l + (size_t)g * 64 * 64 + 32 * dh;
    for (int cc = 0; cc < 64; ++cc) { const float av = ar[cc];
#pragma unroll
        for (int d = 0; d < 32; ++d) acc[d] += av * wp[cc * 64 + d]; }
#pragma unroll
    for (int d = 0; d < 32; ++d) scr[lane * 33 + d] = acc[d];
    asm volatile("s_waitcnt lgkmcnt(0)" ::: "memory");
    const int c = lane & 7;
#pragma unroll
    for (int j = 0; j < 4; ++j) { const int n = (lane >> 3) + 8 * j; const LAS float* sp = scr + (8 * c) * 33 + n;
        u32x4 o; o.x = cvt_pk_bf16(sp[0 * 33], sp[1 * 33]); o.y = cvt_pk_bf16(sp[2 * 33], sp[3 * 33]); o.z = cvt_pk_bf16(sp[4 * 33], sp[5 * 33]); o.w = cvt_pk_bf16(sp[6 * 33], sp[7 * 33]);
        *(u32x4*)(WT + (size_t)(512 + 64 * g + 32 * dh + n) * DM + k0 + 8 * c) = o; }
    asm volatile("s_waitcnt lgkmcnt(0)" ::: "memory");
}

struct MkArgs { const float* in[23]; float* out; unsigned char* ws; int ph_lo, ph_hi; };
constexpr int MK_LDS = 147456;
constexpr int MK_XL_OFF = 131072;
enum { PH_P0A = 0, PH_P0B = 1, PH_L0 = 2, PH_PER_LAYER = 6, PH_G1 = 0, PH_G2 = 1, PH_G3 = 2, PH_G4 = 3, PH_G5 = 4, PH_G6 = 5, PH_END = 14 };

__global__ void __launch_bounds__(512, 2) mk_fwd(MkArgs a) {
    extern __shared__ __attribute__((aligned(16))) unsigned char lds_raw[];
    LAS unsigned char* lds = (LAS unsigned char*)lds_raw; LAS unsigned char* xl = lds + MK_XL_OFF;
    const int tid = threadIdx.x, lane = tid & 63, wave = __builtin_amdgcn_readfirstlane(tid >> 6);
    const int G = gridDim.x; const int gw = blockIdx.x * 8 + wave, NGW = G * 8;
    unsigned char* ws = a.ws;
    float* XL = a.out; float* XC = (float*)(ws + WS_XC); float* MOD = (float*)(ws + WS_MOD);
    float* RSQ1 = (float*)(ws + WS_RSQ1); float* RSQ2 = (float*)(ws + WS_RSQ2); bf16_t* XG = (bf16_t*)(ws + WS_XG); bf16_t* MIX = (bf16_t*)(ws + WS_MIX); bf16_t* ACT = (bf16_t*)(ws + WS_ACT);
    float* BIAS2P = (float*)(ws + WS_BIAS2P);
    const float* norm1_g = a.in[4]; const float* norm2_g = a.in[5];
#define IN(k) (a.ph_lo <= (k) && (k) < a.ph_hi)
    if (IN(PH_P0A)) {
        LAS float* scr = (LAS float*)(lds + wave * 16384);
        for (int l = 0; l < DEPTH; ++l) {
            bf16_t* WB = (bf16_t*)(ws + WS_WB + (size_t)l * 22 * MiB);
            const float* w_out = a.in[20] + (size_t)l * DM * DM; const float* w_gu = a.in[21] + (size_t)l * DM * 2 * DFF; const float* w_dn = a.in[22] + (size_t)l * DFF * DM;
            const float* w_in = a.in[8] + (size_t)l * DM * DIN; const float* w_pool = a.in[12] + (size_t)l * 4 * 64 * 64;
            constexpr int I_OUT = 16 * 32, I_GU = 16 * 176, I_DN = 44 * 32, I_IN = 16 * 29, I_FOLD = 16 * 8, I_Z = 96 * DM / 512, I_ALL = I_OUT + I_GU + I_DN + I_IN + I_FOLD + I_Z;
            for (int it = gw; it < I_ALL; it += NGW) { int r = it;
                if (r < I_IN) { const int kb = r / 29, nq = r % 29, nb = nq < 16 ? nq : nq + 8; transpose_item(w_in, DIN, DM, WB + WL_IN, kb * 64, nb * 32, nb * 32, scr, lane); continue; } r -= I_IN;
                if (r < I_FOLD) { const int kb = r >> 3, g = (r >> 1) & 3, dh = r & 1; fold_item(w_in, w_pool, WB + WL_IN, kb * 64, g, dh, scr, lane); continue; } r -= I_FOLD;
                if (r < I_Z) { *(u32x4*)(WB + WL_IN + (size_t)DIN * DM + (size_t)r * 512 + lane * 8) = (u32x4){0u, 0u, 0u, 0u}; continue; } r -= I_Z;
                if (r < I_OUT) { const int kb = r / 32, nb = r % 32; transpose_item(w_out, DM, DM, WB + WL_OUT, kb * 64, nb * 32, nb * 32, scr, lane); continue; } r -= I_OUT;
                if (r < I_GU) { const int kb = r / 176, nb = r % 176; const int n0 = nb * 32, f = n0 % DFF, isup = n0 / DFF; transpose_item(w_gu, 2 * DFF, DM, WB + WL_GU, kb * 64, n0, 256 * (f / 128) + 128 * isup + (f % 128), scr, lane); continue; } r -= I_GU;
                { const int kb = r / 32, nb = r % 32; transpose_item(w_dn, DM, DFF, WB + WL_DN, kb * 64, nb * 32, nb * 32, scr, lane); }
            }
        }
    }
    if (IN(PH_P0B)) {
        float* BIAS1P = (float*)(ws + WS_BIAS1P);
        constexpr int NB_ROWS = 2 * DFF + 1280;
        for (int it = gw; it < DEPTH * NB_ROWS; it += NGW) { const int l = it / NB_ROWS; int n = it % NB_ROWS; const bool isgu = n < 2 * DFF; if (!isgu) n -= 2 * DFF;
            const bf16_t* wrow = (const bf16_t*)(ws + WS_WB + (size_t)l * 22 * MiB) + (isgu ? WL_GU : WL_IN) + (size_t)n * DM; const float* sh = MOD + (size_t)l * 5 * NMOD * DM + (isgu ? 3 : 0) * DM;
            float* outp = isgu ? BIAS2P + (size_t)l * 5 * 2 * DFF + n : BIAS1P + (size_t)l * 5 * 1280 + n; const int ldo = isgu ? 2 * DFF : 1280;
            float w[16]; { const u32x4 q0 = *(const u32x4*)(wrow + lane * 16), q1 = *(const u32x4*)(wrow + lane * 16 + 8);
#pragma unroll
                for (int j = 0; j < 4; ++j) { w[2 * j] = __uint_as_float(q0[j] << 16); w[2 * j + 1] = __uint_as_float(q0[j] & 0xffff0000u); w[8 + 2 * j] = __uint_as_float(q1[j] << 16); w[9 + 2 * j] = __uint_as_float(q1[j] & 0xffff0000u); } }
#pragma unroll
            for (int r = 0; r < 5; ++r) { const float* sv = sh + (size_t)r * NMOD * DM + lane * 16; float acc = 0.f;
#pragma unroll
                for (int j = 0; j < 16; ++j) acc += sv[j] * w[j];
                acc = wave_sum(acc); if (lane == 0) outp[(size_t)r * ldo] = acc; }
        }
    }
    for (int l = 0; l < DEPTH; ++l) {
        const int pb = PH_L0 + l * PH_PER_LAYER; const int Mrows = (l == 0) ? R : RL;
        const bf16_t* WB = (const bf16_t*)(ws + WS_WB + (size_t)l * 22 * MiB); const float* modl = MOD + (size_t)l * 5 * NMOD * DM;
        if (IN(pb + PH_G1)) {
            pg8::Gemm g{XG, WB + WL_IN, R, 1280, DM}; pg8::StaticOrder S; S.init(R, 1280, G, (int)blockIdx.x);
            EpiG1 E{RSQ1, (const float*)(ws + WS_BIAS1P) + (size_t)l * 5 * 1280, a.in[9] + l * 256, a.in[14] + l * 256, a.in[16] + l * 128,
                    (bf16_t*)(ws + WS_U), (bf16_t*)(ws + WS_VT), (bf16_t*)(ws + WS_BW), (bf16_t*)(ws + WS_QA), (bf16_t*)(ws + WS_KVA), (float*)(ws + WS_KR)};
            pg8::gemm_phase(lds, xl, g, S, E);
        }
        if (IN(pb + PH_G3)) {
            const bf16_t* Qp = (const bf16_t*)(ws + WS_Q); const bf16_t* Kp = (const bf16_t*)(ws + WS_K); const bf16_t* Vp = (const bf16_t*)(ws + WS_V);
            const int vcu = (G % 8 == 0) ? ((int)blockIdx.x % 8) * (G / 8) + (int)blockIdx.x / 8 : (int)blockIdx.x;
            const int nun = NB * NH * 16 + (l == 0 ? NB * NH : 0);
            for (int un = vcu; un < nun; un += G) {
                int bh, row0, seq;
                if (un < NB * NH * 16) { const int per = ((NB * NH * 16) % G == 0) ? (NB * NH * 16) / G : 0; const int v = per ? (un % G) * per + un / G : un; bh = v >> 4; row0 = (bh >> 3) * SEQ + (v & 15) * 256; seq = NKEY; }
                else { bh = un - NB * NH * 16; row0 = RL + (bh >> 3) * CTXL; seq = CTXL; }
                const int h = bh & 7;
                att::attn_unit(Qp + ((size_t)row0 * NH + h) * QKH, Kp + (size_t)bh * NKEY * QKH, Vp + (size_t)bh * NKEY * VD, MIX + (size_t)row0 * DM + 512 + h * 64, seq, lds);
            }
        }
        if (IN(pb + PH_G4)) {
            pg8::Gemm g{MIX, WB + WL_OUT, Mrows, DM, DM}; pg8::StaticOrder S; S.init(Mrows, DM, G, (int)blockIdx.x);
            EpiRes E{XL, XC, modl + 2 * DM, RSQ2, XG, norm2_g + l * DM, modl + 4 * DM, 1, 0};
            pg8::gemm_phase(lds, xl, g, S, E);
        }
        if (IN(pb + PH_G5)) {
            pg8::Gemm g{XG, WB + WL_GU, Mrows, 2 * DFF, DM}; pg8::StaticOrder S; S.init(Mrows, 2 * DFF, G, (int)blockIdx.x);
            EpiGU E{ACT, RSQ2, BIAS2P + (size_t)l * 5 * 2 * DFF};
            pg8::gemm_phase(lds, xl, g, S, E);
        }
        if (IN(pb + PH_G6)) {
            pg8::Gemm g{ACT, WB + WL_DN, Mrows, DM, DFF}; pg8::StaticOrder S; S.init(Mrows, DM, G, (int)blockIdx.x);
            const int nx = l + 1 < DEPTH;
            EpiRes E{XL, XC, modl + 5 * DM, RSQ1, XG, norm1_g + (nx ? (l + 1) * DM : 0), MOD + (size_t)(nx ? l + 1 : 0) * 5 * NMOD * DM + 1 * DM, nx, 0};
            pg8::gemm_phase(lds, xl, g, S, E);
        }
    }
#undef IN
}

extern "C" void kernel_launch(void* const* d_in, const int* in_sizes, int n_in, void* d_out, int out_size, void* d_ws, size_t ws_size, hipStream_t stream) {
    const float* x = (const float*)d_in[0]; const float* c = (const float*)d_in[1]; const float* ctx = (const float*)d_in[2]; const float* cctx = (const float*)d_in[3];
    const float* norm1_g = (const float*)d_in[4]; const float* norm2_g = (const float*)d_in[5]; const float* w_ada = (const float*)d_in[6]; const float* b_ada = (const float*)d_in[7];
    const float* w_in = (const float*)d_in[8]; const float* sgu_g = (const float*)d_in[9]; const float* w_sp = (const float*)d_in[10]; const float* b_sp = (const float*)d_in[11];
    const float* w_pool = (const float*)d_in[12]; const float* pscale = (const float*)d_in[13]; const float* qa_g = (const float*)d_in[14]; const float* w_qb = (const float*)d_in[15];
    const float* kva_g = (const float*)d_in[16]; const float* w_kvb = (const float*)d_in[17]; const float* qn_g = (const float*)d_in[18]; const float* kn_g = (const float*)d_in[19];
    const float* w_out = (const float*)d_in[20]; const float* w_gu = (const float*)d_in[21]; const float* w_dn = (const float*)d_in[22];
    if (ws_size < 256 * MiB) { fprintf(stderr, "ws too small: %zu\n", ws_size); return; }
    unsigned char* ws = (unsigned char*)d_ws;
    float* MOD = (float*)(ws + WS_MOD); float* BIAS1 = (float*)(ws + WS_BIAS1); float* BIAS2 = (float*)(ws + WS_BIAS2); float* ROPE = (float*)(ws + WS_ROPE);
    float* RSQ1 = (float*)(ws + WS_RSQ1); float* RSQ2 = (float*)(ws + WS_RSQ2); float* XL = (float*)d_out; float* XC = (float*)(ws + WS_XC);
    bf16_t* XG = (bf16_t*)(ws + WS_XG); bf16_t* MIX = (bf16_t*)(ws + WS_MIX); float* WF = (float*)(ws + 246 * MiB);
    bf16_t* ACT = (bf16_t*)(ws + WS_ACT); bf16_t* U = (bf16_t*)(ws + WS_U); bf16_t* VT = (bf16_t*)(ws + WS_VT); bf16_t* BW = (bf16_t*)(ws + WS_BW); bf16_t* QA = (bf16_t*)(ws + WS_QA);
    bf16_t* KVA = (bf16_t*)(ws + WS_KVA); float* KR = (float*)(ws + WS_KR); bf16_t* Q = (bf16_t*)(ws + WS_Q); bf16_t* Kb = (bf16_t*)(ws + WS_K); bf16_t* Vb = (bf16_t*)(ws + WS_V); float* P = (float*)(ws + WS_P);

    static int grid = 0;
    if (grid == 0) {
        int dev = 0, cus = 0, per_cu = 0;
        hipGetDevice(&dev); hipDeviceGetAttribute(&cus, hipDeviceAttributeMultiprocessorCount, dev);
        if (hipFuncSetAttribute((const void*)mk_fwd, hipFuncAttributeMaxDynamicSharedMemorySize, MK_LDS) != hipSuccess) { fprintf(stderr, "hipFuncSetAttribute failed\n"); return; }
        if (hipOccupancyMaxActiveBlocksPerMultiprocessor(&per_cu, (const void*)mk_fwd, 512, MK_LDS) != hipSuccess || per_cu < 1) { fprintf(stderr, "occupancy query: %d\n", per_cu); (void)hipGetLastError(); return; }
        grid = cus;
    }
    MkArgs ma{}; for (int i = 0; i < 23; ++i) ma.in[i] = (const float*)d_in[i]; ma.out = (float*)d_out; ma.ws = ws;
#define MK(lo, hi) do { ma.ph_lo = (lo); ma.ph_hi = (hi); hipLaunchKernelGGL(mk_fwd, dim3(grid), dim3(512), MK_LDS, stream, ma); } while (0)
    n_mod<<<dim3(NMOD * DM / 256, DEPTH), 256, 0, stream>>>(c, cctx, w_ada, b_ada, MOD);
    n_foldw<<<(unsigned)(((size_t)DEPTH * DM * DIN + 255) / 256), 256, 0, stream>>>(w_in, w_pool, WF);
    n_rope<<<2, 256, 0, stream>>>(ROPE);
    n_copy_in<<<(unsigned)((size_t)R * DM / 4 / 256), 256, 0, stream>>>(x, ctx, XL, XC);
    n_bias<<<dim3((DIN + 255) / 256, DEPTH), 256, 0, stream>>>(MOD, WF, BIAS1, 0, DIN, 1280, 0);
    n_bias<<<dim3(2 * DFF / 256, DEPTH), 256, 0, stream>>>(MOD, w_gu, BIAS2, 3, 2 * DFF, 2 * DFF, 0);
    n_rowprep<<<R / 4, 256, 0, stream>>>(XL, XC, norm1_g, MOD + 1 * DM, RSQ1, XG, R, 0);
    MK(PH_P0A, PH_P0A + 1); MK(PH_P0B, PH_P0B + 1);
    for (int l = 0; l < DEPTH; ++l) {
        const int pb = PH_L0 + l * PH_PER_LAYER;
        const float* modl = MOD + (size_t)l * 5 * NMOD * DM;
        const int Mrows = (l == 0) ? R : RL;
#if FAST_G1
        MK(pb + PH_G1, pb + PH_G1 + 1);
#else
        n_gemm<false, EpiStoreF32><<<dim3((DIN + 63) / 64, R / 64), 256, 0, stream>>>(XG, WF + (size_t)l * DM * DIN, DM, DIN, DIN, DM, 0, 0, EpiStoreF32{P, DIN, 0});
        n_g1_epi<<<R / 4, 256, 0, stream>>>(P, RSQ1, BIAS1 + (size_t)l * 5 * 1280, sgu_g + l * 256, qa_g + l * 256, kva_g + l * 128, U, VT, BW, QA, KVA, KR);
#endif
        n_spatial<<<Mrows, 256, 0, stream>>>(U, VT, w_sp + (size_t)l * 4 * 128 * 128, b_sp + l * 4 * 128, MIX);
        n_pool<<<Mrows, 256, 0, stream>>>(BW, pscale + l * 256, MIX);
        n_q<<<Mrows / 8, 256, 0, stream>>>(QA, w_qb + (size_t)l * 256 * 768, qn_g + l * 96, ROPE, Q, 0, 0);
        n_kv<<<R / 8, 256, 0, stream>>>(KVA, KR, w_kvb + (size_t)l * 128 * 1024, kn_g + l * 96, ROPE, Kb, Vb);
#if FAST_G3
        MK(pb + PH_G3, pb + PH_G3 + 1);
#else
        n_attn<<<NB * NH * 16, 256, 0, stream>>>(Q, Kb, Vb, MIX, 0, 0);
        if (l == 0) n_attn<<<NB * NH, 256, 0, stream>>>(Q, Kb, Vb, MIX, 1, 0);
#endif
#if FAST_G4
        MK(pb + PH_G4, pb + PH_G4 + 1);
#else
        n_gemm<false, EpiResid><<<dim3(DM / 64, Mrows / 64), 256, 0, stream>>>(MIX, w_out + (size_t)l * DM * DM, DM, DM, DM, DM, 0, 0, EpiResid{XL, XC, modl + 2 * DM});
        n_rowprep<<<Mrows / 4, 256, 0, stream>>>(XL, XC, norm2_g + l * DM, modl + 4 * DM, RSQ2, XG, Mrows, 0);
#endif
#if FAST_G5
        MK(pb + PH_G5, pb + PH_G5 + 1);
#else
        n_gemm<true, EpiAct><<<dim3(DFF / 64, Mrows / 64), 256, 0, stream>>>(XG, w_gu + (size_t)l * DM * 2 * DFF, DM, 2 * DFF, DFF, DM, DFF, 0, EpiAct{ACT, RSQ2, BIAS2 + (size_t)l * 5 * 2 * DFF});
#endif
#if FAST_G6
        MK(pb + PH_G6, pb + PH_G6 + 1);
#else
        n_gemm<false, EpiResid><<<dim3(DM / 64, Mrows / 64), 256, 0, stream>>>(ACT, w_dn + (size_t)l * DFF * DM, DFF, DM, DM, DFF, 0, 0, EpiResid{XL, XC, modl + 5 * DM});
        if (l + 1 < DEPTH) n_rowprep<<<R / 4, 256, 0, stream>>>(XL, XC, norm1_g + (l + 1) * DM, MOD + (size_t)(l + 1) * 5 * NMOD * DM + 1 * DM, RSQ1, XG, R, 0);
#endif
    }
}
```

```cpp
#include <hip/hip_runtime.h>
#include <cstdint>
#include <cstdio>
#define FUSED 1
#define FAST_G5 1
#define FAST_G2 1
#define FAST_G3 1
#define FAST_G1 1
#define FAST_G4 1
#define FAST_G6 1

constexpr int DM = 1024, NB = 4, SEQ = 4096, CTXL = 256, DEPTH = 2;
constexpr int RL = NB * SEQ;
constexpr int RC = NB * CTXL;
constexpr int R = RL + RC;
constexpr int WA = 256, DIN = 1184, DFF = 2816, NMOD = 6;
constexpr int NH = 8, QKH = 96, QKN = 64, QKR = 32, VD = 64, QRANK = 256, KVRANK = 128;
constexpr int NKEY = CTXL + SEQ;
constexpr float EPS = 1e-6f;
constexpr float QSCALE = 0.10206207261596577f * 1.4426950408889634f;

typedef unsigned short bf16_t;
__device__ __forceinline__ float bf2f(bf16_t v) { return __uint_as_float(((unsigned)v) << 16); }
__device__ __forceinline__ bf16_t f2bf(float f) { unsigned u = __float_as_uint(f); return (bf16_t)((u + 0x7fffu + ((u >> 16) & 1u)) >> 16); }
__device__ __forceinline__ int mrow_of(int r) { return r < RL ? (r >> 12) : 4; }
__device__ __forceinline__ float wave_sum(float v) {
#pragma unroll
    for (int o = 1; o < 64; o <<= 1) v += __shfl_xor(v, o);
    return v;
}
__device__ __forceinline__ float silu_f(float x) { return x / (1.f + __expf(-x)); }
__device__ __forceinline__ float gelu_f(float x) { return 0.5f * x * (1.f + erff(x * 0.70710678118654752f)); }

constexpr size_t MiB = 1u << 20;
constexpr size_t WS_MOD = 1 * MiB;
constexpr size_t WS_BIAS1 = WS_MOD + 256 * 1024;
constexpr size_t WS_BIAS2 = WS_BIAS1 + 64 * 1024;
constexpr size_t WS_ROPE = WS_BIAS2 + 256 * 1024;
constexpr size_t WS_RSQ1 = 2 * MiB;
constexpr size_t WS_RSQ2 = 2 * MiB + 512 * 1024;
constexpr size_t WS_XC = 4 * MiB;
constexpr size_t WS_XG = 8 * MiB;
constexpr size_t WS_MIX = 42 * MiB;
constexpr size_t WS_W = 76 * MiB;
constexpr size_t WS_OV = 120 * MiB;
constexpr size_t WS_ACT = WS_OV;
constexpr size_t WS_U = WS_OV;
constexpr size_t WS_VT = WS_U + (size_t)R * 256 * 2;
constexpr size_t WS_BW = WS_VT + (size_t)R * 256 * 2;
constexpr size_t WS_QA = WS_BW + (size_t)R * 256 * 2;
constexpr size_t WS_KVA = WS_QA + (size_t)R * 256 * 2;
constexpr size_t WS_KR = WS_KVA + (size_t)R * 128 * 2;
constexpr size_t WS_Q = 161 * MiB;
constexpr size_t WS_K = WS_Q + (size_t)R * 768 * 2;
constexpr size_t WS_V = WS_K + (size_t)NB * NH * NKEY * QKH * 2;
constexpr size_t WS_P = 161 * MiB;
static_assert(WS_KR + (size_t)R * 32 * 4 <= WS_Q, "map");
static_assert(WS_V + (size_t)NB * NH * NKEY * VD * 2 <= 256 * MiB, "map");
static_assert(WS_P + (size_t)R * DIN * 4 <= 256 * MiB, "map");
static_assert(WS_ACT + (size_t)R * DFF * 2 <= 256 * MiB, "map");

__global__ void __launch_bounds__(256) n_mod(const float* __restrict__ c, const float* __restrict__ cctx, const float* __restrict__ w_ada, const float* __restrict__ b_ada, float* __restrict__ MOD) {
    __shared__ float s[5][DM];
    const int l = blockIdx.y, n = blockIdx.x * 256 + threadIdx.x;
    for (int i = threadIdx.x; i < 5 * DM; i += 256) { const int mr = i / DM, k = i % DM; const float v = mr < 4 ? c[mr * DM + k] : cctx[k]; s[mr][k] = silu_f(v); }
    __syncthreads();
    float acc[5] = {0.f, 0.f, 0.f, 0.f, 0.f};
    const float* w = w_ada + (size_t)l * DM * (NMOD * DM) + n;
    for (int k = 0; k < DM; ++k) { const float wv = w[(size_t)k * (NMOD * DM)];
#pragma unroll
        for (int m = 0; m < 5; ++m) acc[m] += s[m][k] * wv; }
    const float bb = b_ada[l * NMOD * DM + n];
#pragma unroll
    for (int m = 0; m < 5; ++m) MOD[((size_t)l * 5 + m) * (NMOD * DM) + n] = acc[m] + bb;
}
__global__ void __launch_bounds__(256) n_foldw(const float* __restrict__ w_in, const float* __restrict__ w_pool, float* __restrict__ WF) {
    const size_t idx = (size_t)blockIdx.x * 256 + threadIdx.x; if (idx >= (size_t)DEPTH * DM * DIN) return;
    const int n = idx % DIN; const size_t lk = idx / DIN; const int l = lk / DM;
    float v;
    if (n >= 512 && n < 768) { const int g = (n - 512) >> 6, d = (n - 512) & 63; const float* wr = w_in + lk * DIN + 512 + g * 64; const float* wp = w_pool + ((size_t)(l * 4 + g) * 64) * 64 + d;
        float a = 0.f; for (int cc = 0; cc < 64; ++cc) a += wr[cc] * wp[cc * 64]; v = a; }
    else v = w_in[idx];
    WF[idx] = v;
}
__global__ void __launch_bounds__(256) n_bias(const float* __restrict__ MOD, const float* __restrict__ W, float* __restrict__ BIAS, int shift_idx, int N, int ldo, int pad_) {
    const int l = blockIdx.y, n = blockIdx.x * 256 + threadIdx.x; if (n >= N) return;
    float acc[5] = {0.f, 0.f, 0.f, 0.f, 0.f};
    const float* w = W + (size_t)l * DM * N + n; const float* m = MOD + (size_t)l * 5 * (NMOD * DM) + shift_idx * DM;
    for (int k = 0; k < DM; ++k) { const float wv = w[(size_t)k * N];
#pragma unroll
        for (int r = 0; r < 5; ++r) acc[r] += m[(size_t)r * (NMOD * DM) + k] * wv; }
#pragma unroll
    for (int r = 0; r < 5; ++r) BIAS[((size_t)l * 5 + r) * ldo + n] = acc[r];
}
__device__ void sincos_d(double x, double& s, double& c) {
    const double k = rint(x * 0.63661977236758134308); const double r = fma(-k, 1.5707963267948966192, x) - k * 6.123233995736766e-17;
    const double r2 = r * r;
    double sp = -7.6471637318198164759e-13; sp = sp * r2 + 1.6059043836821614599e-10; sp = sp * r2 - 2.5052108385441718775e-08; sp = sp * r2 + 2.7557319223985890653e-06; sp = sp * r2 - 1.9841269841269841270e-04; sp = sp * r2 + 8.3333333333333333333e-03; sp = sp * r2 - 1.6666666666666666667e-01; sp = r + r * r2 * sp;
    double cp = 4.7794773323873852974e-14; cp = cp * r2 - 1.1470745597729724714e-11; cp = cp * r2 + 2.0876756987868098979e-09; cp = cp * r2 - 2.7557319223985890653e-07; cp = cp * r2 + 2.4801587301587301587e-05; cp = cp * r2 - 1.3888888888888888889e-03; cp = cp * r2 + 4.1666666666666666667e-02; cp = cp * r2 - 0.5; cp = 1.0 + r2 * cp;
    const int q = ((int)k) & 3;
    s = (q == 0) ? sp : (q == 1) ? cp : (q == 2) ? -sp : -cp;
    c = (q == 0) ? cp : (q == 1) ? -sp : (q == 2) ? -cp : sp;
}
__global__ void n_rope(float* __restrict__ ROPE) {
    const int t = threadIdx.x + blockIdx.x * blockDim.x; if (t >= 512) return;
    const int pos = t >> 3, i = t & 7;
    const float inv = (float)exp2(-(double)i / 8.0 * 13.287712379549449);
    const float ang = (float)pos * inv;
    double s, c; sincos_d((double)ang, s, c);
    ROPE[t * 2] = (float)c; ROPE[t * 2 + 1] = (float)s;
}
__global__ void __launch_bounds__(256) n_copy_in(const float* __restrict__ x, const float* __restrict__ ctx, float* __restrict__ XL, float* __restrict__ XC) {
    const size_t i = ((size_t)blockIdx.x * 256 + threadIdx.x) * 4;
    if (i < (size_t)RL * DM) *(float4*)(XL + i) = *(const float4*)(x + i);
    else if (i < (size_t)R * DM) *(float4*)(XC + (i - (size_t)RL * DM)) = *(const float4*)(ctx + (i - (size_t)RL * DM));
}
__global__ void __launch_bounds__(256) n_rowprep(const float* __restrict__ XL, const float* __restrict__ XC, const float* __restrict__ g, const float* __restrict__ sc  ,
                                                 float* __restrict__ RSQ, bf16_t* __restrict__ XG, int nrows, int pad_) {
    const int r = blockIdx.x * 4 + (threadIdx.x >> 6), lane = threadIdx.x & 63; if (r >= nrows) return;
    const float* xr = r < RL ? XL + (size_t)r * DM : XC + (size_t)(r - RL) * DM; const float* scr = sc + (size_t)mrow_of(r) * (NMOD * DM);
    float ssv[4];
#pragma unroll
    for (int j = 0; j < 4; ++j) { const int k = j * 256 + lane * 4; const float4 v = *(const float4*)(xr + k); const float4 gg = *(const float4*)(g + k); const float4 s4 = *(const float4*)(scr + k);
        ssv[j] = wave_sum(v.x * v.x + v.y * v.y + v.z * v.z + v.w * v.w);
        ushort4 o; o.x = f2bf(v.x * gg.x * (1.f + s4.x)); o.y = f2bf(v.y * gg.y * (1.f + s4.y)); o.z = f2bf(v.z * gg.z * (1.f + s4.z)); o.w = f2bf(v.w * gg.w * (1.f + s4.w));
        *(ushort4*)(XG + (size_t)r * DM + k) = o; }
    if (lane == 0) *(float4*)(RSQ + (size_t)r * 4) = make_float4(ssv[0], ssv[1], ssv[2], ssv[3]);
}
__device__ __forceinline__ float rstd_of(const float* RSQ, int r) { const float4 p = *(const float4*)(RSQ + (size_t)r * 4); return rsqrtf(((p.x + p.y) + (p.z + p.w)) * (1.f / DM) + EPS); }

struct EpiStoreF32 { float* C; int ldc; int pad;
    __device__ void operator()(int row, int col, float a, float) const { C[(size_t)row * ldc + col] = a; } };
struct EpiResid { float* XL; float* XC; const float* gate;
    __device__ void operator()(int row, int col, float a, float) const { float* p = row < RL ? XL + (size_t)row * DM + col : XC + (size_t)(row - RL) * DM + col; *p += gate[(size_t)mrow_of(row) * (NMOD * DM) + col] * a; } };
struct EpiAct { bf16_t* ACT; const float* RSQ; const float* BIAS;
    __device__ void operator()(int row, int col, float a, float b) const { const float rs = rstd_of(RSQ, row); const float* bb = BIAS + (size_t)mrow_of(row) * (2 * DFF);
        const float gq = rs * a + bb[col], up = rs * b + bb[col + DFF]; ACT[(size_t)row * DFF + col] = f2bf(silu_f(gq) * up); } };
template <bool DUAL, class Epi>
__global__ void __launch_bounds__(256) n_gemm(const bf16_t* __restrict__ A, const float* __restrict__ B, int lda, int ldb, int N, int K, int dual_off, int pad_, Epi epi) {
    __shared__ float As[16][68]; __shared__ float Bs[16][64]; __shared__ float Bs2[DUAL ? 16 : 1][64];
    const int tid = threadIdx.x, tx = tid & 15, ty = tid >> 4; const int m0 = blockIdx.y * 64, n0 = blockIdx.x * 64;
    float acc[4][4], acc2[4][4];
#pragma unroll
    for (int i = 0; i < 4; ++i)
#pragma unroll
        for (int j = 0; j < 4; ++j) { acc[i][j] = 0.f; acc2[i][j] = 0.f; }
    for (int k0 = 0; k0 < K; k0 += 16) {
        { const int m = tid >> 2, kk = (tid & 3) * 4; const ushort4 a = *(const ushort4*)(A + (size_t)(m0 + m) * lda + k0 + kk);
          As[kk][m] = bf2f(a.x); As[kk + 1][m] = bf2f(a.y); As[kk + 2][m] = bf2f(a.z); As[kk + 3][m] = bf2f(a.w); }
        { const int kk = tid >> 4, n = (tid & 15) * 4;
#pragma unroll
          for (int j = 0; j < 4; ++j) { const int col = n0 + n + j; Bs[kk][n + j] = col < N ? B[(size_t)(k0 + kk) * ldb + col] : 0.f; if (DUAL) Bs2[kk][n + j] = col < N ? B[(size_t)(k0 + kk) * ldb + col + dual_off] : 0.f; } }
        __syncthreads();
#pragma unroll
        for (int kk = 0; kk < 16; ++kk) { float a[4], b[4], b2[4];
#pragma unroll
            for (int i = 0; i < 4; ++i) a[i] = As[kk][ty * 4 + i];
#pragma unroll
            for (int j = 0; j < 4; ++j) { b[j] = Bs[kk][tx * 4 + j]; if (DUAL) b2[j] = Bs2[kk][tx * 4 + j]; }
#pragma unroll
            for (int i = 0; i < 4; ++i)
#pragma unroll
                for (int j = 0; j < 4; ++j) { acc[i][j] += a[i] * b[j]; if (DUAL) acc2[i][j] += a[i] * b2[j]; } }
        __syncthreads();
    }
#pragma unroll
    for (int i = 0; i < 4; ++i)
#pragma unroll
        for (int j = 0; j < 4; ++j) { const int row = m0 + ty * 4 + i, col = n0 + tx * 4 + j; if (col < N) epi(row, col, acc[i][j], acc2[i][j]); }
}

__global__ void __launch_bounds__(256) n_g1_epi(const float* __restrict__ P, const float* __restrict__ RSQ1, const float* __restrict__ BIAS  ,
                                                const float* __restrict__ sgu_g, const float* __restrict__ qa_g, const float* __restrict__ kva_g,
                                                bf16_t* __restrict__ U, bf16_t* __restrict__ VT, bf16_t* __restrict__ BW, bf16_t* __restrict__ QA, bf16_t* __restrict__ KVA, float* __restrict__ KR) {
    const int r = blockIdx.x * 4 + (threadIdx.x >> 6), lane = threadIdx.x & 63; if (r >= R) return;
    const float rs = rstd_of(RSQ1, r); const float* p = P + (size_t)r * DIN; const float* bb = BIAS + (size_t)mrow_of(r) * 1280;
    const int c = lane * 4;
    float v[4];
#pragma unroll
    for (int j = 0; j < 4; ++j) v[j] = gelu_f(rs * p[c + j] + bb[c + j]);
    { ushort4 o; o.x = f2bf(v[0]); o.y = f2bf(v[1]); o.z = f2bf(v[2]); o.w = f2bf(v[3]); *(ushort4*)(U + (size_t)r * 256 + c) = o; }
    float ss = 0.f;
#pragma unroll
    for (int j = 0; j < 4; ++j) { v[j] = gelu_f(rs * p[256 + c + j] + bb[256 + c + j]); ss += v[j] * v[j]; }
    ss = wave_sum(ss); float rn = rsqrtf(ss * (1.f / 256.f) + EPS);
    { const int chunk = r >> 7, jj = r & 127;
#pragma unroll
      for (int j = 0; j < 4; ++j) VT[((size_t)chunk * 256 + c + j) * 128 + jj] = f2bf(v[j] * rn * sgu_g[c + j]); }
#pragma unroll
    for (int j = 0; j < 4; ++j) v[j] = rs * p[512 + c + j] + bb[512 + c + j];
    { ushort4 o; o.x = f2bf(v[0]); o.y = f2bf(v[1]); o.z = f2bf(v[2]); o.w = f2bf(v[3]); *(ushort4*)(BW + (size_t)r * 256 + c) = o; }
    ss = 0.f;
#pragma unroll
    for (int j = 0; j < 4; ++j) { v[j] = rs * p[768 + c + j] + bb[768 + c + j]; ss += v[j] * v[j]; }
    ss = wave_sum(ss); rn = rsqrtf(ss * (1.f / 256.f) + EPS);
    { ushort4 o; o.x = f2bf(v[0] * rn * qa_g[c]); o.y = f2bf(v[1] * rn * qa_g[c + 1]); o.z = f2bf(v[2] * rn * qa_g[c + 2]); o.w = f2bf(v[3] * rn * qa_g[c + 3]); *(ushort4*)(QA + (size_t)r * 256 + c) = o; }
    { const int c2 = lane * 2; float a0 = rs * p[1024 + c2] + bb[1024 + c2], a1 = rs * p[1024 + c2 + 1] + bb[1024 + c2 + 1];
      ss = wave_sum(a0 * a0 + a1 * a1); rn = rsqrtf(ss * (1.f / 128.f) + EPS);
      ushort2 o; o.x = f2bf(a0 * rn * kva_g[c2]); o.y = f2bf(a1 * rn * kva_g[c2 + 1]); *(ushort2*)(KVA + (size_t)r * 128 + c2) = o; }
    if (lane < 32) KR[(size_t)r * 32 + lane] = rs * p[1152 + lane] + bb[1152 + lane];
}

__global__ void __launch_bounds__(256) n_spatial(const bf16_t* __restrict__ U, const bf16_t* __restrict__ VT, const float* __restrict__ wsp  , const float* __restrict__ bsp  , bf16_t* __restrict__ MIX) {
    const int r = blockIdx.x, c = threadIdx.x, h = c >> 6, i = r & 127, chunk = r >> 7;
    const float* w = wsp + ((size_t)h * 128 + i) * 128; const bf16_t* vt = VT + ((size_t)chunk * 256 + c) * 128;
    float a = 0.f;
    for (int j = 0; j < 128; ++j) a += w[j] * bf2f(vt[j]);
    a += bsp[h * 128 + i];
    MIX[(size_t)r * DM + c] = f2bf(bf2f(U[(size_t)r * 256 + c]) * a);
}
__global__ void __launch_bounds__(256) n_pool(const bf16_t* __restrict__ BW, const float* __restrict__ pscale, bf16_t* __restrict__ MIX) {
    const int r = blockIdx.x, n = threadIdx.x, g = n >> 6, hw = 1 << g;
    int t, ntok, base; if (r < RL) { t = r & 4095; ntok = SEQ; base = r - t; } else { t = (r - RL) & 255; ntok = CTXL; base = r - t; }
    const int lo = max(t - hw, 0), hi = min(t + hw, ntok);
    float s = 0.f; for (int q = lo; q < hi; ++q) s += bf2f(BW[(size_t)(base + q) * 256 + n]);
    const float mean = s / (float)(hi - lo);
    MIX[(size_t)r * DM + 256 + n] = f2bf(pscale[n] * (mean - bf2f(BW[(size_t)r * 256 + n])));
}
__global__ void __launch_bounds__(256) n_q(const bf16_t* __restrict__ QA, const float* __restrict__ wqb  , const float* __restrict__ qn_g, const float* __restrict__ ROPE, bf16_t* __restrict__ Q, int row0, int pad_) {
    __shared__ float a[8][256]; __shared__ float q[8][768];
    const int tid = threadIdx.x, r0 = row0 + blockIdx.x * 8;
    for (int i = tid; i < 8 * 256; i += 256) a[i >> 8][i & 255] = bf2f(QA[(size_t)(r0 + (i >> 8)) * 256 + (i & 255)]);
    __syncthreads();
    float acc[3][8];
#pragma unroll
    for (int i = 0; i < 3; ++i)
#pragma unroll
        for (int m = 0; m < 8; ++m) acc[i][m] = 0.f;
    for (int k = 0; k < 256; ++k) { float w[3];
#pragma unroll
        for (int i = 0; i < 3; ++i) w[i] = wqb[(size_t)k * 768 + tid + 256 * i];
#pragma unroll
        for (int m = 0; m < 8; ++m) { const float av = a[m][k];
#pragma unroll
            for (int i = 0; i < 3; ++i) acc[i][m] += av * w[i]; } }
#pragma unroll
    for (int i = 0; i < 3; ++i)
#pragma unroll
        for (int m = 0; m < 8; ++m) q[m][tid + 256 * i] = acc[i][m];
    __syncthreads();
    if (tid < 64) { const int m = tid >> 3, h = tid & 7, r = r0 + m; float* qq = &q[m][h * 96];
        float ss = 0.f; for (int i = 0; i < 96; ++i) ss += qq[i] * qq[i];
        const float rn = rsqrtf(ss * (1.f / 96.f) + EPS);
        bf16_t* o = Q + ((size_t)r * NH + h) * QKH;
        for (int i = 0; i < 64; ++i) o[i] = f2bf(qq[i] * rn * qn_g[i] * QSCALE);
        const bool lat = r < RL; const int t = r & 4095;
        for (int pp = 0; pp < 16; ++pp) { float x1 = qq[64 + 2 * pp] * rn * qn_g[64 + 2 * pp], x2 = qq[65 + 2 * pp] * rn * qn_g[65 + 2 * pp];
            if (lat) { const int pos = pp < 8 ? (t >> 6) : (t & 63); const float cs = ROPE[(pos * 8 + (pp & 7)) * 2], sn = ROPE[(pos * 8 + (pp & 7)) * 2 + 1];
                const float y1 = x1 * cs - x2 * sn, y2 = x1 * sn + x2 * cs; x1 = y1; x2 = y2; }
            o[64 + 2 * pp] = f2bf(x1 * QSCALE); o[65 + 2 * pp] = f2bf(x2 * QSCALE); } }
}
__global__ void __launch_bounds__(256) n_kv(const bf16_t* __restrict__ KVA, const float* __restrict__ KR, const float* __restrict__ wkvb  , const float* __restrict__ kn_g, const float* __restrict__ ROPE,
                                            bf16_t* __restrict__ Kb, bf16_t* __restrict__ Vb) {
    __shared__ float a[8][128]; __shared__ float kv[8][1024];
    const int tid = threadIdx.x, r0 = blockIdx.x * 8;
    for (int i = tid; i < 8 * 128; i += 256) a[i >> 7][i & 127] = bf2f(KVA[(size_t)(r0 + (i >> 7)) * 128 + (i & 127)]);
    __syncthreads();
    float acc[4][8];
#pragma unroll
    for (int i = 0; i < 4; ++i)
#pragma unroll
        for (int m = 0; m < 8; ++m) acc[i][m] = 0.f;
    for (int k = 0; k < 128; ++k) { float w[4];
#pragma unroll
        for (int i = 0; i < 4; ++i) w[i] = wkvb[(size_t)k * 1024 + tid + 256 * i];
#pragma unroll
        for (int m = 0; m < 8; ++m) { const float av = a[m][k];
#pragma unroll
            for (int i = 0; i < 4; ++i) acc[i][m] += av * w[i]; } }
#pragma unroll
    for (int i = 0; i < 4; ++i)
#pragma unroll
        for (int m = 0; m < 8; ++m) kv[m][tid + 256 * i] = acc[i][m];
    __syncthreads();
    if (tid < 64) { const int m = tid >> 3, h = tid & 7, r = r0 + m; const float* kk = &kv[m][h * 128]; const float* kr = KR + (size_t)r * 32;
        const bool lat = r < RL; const int b = lat ? (r >> 12) : ((r - RL) >> 8), t = lat ? (r & 4095) : ((r - RL) & 255), key = lat ? CTXL + t : t;
        float ss = 0.f; for (int i = 0; i < 64; ++i) ss += kk[i] * kk[i]; for (int i = 0; i < 32; ++i) ss += kr[i] * kr[i];
        const float rn = rsqrtf(ss * (1.f / 96.f) + EPS);
        bf16_t* ko = Kb + (((size_t)b * NH + h) * NKEY + key) * QKH; bf16_t* vo = Vb + (((size_t)b * NH + h) * NKEY + key) * VD;
        for (int i = 0; i < 64; ++i) ko[i] = f2bf(kk[i] * rn * kn_g[i]);
        for (int pp = 0; pp < 16; ++pp) { float x1 = kr[2 * pp] * rn * kn_g[64 + 2 * pp], x2 = kr[2 * pp + 1] * rn * kn_g[65 + 2 * pp];
            if (lat) { const int pos = pp < 8 ? (t >> 6) : (t & 63); const float cs = ROPE[(pos * 8 + (pp & 7)) * 2], sn = ROPE[(pos * 8 + (pp & 7)) * 2 + 1];
                const float y1 = x1 * cs - x2 * sn, y2 = x1 * sn + x2 * cs; x1 = y1; x2 = y2; }
            ko[64 + 2 * pp] = f2bf(x1); ko[65 + 2 * pp] = f2bf(x2); }
        for (int i = 0; i < 64; ++i) vo[i] = f2bf(kk[64 + i]); }
}
__global__ void __launch_bounds__(256) n_attn(const bf16_t* __restrict__ Q, const bf16_t* __restrict__ Kb, const bf16_t* __restrict__ Vb, bf16_t* __restrict__ MIX, int ctx_mode, int pad_) {
    __shared__ float Ks[32][96]; __shared__ float Vs[32][64];
    const int tid = threadIdx.x; int b, h, r, nkeys;
    if (!ctx_mode) { const int u = blockIdx.x; const int qb = u & 15; h = (u >> 4) & 7; b = u >> 7; r = b * SEQ + qb * 256 + tid; nkeys = NKEY; }
    else { const int u = blockIdx.x; h = u & 7; b = u >> 3; r = RL + b * CTXL + tid; nkeys = CTXL; }
    float q[96], o[64];
    { const bf16_t* qp = Q + ((size_t)r * NH + h) * QKH;
#pragma unroll
      for (int i = 0; i < 96; ++i) q[i] = bf2f(qp[i]); }
#pragma unroll
    for (int i = 0; i < 64; ++i) o[i] = 0.f;
    float m = -1e30f, l = 0.f;
    const bf16_t* kbase = Kb + ((size_t)b * NH + h) * NKEY * QKH; const bf16_t* vbase = Vb + ((size_t)b * NH + h) * NKEY * VD;
    for (int k0 = 0; k0 < nkeys; k0 += 32) {
        __syncthreads();
        for (int i = tid; i < 32 * 96; i += 256) Ks[i / 96][i % 96] = bf2f(kbase[(size_t)k0 * QKH + i]);
        for (int i = tid; i < 32 * 64; i += 256) Vs[i >> 6][i & 63] = bf2f(vbase[(size_t)k0 * VD + i]);
        __syncthreads();
        float s[32]; float mx = m;
#pragma unroll
        for (int j = 0; j < 32; ++j) { float a = 0.f;
#pragma unroll
            for (int i = 0; i < 96; ++i) a += q[i] * Ks[j][i];
            s[j] = a; mx = fmaxf(mx, a); }
        const float alpha = exp2f(m - mx); m = mx; l *= alpha;
#pragma unroll
        for (int i = 0; i < 64; ++i) o[i] *= alpha;
#pragma unroll
        for (int j = 0; j < 32; ++j) { const float p = exp2f(s[j] - m); l += p;
#pragma unroll
            for (int i = 0; i < 64; ++i) o[i] += p * Vs[j][i]; }
    }
    const float il = 1.f / l; bf16_t* op = MIX + (size_t)r * DM + 512 + h * 64;
#pragma unroll
    for (int i = 0; i < 64; ++i) op[i] = f2bf(o[i] * il);
}


#define LAS __attribute__((address_space(3)))
#define GAS __attribute__((address_space(1)))
typedef short bf16x8 __attribute__((ext_vector_type(8)));
typedef float f32x4 __attribute__((ext_vector_type(4)));
typedef float f32x2 __attribute__((ext_vector_type(2)));
typedef unsigned u32x4 __attribute__((ext_vector_type(4)));
typedef unsigned u32x2 __attribute__((ext_vector_type(2)));
__device__ __forceinline__ unsigned cvt_pk_bf16(float lo, float hi) { unsigned r; asm volatile("v_cvt_pk_bf16_f32 %0, %1, %2" : "=v"(r) : "v"(lo), "v"(hi)); return r; }
__device__ __forceinline__ float fast_silu(float x) { return x * __builtin_amdgcn_rcpf(1.f + __builtin_amdgcn_exp2f(-1.4426950408889634f * x)); }

constexpr size_t WL_IN = 0;
constexpr size_t WL_OUT = WL_IN + (size_t)1280 * 1024;
constexpr size_t WL_GU = WL_OUT + (size_t)1024 * 1024;
constexpr size_t WL_DN = WL_GU + (size_t)5632 * 1024;
constexpr size_t WL_QB = WL_DN + (size_t)1024 * 2816;
constexpr size_t WL_KVB = WL_QB + (size_t)768 * 256;
constexpr size_t WL_SP = WL_KVB + (size_t)1024 * 128;
constexpr size_t WL_END = WL_SP + (size_t)4 * 128 * 128;
static_assert(WL_END * 2 <= 22 * MiB, "weights per layer");
constexpr size_t WS_WB = WS_W;
constexpr size_t WS_BIAS2P = 3 * MiB;
constexpr size_t WS_BIAS1P = 3 * MiB + 256 * 1024;

namespace pg8 {
constexpr int BM = 256, BK = 64, HALF = 128, HTB = HALF * BK * 2, STAGE_BYTES = 8 * HTB, NXCD = 8, WGM = 8;
__host__ __device__ __forceinline__ int lds_byte(int r, int c) { const int st = (r >> 4) * 2 + (c >> 5), rr = r & 15, cc = c & 31, ob = rr * 64 + cc * 2; return st * 1024 + (ob ^ (((ob >> 9) & 1) << 5)); }
__host__ __device__ __forceinline__ void stage_rc(int b, int& Rr, int& C) { const int st = b / 1024, sb = b % 1024, swz = sb ^ (((sb >> 9) & 1) << 5); Rr = (st >> 1) * 16 + swz / 64; C = (st & 1) * 32 + (swz % 64) / 2; }
__host__ __device__ __forceinline__ int perm32(int rho) { const int n = rho >> 4, i = rho & 15; return 8 * (i >> 2) + 4 * n + (i & 3); }
struct Unit { int pm, pn; };
struct Gemm { const bf16_t* A; const bf16_t* Bt; int M, N, K; };
struct StaticOrder {
    int nM, nN, nwg, G, c;
    __device__ void init(int M, int N, int G_, int c_) { nM = M / BM; nN = N / BM; nwg = nM * nN; G = G_; c = c_; }
    __device__ bool next(int i, Unit& u) const {
        const long L = (long)i * G + c; if (L >= nwg) return false;
        int wgid = (int)L; { const int q = nwg / NXCD, r = nwg % NXCD, xcd = wgid % NXCD, off = wgid / NXCD; wgid = (xcd < r ? xcd * (q + 1) : r * (q + 1) + (xcd - r) * q) + off; }
        const int nig = WGM * nN, gid = wgid / nig, fm = gid * WGM, gsz = (nM - fm) < WGM ? (nM - fm) : WGM;
        u.pm = fm + ((wgid % nig) % gsz); u.pn = (wgid % nig) / gsz; return true;
    }
};
template <class Epi, class Sched>
__device__ __forceinline__ void gemm_phase(LAS unsigned char* lds, LAS unsigned char* xl, const Gemm g, const Sched& S, const Epi& E) {
    const int tid = threadIdx.x, wid = __builtin_amdgcn_readfirstlane(tid >> 6), lane = tid & 63, wr = wid >> 2, wc = wid & 3, fr = lane & 15, fq = lane >> 4;
    const int K = g.K, nt = K / BK;
    unsigned voffA[2], voffB[2];
#pragma unroll
    for (int i = 0; i < 2; ++i) { int Rr, C; stage_rc(tid * 16 + i * 8192, Rr, C); const int Rb = (Rr & ~31) + perm32(Rr & 31);
        voffA[i] = (unsigned)(Rr * K + C) * 2u; voffB[i] = (unsigned)(Rb * K + C) * 2u; }
    const size_t kstep = (size_t)(BK * 2);
    const size_t hstep = (size_t)HALF * K * 2;
    const size_t tstep = 2 * hstep;
    const unsigned ldsw = (unsigned)wid * 1024u;
    const int aoff = lds_byte(wr * 64 + fr, fq * 8), boff = lds_byte(wc * 32 + fr, fq * 8);
#define PG8_SA(b, h) (((b) * 2 + (h)) * HTB)
#define PG8_SB(b, h) ((4 + (b) * 2 + (h)) * HTB)
#define PG8_STAGE(bufoff, gbase, voff) do { _Pragma("unroll") for (int _i = 0; _i < 2; ++_i) \
        __builtin_amdgcn_global_load_lds((const unsigned*)((const char*)(gbase) + (voff)[_i]), (LAS unsigned*)(lds + (bufoff) + ldsw + _i * 8192), 16, 0, 0); } while (0)
#define PG8_LDA(dst, b, h) do { _Pragma("unroll") for (int m = 0; m < 4; ++m) _Pragma("unroll") for (int k = 0; k < 2; ++k) dst[m][k] = *(const LAS bf16x8*)(lds + PG8_SA(b, h) + aoff + m * 2048 + k * 1024); } while (0)
#define PG8_LDB(dst, b, h) do { _Pragma("unroll") for (int n = 0; n < 2; ++n) _Pragma("unroll") for (int k = 0; k < 2; ++k) dst[n][k] = *(const LAS bf16x8*)(lds + PG8_SB(b, h) + boff + n * 2048 + k * 1024); } while (0)
#define PG8_MMA(ai, bj, At, Bt) do { __builtin_amdgcn_s_setprio(1); _Pragma("unroll") for (int m = 0; m < 4; ++m) _Pragma("unroll") for (int n = 0; n < 2; ++n) _Pragma("unroll") for (int k = 0; k < 2; ++k) \
        acc[ai][bj][m][n] = __builtin_amdgcn_mfma_f32_16x16x32_bf16(Bt[n][k], At[m][k], acc[ai][bj][m][n], 0, 0, 0); __builtin_amdgcn_s_setprio(0); } while (0)
#define PG8_WAIT_V(n) asm volatile("s_waitcnt vmcnt(" #n ")" ::: "memory")
#define PG8_WAIT_L(n) asm volatile("s_waitcnt lgkmcnt(" #n ")" ::: "memory")
#define PG8_BAR __builtin_amdgcn_s_barrier()
#define PG8_SCHED __builtin_amdgcn_sched_barrier(0)
    Unit cur, nxt; int ui = 0;
    if (!S.next(0, cur)) return;
    f32x4 acc[2][2][4][2];
#pragma unroll
    for (int a = 0; a < 2; ++a)
#pragma unroll
        for (int b = 0; b < 2; ++b)
#pragma unroll
            for (int m = 0; m < 4; ++m)
#pragma unroll
                for (int n = 0; n < 2; ++n) acc[a][b][m][n] = (f32x4){0.f, 0.f, 0.f, 0.f};
    bf16x8 At[4][2], B0[2][2], B1[2][2];
    const char* cA = (const char*)g.A + (size_t)cur.pm * tstep; const char* cB = (const char*)g.Bt + (size_t)cur.pn * tstep;
    PG8_STAGE(PG8_SB(0, 0), cB, voffB); PG8_STAGE(PG8_SB(0, 1), cB + hstep, voffB); PG8_STAGE(PG8_SA(0, 0), cA, voffA); PG8_STAGE(PG8_SA(0, 1), cA + hstep, voffA);
    if (wr == 1) PG8_BAR;
    PG8_WAIT_V(2); PG8_BAR;
    PG8_STAGE(PG8_SB(1, 0), cB + kstep, voffB); PG8_STAGE(PG8_SA(1, 0), cA + kstep, voffA); PG8_STAGE(PG8_SB(1, 1), cB + hstep + kstep, voffB);
    PG8_WAIT_V(6); PG8_BAR;
    for (;;) {
        const bool has_next = S.next(ui + 1, nxt);
        const char* nA = has_next ? (const char*)g.A + (size_t)nxt.pm * tstep : cA; const char* nB = has_next ? (const char*)g.Bt + (size_t)nxt.pn * tstep : cB;
        for (int t = 0; t < nt; t += 2) {
            const bool last = (t == nt - 2);
            const char* a1 = cA + (size_t)(t + 1) * kstep;
            const char* a2 = last ? nA : cA + (size_t)(t + 2) * kstep; const char* b2 = last ? nB : cB + (size_t)(t + 2) * kstep;
            const char* a3 = a2 + kstep; const char* b3 = b2 + kstep;
            PG8_LDB(B0, 0, 0); PG8_LDB(B1, 0, 1); PG8_SCHED; PG8_LDA(At, 0, 0); PG8_STAGE(PG8_SA(1, 1), a1 + hstep, voffA);
            PG8_WAIT_V(8); PG8_WAIT_L(0); PG8_BAR; PG8_MMA(0, 0, At, B0); PG8_MMA(0, 1, At, B1); PG8_BAR; PG8_SCHED;
            PG8_LDA(At, 0, 1); PG8_STAGE(PG8_SB(0, 0), b2, voffB); PG8_STAGE(PG8_SB(0, 1), b2 + hstep, voffB); PG8_STAGE(PG8_SA(0, 0), a2, voffA);
            PG8_WAIT_V(8); PG8_WAIT_L(0); PG8_BAR; PG8_MMA(1, 0, At, B0); PG8_MMA(1, 1, At, B1); PG8_BAR; PG8_SCHED;
            PG8_LDB(B0, 1, 0); PG8_LDB(B1, 1, 1); PG8_SCHED; PG8_LDA(At, 1, 0); PG8_STAGE(PG8_SA(0, 1), a2 + hstep, voffA);
            PG8_WAIT_V(8); PG8_WAIT_L(0); PG8_BAR; PG8_MMA(0, 0, At, B0); PG8_MMA(0, 1, At, B1); PG8_BAR; PG8_SCHED;
            PG8_LDA(At, 1, 1); PG8_STAGE(PG8_SB(1, 0), b3, voffB); PG8_STAGE(PG8_SB(1, 1), b3 + hstep, voffB); PG8_STAGE(PG8_SA(1, 0), a3, voffA);
            PG8_WAIT_V(8); PG8_WAIT_L(0); PG8_BAR; PG8_MMA(1, 0, At, B0); PG8_MMA(1, 1, At, B1); PG8_BAR; PG8_SCHED;
        }
        if (wr == 0) PG8_BAR;
        { int fr_ = fr, fq_ = fq; asm volatile("" : "+v"(fr_), "+v"(fq_)); E(acc, cur, wr, wc, fr_, fq_, xl); }
        if (!has_next) break;
#pragma unroll
        for (int a = 0; a < 2; ++a)
#pragma unroll
            for (int b = 0; b < 2; ++b)
#pragma unroll
                for (int m = 0; m < 4; ++m)
#pragma unroll
                    for (int n = 0; n < 2; ++n) acc[a][b][m][n] = (f32x4){0.f, 0.f, 0.f, 0.f};
        cur = nxt; cA = nA; cB = nB; ++ui;
        if (wr == 1) PG8_BAR;
    }
    PG8_WAIT_V(0);
    PG8_BAR;
#undef PG8_SA
#undef PG8_SB
#undef PG8_STAGE
#undef PG8_LDA
#undef PG8_LDB
#undef PG8_MMA
}
}

__device__ __forceinline__ f32x4 ld4(const float* p) { return *(const f32x4*)p; }
struct EpiGU {
    bf16_t* ACT; const float* RSQ; const float* BIAS;
    __device__ __forceinline__ void operator()(f32x4 (&acc)[2][2][4][2], const pg8::Unit& u, int wr, int wc, int fr, int fq, LAS unsigned char*) const {
        const int row0 = u.pm * 256 + wr * 64 + fr; const int mr = mrow_of(u.pm * 256);
        const float* bb = BIAS + (size_t)mr * (2 * DFF) + u.pn * 256 + wc * 32 + 8 * fq;
        const f32x4 bg0 = ld4(bb), bg1 = ld4(bb + 4), bu0 = ld4(bb + 128), bu1 = ld4(bb + 132);
        bf16_t* ob = ACT + u.pn * 128 + wc * 32 + 8 * fq;
#pragma unroll
        for (int ai = 0; ai < 2; ++ai)
#pragma unroll
            for (int m = 0; m < 4; ++m) { const int row = row0 + ai * 128 + m * 16; const float rs = rstd_of(RSQ, row);
                const f32x4 g0 = acc[ai][0][m][0] * rs + bg0, g1 = acc[ai][0][m][1] * rs + bg1, u0 = acc[ai][1][m][0] * rs + bu0, u1 = acc[ai][1][m][1] * rs + bu1;
                u32x4 w; w.x = cvt_pk_bf16(fast_silu(g0[0]) * u0[0], fast_silu(g0[1]) * u0[1]); w.y = cvt_pk_bf16(fast_silu(g0[2]) * u0[2], fast_silu(g0[3]) * u0[3]);
                w.z = cvt_pk_bf16(fast_silu(g1[0]) * u1[0], fast_silu(g1[1]) * u1[1]); w.w = cvt_pk_bf16(fast_silu(g1[2]) * u1[2], fast_silu(g1[3]) * u1[3]);
                *(u32x4*)(ob + (size_t)row * DFF) = w; }
    }
};
struct EpiRes {
    float* XL; float* XC; const float* gate; float* RSQ; bf16_t* XG; const float* ng; const float* nsc; int do_next; int pad;
    __device__ __forceinline__ void operator()(f32x4 (&acc)[2][2][4][2], const pg8::Unit& u, int wr, int wc, int fr, int fq, LAS unsigned char* xl) const {
        const int mr = mrow_of(u.pm * 256); const int col0 = u.pn * 256 + wc * 32 + 8 * fq; const int rl0 = wr * 64 + fr;
        float* xbase = u.pm < 64 ? XL + (size_t)(u.pm * 256) * DM : XC + (size_t)(u.pm * 256 - RL) * DM;
        LAS float* P = (LAS float*)xl;
        float ss[8];
#pragma unroll
        for (int q = 0; q < 8; ++q) ss[q] = 0.f;
#pragma unroll
        for (int bj = 0; bj < 2; ++bj) {
            f32x4 gt[2], gm[2];
#pragma unroll
            for (int n = 0; n < 2; ++n) { const int c = col0 + bj * 128 + 4 * n; gt[n] = ld4(gate + (size_t)mr * (NMOD * DM) + c);
                if (do_next) gm[n] = ld4(ng + c) * (ld4(nsc + (size_t)mr * (NMOD * DM) + c) + 1.f); else gm[n] = (f32x4){0.f, 0.f, 0.f, 0.f}; }
#pragma unroll
            for (int ai = 0; ai < 2; ++ai)
#pragma unroll
                for (int m = 0; m < 4; ++m) { const int rl = rl0 + ai * 128 + m * 16; float* xp = xbase + (size_t)rl * DM + col0 + bj * 128;
                    const f32x4 y0 = ld4(xp) + gt[0] * acc[ai][bj][m][0], y1 = ld4(xp + 4) + gt[1] * acc[ai][bj][m][1];
                    *(f32x4*)(xp) = y0; *(f32x4*)(xp + 4) = y1;
                    if (do_next) { ss[ai * 4 + m] += (y0[0] * y0[0] + y0[1] * y0[1]) + (y0[2] * y0[2] + y0[3] * y0[3]) + (y1[0] * y1[0] + y1[1] * y1[1]) + (y1[2] * y1[2] + y1[3] * y1[3]);
                        const f32x4 z0 = y0 * gm[0], z1 = y1 * gm[1]; u32x4 w; w.x = cvt_pk_bf16(z0[0], z0[1]); w.y = cvt_pk_bf16(z0[2], z0[3]); w.z = cvt_pk_bf16(z1[0], z1[1]); w.w = cvt_pk_bf16(z1[2], z1[3]);
                        *(u32x4*)(XG + (size_t)(u.pm * 256 + rl) * DM + col0 + bj * 128) = w; }
                    if (m & 1) asm volatile("" ::: "memory"); }
        }
        if (do_next) {
#pragma unroll
            for (int q = 0; q < 8; ++q) { float t = ss[q]; t += __shfl_xor(t, 16); t += __shfl_xor(t, 32); if (fq == 0) P[(rl0 + (q >> 2) * 128 + (q & 3) * 16) * 4 + wc] = t; }
        }
        if (do_next) {
            asm volatile("s_waitcnt lgkmcnt(0)" ::: "memory"); __builtin_amdgcn_s_barrier(); asm volatile("" ::: "memory");
            const int tid = threadIdx.x;
            if (tid < 256) { const f32x4 p = *(const LAS f32x4*)(P + tid * 4); RSQ[(size_t)(u.pm * 256 + tid) * 4 + u.pn] = (p[0] + p[1]) + (p[2] + p[3]); }
        }
    }
};


__device__ __forceinline__ float gelu_fast(float v) {
    const float av = fabsf(v), d = av * 0.2316418882f + 1.0f, t = __builtin_amdgcn_rcpf(d);
    float q = t * 0.5307027145f + (-0.7265760135f); q = q * t + 0.7107068705f; q = q * t + (-0.142248368f); q = q * t + 0.127414796f; q = q * t;
    const float e = __builtin_amdgcn_exp2f((v * v) * (-0.72134752044f));
    const float m = v * (q * e), r = v - m; return v < 0.f ? m : r;
}
struct EpiG1 {
    const float* RSQ; const float* BIAS; const float* sgu_g; const float* qa_g; const float* kva_g;
    bf16_t* U; bf16_t* VT; bf16_t* BW; bf16_t* QA; bf16_t* KVA; float* KR;
#define G1_PACK(v0, v1) (u32x4){cvt_pk_bf16((v0)[0], (v0)[1]), cvt_pk_bf16((v0)[2], (v0)[3]), cvt_pk_bf16((v1)[0], (v1)[1]), cvt_pk_bf16((v1)[2], (v1)[3])}
#define G1_SS(v) (((v)[0] * (v)[0] + (v)[1] * (v)[1]) + ((v)[2] * (v)[2] + (v)[3] * (v)[3]))
    __device__ __forceinline__ void operator()(f32x4 (&acc)[2][2][4][2], const pg8::Unit& u, int wr, int wc, int fr, int fq, LAS unsigned char* xl) const {
        const int mr = mrow_of(u.pm * 256); const int cl = wc * 32 + 8 * fq; const int rl0 = wr * 64 + fr; const int pn = u.pn;
        LAS float* P = (LAS float*)xl;
        {   f32x4 bv[2][2];
#pragma unroll
            for (int bj = 0; bj < 2; ++bj)
#pragma unroll
                for (int n = 0; n < 2; ++n) bv[bj][n] = ld4(BIAS + (size_t)mr * 1280 + pn * 256 + bj * 128 + cl + 4 * n);
            const bool act = (pn <= 1);
#pragma unroll
            for (int ai = 0; ai < 2; ++ai)
#pragma unroll
                for (int m = 0; m < 4; ++m) { const float rs = rstd_of(RSQ, u.pm * 256 + rl0 + ai * 128 + m * 16);
#pragma unroll
                    for (int bj = 0; bj < 2; ++bj)
#pragma unroll
                        for (int n = 0; n < 2; ++n) { f32x4 v = acc[ai][bj][m][n] * rs + bv[bj][n];
                            if (act) v = (f32x4){gelu_fast(v[0]), gelu_fast(v[1]), gelu_fast(v[2]), gelu_fast(v[3])};
                            acc[ai][bj][m][n] = v; }
                    if (m & 1) asm volatile("" ::: "memory"); }
        }
        if (pn == 0) {
#pragma unroll
            for (int ai = 0; ai < 2; ++ai)
#pragma unroll
                for (int m = 0; m < 4; ++m) { const int row = u.pm * 256 + rl0 + ai * 128 + m * 16;
#pragma unroll
                    for (int bj = 0; bj < 2; ++bj) *(u32x4*)(U + (size_t)row * 256 + bj * 128 + cl) = G1_PACK(acc[ai][bj][m][0], acc[ai][bj][m][1]); }
            return;
        }
        if (pn == 2) {
#pragma unroll
            for (int ai = 0; ai < 2; ++ai)
#pragma unroll
                for (int m = 0; m < 4; ++m) { const int row = u.pm * 256 + rl0 + ai * 128 + m * 16;
#pragma unroll
                    for (int bj = 0; bj < 2; ++bj) *(u32x4*)(BW + (size_t)row * 256 + bj * 128 + cl) = G1_PACK(acc[ai][bj][m][0], acc[ai][bj][m][1]); }
            return;
        }
#pragma unroll
        for (int ai = 0; ai < 2; ++ai)
#pragma unroll
            for (int m = 0; m < 4; ++m) { float ss = G1_SS(acc[ai][0][m][0]) + G1_SS(acc[ai][0][m][1]);
                if (pn != 4) ss += G1_SS(acc[ai][1][m][0]) + G1_SS(acc[ai][1][m][1]);
                ss += __shfl_xor(ss, 16); ss += __shfl_xor(ss, 32);
                if (fq == 0) P[(rl0 + ai * 128 + m * 16) * 4 + wc] = ss; }
        asm volatile("s_waitcnt lgkmcnt(0)" ::: "memory"); __builtin_amdgcn_s_barrier(); asm volatile("" ::: "memory");
        if (pn == 1) {
#pragma unroll
            for (int bj = 0; bj < 2; ++bj) { const f32x4 g0 = ld4(sgu_g + bj * 128 + cl), g1 = ld4(sgu_g + bj * 128 + cl + 4);
#pragma unroll
                for (int ai = 0; ai < 2; ++ai)
#pragma unroll
                    for (int m = 0; m < 4; ++m) { const int rl = rl0 + ai * 128 + m * 16; const int row = u.pm * 256 + rl;
                        const f32x4 p = *(const LAS f32x4*)(P + rl * 4); const float rn = rsqrtf(((p[0] + p[1]) + (p[2] + p[3])) * (1.f / 256.f) + EPS);
                        const f32x4 v0 = acc[ai][bj][m][0] * rn * g0, v1 = acc[ai][bj][m][1] * rn * g1;
                        bf16_t* vt = VT + ((size_t)(row >> 7) * 256 + bj * 128 + cl) * 128 + (row & 127);
#pragma unroll
                        for (int i = 0; i < 4; ++i) { vt[(size_t)i * 128] = (bf16_t)(cvt_pk_bf16(v0[i], 0.f) & 0xffffu); vt[(size_t)(4 + i) * 128] = (bf16_t)(cvt_pk_bf16(v1[i], 0.f) & 0xffffu); } } }
        } else if (pn == 3) {
#pragma unroll
            for (int bj = 0; bj < 2; ++bj) { const f32x4 g0 = ld4(qa_g + bj * 128 + cl), g1 = ld4(qa_g + bj * 128 + cl + 4);
#pragma unroll
                for (int ai = 0; ai < 2; ++ai)
#pragma unroll
                    for (int m = 0; m < 4; ++m) { const int rl = rl0 + ai * 128 + m * 16; const int row = u.pm * 256 + rl;
                        const f32x4 p = *(const LAS f32x4*)(P + rl * 4); const float rn = rsqrtf(((p[0] + p[1]) + (p[2] + p[3])) * (1.f / 256.f) + EPS);
                        const f32x4 v0 = acc[ai][bj][m][0] * rn * g0, v1 = acc[ai][bj][m][1] * rn * g1;
                        *(u32x4*)(QA + (size_t)row * 256 + bj * 128 + cl) = G1_PACK(v0, v1); } }
        } else {
            const f32x4 g0 = ld4(kva_g + cl), g1 = ld4(kva_g + cl + 4);
#pragma unroll
            for (int ai = 0; ai < 2; ++ai)
#pragma unroll
                for (int m = 0; m < 4; ++m) { const int rl = rl0 + ai * 128 + m * 16; const int row = u.pm * 256 + rl;
                    const f32x4 p = *(const LAS f32x4*)(P + rl * 4); const float rn = rsqrtf(((p[0] + p[1]) + (p[2] + p[3])) * (1.f / 128.f) + EPS);
                    const f32x4 v0 = acc[ai][0][m][0] * rn * g0, v1 = acc[ai][0][m][1] * rn * g1;
                    *(u32x4*)(KVA + (size_t)row * 128 + cl) = G1_PACK(v0, v1);
                    if (wc == 0) { *(f32x4*)(KR + (size_t)row * 32 + 8 * fq) = acc[ai][1][m][0]; *(f32x4*)(KR + (size_t)row * 32 + 8 * fq + 4) = acc[ai][1][m][1]; } }
        }
    }
#undef G1_PACK
#undef G1_SS
};


namespace att {
using s16x4 = __attribute__((ext_vector_type(4))) short;
using f32x16 = __attribute__((ext_vector_type(16))) float;
constexpr int KROW = 208;
constexpr int SHM_V = 64 * 64 * 2, SHM_K = 64 * KROW, OFF_K = 2 * SHM_V, OFF_WS = OFF_K + 2 * SHM_K, SHM_ATTN = OFF_WS + 8 * 64 * 4;
constexpr float THRL = 8.f;
#define ASBAR() __builtin_amdgcn_sched_barrier(0)
__device__ __forceinline__ int crow(int r, int hi) { return (r & 3) + 8 * (r >> 2) + 4 * hi; }
__device__ __forceinline__ int v_st(int k, int c) { const int kk = (k & ~0xC) | ((k & 4) << 1) | ((k & 8) >> 1); return ((kk >> 3) * 2 + (c >> 5)) * 512 + ((kk & 7) * 32 + (c & 31)) * 2; }
__device__ __forceinline__ int v_rd_base(int lane) { return ((lane & 3) << 3) | (((lane >> 2) & 3) << 6) | (((lane >> 4) & 1) << 5) | (((lane >> 5) & 1) << 8); }
constexpr int v_rd_off(int d0, int ks, int half) { return d0 * 512 + ks * 2048 + half * 1024; }
template <int OFF> __device__ __forceinline__ s16x4 tr_read(int vb) { s16x4 r; asm volatile("ds_read_b64_tr_b16 %0, %1 offset:%2" : "=&v"(r) : "v"(vb), "i"(OFF) : "memory"); return r; }
__device__ __forceinline__ void partialSM(f32x16& p0, f32x16& p1, float& m_reg, float& mn, float& alpha) {
    float pmax = p0[0];
#pragma unroll
    for (int r = 1; r < 16; ++r) pmax = fmaxf(pmax, p0[r]);
#pragma unroll
    for (int r = 0; r < 16; ++r) pmax = fmaxf(pmax, p1[r]);
    { auto rr = __builtin_amdgcn_permlane32_swap(__float_as_uint(pmax), __float_as_uint(pmax), false, false); pmax = fmaxf(__uint_as_float(rr[0]), __uint_as_float(rr[1])); }
    if (__builtin_expect(__all(pmax - m_reg <= THRL), 1)) { mn = m_reg; alpha = 1.f; }
    else { mn = fmaxf(m_reg, pmax); alpha = __builtin_amdgcn_exp2f(m_reg - mn); m_reg = mn; }
#pragma unroll
    for (int r = 0; r < 16; ++r) p0[r] = p0[r] - mn;
#pragma unroll
    for (int r = 0; r < 16; ++r) p1[r] = p1[r] - mn;
#pragma unroll
    for (int r = 0; r < 16; ++r) p0[r] = __builtin_amdgcn_exp2f(p0[r]);
}
__device__ __forceinline__ void finishSM(f32x16& p0, f32x16& p1, float alpha, float& l_reg, bf16x8& pa0, bf16x8& pa1, bf16x8& pa2, bf16x8& pa3) {
#pragma unroll
    for (int r = 0; r < 16; ++r) p1[r] = __builtin_amdgcn_exp2f(p1[r]);
    float ps = 0;
#pragma unroll
    for (int r = 0; r < 16; ++r) ps += p0[r];
#pragma unroll
    for (int r = 0; r < 16; ++r) ps += p1[r];
    { auto rr = __builtin_amdgcn_permlane32_swap(__float_as_uint(ps), __float_as_uint(ps), false, false); ps = __uint_as_float(rr[0]) + __uint_as_float(rr[1]); }
    l_reg = l_reg * alpha + ps;
#define PK4(P, BASE, OUT) do { unsigned a0 = cvt_pk_bf16(P[BASE + 0], P[BASE + 1]), a1 = cvt_pk_bf16(P[BASE + 2], P[BASE + 3]);   \
    unsigned b0 = cvt_pk_bf16(P[BASE + 4], P[BASE + 5]), b1 = cvt_pk_bf16(P[BASE + 6], P[BASE + 7]);                              \
    auto r0 = __builtin_amdgcn_permlane32_swap(a0, b0, false, false); auto r1 = __builtin_amdgcn_permlane32_swap(a1, b1, false, false); \
    u32x4 w = {r0[0], r1[0], r0[1], r1[1]}; OUT = *reinterpret_cast<bf16x8*>(&w); } while (0)
    PK4(p0, 0, pa0); PK4(p0, 8, pa1); PK4(p1, 0, pa2); PK4(p1, 8, pa3);
#undef PK4
}
__device__ __forceinline__ void qkt(f32x16& p0, f32x16& p1, LAS const unsigned char* Ks, const bf16x8 (&qr)[6], int r32, int hi) {
    p0 = f32x16{}; p1 = f32x16{};
#pragma unroll
    for (int d0 = 0; d0 < 6; ++d0) {
        const bf16x8 b0 = *(LAS const bf16x8*)(Ks + r32 * KROW + d0 * 32 + hi * 16);
        const bf16x8 b1 = *(LAS const bf16x8*)(Ks + (32 + r32) * KROW + d0 * 32 + hi * 16);
        p0 = __builtin_amdgcn_mfma_f32_32x32x16_bf16(b0, qr[d0], p0, 0, 0, 0);
        p1 = __builtin_amdgcn_mfma_f32_32x32x16_bf16(b1, qr[d0], p1, 0, 0, 0); }
}
template <int D0> __device__ __forceinline__ void pv_one(f32x16& od, int vb, bf16x8 pa0, bf16x8 pa1, bf16x8 pa2, bf16x8 pa3) {
    const s16x4 l0 = tr_read<v_rd_off(D0, 0, 0)>(vb), h0 = tr_read<v_rd_off(D0, 0, 1)>(vb), l1 = tr_read<v_rd_off(D0, 1, 0)>(vb), h1 = tr_read<v_rd_off(D0, 1, 1)>(vb);
    const s16x4 l2 = tr_read<v_rd_off(D0, 2, 0)>(vb), h2 = tr_read<v_rd_off(D0, 2, 1)>(vb), l3 = tr_read<v_rd_off(D0, 3, 0)>(vb), h3 = tr_read<v_rd_off(D0, 3, 1)>(vb);
    asm volatile("s_waitcnt lgkmcnt(0)" ::: "memory"); ASBAR();
#define PK(L, H) (bf16x8){L[0], L[1], L[2], L[3], H[0], H[1], H[2], H[3]}
    od = __builtin_amdgcn_mfma_f32_32x32x16_bf16(pa0, PK(l0, h0), od, 0, 0, 0);
    od = __builtin_amdgcn_mfma_f32_32x32x16_bf16(pa1, PK(l1, h1), od, 0, 0, 0);
    od = __builtin_amdgcn_mfma_f32_32x32x16_bf16(pa2, PK(l2, h2), od, 0, 0, 0);
    od = __builtin_amdgcn_mfma_f32_32x32x16_bf16(pa3, PK(l3, h3), od, 0, 0, 0);
#undef PK
}
__device__ __forceinline__ void attn_unit(const bf16_t* __restrict__ Qb, const bf16_t* __restrict__ Kh, const bf16_t* __restrict__ Vh, bf16_t* __restrict__ Ob, int seq, LAS unsigned char* lds) {
    int tid = threadIdx.x; asm volatile("" : "+v"(tid));
    const int wid = __builtin_amdgcn_readfirstlane(tid >> 6), lane = tid & 63, r32 = lane & 31, hi = lane >> 5;
    LAS float* wsf = (LAS float*)(lds + OFF_WS) + wid * 64; LAS float* li_l = wsf; LAS float* al_l = wsf + 32;
    float m_reg = -1e30f, l_reg = 0; f32x16 o[2] = {}; bf16x8 qr[6];
    const bf16_t* Qw = Qb + (size_t)(wid * 32 + r32) * 768 + hi * 8;
#pragma unroll
    for (int d0 = 0; d0 < 6; ++d0) qr[d0] = *(const bf16x8*)(Qw + d0 * 16);
    const bool isK = wid < 4; const int t = tid & 255;
    const unsigned char* gbase = isK ? (const unsigned char*)Kh : (const unsigned char*)Vh; const int tstride = isK ? 64 * 96 * 2 : 64 * 64 * 2;
    int loff0, loff1, loff2;
    { const int c0 = t, c1 = t + 256, c2 = t + 512;
      loff0 = isK ? (c0 / 12) * KROW + (c0 % 12) * 16 : v_st(c0 >> 3, (c0 & 7) * 8);
      loff1 = isK ? (c1 / 12) * KROW + (c1 % 12) * 16 : v_st(c1 >> 3, (c1 & 7) * 8);
      loff2 = (c2 / 12) * KROW + (c2 % 12) * 16; }
    const int vb0 = (int)(uintptr_t)(lds) + v_rd_base(lane);
    bf16x8 sA0, sA1, sA2, sB0, sB1, sB2;
#define SLOAD(S, tile) do { const unsigned char* p_ = gbase + (size_t)(tile) * tstride + t * 16; S##0 = *(const bf16x8*)(p_); S##1 = *(const bf16x8*)(p_ + 4096); if (isK) S##2 = *(const bf16x8*)(p_ + 8192); } while (0)
#define SWRITE(b, S) do { LAS unsigned char* d_ = lds + (isK ? OFF_K + (b) * SHM_K : (b) * SHM_V); *(LAS bf16x8*)(d_ + loff0) = S##0; *(LAS bf16x8*)(d_ + loff1) = S##1; if (isK) *(LAS bf16x8*)(d_ + loff2) = S##2; } while (0)
#define RESC(a) do { if (__any((a) < 1.f)) { if (hi == 0) al_l[r32] = (a); asm volatile("s_waitcnt lgkmcnt(0)" ::: "memory"); \
    _Pragma("unroll") for (int d = 0; d < 2; ++d) _Pragma("unroll") for (int r = 0; r < 16; ++r) o[d][r] *= al_l[crow(r, hi)]; } } while (0)
    f32x16 pA0, pA1, pB0, pB1; float mnA, mnB, alA, alB; bf16x8 pa0, pa1, pa2, pa3; const int NT = seq / 64;
    LAS const unsigned char* K0 = lds + OFF_K; LAS const unsigned char* K1 = lds + OFF_K + SHM_K;
    SLOAD(sA, 0); SWRITE(0, sA); __syncthreads();
    qkt(pA0, pA1, K0, qr, r32, hi); partialSM(pA0, pA1, m_reg, mnA, alA);
    SLOAD(sB, 1); if (2 < NT) SLOAD(sA, 2);
    SWRITE(1, sB); __syncthreads();
    for (int j = 1; j + 1 < NT; j += 2) {
        ASBAR(); qkt(pB0, pB1, K1, qr, r32, hi);
        finishSM(pA0, pA1, alA, l_reg, pa0, pa1, pa2, pa3); ASBAR();
        SLOAD(sB, j + 2); ASBAR();
        pv_one<0>(o[0], vb0, pa0, pa1, pa2, pa3); pv_one<1>(o[1], vb0, pa0, pa1, pa2, pa3); partialSM(pB0, pB1, m_reg, mnB, alB);
        __syncthreads(); SWRITE(0, sA);
        RESC(alB); __syncthreads();
        ASBAR(); qkt(pA0, pA1, K0, qr, r32, hi);
        finishSM(pB0, pB1, alB, l_reg, pa0, pa1, pa2, pa3); ASBAR();
        if (j + 3 < NT) SLOAD(sA, j + 3); ASBAR();
        pv_one<0>(o[0], vb0 + SHM_V, pa0, pa1, pa2, pa3); pv_one<1>(o[1], vb0 + SHM_V, pa0, pa1, pa2, pa3); partialSM(pA0, pA1, m_reg, mnA, alA);
        __syncthreads(); SWRITE(1, sB);
        RESC(alA); __syncthreads();
    }
    ASBAR(); qkt(pB0, pB1, K1, qr, r32, hi);
    finishSM(pA0, pA1, alA, l_reg, pa0, pa1, pa2, pa3); ASBAR();
    pv_one<0>(o[0], vb0, pa0, pa1, pa2, pa3); pv_one<1>(o[1], vb0, pa0, pa1, pa2, pa3); partialSM(pB0, pB1, m_reg, mnB, alB);
    __syncthreads(); RESC(alB);
    finishSM(pB0, pB1, alB, l_reg, pa0, pa1, pa2, pa3); ASBAR();
    pv_one<0>(o[0], vb0 + SHM_V, pa0, pa1, pa2, pa3); pv_one<1>(o[1], vb0 + SHM_V, pa0, pa1, pa2, pa3);
    if (hi == 0) li_l[r32] = l_reg; asm volatile("s_waitcnt lgkmcnt(0)" ::: "memory");
    int hi_e = hi, r32_e = r32; asm volatile("" : "+v"(hi_e), "+v"(r32_e));
    bf16_t* Ow = Ob + (size_t)(wid * 32 + 4 * hi_e) * DM + r32_e;
#pragma unroll
    for (int r = 0; r < 16; ++r) { const int orow = (r & 3) + 8 * (r >> 2); const float rl = __builtin_amdgcn_rcpf(li_l[orow + 4 * hi_e]);
#pragma unroll
        for (int d0 = 0; d0 < 2; ++d0) Ow[(size_t)orow * DM + d0 * 32] = (bf16_t)(cvt_pk_bf16(o[d0][r] * rl, 0.f) & 0xffffu); }
    __syncthreads();
#undef SLOAD
#undef SWRITE
#undef RESC
}
#undef ASBAR
}


namespace g2 {
using f32x16 = __attribute__((ext_vector_type(16))) float;
__device__ __forceinline__ int crow(int r, int hi) { return (r & 3) + 8 * (r >> 2) + 4 * hi; }
__device__ __forceinline__ float half_swap_sum(float v) { auto rr = __builtin_amdgcn_permlane32_swap(__float_as_uint(v), __float_as_uint(v), false, false); return __uint_as_float(rr[0]) + __uint_as_float(rr[1]); }
__device__ __forceinline__ void rope_pair(const float* __restrict__ ROPE, int t, int pp, float& x1, float& x2) {
    const int pos = pp < 8 ? (t >> 6) : (t & 63); const f32x2 cs = *(const f32x2*)(ROPE + (pos * 8 + (pp & 7)) * 2);
    const float y1 = x1 * cs[0] - x2 * cs[1], y2 = x1 * cs[1] + x2 * cs[0]; x1 = y1; x2 = y2;
}
__device__ __forceinline__ void q_item(const bf16_t* __restrict__ QA, const bf16_t* __restrict__ WQ, const float* __restrict__ qn_g, const float* __restrict__ ROPE, bf16_t* __restrict__ Q, int row0, int h, int lane) {
    const int r32 = lane & 31, hi = lane >> 5;
    f32x16 acc[2][3];
#pragma unroll
    for (int tg = 0; tg < 2; ++tg)
#pragma unroll
        for (int b = 0; b < 3; ++b) acc[tg][b] = f32x16{};
    const bf16_t* wp = WQ + (size_t)(96 * h + r32) * 256 + 8 * hi; const bf16_t* ap = QA + (size_t)(row0 + r32) * 256 + 8 * hi;
#pragma unroll 4
    for (int ks = 0; ks < 16; ++ks) {
        const bf16x8 b0 = *(const bf16x8*)(ap + ks * 16), b1 = *(const bf16x8*)(ap + 32 * 256 + ks * 16);
#pragma unroll
        for (int b = 0; b < 3; ++b) { const bf16x8 wf = *(const bf16x8*)(wp + (size_t)b * 32 * 256 + ks * 16);
            acc[0][b] = __builtin_amdgcn_mfma_f32_32x32x16_bf16(wf, b0, acc[0][b], 0, 0, 0); acc[1][b] = __builtin_amdgcn_mfma_f32_32x32x16_bf16(wf, b1, acc[1][b], 0, 0, 0); } }
#pragma unroll
    for (int tg = 0; tg < 2; ++tg) { const int row = row0 + tg * 32 + r32; const bool lat = row < RL; const int t = row & 4095;
        float ss = 0.f;
#pragma unroll
        for (int b = 0; b < 3; ++b)
#pragma unroll
            for (int r = 0; r < 16; ++r) ss += acc[tg][b][r] * acc[tg][b][r];
        ss = half_swap_sum(ss); const float rn = rsqrtf(ss * (1.f / 96.f) + EPS) * QSCALE;
        bf16_t* qo = Q + ((size_t)row * NH + h) * QKH + 4 * hi;
#pragma unroll
        for (int b = 0; b < 3; ++b)
#pragma unroll
            for (int rq = 0; rq < 4; ++rq) { const int f0 = 32 * b + 8 * rq + 4 * hi; const f32x4 g = ld4(qn_g + f0);
                float v0 = acc[tg][b][4 * rq] * rn * g[0], v1 = acc[tg][b][4 * rq + 1] * rn * g[1], v2 = acc[tg][b][4 * rq + 2] * rn * g[2], v3 = acc[tg][b][4 * rq + 3] * rn * g[3];
                if (b == 2 && lat) { const int pp = 4 * rq + 2 * hi; rope_pair(ROPE, t, pp, v0, v1); rope_pair(ROPE, t, pp + 1, v2, v3); }
                *(u32x2*)(qo + 32 * b + 8 * rq) = (u32x2){cvt_pk_bf16(v0, v1), cvt_pk_bf16(v2, v3)}; } }
}
__device__ __forceinline__ void kv_item(const bf16_t* __restrict__ KVA, const float* __restrict__ KR, const bf16_t* __restrict__ WKV, const float* __restrict__ kn_g, const float* __restrict__ ROPE,
                                        bf16_t* __restrict__ Kb, bf16_t* __restrict__ Vb, int row0, int h, int lane) {
    const int r32 = lane & 31, hi = lane >> 5;
    f32x16 acc[4];
#pragma unroll
    for (int b = 0; b < 4; ++b) acc[b] = f32x16{};
    const bf16_t* wp = WKV + (size_t)(128 * h + r32) * 128 + 8 * hi; const bf16_t* ap = KVA + (size_t)(row0 + r32) * 128 + 8 * hi;
#pragma unroll 4
    for (int ks = 0; ks < 8; ++ks) { const bf16x8 b0 = *(const bf16x8*)(ap + ks * 16);
#pragma unroll
        for (int b = 0; b < 4; ++b) { const bf16x8 wf = *(const bf16x8*)(wp + (size_t)b * 32 * 128 + ks * 16); acc[b] = __builtin_amdgcn_mfma_f32_32x32x16_bf16(wf, b0, acc[b], 0, 0, 0); } }
    const int row = row0 + r32; const bool lat = row < RL; const int bb = lat ? (row >> 12) : ((row - RL) >> 8), t = lat ? (row & 4095) : ((row - RL) & 255), key = lat ? CTXL + t : t;
    float kr[16];
    { const float* krp = KR + (size_t)row * 32 + 16 * hi;
#pragma unroll
      for (int q = 0; q < 4; ++q) { const f32x4 v = ld4(krp + 4 * q); kr[4 * q] = v[0]; kr[4 * q + 1] = v[1]; kr[4 * q + 2] = v[2]; kr[4 * q + 3] = v[3]; } }
    float ss = 0.f;
#pragma unroll
    for (int b = 0; b < 2; ++b)
#pragma unroll
        for (int r = 0; r < 16; ++r) ss += acc[b][r] * acc[b][r];
#pragma unroll
    for (int i = 0; i < 16; ++i) ss += kr[i] * kr[i];
    ss = half_swap_sum(ss); const float rn = rsqrtf(ss * (1.f / 96.f) + EPS);
    bf16_t* ko = Kb + (((size_t)bb * NH + h) * NKEY + key) * QKH; bf16_t* vo = Vb + (((size_t)bb * NH + h) * NKEY + key) * VD;
#pragma unroll
    for (int b = 0; b < 2; ++b)
#pragma unroll
        for (int rq = 0; rq < 4; ++rq) { const int f0 = 32 * b + 8 * rq + 4 * hi; const f32x4 g = ld4(kn_g + f0);
            *(u32x2*)(ko + f0) = (u32x2){cvt_pk_bf16(acc[b][4 * rq] * rn * g[0], acc[b][4 * rq + 1] * rn * g[1]), cvt_pk_bf16(acc[b][4 * rq + 2] * rn * g[2], acc[b][4 * rq + 3] * rn * g[3])};
            *(u32x2*)(vo + f0) = (u32x2){cvt_pk_bf16(acc[2 + b][4 * rq], acc[2 + b][4 * rq + 1]), cvt_pk_bf16(acc[2 + b][4 * rq + 2], acc[2 + b][4 * rq + 3])}; }
    unsigned pk[8];
#pragma unroll
    for (int q = 0; q < 8; ++q) { float x1 = kr[2 * q] * rn * kn_g[64 + 16 * hi + 2 * q], x2 = kr[2 * q + 1] * rn * kn_g[65 + 16 * hi + 2 * q];
        if (lat) rope_pair(ROPE, t, 8 * hi + q, x1, x2);
        pk[q] = cvt_pk_bf16(x1, x2); }
    *(u32x4*)(ko + 64 + 16 * hi) = (u32x4){pk[0], pk[1], pk[2], pk[3]}; *(u32x4*)(ko + 72 + 16 * hi) = (u32x4){pk[4], pk[5], pk[6], pk[7]};
}
__device__ __forceinline__ void sp_item(const bf16_t* __restrict__ VT, const bf16_t* __restrict__ WSP, const float* __restrict__ bsp, const bf16_t* __restrict__ U, bf16_t* __restrict__ MIX, int chunk, int h, int ih, int lane) {
    const int r32 = lane & 31, hi = lane >> 5;
    f32x16 acc[2][2];
#pragma unroll
    for (int cb = 0; cb < 2; ++cb)
#pragma unroll
        for (int ib = 0; ib < 2; ++ib) acc[cb][ib] = f32x16{};
    const bf16_t* vp = VT + ((size_t)chunk * 256 + 64 * h + r32) * 128 + 8 * hi; const bf16_t* wp = WSP + ((size_t)h * 128 + 64 * ih + r32) * 128 + 8 * hi;
#pragma unroll 4
    for (int ks = 0; ks < 8; ++ks) { const bf16x8 a0 = *(const bf16x8*)(vp + ks * 16), a1 = *(const bf16x8*)(vp + 32 * 128 + ks * 16), b0 = *(const bf16x8*)(wp + ks * 16), b1 = *(const bf16x8*)(wp + 32 * 128 + ks * 16);
        acc[0][0] = __builtin_amdgcn_mfma_f32_32x32x16_bf16(a0, b0, acc[0][0], 0, 0, 0); acc[0][1] = __builtin_amdgcn_mfma_f32_32x32x16_bf16(a0, b1, acc[0][1], 0, 0, 0);
        acc[1][0] = __builtin_amdgcn_mfma_f32_32x32x16_bf16(a1, b0, acc[1][0], 0, 0, 0); acc[1][1] = __builtin_amdgcn_mfma_f32_32x32x16_bf16(a1, b1, acc[1][1], 0, 0, 0); }
#pragma unroll
    for (int ib = 0; ib < 2; ++ib) { const int i = 64 * ih + 32 * ib + r32; const float bias = bsp[h * 128 + i]; const size_t row = (size_t)chunk * 128 + i;
#pragma unroll
        for (int cb = 0; cb < 2; ++cb)
#pragma unroll
            for (int rq = 0; rq < 4; ++rq) { const int c = 64 * h + 32 * cb + 8 * rq + 4 * hi; const u32x2 uu = *(const u32x2*)(U + row * 256 + c);
                const float u0 = __uint_as_float(uu[0] << 16), u1 = __uint_as_float(uu[0] & 0xffff0000u), u2 = __uint_as_float(uu[1] << 16), u3 = __uint_as_float(uu[1] & 0xffff0000u);
                *(u32x2*)(MIX + row * DM + c) = (u32x2){cvt_pk_bf16(u0 * (acc[cb][ib][4 * rq] + bias), u1 * (acc[cb][ib][4 * rq + 1] + bias)), cvt_pk_bf16(u2 * (acc[cb][ib][4 * rq + 2] + bias), u3 * (acc[cb][ib][4 * rq + 3] + bias))}; } }
}
__device__ __forceinline__ void pool_item(const bf16_t* __restrict__ BW, const float* __restrict__ pscale, bf16_t* __restrict__ MIX, int row0, int lane) {
    const int row = row0 + (lane >> 5), n0 = (lane & 31) * 8, g = n0 >> 6, hw = 1 << g;
    int t, ntok; if (row < RL) { t = row & 4095; ntok = SEQ; } else { t = (row - RL) & 255; ntok = CTXL; }
    const int base = row - t, lo = max(t - hw, 0), hi = min(t + hw, ntok);
    float s[8];
#pragma unroll
    for (int j = 0; j < 8; ++j) s[j] = 0.f;
    for (int q = lo; q < hi; ++q) { const u32x4 v = *(const u32x4*)(BW + (size_t)(base + q) * 256 + n0);
#pragma unroll
        for (int j = 0; j < 4; ++j) { s[2 * j] += __uint_as_float(v[j] << 16); s[2 * j + 1] += __uint_as_float(v[j] & 0xffff0000u); } }
    const float inv = 1.f / (float)(hi - lo); const u32x4 v = *(const u32x4*)(BW + (size_t)row * 256 + n0); const f32x4 p0 = ld4(pscale + n0), p1 = ld4(pscale + n0 + 4);
    float z[8];
#pragma unroll
    for (int j = 0; j < 4; ++j) { z[2 * j] = s[2 * j] * inv - __uint_as_float(v[j] << 16); z[2 * j + 1] = s[2 * j + 1] * inv - __uint_as_float(v[j] & 0xffff0000u); }
    *(u32x4*)(MIX + (size_t)row * DM + 256 + n0) = (u32x4){cvt_pk_bf16(z[0] * p0[0], z[1] * p0[1]), cvt_pk_bf16(z[2] * p0[2], z[3] * p0[3]), cvt_pk_bf16(z[4] * p1[0], z[5] * p1[1]), cvt_pk_bf16(z[6] * p1[2], z[7] * p1[3])};
}
}

__device__ __forceinline__ void transpose_item(const float* W, int ldw, int K, bf16_t* WT, int k0, int n0, int dst_row0, LAS float* scr, int lane) {
#pragma unroll 8
    for (int i = 0; i < 32; ++i) { const int kk = 2 * i + (lane >> 5); scr[kk * 33 + (lane & 31)] = W[(size_t)(k0 + kk) * ldw + n0 + (lane & 31)]; }
    asm volatile("s_waitcnt lgkmcnt(0)" ::: "memory");
    const int c = lane & 7;
#pragma unroll
    for (int j = 0; j < 4; ++j) { const int n = (lane >> 3) + 8 * j; const LAS float* sp = scr + (8 * c) * 33 + n;
        u32x4 o; o.x = cvt_pk_bf16(sp[0 * 33], sp[1 * 33]); o.y = cvt_pk_bf16(sp[2 * 33], sp[3 * 33]); o.z = cvt_pk_bf16(sp[4 * 33], sp[5 * 33]); o.w = cvt_pk_bf16(sp[6 * 33], sp[7 * 33]);
        *(u32x4*)(WT + (size_t)(dst_row0 + n) * K + k0 + 8 * c) = o; }
    asm volatile("s_waitcnt lgkmcnt(0)" ::: "memory");
}


__device__ __forceinline__ void fold_item(const float* w_in_l, const float* w_pool_l, bf16_t* WT, int k0, int g, int dh, LAS float* scr, int lane) {
    float acc[32];
#pragma unroll
    for (int d = 0; d < 32; ++d) acc[d] = 0.f;
    const float* ar = w_in_l + (size_t)(k0 + lane) * DIN + 512 + 64 * g; const float* wp = w_pool_l + (size_t)g * 64 * 64 + 32 * dh;
    for (int cc = 0; cc < 64; ++cc) { const float av = ar[cc];
#pragma unroll
        for (int d = 0; d < 32; ++d) acc[d] += av * wp[cc * 64 + d]; }
#pragma unroll
    for (int d = 0; d < 32; ++d) scr[lane * 33 + d] = acc[d];
    asm volatile("s_waitcnt lgkmcnt(0)" ::: "memory");
    const int c = lane & 7;
#pragma unroll
    for (int j = 0; j < 4; ++j) { const int n = (lane >> 3) + 8 * j; const LAS float* sp = scr + (8 * c) * 33 + n;
        u32x4 o; o.x = cvt_pk_bf16(sp[0 * 33], sp[1 * 33]); o.y = cvt_pk_bf16(sp[2 * 33], sp[3 * 33]); o.z = cvt_pk_bf16(sp[4 * 33], sp[5 * 33]); o.w = cvt_pk_bf16(sp[6 * 33], sp[7 * 33]);
        *(u32x4*)(WT + (size_t)(512 + 64 * g + 32 * dh + n) * DM + k0 + 8 * c) = o; }
    asm volatile("s_waitcnt lgkmcnt(0)" ::: "memory");
}

#define XB_TMO      128
#define XB_XCNT(j)  (256  + 64 * (j))
#define XB_XSUB(j)  (1280 + 64 * (j))
#define XB_XGEN(j)  (2304 + 64 * (j))
#define XB_TOP      3328
#define XB_TOPGEN   3392
#define XCD_BAR_WORDS 3456
#define XB_SPIN_CAP (1u << 18)
__device__ __forceinline__ unsigned xb_ld(unsigned* p)              { return __hip_atomic_load(p, __ATOMIC_RELAXED, __HIP_MEMORY_SCOPE_AGENT); }
__device__ __forceinline__ unsigned xb_add(unsigned* p, unsigned v) { return __hip_atomic_fetch_add(p, v, __ATOMIC_RELAXED, __HIP_MEMORY_SCOPE_AGENT); }
__device__ __forceinline__ unsigned xb_xcc_id() { return (unsigned)__builtin_amdgcn_s_getreg((3 << 11) | 20) & 0xFu; }
#define XB_SPIN(cond, bar) do { unsigned _sp = 0; while (cond) { __builtin_amdgcn_s_sleep(1); \
    if ((++_sp & 255u) == 0u) { if (xb_ld(&(bar)[XB_TMO])) break; if (_sp > XB_SPIN_CAP) { atomicAdd(&(bar)[XB_TMO], 1u); break; } } } } while (0)
struct XcdBarrier { unsigned* bar; unsigned x; volatile LAS unsigned* st; };
__device__ __forceinline__ XcdBarrier xcd_barrier_post(unsigned* bar, volatile LAS unsigned* st) {
    XcdBarrier b; b.bar = bar; b.x = xb_xcc_id(); b.st = st;
    if (threadIdx.x == 0) (void)xb_add(&bar[XB_XCNT(b.x)], 1u);
    return b;
}
__device__ __forceinline__ void xcd_barrier_complete(unsigned* bar, unsigned x, unsigned& nloc, unsigned& nx) {
    const unsigned G = gridDim.x * gridDim.y * gridDim.z;
    unsigned sum, cnt, mine, sp = 0u;
    for (;;) {
        sum = 0u; cnt = 0u; mine = 0u;
#pragma unroll
        for (unsigned j = 0; j < 16; ++j) { const unsigned c = xb_ld(&bar[XB_XCNT(j)]); sum += c; cnt += (c > 0u) ? 1u : 0u; mine = (j == x) ? c : mine; }
        if (sum == G) break;
        __builtin_amdgcn_s_sleep(1);
        if ((++sp & 255u) == 0u) { if (xb_ld(&bar[XB_TMO])) break; if (sp > XB_SPIN_CAP) { atomicAdd(&bar[XB_TMO], 1u); break; } }
    }
    nloc = mine > 0u ? mine : 1u; nx = cnt > 0u ? cnt : 1u;
}
__device__ __forceinline__ void xcd_barrier(const XcdBarrier& b) {
    asm volatile("s_waitcnt vmcnt(0)" ::: "memory");
    __syncthreads();
    if (threadIdx.x == 0) {
        unsigned* bar = b.bar;
        __builtin_amdgcn_s_waitcnt(0);
        unsigned nloc = b.st[0], nx = b.st[1];
        if (nloc == 0u) { xcd_barrier_complete(bar, b.x, nloc, nx); b.st[0] = nloc; b.st[1] = nx; }
        const unsigned old = xb_add(&bar[XB_XSUB(b.x)], 1u);
        const unsigned gen = old / nloc;
        if (old + 1u == (gen + 1u) * nloc) {
            __builtin_amdgcn_fence(__ATOMIC_RELEASE, "agent");
            asm volatile("s_waitcnt vmcnt(0)" ::: "memory");
            const unsigned og = xb_add(&bar[XB_TOP], 1u);
            const unsigned tg = og / nx;
            if (og + 1u == (tg + 1u) * nx) xb_add(&bar[XB_TOPGEN], 1u);
            else XB_SPIN(xb_ld(&bar[XB_TOPGEN]) == tg, bar);
            __builtin_amdgcn_fence(__ATOMIC_ACQUIRE, "agent");
            xb_add(&bar[XB_XGEN(b.x)], 1u);
            asm volatile("s_waitcnt vmcnt(0)" ::: "memory");
        } else {
            XB_SPIN(xb_ld(&bar[XB_XGEN(b.x)]) == gen, bar);
            __builtin_amdgcn_fence(__ATOMIC_ACQUIRE, "agent");
            asm volatile("s_waitcnt vmcnt(0)" ::: "memory");
        }
    }
    __syncthreads();
}

struct MkArgs { const float* in[23]; float* out; unsigned char* ws; int ph_lo, ph_hi; };
constexpr int MK_LDS = 147456;
constexpr int MK_XL_OFF = 131072;
enum { PH_P0A = 0, PH_P0B = 1, PH_L0 = 2, PH_PER_LAYER = 6, PH_G1 = 0, PH_G2 = 1, PH_G3 = 2, PH_G4 = 3, PH_G5 = 4, PH_G6 = 5, PH_END = 14 };

__global__ void __launch_bounds__(512, 2) mk_fwd(MkArgs a) {
    extern __shared__ __attribute__((aligned(16))) unsigned char lds_raw[];
    LAS unsigned char* lds = (LAS unsigned char*)lds_raw; LAS unsigned char* xl = lds + MK_XL_OFF;
    const int tid = threadIdx.x, lane = tid & 63, wave = __builtin_amdgcn_readfirstlane(tid >> 6);
    const int G = gridDim.x; const int gw = blockIdx.x * 8 + wave, NGW = G * 8;
    unsigned char* ws = a.ws;
    float* XL = a.out; float* XC = (float*)(ws + WS_XC); float* MOD = (float*)(ws + WS_MOD);
    float* RSQ1 = (float*)(ws + WS_RSQ1); float* RSQ2 = (float*)(ws + WS_RSQ2); bf16_t* XG = (bf16_t*)(ws + WS_XG); bf16_t* MIX = (bf16_t*)(ws + WS_MIX); bf16_t* ACT = (bf16_t*)(ws + WS_ACT);
    float* BIAS2P = (float*)(ws + WS_BIAS2P);
    const float* norm1_g = a.in[4]; const float* norm2_g = a.in[5];
#define IN(k) (a.ph_lo <= (k) && (k) < a.ph_hi)
    volatile LAS unsigned* bst = (volatile LAS unsigned*)(lds + MK_XL_OFF + 8192);
    if (tid < 4) bst[tid] = 0u;
    __syncthreads();
    const bool fused = (a.ph_hi - a.ph_lo) > 1;
    XcdBarrier gbar; gbar.bar = (unsigned*)ws; gbar.x = 0; gbar.st = bst;
    if (fused) gbar = xcd_barrier_post((unsigned*)ws, bst);
#define GRID_BAR(k) do { if (IN(k) && IN((k) + 1)) xcd_barrier(gbar); } while (0)
    if (IN(PH_P0A)) {
        {   LAS float* sl = (LAS float*)lds; LAS float* part = (LAS float*)(lds + 20480);
            for (int i = tid; i < 5 * DM; i += 512) { const int mr = i >> 10, k = i & 1023; const float v = mr < 4 ? a.in[1][mr * DM + k] : a.in[3][k]; sl[i] = silu_f(v); }
            __syncthreads();
            for (int strip = blockIdx.x; strip < DEPTH * 128; strip += G) { const int l = strip >> 7, n0 = (strip & 127) * 48;
                const int kg = tid / 12, c4 = tid % 12;
                if (tid < 504) { f32x4 acc[5];
#pragma unroll
                    for (int r = 0; r < 5; ++r) acc[r] = (f32x4){0.f, 0.f, 0.f, 0.f};
                    const float* wp = a.in[6] + (size_t)l * DM * (NMOD * DM) + n0 + c4 * 4;
#pragma unroll 4
                    for (int k = kg; k < DM; k += 42) { const f32x4 w = ld4(wp + (size_t)k * (NMOD * DM));
#pragma unroll
                        for (int r = 0; r < 5; ++r) acc[r] += w * sl[r * DM + k]; }
#pragma unroll
                    for (int r = 0; r < 5; ++r) *(LAS f32x4*)(part + (kg * 5 + r) * 48 + c4 * 4) = acc[r]; }
                __syncthreads();
                if (tid < 240) { const int r = tid / 48, c = tid % 48; float sum = 0.f;
                    for (int q = 0; q < 42; ++q) sum += part[(q * 5 + r) * 48 + c];
                    MOD[((size_t)l * 5 + r) * (NMOD * DM) + n0 + c] = sum + a.in[7][l * NMOD * DM + n0 + c]; }
                __syncthreads(); }
        }
        if (blockIdx.x == 0) { float* ROPE = (float*)(ws + WS_ROPE); const int pos = tid >> 3, i = tid & 7;
            const float inv = (float)exp2(-(double)i / 8.0 * 13.287712379549449); const float ang = (float)pos * inv;
            double sn, cs; sincos_d((double)ang, sn, cs); ROPE[tid * 2] = (float)cs; ROPE[tid * 2 + 1] = (float)sn; }
        LAS float* scr = (LAS float*)(lds + wave * 16384);
        for (int l = 0; l < DEPTH; ++l) {
            bf16_t* WB = (bf16_t*)(ws + WS_WB + (size_t)l * 22 * MiB);
            const float* w_out = a.in[20] + (size_t)l * DM * DM; const float* w_gu = a.in[21] + (size_t)l * DM * 2 * DFF; const float* w_dn = a.in[22] + (size_t)l * DFF * DM;
            const float* w_in = a.in[8] + (size_t)l * DM * DIN; const float* w_pool = a.in[12] + (size_t)l * 4 * 64 * 64;
            const float* w_qb = a.in[15] + (size_t)l * 256 * 768; const float* w_kvb = a.in[17] + (size_t)l * 128 * 1024; const float* w_sp = a.in[10] + (size_t)l * 4 * 128 * 128;
            constexpr int I_OUT = 16 * 32, I_GU = 16 * 176, I_DN = 44 * 32, I_IN = 16 * 29, I_FOLD = 16 * 8, I_Z = 96 * DM / 512, I_QB = 4 * 24, I_KVB = 2 * 32, I_SP = 4 * 128 * 128 / 512;
            constexpr int I_ALL = I_OUT + I_GU + I_DN + I_IN + I_FOLD + I_Z + I_QB + I_KVB + I_SP;
            for (int it = gw; it < I_ALL; it += NGW) { int r = it;
                if (r < I_QB) { const int kb = r / 24, nb = r % 24; transpose_item(w_qb, 768, 256, WB + WL_QB, kb * 64, nb * 32, nb * 32, scr, lane); continue; } r -= I_QB;
                if (r < I_KVB) { const int kb = r / 32, nb = r % 32; transpose_item(w_kvb, 1024, 128, WB + WL_KVB, kb * 64, nb * 32, nb * 32, scr, lane); continue; } r -= I_KVB;
                if (r < I_SP) { const float* sp_ = w_sp + (size_t)r * 512 + lane * 8; const f32x4 x0 = ld4(sp_), x1 = ld4(sp_ + 4);
                    *(u32x4*)(WB + WL_SP + (size_t)r * 512 + lane * 8) = (u32x4){cvt_pk_bf16(x0[0], x0[1]), cvt_pk_bf16(x0[2], x0[3]), cvt_pk_bf16(x1[0], x1[1]), cvt_pk_bf16(x1[2], x1[3])}; continue; } r -= I_SP;
                if (r < I_IN) { const int kb = r / 29, nq = r % 29, nb = nq < 16 ? nq : nq + 8; transpose_item(w_in, DIN, DM, WB + WL_IN, kb * 64, nb * 32, nb * 32, scr, lane); continue; } r -= I_IN;
                if (r < I_FOLD) { const int kb = r >> 3, g = (r >> 1) & 3, dh = r & 1; fold_item(w_in, w_pool, WB + WL_IN, kb * 64, g, dh, scr, lane); continue; } r -= I_FOLD;
                if (r < I_Z) { *(u32x4*)(WB + WL_IN + (size_t)DIN * DM + (size_t)r * 512 + lane * 8) = (u32x4){0u, 0u, 0u, 0u}; continue; } r -= I_Z;
                if (r < I_OUT) { const int kb = r / 32, nb = r % 32; transpose_item(w_out, DM, DM, WB + WL_OUT, kb * 64, nb * 32, nb * 32, scr, lane); continue; } r -= I_OUT;
                if (r < I_GU) { const int kb = r / 176, nb = r % 176; const int n0 = nb * 32, f = n0 % DFF, isup = n0 / DFF; transpose_item(w_gu, 2 * DFF, DM, WB + WL_GU, kb * 64, n0, 256 * (f / 128) + 128 * isup + (f % 128), scr, lane); continue; } r -= I_GU;
                { const int kb = r / 32, nb = r % 32; transpose_item(w_dn, DM, DFF, WB + WL_DN, kb * 64, nb * 32, nb * 32, scr, lane); }
            }
        }
    }
    GRID_BAR(PH_P0A);
    if (IN(PH_P0B)) {
        float* BIAS1P = (float*)(ws + WS_BIAS1P);
        constexpr int NB_ROWS = 2 * DFF + 1280;
        for (int it = gw; it < DEPTH * NB_ROWS; it += NGW) { const int l = it / NB_ROWS; int n = it % NB_ROWS; const bool isgu = n < 2 * DFF; if (!isgu) n -= 2 * DFF;
            const bf16_t* wrow = (const bf16_t*)(ws + WS_WB + (size_t)l * 22 * MiB) + (isgu ? WL_GU : WL_IN) + (size_t)n * DM; const float* sh = MOD + (size_t)l * 5 * NMOD * DM + (isgu ? 3 : 0) * DM;
            float* outp = isgu ? BIAS2P + (size_t)l * 5 * 2 * DFF + n : BIAS1P + (size_t)l * 5 * 1280 + n; const int ldo = isgu ? 2 * DFF : 1280;
            float w[16]; { const u32x4 q0 = *(const u32x4*)(wrow + lane * 16), q1 = *(const u32x4*)(wrow + lane * 16 + 8);
#pragma unroll
                for (int j = 0; j < 4; ++j) { w[2 * j] = __uint_as_float(q0[j] << 16); w[2 * j + 1] = __uint_as_float(q0[j] & 0xffff0000u); w[8 + 2 * j] = __uint_as_float(q1[j] << 16); w[9 + 2 * j] = __uint_as_float(q1[j] & 0xffff0000u); } }
#pragma unroll
            for (int r = 0; r < 5; ++r) { const float* sv = sh + (size_t)r * NMOD * DM + lane * 16; float acc = 0.f;
#pragma unroll
                for (int j = 0; j < 16; ++j) acc += sv[j] * w[j];
                acc = wave_sum(acc); if (lane == 0) outp[(size_t)r * ldo] = acc; }
        }
    }
    if (IN(PH_P0B)) {
        const float* sc = MOD + 1 * DM;
        for (int r = gw; r < R; r += NGW) {
            const float* xr = r < RL ? a.in[0] + (size_t)r * DM : a.in[2] + (size_t)(r - RL) * DM; float* xo = r < RL ? XL + (size_t)r * DM : XC + (size_t)(r - RL) * DM;
            const float* scr_ = sc + (size_t)mrow_of(r) * (NMOD * DM); float ssv[4];
#pragma unroll
            for (int j = 0; j < 4; ++j) { const int k = j * 256 + lane * 4; const f32x4 v = ld4(xr + k), gg = ld4(norm1_g + k), s4 = ld4(scr_ + k);
                *(f32x4*)(xo + k) = v; ssv[j] = wave_sum((v[0] * v[0] + v[1] * v[1]) + (v[2] * v[2] + v[3] * v[3]));
                const f32x4 z = v * gg * (s4 + 1.f); *(u32x2*)(XG + (size_t)r * DM + k) = (u32x2){cvt_pk_bf16(z[0], z[1]), cvt_pk_bf16(z[2], z[3])}; }
            if (lane == 0) *(f32x4*)(RSQ1 + (size_t)r * 4) = (f32x4){ssv[0], ssv[1], ssv[2], ssv[3]};
        }
    }
    GRID_BAR(PH_P0B);
    for (int l = 0; l < DEPTH; ++l) {
        const int pb = PH_L0 + l * PH_PER_LAYER; const int Mrows = (l == 0) ? R : RL;
        const bf16_t* WB = (const bf16_t*)(ws + WS_WB + (size_t)l * 22 * MiB); const float* modl = MOD + (size_t)l * 5 * NMOD * DM;
        if (IN(pb + PH_G1)) {
            pg8::Gemm g{XG, WB + WL_IN, R, 1280, DM}; pg8::StaticOrder S; S.init(R, 1280, G, (int)blockIdx.x);
            EpiG1 E{RSQ1, (const float*)(ws + WS_BIAS1P) + (size_t)l * 5 * 1280, a.in[9] + l * 256, a.in[14] + l * 256, a.in[16] + l * 128,
                    (bf16_t*)(ws + WS_U), (bf16_t*)(ws + WS_VT), (bf16_t*)(ws + WS_BW), (bf16_t*)(ws + WS_QA), (bf16_t*)(ws + WS_KVA), (float*)(ws + WS_KR)};
            pg8::gemm_phase(lds, xl, g, S, E);
        }
        GRID_BAR(pb + PH_G1);
        if (IN(pb + PH_G2)) {
            const bf16_t* Uq = (const bf16_t*)(ws + WS_U); const bf16_t* VTq = (const bf16_t*)(ws + WS_VT); const bf16_t* BWq = (const bf16_t*)(ws + WS_BW); const bf16_t* QAq = (const bf16_t*)(ws + WS_QA);
            const bf16_t* KVAq = (const bf16_t*)(ws + WS_KVA); const float* KRq = (const float*)(ws + WS_KR); const float* ROPEq = (const float*)(ws + WS_ROPE);
            bf16_t* Qo = (bf16_t*)(ws + WS_Q); bf16_t* Ko = (bf16_t*)(ws + WS_K); bf16_t* Vo = (bf16_t*)(ws + WS_V);
            const int nQ = (Mrows / 64) * NH, nKV = (R / 32) * NH, nSP = (Mrows / 128) * 8, nPL = Mrows / 2, nAll = nQ + nKV + nSP + nPL;
            for (int it = gw; it < nAll; it += NGW) { int r = it; int ln = lane; asm volatile("" : "+v"(ln));
                if (r < nQ) { g2::q_item(QAq, WB + WL_QB, a.in[18] + l * QKH, ROPEq, Qo, (r >> 3) * 64, r & 7, ln); continue; } r -= nQ;
                if (r < nKV) { g2::kv_item(KVAq, KRq, WB + WL_KVB, a.in[19] + l * QKH, ROPEq, Ko, Vo, (r >> 3) * 32, r & 7, ln); continue; } r -= nKV;
                if (r < nSP) { g2::sp_item(VTq, WB + WL_SP, a.in[11] + l * 4 * 128, Uq, MIX, r >> 3, (r >> 1) & 3, r & 1, ln); continue; } r -= nSP;
                g2::pool_item(BWq, a.in[13] + l * 256, MIX, r * 2, ln);
            }
        }
        GRID_BAR(pb + PH_G2);
        if (IN(pb + PH_G3)) {
            const bf16_t* Qp = (const bf16_t*)(ws + WS_Q); const bf16_t* Kp = (const bf16_t*)(ws + WS_K); const bf16_t* Vp = (const bf16_t*)(ws + WS_V);
            const int vcu = (G % 8 == 0) ? ((int)blockIdx.x % 8) * (G / 8) + (int)blockIdx.x / 8 : (int)blockIdx.x;
            const int nun = NB * NH * 16 + (l == 0 ? NB * NH : 0);
            for (int un = vcu; un < nun; un += G) {
                int bh, row0, seq;
                if (un < NB * NH * 16) { const int per = ((NB * NH * 16) % G == 0) ? (NB * NH * 16) / G : 0; const int v = per ? (un % G) * per + un / G : un; bh = v >> 4; row0 = (bh >> 3) * SEQ + (v & 15) * 256; seq = NKEY; }
                else { bh = un - NB * NH * 16; row0 = RL + (bh >> 3) * CTXL; seq = CTXL; }
                const int h = bh & 7;
                att::attn_unit(Qp + ((size_t)row0 * NH + h) * QKH, Kp + (size_t)bh * NKEY * QKH, Vp + (size_t)bh * NKEY * VD, MIX + (size_t)row0 * DM + 512 + h * 64, seq, lds);
            }
        }
        GRID_BAR(pb + PH_G3);
        if (IN(pb + PH_G4)) {
            pg8::Gemm g{MIX, WB + WL_OUT, Mrows, DM, DM}; pg8::StaticOrder S; S.init(Mrows, DM, G, (int)blockIdx.x);
            EpiRes E{XL, XC, modl + 2 * DM, RSQ2, XG, norm2_g + l * DM, modl + 4 * DM, 1, 0};
            pg8::gemm_phase(lds, xl, g, S, E);
        }
        GRID_BAR(pb + PH_G4);
        if (IN(pb + PH_G5)) {
            pg8::Gemm g{XG, WB + WL_GU, Mrows, 2 * DFF, DM}; pg8::StaticOrder S; S.init(Mrows, 2 * DFF, G, (int)blockIdx.x);
            EpiGU E{ACT, RSQ2, BIAS2P + (size_t)l * 5 * 2 * DFF};
            pg8::gemm_phase(lds, xl, g, S, E);
        }
        GRID_BAR(pb + PH_G5);
        if (IN(pb + PH_G6)) {
            pg8::Gemm g{ACT, WB + WL_DN, Mrows, DM, DFF}; pg8::StaticOrder S; S.init(Mrows, DM, G, (int)blockIdx.x);
            const int nx = l + 1 < DEPTH;
            EpiRes E{XL, XC, modl + 5 * DM, RSQ1, XG, norm1_g + (nx ? (l + 1) * DM : 0), MOD + (size_t)(nx ? l + 1 : 0) * 5 * NMOD * DM + 1 * DM, nx, 0};
            pg8::gemm_phase(lds, xl, g, S, E);
        }
        GRID_BAR(pb + PH_G6);
    }
#undef IN
}

extern "C" void kernel_launch(void* const* d_in, const int* in_sizes, int n_in, void* d_out, int out_size, void* d_ws, size_t ws_size, hipStream_t stream) {
    const float* x = (const float*)d_in[0]; const float* c = (const float*)d_in[1]; const float* ctx = (const float*)d_in[2]; const float* cctx = (const float*)d_in[3];
    const float* norm1_g = (const float*)d_in[4]; const float* norm2_g = (const float*)d_in[5]; const float* w_ada = (const float*)d_in[6]; const float* b_ada = (const float*)d_in[7];
    const float* w_in = (const float*)d_in[8]; const float* sgu_g = (const float*)d_in[9]; const float* w_sp = (const float*)d_in[10]; const float* b_sp = (const float*)d_in[11];
    const float* w_pool = (const float*)d_in[12]; const float* pscale = (const float*)d_in[13]; const float* qa_g = (const float*)d_in[14]; const float* w_qb = (const float*)d_in[15];
    const float* kva_g = (const float*)d_in[16]; const float* w_kvb = (const float*)d_in[17]; const float* qn_g = (const float*)d_in[18]; const float* kn_g = (const float*)d_in[19];
    const float* w_out = (const float*)d_in[20]; const float* w_gu = (const float*)d_in[21]; const float* w_dn = (const float*)d_in[22];
    if (ws_size < 256 * MiB) { fprintf(stderr, "ws too small: %zu\n", ws_size); return; }
    unsigned char* ws = (unsigned char*)d_ws;
    float* MOD = (float*)(ws + WS_MOD); float* BIAS1 = (float*)(ws + WS_BIAS1); float* BIAS2 = (float*)(ws + WS_BIAS2); float* ROPE = (float*)(ws + WS_ROPE);
    float* RSQ1 = (float*)(ws + WS_RSQ1); float* RSQ2 = (float*)(ws + WS_RSQ2); float* XL = (float*)d_out; float* XC = (float*)(ws + WS_XC);
    bf16_t* XG = (bf16_t*)(ws + WS_XG); bf16_t* MIX = (bf16_t*)(ws + WS_MIX); float* WF = (float*)(ws + 246 * MiB);
    bf16_t* ACT = (bf16_t*)(ws + WS_ACT); bf16_t* U = (bf16_t*)(ws + WS_U); bf16_t* VT = (bf16_t*)(ws + WS_VT); bf16_t* BW = (bf16_t*)(ws + WS_BW); bf16_t* QA = (bf16_t*)(ws + WS_QA);
    bf16_t* KVA = (bf16_t*)(ws + WS_KVA); float* KR = (float*)(ws + WS_KR); bf16_t* Q = (bf16_t*)(ws + WS_Q); bf16_t* Kb = (bf16_t*)(ws + WS_K); bf16_t* Vb = (bf16_t*)(ws + WS_V); float* P = (float*)(ws + WS_P);

    static int grid = 0;
    if (grid == 0) {
        int dev = 0, cus = 0, per_cu = 0;
        hipGetDevice(&dev); hipDeviceGetAttribute(&cus, hipDeviceAttributeMultiprocessorCount, dev);
        if (hipFuncSetAttribute((const void*)mk_fwd, hipFuncAttributeMaxDynamicSharedMemorySize, MK_LDS) != hipSuccess) { fprintf(stderr, "hipFuncSetAttribute failed\n"); return; }
        if (hipOccupancyMaxActiveBlocksPerMultiprocessor(&per_cu, (const void*)mk_fwd, 512, MK_LDS) != hipSuccess || per_cu < 1) { fprintf(stderr, "occupancy query: %d\n", per_cu); (void)hipGetLastError(); return; }
        grid = cus;
    }
    MkArgs ma{}; for (int i = 0; i < 23; ++i) ma.in[i] = (const float*)d_in[i]; ma.out = (float*)d_out; ma.ws = ws;
#define MK(lo, hi) do { ma.ph_lo = (lo); ma.ph_hi = (hi); hipLaunchKernelGGL(mk_fwd, dim3(grid), dim3(512), MK_LDS, stream, ma); } while (0)
#if FUSED
    hipMemsetAsync(ws, 0, 65536, stream);
    MK(0, PH_END);
    return;
#endif
    n_mod<<<dim3(NMOD * DM / 256, DEPTH), 256, 0, stream>>>(c, cctx, w_ada, b_ada, MOD);
    n_foldw<<<(unsigned)(((size_t)DEPTH * DM * DIN + 255) / 256), 256, 0, stream>>>(w_in, w_pool, WF);
    n_rope<<<2, 256, 0, stream>>>(ROPE);
    n_copy_in<<<(unsigned)((size_t)R * DM / 4 / 256), 256, 0, stream>>>(x, ctx, XL, XC);
    n_bias<<<dim3((DIN + 255) / 256, DEPTH), 256, 0, stream>>>(MOD, WF, BIAS1, 0, DIN, 1280, 0);
    n_bias<<<dim3(2 * DFF / 256, DEPTH), 256, 0, stream>>>(MOD, w_gu, BIAS2, 3, 2 * DFF, 2 * DFF, 0);
    n_rowprep<<<R / 4, 256, 0, stream>>>(XL, XC, norm1_g, MOD + 1 * DM, RSQ1, XG, R, 0);
    MK(PH_P0A, PH_P0A + 1); MK(PH_P0B, PH_P0B + 1);
    for (int l = 0; l < DEPTH; ++l) {
        const int pb = PH_L0 + l * PH_PER_LAYER;
        const float* modl = MOD + (size_t)l * 5 * NMOD * DM;
        const int Mrows = (l == 0) ? R : RL;
#if FAST_G1
        MK(pb + PH_G1, pb + PH_G1 + 1);
#else
        n_gemm<false, EpiStoreF32><<<dim3((DIN + 63) / 64, R / 64), 256, 0, stream>>>(XG, WF + (size_t)l * DM * DIN, DM, DIN, DIN, DM, 0, 0, EpiStoreF32{P, DIN, 0});
        n_g1_epi<<<R / 4, 256, 0, stream>>>(P, RSQ1, BIAS1 + (size_t)l * 5 * 1280, sgu_g + l * 256, qa_g + l * 256, kva_g + l * 128, U, VT, BW, QA, KVA, KR);
#endif
#if FAST_G2
        MK(pb + PH_G2, pb + PH_G2 + 1);
#else
        n_spatial<<<Mrows, 256, 0, stream>>>(U, VT, w_sp + (size_t)l * 4 * 128 * 128, b_sp + l * 4 * 128, MIX);
        n_pool<<<Mrows, 256, 0, stream>>>(BW, pscale + l * 256, MIX);
        n_q<<<Mrows / 8, 256, 0, stream>>>(QA, w_qb + (size_t)l * 256 * 768, qn_g + l * 96, ROPE, Q, 0, 0);
        n_kv<<<R / 8, 256, 0, stream>>>(KVA, KR, w_kvb + (size_t)l * 128 * 1024, kn_g + l * 96, ROPE, Kb, Vb);
#endif
#if FAST_G3
        MK(pb + PH_G3, pb + PH_G3 + 1);
#else
        n_attn<<<NB * NH * 16, 256, 0, stream>>>(Q, Kb, Vb, MIX, 0, 0);
        if (l == 0) n_attn<<<NB * NH, 256, 0, stream>>>(Q, Kb, Vb, MIX, 1, 0);
#endif
#if FAST_G4
        MK(pb + PH_G4, pb + PH_G4 + 1);
#else
        n_gemm<false, EpiResid><<<dim3(DM / 64, Mrows / 64), 256, 0, stream>>>(MIX, w_out + (size_t)l * DM * DM, DM, DM, DM, DM, 0, 0, EpiResid{XL, XC, modl + 2 * DM});
        n_rowprep<<<Mrows / 4, 256, 0, stream>>>(XL, XC, norm2_g + l * DM, modl + 4 * DM, RSQ2, XG, Mrows, 0);
#endif
#if FAST_G5
        MK(pb + PH_G5, pb + PH_G5 + 1);
#else
        n_gemm<true, EpiAct><<<dim3(DFF / 64, Mrows / 64), 256, 0, stream>>>(XG, w_gu + (size_t)l * DM * 2 * DFF, DM, 2 * DFF, DFF, DM, DFF, 0, EpiAct{ACT, RSQ2, BIAS2 + (size_t)l * 5 * 2 * DFF});
#endif
#if FAST_G6
        MK(pb + PH_G6, pb + PH_G6 + 1);
#else
        n_gemm<false, EpiResid><<<dim3(DM / 64, Mrows / 64), 256, 0, stream>>>(ACT, w_dn + (size_t)l * DFF * DM, DFF, DM, DM, DFF, 0, 0, EpiResid{XL, XC, modl + 5 * DM});
        if (l + 1 < DEPTH) n_rowprep<<<R / 4, 256, 0, stream>>>(XL, XC, norm1_g + (l + 1) * DM, MOD + (size_t)(l + 1) * 5 * NMOD * DM + 1 * DM, RSQ1, XG, R, 0);
#endif
    }
}
```

```cpp
#include <hip/hip_runtime.h>
#include <cstdint>
#include <cstdio>
#define FUSED 1
#ifndef DUPH
#define DUPH -1
#endif
#ifndef DUPH2
#define DUPH2 -1
#endif

constexpr int DM = 1024, NB = 4, SEQ = 4096, CTXL = 256, DEPTH = 2;
constexpr int RL = NB * SEQ;
constexpr int RC = NB * CTXL;
constexpr int R = RL + RC;
constexpr int WA = 256, DIN = 1184, DFF = 2816, NMOD = 6;
constexpr int NH = 8, QKH = 96, QKN = 64, QKR = 32, VD = 64, QRANK = 256, KVRANK = 128;
constexpr int NKEY = CTXL + SEQ;
constexpr float EPS = 1e-6f;
constexpr float QSCALE = 0.10206207261596577f * 1.4426950408889634f;

typedef unsigned short bf16_t;
__device__ __forceinline__ float bf2f(bf16_t v) { return __uint_as_float(((unsigned)v) << 16); }
__device__ __forceinline__ bf16_t f2bf(float f) { unsigned u = __float_as_uint(f); return (bf16_t)((u + 0x7fffu + ((u >> 16) & 1u)) >> 16); }
__device__ __forceinline__ int mrow_of(int r) { return r < RL ? (r >> 12) : 4; }
__device__ __forceinline__ float wave_sum(float v) {
#pragma unroll
    for (int o = 1; o < 64; o <<= 1) v += __shfl_xor(v, o);
    return v;
}
__device__ __forceinline__ float silu_f(float x) { return x / (1.f + __expf(-x)); }
__device__ __forceinline__ float gelu_f(float x) { return 0.5f * x * (1.f + erff(x * 0.70710678118654752f)); }

constexpr size_t MiB = 1u << 20;
constexpr size_t WS_MOD = 1 * MiB;
constexpr size_t WS_BIAS1 = WS_MOD + 256 * 1024;
constexpr size_t WS_BIAS2 = WS_BIAS1 + 64 * 1024;
constexpr size_t WS_ROPE = WS_BIAS2 + 256 * 1024;
constexpr size_t WS_RSQ1 = 2 * MiB;
constexpr size_t WS_RSQ2 = 2 * MiB + 512 * 1024;
constexpr size_t WS_XC = 4 * MiB;
constexpr size_t WS_XG = 8 * MiB;
constexpr size_t WS_MIX = 42 * MiB;
constexpr size_t WS_W = 76 * MiB;
constexpr size_t WS_OV = 120 * MiB;
constexpr size_t WS_ACT = WS_OV;
constexpr size_t WS_U = WS_OV;
constexpr size_t WS_VT = WS_U + (size_t)R * 256 * 2;
constexpr size_t WS_BW = WS_VT + (size_t)R * 256 * 2;
constexpr size_t WS_QA = WS_BW + (size_t)R * 256 * 2;
constexpr size_t WS_KVA = WS_QA + (size_t)R * 256 * 2;
constexpr size_t WS_KR = WS_KVA + (size_t)R * 128 * 2;
constexpr size_t WS_Q = 161 * MiB;
constexpr size_t WS_K = WS_Q + (size_t)R * 768 * 2;
constexpr size_t WS_V = WS_K + (size_t)NB * NH * NKEY * QKH * 2;
constexpr size_t WS_P = 161 * MiB;
static_assert(WS_KR + (size_t)R * 32 * 4 <= WS_Q, "map");
static_assert(WS_V + (size_t)NB * NH * NKEY * VD * 2 <= 256 * MiB, "map");
static_assert(WS_P + (size_t)R * DIN * 4 <= 256 * MiB, "map");
static_assert(WS_ACT + (size_t)R * DFF * 2 <= 256 * MiB, "map");

__device__ void sincos_d(double x, double& s, double& c) {
    const double k = rint(x * 0.63661977236758134308); const double r = fma(-k, 1.5707963267948966192, x) - k * 6.123233995736766e-17;
    const double r2 = r * r;
    double sp = -7.6471637318198164759e-13; sp = sp * r2 + 1.6059043836821614599e-10; sp = sp * r2 - 2.5052108385441718775e-08; sp = sp * r2 + 2.7557319223985890653e-06; sp = sp * r2 - 1.9841269841269841270e-04; sp = sp * r2 + 8.3333333333333333333e-03; sp = sp * r2 - 1.6666666666666666667e-01; sp = r + r * r2 * sp;
    double cp = 4.7794773323873852974e-14; cp = cp * r2 - 1.1470745597729724714e-11; cp = cp * r2 + 2.0876756987868098979e-09; cp = cp * r2 - 2.7557319223985890653e-07; cp = cp * r2 + 2.4801587301587301587e-05; cp = cp * r2 - 1.3888888888888888889e-03; cp = cp * r2 + 4.1666666666666666667e-02; cp = cp * r2 - 0.5; cp = 1.0 + r2 * cp;
    const int q = ((int)k) & 3;
    s = (q == 0) ? sp : (q == 1) ? cp : (q == 2) ? -sp : -cp;
    c = (q == 0) ? cp : (q == 1) ? -sp : (q == 2) ? -cp : sp;
}
__device__ __forceinline__ float rstd_of(const float* RSQ, int r) { const float4 p = *(const float4*)(RSQ + (size_t)r * 4); return rsqrtf(((p.x + p.y) + (p.z + p.w)) * (1.f / DM) + EPS); }

#define LAS __attribute__((address_space(3)))
#define GAS __attribute__((address_space(1)))
typedef short bf16x8 __attribute__((ext_vector_type(8)));
typedef float f32x4 __attribute__((ext_vector_type(4)));
typedef float f32x2 __attribute__((ext_vector_type(2)));
typedef unsigned u32x4 __attribute__((ext_vector_type(4)));
typedef unsigned u32x2 __attribute__((ext_vector_type(2)));
__device__ __forceinline__ unsigned cvt_pk_bf16(float lo, float hi) { unsigned r; asm volatile("v_cvt_pk_bf16_f32 %0, %1, %2" : "=v"(r) : "v"(lo), "v"(hi)); return r; }
__device__ __forceinline__ float fast_silu(float x) { return x * __builtin_amdgcn_rcpf(1.f + __builtin_amdgcn_exp2f(-1.4426950408889634f * x)); }

constexpr size_t WL_IN = 0;
constexpr size_t WL_OUT = WL_IN + (size_t)1280 * 1024;
constexpr size_t WL_GU = WL_OUT + (size_t)1024 * 1024;
constexpr size_t WL_DN = WL_GU + (size_t)5632 * 1024;
constexpr size_t WL_QB = WL_DN + (size_t)1024 * 2816;
constexpr size_t WL_KVB = WL_QB + (size_t)768 * 256;
constexpr size_t WL_SP = WL_KVB + (size_t)1024 * 128;
constexpr size_t WL_END = WL_SP + (size_t)4 * 128 * 128;
static_assert(WL_END * 2 <= 22 * MiB, "weights per layer");
constexpr size_t WS_WB = WS_W;
constexpr size_t WS_BIAS2P = 3 * MiB;
constexpr size_t WS_BIAS1P = 3 * MiB + 256 * 1024;

namespace pg8 {
constexpr int BM = 256, BK = 64, HALF = 128, HTB = HALF * BK * 2, STAGE_BYTES = 8 * HTB, NXCD = 8, WGM = 8;
__host__ __device__ __forceinline__ int lds_byte(int r, int c) { const int st = (r >> 4) * 2 + (c >> 5), rr = r & 15, cc = c & 31, ob = rr * 64 + cc * 2; return st * 1024 + (ob ^ (((ob >> 9) & 1) << 5)); }
__host__ __device__ __forceinline__ void stage_rc(int b, int& Rr, int& C) { const int st = b / 1024, sb = b % 1024, swz = sb ^ (((sb >> 9) & 1) << 5); Rr = (st >> 1) * 16 + swz / 64; C = (st & 1) * 32 + (swz % 64) / 2; }
__host__ __device__ __forceinline__ int perm32(int rho) { const int n = rho >> 4, i = rho & 15; return 8 * (i >> 2) + 4 * n + (i & 3); }
struct Unit { int pm, pn; };
struct Gemm { const bf16_t* A; const bf16_t* Bt; int M, N, K; };
struct StaticOrder {
    int nM, nN, nwg, G, c;
    __device__ void init(int M, int N, int G_, int c_) { nM = M / BM; nN = N / BM; nwg = nM * nN; G = G_; c = c_; }
    __device__ bool next(int i, Unit& u) const {
        const long L = (long)i * G + c; if (L >= nwg) return false;
        int wgid = (int)L; { const int q = nwg / NXCD, r = nwg % NXCD, xcd = wgid % NXCD, off = wgid / NXCD; wgid = (xcd < r ? xcd * (q + 1) : r * (q + 1) + (xcd - r) * q) + off; }
        const int nig = WGM * nN, gid = wgid / nig, fm = gid * WGM, gsz = (nM - fm) < WGM ? (nM - fm) : WGM;
        u.pm = fm + ((wgid % nig) % gsz); u.pn = (wgid % nig) / gsz; return true;
    }
};
template <class Epi, class Sched>
__device__ __forceinline__ void gemm_phase(LAS unsigned char* lds, LAS unsigned char* xl, const Gemm g, const Sched& S, const Epi& E) {
    const int tid = threadIdx.x, wid = __builtin_amdgcn_readfirstlane(tid >> 6), lane = tid & 63, wr = wid >> 2, wc = wid & 3, fr = lane & 15, fq = lane >> 4;
    const int K = g.K, nt = K / BK;
    unsigned voffA[2], voffB[2];
#pragma unroll
    for (int i = 0; i < 2; ++i) { int Rr, C; stage_rc(tid * 16 + i * 8192, Rr, C); const int Rb = (Rr & ~31) + perm32(Rr & 31);
        voffA[i] = (unsigned)(Rr * K + C) * 2u; voffB[i] = (unsigned)(Rb * K + C) * 2u; }
    const size_t kstep = (size_t)(BK * 2);
    const size_t hstep = (size_t)HALF * K * 2;
    const size_t tstep = 2 * hstep;
    const unsigned ldsw = (unsigned)wid * 1024u;
    const int aoff = lds_byte(wr * 64 + fr, fq * 8), boff = lds_byte(wc * 32 + fr, fq * 8);
#define PG8_SA(b, h) (((b) * 2 + (h)) * HTB)
#define PG8_SB(b, h) ((4 + (b) * 2 + (h)) * HTB)
#define PG8_STAGE(bufoff, gbase, voff) do { _Pragma("unroll") for (int _i = 0; _i < 2; ++_i) \
        __builtin_amdgcn_global_load_lds((const unsigned*)((const char*)(gbase) + (voff)[_i]), (LAS unsigned*)(lds + (bufoff) + ldsw + _i * 8192), 16, 0, 0); } while (0)
#define PG8_LDA(dst, b, h) do { _Pragma("unroll") for (int m = 0; m < 4; ++m) _Pragma("unroll") for (int k = 0; k < 2; ++k) dst[m][k] = *(const LAS bf16x8*)(lds + PG8_SA(b, h) + aoff + m * 2048 + k * 1024); } while (0)
#define PG8_LDB(dst, b, h) do { _Pragma("unroll") for (int n = 0; n < 2; ++n) _Pragma("unroll") for (int k = 0; k < 2; ++k) dst[n][k] = *(const LAS bf16x8*)(lds + PG8_SB(b, h) + boff + n * 2048 + k * 1024); } while (0)
#define PG8_MMA(ai, bj, At, Bt) do { __builtin_amdgcn_s_setprio(1); _Pragma("unroll") for (int m = 0; m < 4; ++m) _Pragma("unroll") for (int n = 0; n < 2; ++n) _Pragma("unroll") for (int k = 0; k < 2; ++k) \
        acc[ai][bj][m][n] = __builtin_amdgcn_mfma_f32_16x16x32_bf16(Bt[n][k], At[m][k], acc[ai][bj][m][n], 0, 0, 0); __builtin_amdgcn_s_setprio(0); } while (0)
#define PG8_WAIT_V(n) asm volatile("s_waitcnt vmcnt(" #n ")" ::: "memory")
#define PG8_WAIT_L(n) asm volatile("s_waitcnt lgkmcnt(" #n ")" ::: "memory")
#define PG8_BAR __builtin_amdgcn_s_barrier()
#define PG8_SCHED __builtin_amdgcn_sched_barrier(0)
    Unit cur, nxt; int ui = 0;
    if (!S.next(0, cur)) return;
    f32x4 acc[2][2][4][2];
#pragma unroll
    for (int a = 0; a < 2; ++a)
#pragma unroll
        for (int b = 0; b < 2; ++b)
#pragma unroll
            for (int m = 0; m < 4; ++m)
#pragma unroll
                for (int n = 0; n < 2; ++n) acc[a][b][m][n] = (f32x4){0.f, 0.f, 0.f, 0.f};
    bf16x8 At[4][2], B0[2][2], B1[2][2];
    const char* cA = (const char*)g.A + (size_t)cur.pm * tstep; const char* cB = (const char*)g.Bt + (size_t)cur.pn * tstep;
    PG8_STAGE(PG8_SB(0, 0), cB, voffB); PG8_STAGE(PG8_SB(0, 1), cB + hstep, voffB); PG8_STAGE(PG8_SA(0, 0), cA, voffA); PG8_STAGE(PG8_SA(0, 1), cA + hstep, voffA);
    if (wr == 1) PG8_BAR;
    PG8_WAIT_V(2); PG8_BAR;
    PG8_STAGE(PG8_SB(1, 0), cB + kstep, voffB); PG8_STAGE(PG8_SA(1, 0), cA + kstep, voffA); PG8_STAGE(PG8_SB(1, 1), cB + hstep + kstep, voffB);
    PG8_WAIT_V(6); PG8_BAR;
    for (;;) {
        const bool has_next = S.next(ui + 1, nxt);
        const char* nA = has_next ? (const char*)g.A + (size_t)nxt.pm * tstep : cA; const char* nB = has_next ? (const char*)g.Bt + (size_t)nxt.pn * tstep : cB;
        for (int t = 0; t < nt; t += 2) {
            const bool last = (t == nt - 2);
            const char* a1 = cA + (size_t)(t + 1) * kstep;
            const char* a2 = last ? nA : cA + (size_t)(t + 2) * kstep; const char* b2 = last ? nB : cB + (size_t)(t + 2) * kstep;
            const char* a3 = a2 + kstep; const char* b3 = b2 + kstep;
            PG8_LDB(B0, 0, 0); PG8_LDB(B1, 0, 1); PG8_SCHED; PG8_LDA(At, 0, 0); PG8_STAGE(PG8_SA(1, 1), a1 + hstep, voffA);
            PG8_WAIT_V(8); PG8_WAIT_L(0); PG8_BAR; PG8_MMA(0, 0, At, B0); PG8_MMA(0, 1, At, B1); PG8_BAR; PG8_SCHED;
            PG8_LDA(At, 0, 1); PG8_STAGE(PG8_SB(0, 0), b2, voffB); PG8_STAGE(PG8_SB(0, 1), b2 + hstep, voffB); PG8_STAGE(PG8_SA(0, 0), a2, voffA);
            PG8_WAIT_V(8); PG8_WAIT_L(0); PG8_BAR; PG8_MMA(1, 0, At, B0); PG8_MMA(1, 1, At, B1); PG8_BAR; PG8_SCHED;
            PG8_LDB(B0, 1, 0); PG8_LDB(B1, 1, 1); PG8_SCHED; PG8_LDA(At, 1, 0); PG8_STAGE(PG8_SA(0, 1), a2 + hstep, voffA);
            PG8_WAIT_V(8); PG8_WAIT_L(0); PG8_BAR; PG8_MMA(0, 0, At, B0); PG8_MMA(0, 1, At, B1); PG8_BAR; PG8_SCHED;
            PG8_LDA(At, 1, 1); PG8_STAGE(PG8_SB(1, 0), b3, voffB); PG8_STAGE(PG8_SB(1, 1), b3 + hstep, voffB); PG8_STAGE(PG8_SA(1, 0), a3, voffA);
            PG8_WAIT_V(8); PG8_WAIT_L(0); PG8_BAR; PG8_MMA(1, 0, At, B0); PG8_MMA(1, 1, At, B1); PG8_BAR; PG8_SCHED;
        }
        if (wr == 0) PG8_BAR;
        { int fr_ = fr, fq_ = fq; asm volatile("" : "+v"(fr_), "+v"(fq_)); E(acc, cur, wr, wc, fr_, fq_, xl); }
        if (!has_next) break;
#pragma unroll
        for (int a = 0; a < 2; ++a)
#pragma unroll
            for (int b = 0; b < 2; ++b)
#pragma unroll
                for (int m = 0; m < 4; ++m)
#pragma unroll
                    for (int n = 0; n < 2; ++n) acc[a][b][m][n] = (f32x4){0.f, 0.f, 0.f, 0.f};
        cur = nxt; cA = nA; cB = nB; ++ui;
        if (wr == 1) PG8_BAR;
    }
    PG8_WAIT_V(0);
    PG8_BAR;
#undef PG8_SA
#undef PG8_SB
#undef PG8_STAGE
#undef PG8_LDA
#undef PG8_LDB
#undef PG8_MMA
}
}

__device__ __forceinline__ f32x4 ld4(const float* p) { return *(const f32x4*)p; }
struct EpiGU {
    bf16_t* ACT; const float* RSQ; const float* BIAS;
    __device__ __forceinline__ void operator()(f32x4 (&acc)[2][2][4][2], const pg8::Unit& u, int wr, int wc, int fr, int fq, LAS unsigned char*) const {
        const int row0 = u.pm * 256 + wr * 64 + fr; const int mr = mrow_of(u.pm * 256);
        const float* bb = BIAS + (size_t)mr * (2 * DFF) + u.pn * 256 + wc * 32 + 8 * fq;
        const f32x4 bg0 = ld4(bb), bg1 = ld4(bb + 4), bu0 = ld4(bb + 128), bu1 = ld4(bb + 132);
        bf16_t* ob = ACT + u.pn * 128 + wc * 32 + 8 * fq;
#pragma unroll
        for (int ai = 0; ai < 2; ++ai)
#pragma unroll
            for (int m = 0; m < 4; ++m) { const int row = row0 + ai * 128 + m * 16; const float rs = rstd_of(RSQ, row);
                const f32x4 g0 = acc[ai][0][m][0] * rs + bg0, g1 = acc[ai][0][m][1] * rs + bg1, u0 = acc[ai][1][m][0] * rs + bu0, u1 = acc[ai][1][m][1] * rs + bu1;
                u32x4 w; w.x = cvt_pk_bf16(fast_silu(g0[0]) * u0[0], fast_silu(g0[1]) * u0[1]); w.y = cvt_pk_bf16(fast_silu(g0[2]) * u0[2], fast_silu(g0[3]) * u0[3]);
                w.z = cvt_pk_bf16(fast_silu(g1[0]) * u1[0], fast_silu(g1[1]) * u1[1]); w.w = cvt_pk_bf16(fast_silu(g1[2]) * u1[2], fast_silu(g1[3]) * u1[3]);
                *(u32x4*)(ob + (size_t)row * DFF) = w; }
    }
};
struct EpiRes {
    float* XL; float* XC; const float* gate; float* RSQ; bf16_t* XG; const float* ng; const float* nsc; int do_next; int pad;
    __device__ __forceinline__ void operator()(f32x4 (&acc)[2][2][4][2], const pg8::Unit& u, int wr, int wc, int fr, int fq, LAS unsigned char* xl) const {
        const int mr = mrow_of(u.pm * 256); const int col0 = u.pn * 256 + wc * 32 + 8 * fq; const int rl0 = wr * 64 + fr;
        float* xbase = u.pm < 64 ? XL + (size_t)(u.pm * 256) * DM : XC + (size_t)(u.pm * 256 - RL) * DM;
        LAS float* P = (LAS float*)xl;
        float ss[8];
#pragma unroll
        for (int q = 0; q < 8; ++q) ss[q] = 0.f;
#pragma unroll
        for (int bj = 0; bj < 2; ++bj) {
            f32x4 gt[2], gm[2];
#pragma unroll
            for (int n = 0; n < 2; ++n) { const int c = col0 + bj * 128 + 4 * n; gt[n] = ld4(gate + (size_t)mr * (NMOD * DM) + c);
                if (do_next) gm[n] = ld4(ng + c) * (ld4(nsc + (size_t)mr * (NMOD * DM) + c) + 1.f); else gm[n] = (f32x4){0.f, 0.f, 0.f, 0.f}; }
#pragma unroll
            for (int ai = 0; ai < 2; ++ai)
#pragma unroll
                for (int m = 0; m < 4; ++m) { const int rl = rl0 + ai * 128 + m * 16; float* xp = xbase + (size_t)rl * DM + col0 + bj * 128;
                    const f32x4 y0 = ld4(xp) + gt[0] * acc[ai][bj][m][0], y1 = ld4(xp + 4) + gt[1] * acc[ai][bj][m][1];
                    *(f32x4*)(xp) = y0; *(f32x4*)(xp + 4) = y1;
                    if (do_next) { ss[ai * 4 + m] += (y0[0] * y0[0] + y0[1] * y0[1]) + (y0[2] * y0[2] + y0[3] * y0[3]) + (y1[0] * y1[0] + y1[1] * y1[1]) + (y1[2] * y1[2] + y1[3] * y1[3]);
                        const f32x4 z0 = y0 * gm[0], z1 = y1 * gm[1]; u32x4 w; w.x = cvt_pk_bf16(z0[0], z0[1]); w.y = cvt_pk_bf16(z0[2], z0[3]); w.z = cvt_pk_bf16(z1[0], z1[1]); w.w = cvt_pk_bf16(z1[2], z1[3]);
                        *(u32x4*)(XG + (size_t)(u.pm * 256 + rl) * DM + col0 + bj * 128) = w; }
                    if (m & 1) asm volatile("" ::: "memory"); }
        }
        if (do_next) {
#pragma unroll
            for (int q = 0; q < 8; ++q) { float t = ss[q]; t += __shfl_xor(t, 16); t += __shfl_xor(t, 32); if (fq == 0) P[(rl0 + (q >> 2) * 128 + (q & 3) * 16) * 4 + wc] = t; }
        }
        if (do_next) {
            asm volatile("s_waitcnt lgkmcnt(0)" ::: "memory"); __builtin_amdgcn_s_barrier(); asm volatile("" ::: "memory");
            const int tid = threadIdx.x;
            if (tid < 256) { const f32x4 p = *(const LAS f32x4*)(P + tid * 4); RSQ[(size_t)(u.pm * 256 + tid) * 4 + u.pn] = (p[0] + p[1]) + (p[2] + p[3]); }
        }
    }
};


__device__ __forceinline__ float gelu_fast(float v) {
    const float av = fabsf(v), d = av * 0.2316418882f + 1.0f, t = __builtin_amdgcn_rcpf(d);
    float q = t * 0.5307027145f + (-0.7265760135f); q = q * t + 0.7107068705f; q = q * t + (-0.142248368f); q = q * t + 0.127414796f; q = q * t;
    const float e = __builtin_amdgcn_exp2f((v * v) * (-0.72134752044f));
    const float m = v * (q * e), r = v - m; return v < 0.f ? m : r;
}
struct EpiG1 {
    const float* RSQ; const float* BIAS; const float* sgu_g; const float* qa_g; const float* kva_g;
    bf16_t* U; bf16_t* VT; bf16_t* BW; bf16_t* QA; bf16_t* KVA; float* KR;
#define G1_PACK(v0, v1) (u32x4){cvt_pk_bf16((v0)[0], (v0)[1]), cvt_pk_bf16((v0)[2], (v0)[3]), cvt_pk_bf16((v1)[0], (v1)[1]), cvt_pk_bf16((v1)[2], (v1)[3])}
#define G1_SS(v) (((v)[0] * (v)[0] + (v)[1] * (v)[1]) + ((v)[2] * (v)[2] + (v)[3] * (v)[3]))
    __device__ __forceinline__ void operator()(f32x4 (&acc)[2][2][4][2], const pg8::Unit& u, int wr, int wc, int fr, int fq, LAS unsigned char* xl) const {
        const int mr = mrow_of(u.pm * 256); const int cl = wc * 32 + 8 * fq; const int rl0 = wr * 64 + fr; const int pn = u.pn;
        LAS float* P = (LAS float*)xl;
        {   f32x4 bv[2][2];
#pragma unroll
            for (int bj = 0; bj < 2; ++bj)
#pragma unroll
                for (int n = 0; n < 2; ++n) bv[bj][n] = ld4(BIAS + (size_t)mr * 1280 + pn * 256 + bj * 128 + cl + 4 * n);
            const bool act = (pn <= 1);
#pragma unroll
            for (int ai = 0; ai < 2; ++ai)
#pragma unroll
                for (int m = 0; m < 4; ++m) { const float rs = rstd_of(RSQ, u.pm * 256 + rl0 + ai * 128 + m * 16);
#pragma unroll
                    for (int bj = 0; bj < 2; ++bj)
#pragma unroll
                        for (int n = 0; n < 2; ++n) { f32x4 v = acc[ai][bj][m][n] * rs + bv[bj][n];
                            if (act) v = (f32x4){gelu_fast(v[0]), gelu_fast(v[1]), gelu_fast(v[2]), gelu_fast(v[3])};
                            acc[ai][bj][m][n] = v; }
                    if (m & 1) asm volatile("" ::: "memory"); }
        }
        if (pn == 0) {
#pragma unroll
            for (int ai = 0; ai < 2; ++ai)
#pragma unroll
                for (int m = 0; m < 4; ++m) { const int row = u.pm * 256 + rl0 + ai * 128 + m * 16;
#pragma unroll
                    for (int bj = 0; bj < 2; ++bj) *(u32x4*)(U + (size_t)row * 256 + bj * 128 + cl) = G1_PACK(acc[ai][bj][m][0], acc[ai][bj][m][1]); }
            return;
        }
        if (pn == 2) {
#pragma unroll
            for (int ai = 0; ai < 2; ++ai)
#pragma unroll
                for (int m = 0; m < 4; ++m) { const int row = u.pm * 256 + rl0 + ai * 128 + m * 16;
#pragma unroll
                    for (int bj = 0; bj < 2; ++bj) *(u32x4*)(BW + (size_t)row * 256 + bj * 128 + cl) = G1_PACK(acc[ai][bj][m][0], acc[ai][bj][m][1]); }
            return;
        }
#pragma unroll
        for (int ai = 0; ai < 2; ++ai)
#pragma unroll
            for (int m = 0; m < 4; ++m) { float ss = G1_SS(acc[ai][0][m][0]) + G1_SS(acc[ai][0][m][1]);
                if (pn != 4) ss += G1_SS(acc[ai][1][m][0]) + G1_SS(acc[ai][1][m][1]);
                ss += __shfl_xor(ss, 16); ss += __shfl_xor(ss, 32);
                if (fq == 0) P[(rl0 + ai * 128 + m * 16) * 4 + wc] = ss; }
        asm volatile("s_waitcnt lgkmcnt(0)" ::: "memory"); __builtin_amdgcn_s_barrier(); asm volatile("" ::: "memory");
        if (pn == 1) {
#pragma unroll
            for (int bj = 0; bj < 2; ++bj) { const f32x4 g0 = ld4(sgu_g + bj * 128 + cl), g1 = ld4(sgu_g + bj * 128 + cl + 4);
#pragma unroll
                for (int ai = 0; ai < 2; ++ai)
#pragma unroll
                    for (int m = 0; m < 4; ++m) { const int rl = rl0 + ai * 128 + m * 16; const int row = u.pm * 256 + rl;
                        const f32x4 p = *(const LAS f32x4*)(P + rl * 4); const float rn = rsqrtf(((p[0] + p[1]) + (p[2] + p[3])) * (1.f / 256.f) + EPS);
                        const f32x4 v0 = acc[ai][bj][m][0] * rn * g0, v1 = acc[ai][bj][m][1] * rn * g1;
                        bf16_t* vt = VT + ((size_t)(row >> 7) * 256 + bj * 128 + cl) * 128 + (row & 127);
#pragma unroll
                        for (int i = 0; i < 4; ++i) { vt[(size_t)i * 128] = (bf16_t)(cvt_pk_bf16(v0[i], 0.f) & 0xffffu); vt[(size_t)(4 + i) * 128] = (bf16_t)(cvt_pk_bf16(v1[i], 0.f) & 0xffffu); } } }
        } else if (pn == 3) {
#pragma unroll
            for (int bj = 0; bj < 2; ++bj) { const f32x4 g0 = ld4(qa_g + bj * 128 + cl), g1 = ld4(qa_g + bj * 128 + cl + 4);
#pragma unroll
                for (int ai = 0; ai < 2; ++ai)
#pragma unroll
                    for (int m = 0; m < 4; ++m) { const int rl = rl0 + ai * 128 + m * 16; const int row = u.pm * 256 + rl;
                        const f32x4 p = *(const LAS f32x4*)(P + rl * 4); const float rn = rsqrtf(((p[0] + p[1]) + (p[2] + p[3])) * (1.f / 256.f) + EPS);
                        const f32x4 v0 = acc[ai][bj][m][0] * rn * g0, v1 = acc[ai][bj][m][1] * rn * g1;
                        *(u32x4*)(QA + (size_t)row * 256 + bj * 128 + cl) = G1_PACK(v0, v1); } }
        } else {
            const f32x4 g0 = ld4(kva_g + cl), g1 = ld4(kva_g + cl + 4);
#pragma unroll
            for (int ai = 0; ai < 2; ++ai)
#pragma unroll
                for (int m = 0; m < 4; ++m) { const int rl = rl0 + ai * 128 + m * 16; const int row = u.pm * 256 + rl;
                    const f32x4 p = *(const LAS f32x4*)(P + rl * 4); const float rn = rsqrtf(((p[0] + p[1]) + (p[2] + p[3])) * (1.f / 128.f) + EPS);
                    const f32x4 v0 = acc[ai][0][m][0] * rn * g0, v1 = acc[ai][0][m][1] * rn * g1;
                    *(u32x4*)(KVA + (size_t)row * 128 + cl) = G1_PACK(v0, v1);
                    if (wc == 0) { *(f32x4*)(KR + (size_t)row * 32 + 8 * fq) = acc[ai][1][m][0]; *(f32x4*)(KR + (size_t)row * 32 + 8 * fq + 4) = acc[ai][1][m][1]; } }
        }
    }
#undef G1_PACK
#undef G1_SS
};


namespace att {
using s16x4 = __attribute__((ext_vector_type(4))) short;
using f32x16 = __attribute__((ext_vector_type(16))) float;
constexpr int KROW = 208;
constexpr int SHM_V = 64 * 64 * 2, SHM_K = 64 * KROW, OFF_K = 2 * SHM_V, OFF_WS = OFF_K + 2 * SHM_K, SHM_ATTN = OFF_WS + 8 * 64 * 4;
constexpr float THRL = 8.f;
#define ASBAR() __builtin_amdgcn_sched_barrier(0)
__device__ __forceinline__ int crow(int r, int hi) { return (r & 3) + 8 * (r >> 2) + 4 * hi; }
__device__ __forceinline__ int v_st(int k, int c) { const int kk = (k & ~0xC) | ((k & 4) << 1) | ((k & 8) >> 1); return ((kk >> 3) * 2 + (c >> 5)) * 512 + ((kk & 7) * 32 + (c & 31)) * 2; }
__device__ __forceinline__ int v_rd_base(int lane) { return ((lane & 3) << 3) | (((lane >> 2) & 3) << 6) | (((lane >> 4) & 1) << 5) | (((lane >> 5) & 1) << 8); }
constexpr int v_rd_off(int d0, int ks, int half) { return d0 * 512 + ks * 2048 + half * 1024; }
template <int OFF> __device__ __forceinline__ s16x4 tr_read(int vb) { s16x4 r; asm volatile("ds_read_b64_tr_b16 %0, %1 offset:%2" : "=&v"(r) : "v"(vb), "i"(OFF) : "memory"); return r; }
__device__ __forceinline__ void partialSM(f32x16& p0, f32x16& p1, float& m_reg, float& mn, float& alpha) {
    float pmax = p0[0];
#pragma unroll
    for (int r = 1; r < 16; ++r) pmax = fmaxf(pmax, p0[r]);
#pragma unroll
    for (int r = 0; r < 16; ++r) pmax = fmaxf(pmax, p1[r]);
    { auto rr = __builtin_amdgcn_permlane32_swap(__float_as_uint(pmax), __float_as_uint(pmax), false, false); pmax = fmaxf(__uint_as_float(rr[0]), __uint_as_float(rr[1])); }
    if (__builtin_expect(__all(pmax - m_reg <= THRL), 1)) { mn = m_reg; alpha = 1.f; }
    else { mn = fmaxf(m_reg, pmax); alpha = __builtin_amdgcn_exp2f(m_reg - mn); m_reg = mn; }
#pragma unroll
    for (int r = 0; r < 16; ++r) p0[r] = p0[r] - mn;
#pragma unroll
    for (int r = 0; r < 16; ++r) p1[r] = p1[r] - mn;
#pragma unroll
    for (int r = 0; r < 16; ++r) p0[r] = __builtin_amdgcn_exp2f(p0[r]);
}
__device__ __forceinline__ void finishSM(f32x16& p0, f32x16& p1, float alpha, float& l_reg, bf16x8& pa0, bf16x8& pa1, bf16x8& pa2, bf16x8& pa3) {
#pragma unroll
    for (int r = 0; r < 16; ++r) p1[r] = __builtin_amdgcn_exp2f(p1[r]);
    float ps = 0;
#pragma unroll
    for (int r = 0; r < 16; ++r) ps += p0[r];
#pragma unroll
    for (int r = 0; r < 16; ++r) ps += p1[r];
    { auto rr = __builtin_amdgcn_permlane32_swap(__float_as_uint(ps), __float_as_uint(ps), false, false); ps = __uint_as_float(rr[0]) + __uint_as_float(rr[1]); }
    l_reg = l_reg * alpha + ps;
#define PK4(P, BASE, OUT) do { unsigned a0 = cvt_pk_bf16(P[BASE + 0], P[BASE + 1]), a1 = cvt_pk_bf16(P[BASE + 2], P[BASE + 3]);   \
    unsigned b0 = cvt_pk_bf16(P[BASE + 4], P[BASE + 5]), b1 = cvt_pk_bf16(P[BASE + 6], P[BASE + 7]);                              \
    auto r0 = __builtin_amdgcn_permlane32_swap(a0, b0, false, false); auto r1 = __builtin_amdgcn_permlane32_swap(a1, b1, false, false); \
    u32x4 w = {r0[0], r1[0], r0[1], r1[1]}; OUT = *reinterpret_cast<bf16x8*>(&w); } while (0)
    PK4(p0, 0, pa0); PK4(p0, 8, pa1); PK4(p1, 0, pa2); PK4(p1, 8, pa3);
#undef PK4
}
__device__ __forceinline__ void qkt(f32x16& p0, f32x16& p1, LAS const unsigned char* Ks, const bf16x8 (&qr)[6], int r32, int hi) {
    p0 = f32x16{}; p1 = f32x16{};
#pragma unroll
    for (int d0 = 0; d0 < 6; ++d0) {
        const bf16x8 b0 = *(LAS const bf16x8*)(Ks + r32 * KROW + d0 * 32 + hi * 16);
        const bf16x8 b1 = *(LAS const bf16x8*)(Ks + (32 + r32) * KROW + d0 * 32 + hi * 16);
        p0 = __builtin_amdgcn_mfma_f32_32x32x16_bf16(b0, qr[d0], p0, 0, 0, 0);
        p1 = __builtin_amdgcn_mfma_f32_32x32x16_bf16(b1, qr[d0], p1, 0, 0, 0); }
}
template <int D0> __device__ __forceinline__ void pv_one(f32x16& od, int vb, bf16x8 pa0, bf16x8 pa1, bf16x8 pa2, bf16x8 pa3) {
    const s16x4 l0 = tr_read<v_rd_off(D0, 0, 0)>(vb), h0 = tr_read<v_rd_off(D0, 0, 1)>(vb), l1 = tr_read<v_rd_off(D0, 1, 0)>(vb), h1 = tr_read<v_rd_off(D0, 1, 1)>(vb);
    const s16x4 l2 = tr_read<v_rd_off(D0, 2, 0)>(vb), h2 = tr_read<v_rd_off(D0, 2, 1)>(vb), l3 = tr_read<v_rd_off(D0, 3, 0)>(vb), h3 = tr_read<v_rd_off(D0, 3, 1)>(vb);
    asm volatile("s_waitcnt lgkmcnt(0)" ::: "memory"); ASBAR();
#define PK(L, H) (bf16x8){L[0], L[1], L[2], L[3], H[0], H[1], H[2], H[3]}
    od = __builtin_amdgcn_mfma_f32_32x32x16_bf16(pa0, PK(l0, h0), od, 0, 0, 0);
    od = __builtin_amdgcn_mfma_f32_32x32x16_bf16(pa1, PK(l1, h1), od, 0, 0, 0);
    od = __builtin_amdgcn_mfma_f32_32x32x16_bf16(pa2, PK(l2, h2), od, 0, 0, 0);
    od = __builtin_amdgcn_mfma_f32_32x32x16_bf16(pa3, PK(l3, h3), od, 0, 0, 0);
#undef PK
}
__device__ __forceinline__ void attn_unit(const bf16_t* __restrict__ Qb, const bf16_t* __restrict__ Kh, const bf16_t* __restrict__ Vh, bf16_t* __restrict__ Ob, int seq, LAS unsigned char* lds) {
    int tid = threadIdx.x; asm volatile("" : "+v"(tid));
    const int wid = __builtin_amdgcn_readfirstlane(tid >> 6), lane = tid & 63, r32 = lane & 31, hi = lane >> 5;
    LAS float* wsf = (LAS float*)(lds + OFF_WS) + wid * 64; LAS float* li_l = wsf; LAS float* al_l = wsf + 32;
    float m_reg = -1e30f, l_reg = 0; f32x16 o[2] = {}; bf16x8 qr[6];
    const bf16_t* Qw = Qb + (size_t)(wid * 32 + r32) * 768 + hi * 8;
#pragma unroll
    for (int d0 = 0; d0 < 6; ++d0) qr[d0] = *(const bf16x8*)(Qw + d0 * 16);
    const bool isK = wid < 4; const int t = tid & 255;
    const unsigned char* gbase = isK ? (const unsigned char*)Kh : (const unsigned char*)Vh; const int tstride = isK ? 64 * 96 * 2 : 64 * 64 * 2;
    int loff0, loff1, loff2;
    { const int c0 = t, c1 = t + 256, c2 = t + 512;
      loff0 = isK ? (c0 / 12) * KROW + (c0 % 12) * 16 : v_st(c0 >> 3, (c0 & 7) * 8);
      loff1 = isK ? (c1 / 12) * KROW + (c1 % 12) * 16 : v_st(c1 >> 3, (c1 & 7) * 8);
      loff2 = (c2 / 12) * KROW + (c2 % 12) * 16; }
    const int vb0 = (int)(uintptr_t)(lds) + v_rd_base(lane);
    bf16x8 sA0, sA1, sA2, sB0, sB1, sB2;
#define SLOAD(S, tile) do { const unsigned char* p_ = gbase + (size_t)(tile) * tstride + t * 16; S##0 = *(const bf16x8*)(p_); S##1 = *(const bf16x8*)(p_ + 4096); if (isK) S##2 = *(const bf16x8*)(p_ + 8192); } while (0)
#define SWRITE(b, S) do { LAS unsigned char* d_ = lds + (isK ? OFF_K + (b) * SHM_K : (b) * SHM_V); *(LAS bf16x8*)(d_ + loff0) = S##0; *(LAS bf16x8*)(d_ + loff1) = S##1; if (isK) *(LAS bf16x8*)(d_ + loff2) = S##2; } while (0)
#define RESC(a) do { if (__any((a) < 1.f)) { if (hi == 0) al_l[r32] = (a); asm volatile("s_waitcnt lgkmcnt(0)" ::: "memory"); \
    _Pragma("unroll") for (int d = 0; d < 2; ++d) _Pragma("unroll") for (int r = 0; r < 16; ++r) o[d][r] *= al_l[crow(r, hi)]; } } while (0)
    f32x16 pA0, pA1, pB0, pB1; float mnA, mnB, alA, alB; bf16x8 pa0, pa1, pa2, pa3; const int NT = seq / 64;
    LAS const unsigned char* K0 = lds + OFF_K; LAS const unsigned char* K1 = lds + OFF_K + SHM_K;
    SLOAD(sA, 0); SWRITE(0, sA); __syncthreads();
    qkt(pA0, pA1, K0, qr, r32, hi); partialSM(pA0, pA1, m_reg, mnA, alA);
    SLOAD(sB, 1); if (2 < NT) SLOAD(sA, 2);
    SWRITE(1, sB); __syncthreads();
    for (int j = 1; j + 1 < NT; j += 2) {
        ASBAR(); qkt(pB0, pB1, K1, qr, r32, hi);
        finishSM(pA0, pA1, alA, l_reg, pa0, pa1, pa2, pa3); ASBAR();
        SLOAD(sB, j + 2); ASBAR();
        pv_one<0>(o[0], vb0, pa0, pa1, pa2, pa3); pv_one<1>(o[1], vb0, pa0, pa1, pa2, pa3); partialSM(pB0, pB1, m_reg, mnB, alB);
        __syncthreads(); SWRITE(0, sA);
        RESC(alB); __syncthreads();
        ASBAR(); qkt(pA0, pA1, K0, qr, r32, hi);
        finishSM(pB0, pB1, alB, l_reg, pa0, pa1, pa2, pa3); ASBAR();
        if (j + 3 < NT) SLOAD(sA, j + 3); ASBAR();
        pv_one<0>(o[0], vb0 + SHM_V, pa0, pa1, pa2, pa3); pv_one<1>(o[1], vb0 + SHM_V, pa0, pa1, pa2, pa3); partialSM(pA0, pA1, m_reg, mnA, alA);
        __syncthreads(); SWRITE(1, sB);
        RESC(alA); __syncthreads();
    }
    ASBAR(); qkt(pB0, pB1, K1, qr, r32, hi);
    finishSM(pA0, pA1, alA, l_reg, pa0, pa1, pa2, pa3); ASBAR();
    pv_one<0>(o[0], vb0, pa0, pa1, pa2, pa3); pv_one<1>(o[1], vb0, pa0, pa1, pa2, pa3); partialSM(pB0, pB1, m_reg, mnB, alB);
    __syncthreads(); RESC(alB);
    finishSM(pB0, pB1, alB, l_reg, pa0, pa1, pa2, pa3); ASBAR();
    pv_one<0>(o[0], vb0 + SHM_V, pa0, pa1, pa2, pa3); pv_one<1>(o[1], vb0 + SHM_V, pa0, pa1, pa2, pa3);
    if (hi == 0) li_l[r32] = l_reg; asm volatile("s_waitcnt lgkmcnt(0)" ::: "memory");
    int hi_e = hi, r32_e = r32; asm volatile("" : "+v"(hi_e), "+v"(r32_e));
    bf16_t* Ow = Ob + (size_t)(wid * 32 + 4 * hi_e) * DM + r32_e;
#pragma unroll
    for (int r = 0; r < 16; ++r) { const int orow = (r & 3) + 8 * (r >> 2); const float rl = __builtin_amdgcn_rcpf(li_l[orow + 4 * hi_e]);
#pragma unroll
        for (int d0 = 0; d0 < 2; ++d0) Ow[(size_t)orow * DM + d0 * 32] = (bf16_t)(cvt_pk_bf16(o[d0][r] * rl, 0.f) & 0xffffu); }
    __syncthreads();
#undef SLOAD
#undef SWRITE
#undef RESC
}
#undef ASBAR
}


namespace g2 {
using f32x16 = __attribute__((ext_vector_type(16))) float;
__device__ __forceinline__ int crow(int r, int hi) { return (r & 3) + 8 * (r >> 2) + 4 * hi; }
__device__ __forceinline__ float half_swap_sum(float v) { auto rr = __builtin_amdgcn_permlane32_swap(__float_as_uint(v), __float_as_uint(v), false, false); return __uint_as_float(rr[0]) + __uint_as_float(rr[1]); }
__device__ __forceinline__ void rope_pair(const float* __restrict__ ROPE, int t, int pp, float& x1, float& x2) {
    const int pos = pp < 8 ? (t >> 6) : (t & 63); const f32x2 cs = *(const f32x2*)(ROPE + (pos * 8 + (pp & 7)) * 2);
    const float y1 = x1 * cs[0] - x2 * cs[1], y2 = x1 * cs[1] + x2 * cs[0]; x1 = y1; x2 = y2;
}
__device__ __forceinline__ void q_item(const bf16_t* __restrict__ QA, const bf16_t* __restrict__ WQ, const float* __restrict__ qn_g, const float* __restrict__ ROPE, bf16_t* __restrict__ Q, int row0, int h, int lane) {
    const int r32 = lane & 31, hi = lane >> 5;
    f32x16 acc[2][3];
#pragma unroll
    for (int tg = 0; tg < 2; ++tg)
#pragma unroll
        for (int b = 0; b < 3; ++b) acc[tg][b] = f32x16{};
    const bf16_t* wp = WQ + (size_t)(96 * h + r32) * 256 + 8 * hi; const bf16_t* ap = QA + (size_t)(row0 + r32) * 256 + 8 * hi;
#pragma unroll 4
    for (int ks = 0; ks < 16; ++ks) {
        const bf16x8 b0 = *(const bf16x8*)(ap + ks * 16), b1 = *(const bf16x8*)(ap + 32 * 256 + ks * 16);
#pragma unroll
        for (int b = 0; b < 3; ++b) { const bf16x8 wf = *(const bf16x8*)(wp + (size_t)b * 32 * 256 + ks * 16);
            acc[0][b] = __builtin_amdgcn_mfma_f32_32x32x16_bf16(wf, b0, acc[0][b], 0, 0, 0); acc[1][b] = __builtin_amdgcn_mfma_f32_32x32x16_bf16(wf, b1, acc[1][b], 0, 0, 0); } }
#pragma unroll
    for (int tg = 0; tg < 2; ++tg) { const int row = row0 + tg * 32 + r32; const bool lat = row < RL; const int t = row & 4095;
        float ss = 0.f;
#pragma unroll
        for (int b = 0; b < 3; ++b)
#pragma unroll
            for (int r = 0; r < 16; ++r) ss += acc[tg][b][r] * acc[tg][b][r];
        ss = half_swap_sum(ss); const float rn = rsqrtf(ss * (1.f / 96.f) + EPS) * QSCALE;
        bf16_t* qo = Q + ((size_t)row * NH + h) * QKH + 4 * hi;
#pragma unroll
        for (int b = 0; b < 3; ++b)
#pragma unroll
            for (int rq = 0; rq < 4; ++rq) { const int f0 = 32 * b + 8 * rq + 4 * hi; const f32x4 g = ld4(qn_g + f0);
                float v0 = acc[tg][b][4 * rq] * rn * g[0], v1 = acc[tg][b][4 * rq + 1] * rn * g[1], v2 = acc[tg][b][4 * rq + 2] * rn * g[2], v3 = acc[tg][b][4 * rq + 3] * rn * g[3];
                if (b == 2 && lat) { const int pp = 4 * rq + 2 * hi; rope_pair(ROPE, t, pp, v0, v1); rope_pair(ROPE, t, pp + 1, v2, v3); }
                *(u32x2*)(qo + 32 * b + 8 * rq) = (u32x2){cvt_pk_bf16(v0, v1), cvt_pk_bf16(v2, v3)}; } }
}
__device__ __forceinline__ void kv_item(const bf16_t* __restrict__ KVA, const float* __restrict__ KR, const bf16_t* __restrict__ WKV, const float* __restrict__ kn_g, const float* __restrict__ ROPE,
                                        bf16_t* __restrict__ Kb, bf16_t* __restrict__ Vb, int row0, int h, int lane) {
    const int r32 = lane & 31, hi = lane >> 5;
    f32x16 acc[4];
#pragma unroll
    for (int b = 0; b < 4; ++b) acc[b] = f32x16{};
    const bf16_t* wp = WKV + (size_t)(128 * h + r32) * 128 + 8 * hi; const bf16_t* ap = KVA + (size_t)(row0 + r32) * 128 + 8 * hi;
#pragma unroll 4
    for (int ks = 0; ks < 8; ++ks) { const bf16x8 b0 = *(const bf16x8*)(ap + ks * 16);
#pragma unroll
        for (int b = 0; b < 4; ++b) { const bf16x8 wf = *(const bf16x8*)(wp + (size_t)b * 32 * 128 + ks * 16); acc[b] = __builtin_amdgcn_mfma_f32_32x32x16_bf16(wf, b0, acc[b], 0, 0, 0); } }
    const int row = row0 + r32; const bool lat = row < RL; const int bb = lat ? (row >> 12) : ((row - RL) >> 8), t = lat ? (row & 4095) : ((row - RL) & 255), key = lat ? CTXL + t : t;
    float kr[16];
    { const float* krp = KR + (size_t)row * 32 + 16 * hi;
#pragma unroll
      for (int q = 0; q < 4; ++q) { const f32x4 v = ld4(krp + 4 * q); kr[4 * q] = v[0]; kr[4 * q + 1] = v[1]; kr[4 * q + 2] = v[2]; kr[4 * q + 3] = v[3]; } }
    float ss = 0.f;
#pragma unroll
    for (int b = 0; b < 2; ++b)
#pragma unroll
        for (int r = 0; r < 16; ++r) ss += acc[b][r] * acc[b][r];
#pragma unroll
    for (int i = 0; i < 16; ++i) ss += kr[i] * kr[i];
    ss = half_swap_sum(ss); const float rn = rsqrtf(ss * (1.f / 96.f) + EPS);
    bf16_t* ko = Kb + (((size_t)bb * NH + h) * NKEY + key) * QKH; bf16_t* vo = Vb + (((size_t)bb * NH + h) * NKEY + key) * VD;
#pragma unroll
    for (int b = 0; b < 2; ++b)
#pragma unroll
        for (int rq = 0; rq < 4; ++rq) { const int f0 = 32 * b + 8 * rq + 4 * hi; const f32x4 g = ld4(kn_g + f0);
            *(u32x2*)(ko + f0) = (u32x2){cvt_pk_bf16(acc[b][4 * rq] * rn * g[0], acc[b][4 * rq + 1] * rn * g[1]), cvt_pk_bf16(acc[b][4 * rq + 2] * rn * g[2], acc[b][4 * rq + 3] * rn * g[3])};
            *(u32x2*)(vo + f0) = (u32x2){cvt_pk_bf16(acc[2 + b][4 * rq], acc[2 + b][4 * rq + 1]), cvt_pk_bf16(acc[2 + b][4 * rq + 2], acc[2 + b][4 * rq + 3])}; }
    unsigned pk[8];
#pragma unroll
    for (int q = 0; q < 8; ++q) { float x1 = kr[2 * q] * rn * kn_g[64 + 16 * hi + 2 * q], x2 = kr[2 * q + 1] * rn * kn_g[65 + 16 * hi + 2 * q];
        if (lat) rope_pair(ROPE, t, 8 * hi + q, x1, x2);
        pk[q] = cvt_pk_bf16(x1, x2); }
    *(u32x4*)(ko + 64 + 16 * hi) = (u32x4){pk[0], pk[1], pk[2], pk[3]}; *(u32x4*)(ko + 72 + 16 * hi) = (u32x4){pk[4], pk[5], pk[6], pk[7]};
}
__device__ __forceinline__ void sp_item(const bf16_t* __restrict__ VT, const bf16_t* __restrict__ WSP, const float* __restrict__ bsp, const bf16_t* __restrict__ U, bf16_t* __restrict__ MIX, int chunk, int h, int ih, int lane) {
    const int r32 = lane & 31, hi = lane >> 5;
    f32x16 acc[2][2];
#pragma unroll
    for (int cb = 0; cb < 2; ++cb)
#pragma unroll
        for (int ib = 0; ib < 2; ++ib) acc[cb][ib] = f32x16{};
    const bf16_t* vp = VT + ((size_t)chunk * 256 + 64 * h + r32) * 128 + 8 * hi; const bf16_t* wp = WSP + ((size_t)h * 128 + 64 * ih + r32) * 128 + 8 * hi;
#pragma unroll 4
    for (int ks = 0; ks < 8; ++ks) { const bf16x8 a0 = *(const bf16x8*)(vp + ks * 16), a1 = *(const bf16x8*)(vp + 32 * 128 + ks * 16), b0 = *(const bf16x8*)(wp + ks * 16), b1 = *(const bf16x8*)(wp + 32 * 128 + ks * 16);
        acc[0][0] = __builtin_amdgcn_mfma_f32_32x32x16_bf16(a0, b0, acc[0][0], 0, 0, 0); acc[0][1] = __builtin_amdgcn_mfma_f32_32x32x16_bf16(a0, b1, acc[0][1], 0, 0, 0);
        acc[1][0] = __builtin_amdgcn_mfma_f32_32x32x16_bf16(a1, b0, acc[1][0], 0, 0, 0); acc[1][1] = __builtin_amdgcn_mfma_f32_32x32x16_bf16(a1, b1, acc[1][1], 0, 0, 0); }
#pragma unroll
    for (int ib = 0; ib < 2; ++ib) { const int i = 64 * ih + 32 * ib + r32; const float bias = bsp[h * 128 + i]; const size_t row = (size_t)chunk * 128 + i;
#pragma unroll
        for (int cb = 0; cb < 2; ++cb)
#pragma unroll
            for (int rq = 0; rq < 4; ++rq) { const int c = 64 * h + 32 * cb + 8 * rq + 4 * hi; const u32x2 uu = *(const u32x2*)(U + row * 256 + c);
                const float u0 = __uint_as_float(uu[0] << 16), u1 = __uint_as_float(uu[0] & 0xffff0000u), u2 = __uint_as_float(uu[1] << 16), u3 = __uint_as_float(uu[1] & 0xffff0000u);
                *(u32x2*)(MIX + row * DM + c) = (u32x2){cvt_pk_bf16(u0 * (acc[cb][ib][4 * rq] + bias), u1 * (acc[cb][ib][4 * rq + 1] + bias)), cvt_pk_bf16(u2 * (acc[cb][ib][4 * rq + 2] + bias), u3 * (acc[cb][ib][4 * rq + 3] + bias))}; } }
}
__device__ __forceinline__ void pool_item(const bf16_t* __restrict__ BW, const float* __restrict__ pscale, bf16_t* __restrict__ MIX, int row0, int lane) {
    const int row = row0 + (lane >> 5), n0 = (lane & 31) * 8, g = n0 >> 6, hw = 1 << g;
    int t, ntok; if (row < RL) { t = row & 4095; ntok = SEQ; } else { t = (row - RL) & 255; ntok = CTXL; }
    const int base = row - t, lo = max(t - hw, 0), hi = min(t + hw, ntok);
    float s[8];
#pragma unroll
    for (int j = 0; j < 8; ++j) s[j] = 0.f;
    for (int q = lo; q < hi; ++q) { const u32x4 v = *(const u32x4*)(BW + (size_t)(base + q) * 256 + n0);
#pragma unroll
        for (int j = 0; j < 4; ++j) { s[2 * j] += __uint_as_float(v[j] << 16); s[2 * j + 1] += __uint_as_float(v[j] & 0xffff0000u); } }
    const float inv = 1.f / (float)(hi - lo); const u32x4 v = *(const u32x4*)(BW + (size_t)row * 256 + n0); const f32x4 p0 = ld4(pscale + n0), p1 = ld4(pscale + n0 + 4);
    float z[8];
#pragma unroll
    for (int j = 0; j < 4; ++j) { z[2 * j] = s[2 * j] * inv - __uint_as_float(v[j] << 16); z[2 * j + 1] = s[2 * j + 1] * inv - __uint_as_float(v[j] & 0xffff0000u); }
    *(u32x4*)(MIX + (size_t)row * DM + 256 + n0) = (u32x4){cvt_pk_bf16(z[0] * p0[0], z[1] * p0[1]), cvt_pk_bf16(z[2] * p0[2], z[3] * p0[3]), cvt_pk_bf16(z[4] * p1[0], z[5] * p1[1]), cvt_pk_bf16(z[6] * p1[2], z[7] * p1[3])};
}
}

__device__ __forceinline__ void transpose_item(const float* W, int ldw, int K, bf16_t* WT, int k0, int n0, int dst_row0, LAS float* scr, int lane) {
#pragma unroll 8
    for (int i = 0; i < 32; ++i) { const int kk = 2 * i + (lane >> 5); scr[kk * 33 + (lane & 31)] = W[(size_t)(k0 + kk) * ldw + n0 + (lane & 31)]; }
    asm volatile("s_waitcnt lgkmcnt(0)" ::: "memory");
    const int c = lane & 7;
#pragma unroll
    for (int j = 0; j < 4; ++j) { const int n = (lane >> 3) + 8 * j; const LAS float* sp = scr + (8 * c) * 33 + n;
        u32x4 o; o.x = cvt_pk_bf16(sp[0 * 33], sp[1 * 33]); o.y = cvt_pk_bf16(sp[2 * 33], sp[3 * 33]); o.z = cvt_pk_bf16(sp[4 * 33], sp[5 * 33]); o.w = cvt_pk_bf16(sp[6 * 33], sp[7 * 33]);
        *(u32x4*)(WT + (size_t)(dst_row0 + n) * K + k0 + 8 * c) = o; }
    asm volatile("s_waitcnt lgkmcnt(0)" ::: "memory");
}


__device__ __forceinline__ void fold_item(const float* w_in_l, const float* w_pool_l, bf16_t* WT, int k0, int g, int dh, LAS float* scr, int lane) {
    float acc[32];
#pragma unroll
    for (int d = 0; d < 32; ++d) acc[d] = 0.f;
    const float* ar = w_in_l + (size_t)(k0 + lane) * DIN + 512 + 64 * g; const float* wp = w_pool_l + (size_t)g * 64 * 64 + 32 * dh;
    for (int cc = 0; cc < 64; ++cc) { const float av = ar[cc];
#pragma unroll
        for (int d = 0; d < 32; ++d) acc[d] += av * wp[cc * 64 + d]; }
#pragma unroll
    for (int d = 0; d < 32; ++d) scr[lane * 33 + d] = acc[d];
    asm volatile("s_waitcnt lgkmcnt(0)" ::: "memory");
    const int c = lane & 7;
#pragma unroll
    for (int j = 0; j < 4; ++j) { const int n = (lane >> 3) + 8 * j; const LAS float* sp = scr + (8 * c) * 33 + n;
        u32x4 o; o.x = cvt_pk_bf16(sp[0 * 33], sp[1 * 33]); o.y = cvt_pk_bf16(sp[2 * 33], sp[3 * 33]); o.z = cvt_pk_bf16(sp[4 * 33], sp[5 * 33]); o.w = cvt_pk_bf16(sp[6 * 33], sp[7 * 33]);
        *(u32x4*)(WT + (size_t)(512 + 64 * g + 32 * dh + n) * DM + k0 + 8 * c) = o; }
    asm volatile("s_waitcnt lgkmcnt(0)" ::: "memory");
}

#define XB_TMO      128
#define XB_XCNT(j)  (256  + 64 * (j))
#define XB_XSUB(j)  (1280 + 64 * (j))
#define XB_XGEN(j)  (2304 + 64 * (j))
#define XB_TOP      3328
#define XB_TOPGEN   3392
#define XCD_BAR_WORDS 3456
#define XB_SPIN_CAP (1u << 18)
__device__ __forceinline__ unsigned xb_ld(unsigned* p)              { return __hip_atomic_load(p, __ATOMIC_RELAXED, __HIP_MEMORY_SCOPE_AGENT); }
__device__ __forceinline__ unsigned xb_add(unsigned* p, unsigned v) { return __hip_atomic_fetch_add(p, v, __ATOMIC_RELAXED, __HIP_MEMORY_SCOPE_AGENT); }
__device__ __forceinline__ unsigned xb_xcc_id() { return (unsigned)__builtin_amdgcn_s_getreg((3 << 11) | 20) & 0xFu; }
#define XB_SPIN(cond, bar) do { unsigned _sp = 0; while (cond) { __builtin_amdgcn_s_sleep(1); \
    if ((++_sp & 255u) == 0u) { if (xb_ld(&(bar)[XB_TMO])) break; if (_sp > XB_SPIN_CAP) { atomicAdd(&(bar)[XB_TMO], 1u); break; } } } } while (0)
struct XcdBarrier { unsigned* bar; unsigned x; volatile LAS unsigned* st; };
__device__ __forceinline__ XcdBarrier xcd_barrier_post(unsigned* bar, volatile LAS unsigned* st) {
    XcdBarrier b; b.bar = bar; b.x = xb_xcc_id(); b.st = st;
    if (threadIdx.x == 0) (void)xb_add(&bar[XB_XCNT(b.x)], 1u);
    return b;
}
__device__ __forceinline__ void xcd_barrier_complete(unsigned* bar, unsigned x, unsigned& nloc, unsigned& nx) {
    const unsigned G = gridDim.x * gridDim.y * gridDim.z;
    unsigned sum, cnt, mine, sp = 0u;
    for (;;) {
        sum = 0u; cnt = 0u; mine = 0u;
#pragma unroll
        for (unsigned j = 0; j < 16; ++j) { const unsigned c = xb_ld(&bar[XB_XCNT(j)]); sum += c; cnt += (c > 0u) ? 1u : 0u; mine = (j == x) ? c : mine; }
        if (sum == G) break;
        __builtin_amdgcn_s_sleep(1);
        if ((++sp & 255u) == 0u) { if (xb_ld(&bar[XB_TMO])) break; if (sp > XB_SPIN_CAP) { atomicAdd(&bar[XB_TMO], 1u); break; } }
    }
    nloc = mine > 0u ? mine : 1u; nx = cnt > 0u ? cnt : 1u;
}
__device__ __forceinline__ void xcd_barrier(const XcdBarrier& b) {
    asm volatile("s_waitcnt vmcnt(0)" ::: "memory");
    __syncthreads();
    if (threadIdx.x == 0) {
        unsigned* bar = b.bar;
        __builtin_amdgcn_s_waitcnt(0);
        unsigned nloc = b.st[0], nx = b.st[1];
        if (nloc == 0u) { xcd_barrier_complete(bar, b.x, nloc, nx); b.st[0] = nloc; b.st[1] = nx; }
        const unsigned old = xb_add(&bar[XB_XSUB(b.x)], 1u);
        const unsigned gen = old / nloc;
        if (old + 1u == (gen + 1u) * nloc) {
            __builtin_amdgcn_fence(__ATOMIC_RELEASE, "agent");
            asm volatile("s_waitcnt vmcnt(0)" ::: "memory");
            const unsigned og = xb_add(&bar[XB_TOP], 1u);
            const unsigned tg = og / nx;
            if (og + 1u == (tg + 1u) * nx) xb_add(&bar[XB_TOPGEN], 1u);
            else XB_SPIN(xb_ld(&bar[XB_TOPGEN]) == tg, bar);
            __builtin_amdgcn_fence(__ATOMIC_ACQUIRE, "agent");
            xb_add(&bar[XB_XGEN(b.x)], 1u);
            asm volatile("s_waitcnt vmcnt(0)" ::: "memory");
        } else {
            XB_SPIN(xb_ld(&bar[XB_XGEN(b.x)]) == gen, bar);
            __builtin_amdgcn_fence(__ATOMIC_ACQUIRE, "agent");
            asm volatile("s_waitcnt vmcnt(0)" ::: "memory");
        }
    }
    __syncthreads();
}

struct MkArgs { const float* in[23]; float* out; unsigned char* ws; int ph_lo, ph_hi; };
constexpr int MK_LDS = 147456;
constexpr int MK_XL_OFF = 131072;
enum { PH_P0A = 0, PH_P0B = 1, PH_L0 = 2, PH_PER_LAYER = 6, PH_G1 = 0, PH_G2 = 1, PH_G3 = 2, PH_G4 = 3, PH_G5 = 4, PH_G6 = 5, PH_END = 14 };

__global__ void __launch_bounds__(512, 2) mk_fwd(MkArgs a) {
    extern __shared__ __attribute__((aligned(16))) unsigned char lds_raw[];
    LAS unsigned char* lds = (LAS unsigned char*)lds_raw; LAS unsigned char* xl = lds + MK_XL_OFF;
    const int tid = threadIdx.x, lane = tid & 63, wave = __builtin_amdgcn_readfirstlane(tid >> 6);
    const int G = gridDim.x; const int gw = blockIdx.x * 8 + wave, NGW = G * 8;
    unsigned char* ws = a.ws;
    float* XL = a.out; float* XC = (float*)(ws + WS_XC); float* MOD = (float*)(ws + WS_MOD);
    float* RSQ1 = (float*)(ws + WS_RSQ1); float* RSQ2 = (float*)(ws + WS_RSQ2); bf16_t* XG = (bf16_t*)(ws + WS_XG); bf16_t* MIX = (bf16_t*)(ws + WS_MIX); bf16_t* ACT = (bf16_t*)(ws + WS_ACT);
    float* BIAS2P = (float*)(ws + WS_BIAS2P);
    const float* norm1_g = a.in[4]; const float* norm2_g = a.in[5];
#define IN(k) (a.ph_lo <= (k) && (k) < a.ph_hi)
    volatile LAS unsigned* bst = (volatile LAS unsigned*)(lds + MK_XL_OFF + 8192);
    if (tid < 4) bst[tid] = 0u;
    __syncthreads();
    const bool fused = (a.ph_hi - a.ph_lo) > 1;
    XcdBarrier gbar; gbar.bar = (unsigned*)ws; gbar.x = 0; gbar.st = bst;
    if (fused) gbar = xcd_barrier_post((unsigned*)ws, bst);
#define GRID_BAR(k) do { if (IN(k) && IN((k) + 1)) xcd_barrier(gbar); } while (0)
    if (IN(PH_P0A)) {
        {   LAS float* sl = (LAS float*)lds; LAS float* part = (LAS float*)(lds + 20480);
            for (int i = tid; i < 5 * DM; i += 512) { const int mr = i >> 10, k = i & 1023; const float v = mr < 4 ? a.in[1][mr * DM + k] : a.in[3][k]; sl[i] = silu_f(v); }
            __syncthreads();
            for (int strip = blockIdx.x; strip < DEPTH * 128; strip += G) { const int l = strip >> 7, n0 = (strip & 127) * 48;
                const int kg = tid / 12, c4 = tid % 12;
                if (tid < 504) { f32x4 acc[5];
#pragma unroll
                    for (int r = 0; r < 5; ++r) acc[r] = (f32x4){0.f, 0.f, 0.f, 0.f};
                    const float* wp = a.in[6] + (size_t)l * DM * (NMOD * DM) + n0 + c4 * 4;
#pragma unroll 4
                    for (int k = kg; k < DM; k += 42) { const f32x4 w = ld4(wp + (size_t)k * (NMOD * DM));
#pragma unroll
                        for (int r = 0; r < 5; ++r) acc[r] += w * sl[r * DM + k]; }
#pragma unroll
                    for (int r = 0; r < 5; ++r) *(LAS f32x4*)(part + (kg * 5 + r) * 48 + c4 * 4) = acc[r]; }
                __syncthreads();
                if (tid < 240) { const int r = tid / 48, c = tid % 48; float sum = 0.f;
                    for (int q = 0; q < 42; ++q) sum += part[(q * 5 + r) * 48 + c];
                    MOD[((size_t)l * 5 + r) * (NMOD * DM) + n0 + c] = sum + a.in[7][l * NMOD * DM + n0 + c]; }
                __syncthreads(); }
        }
        if (blockIdx.x == 0) { float* ROPE = (float*)(ws + WS_ROPE); const int pos = tid >> 3, i = tid & 7;
            const float inv = (float)exp2(-(double)i / 8.0 * 13.287712379549449); const float ang = (float)pos * inv;
            double sn, cs; sincos_d((double)ang, sn, cs); ROPE[tid * 2] = (float)cs; ROPE[tid * 2 + 1] = (float)sn; }
        LAS float* scr = (LAS float*)(lds + wave * 16384);
        for (int l = 0; l < DEPTH; ++l) {
            bf16_t* WB = (bf16_t*)(ws + WS_WB + (size_t)l * 22 * MiB);
            const float* w_out = a.in[20] + (size_t)l * DM * DM; const float* w_gu = a.in[21] + (size_t)l * DM * 2 * DFF; const float* w_dn = a.in[22] + (size_t)l * DFF * DM;
            const float* w_in = a.in[8] + (size_t)l * DM * DIN; const float* w_pool = a.in[12] + (size_t)l * 4 * 64 * 64;
            const float* w_qb = a.in[15] + (size_t)l * 256 * 768; const float* w_kvb = a.in[17] + (size_t)l * 128 * 1024; const float* w_sp = a.in[10] + (size_t)l * 4 * 128 * 128;
            constexpr int I_OUT = 16 * 32, I_GU = 16 * 176, I_DN = 44 * 32, I_IN = 16 * 29, I_FOLD = 16 * 8, I_Z = 96 * DM / 512, I_QB = 4 * 24, I_KVB = 2 * 32, I_SP = 4 * 128 * 128 / 512;
            constexpr int I_ALL = I_OUT + I_GU + I_DN + I_IN + I_FOLD + I_Z + I_QB + I_KVB + I_SP;
            for (int it = gw; it < I_ALL; it += NGW) { int r = it;
                if (r < I_QB) { const int kb = r / 24, nb = r % 24; transpose_item(w_qb, 768, 256, WB + WL_QB, kb * 64, nb * 32, nb * 32, scr, lane); continue; } r -= I_QB;
                if (r < I_KVB) { const int kb = r / 32, nb = r % 32; transpose_item(w_kvb, 1024, 128, WB + WL_KVB, kb * 64, nb * 32, nb * 32, scr, lane); continue; } r -= I_KVB;
                if (r < I_SP) { const float* sp_ = w_sp + (size_t)r * 512 + lane * 8; const f32x4 x0 = ld4(sp_), x1 = ld4(sp_ + 4);
                    *(u32x4*)(WB + WL_SP + (size_t)r * 512 + lane * 8) = (u32x4){cvt_pk_bf16(x0[0], x0[1]), cvt_pk_bf16(x0[2], x0[3]), cvt_pk_bf16(x1[0], x1[1]), cvt_pk_bf16(x1[2], x1[3])}; continue; } r -= I_SP;
                if (r < I_IN) { const int kb = r / 29, nq = r % 29, nb = nq < 16 ? nq : nq + 8; transpose_item(w_in, DIN, DM, WB + WL_IN, kb * 64, nb * 32, nb * 32, scr, lane); continue; } r -= I_IN;
                if (r < I_FOLD) { const int kb = r >> 3, g = (r >> 1) & 3, dh = r & 1; fold_item(w_in, w_pool, WB + WL_IN, kb * 64, g, dh, scr, lane); continue; } r -= I_FOLD;
                if (r < I_Z) { *(u32x4*)(WB + WL_IN + (size_t)DIN * DM + (size_t)r * 512 + lane * 8) = (u32x4){0u, 0u, 0u, 0u}; continue; } r -= I_Z;
                if (r < I_OUT) { const int kb = r / 32, nb = r % 32; transpose_item(w_out, DM, DM, WB + WL_OUT, kb * 64, nb * 32, nb * 32, scr, lane); continue; } r -= I_OUT;
                if (r < I_GU) { const int kb = r / 176, nb = r % 176; const int n0 = nb * 32, f = n0 % DFF, isup = n0 / DFF; transpose_item(w_gu, 2 * DFF, DM, WB + WL_GU, kb * 64, n0, 256 * (f / 128) + 128 * isup + (f % 128), scr, lane); continue; } r -= I_GU;
                { const int kb = r / 32, nb = r % 32; transpose_item(w_dn, DM, DFF, WB + WL_DN, kb * 64, nb * 32, nb * 32, scr, lane); }
            }
        }
    }
    GRID_BAR(PH_P0A);
    if (IN(PH_P0B)) {
        float* BIAS1P = (float*)(ws + WS_BIAS1P);
        constexpr int NB_ROWS = 2 * DFF + 1280;
        for (int it = gw; it < DEPTH * NB_ROWS; it += NGW) { const int l = it / NB_ROWS; int n = it % NB_ROWS; const bool isgu = n < 2 * DFF; if (!isgu) n -= 2 * DFF;
            const bf16_t* wrow = (const bf16_t*)(ws + WS_WB + (size_t)l * 22 * MiB) + (isgu ? WL_GU : WL_IN) + (size_t)n * DM; const float* sh = MOD + (size_t)l * 5 * NMOD * DM + (isgu ? 3 : 0) * DM;
            float* outp = isgu ? BIAS2P + (size_t)l * 5 * 2 * DFF + n : BIAS1P + (size_t)l * 5 * 1280 + n; const int ldo = isgu ? 2 * DFF : 1280;
            float w[16]; { const u32x4 q0 = *(const u32x4*)(wrow + lane * 16), q1 = *(const u32x4*)(wrow + lane * 16 + 8);
#pragma unroll
                for (int j = 0; j < 4; ++j) { w[2 * j] = __uint_as_float(q0[j] << 16); w[2 * j + 1] = __uint_as_float(q0[j] & 0xffff0000u); w[8 + 2 * j] = __uint_as_float(q1[j] << 16); w[9 + 2 * j] = __uint_as_float(q1[j] & 0xffff0000u); } }
#pragma unroll
            for (int r = 0; r < 5; ++r) { const float* sv = sh + (size_t)r * NMOD * DM + lane * 16; float acc = 0.f;
#pragma unroll
                for (int j = 0; j < 16; ++j) acc += sv[j] * w[j];
                acc = wave_sum(acc); if (lane == 0) outp[(size_t)r * ldo] = acc; }
        }
    }
    if (IN(PH_P0B)) {
        const float* sc = MOD + 1 * DM;
        for (int r = gw; r < R; r += NGW) {
            const float* xr = r < RL ? a.in[0] + (size_t)r * DM : a.in[2] + (size_t)(r - RL) * DM; float* xo = r < RL ? XL + (size_t)r * DM : XC + (size_t)(r - RL) * DM;
            const float* scr_ = sc + (size_t)mrow_of(r) * (NMOD * DM); float ssv[4];
#pragma unroll
            for (int j = 0; j < 4; ++j) { const int k = j * 256 + lane * 4; const f32x4 v = ld4(xr + k), gg = ld4(norm1_g + k), s4 = ld4(scr_ + k);
                *(f32x4*)(xo + k) = v; ssv[j] = wave_sum((v[0] * v[0] + v[1] * v[1]) + (v[2] * v[2] + v[3] * v[3]));
                const f32x4 z = v * gg * (s4 + 1.f); *(u32x2*)(XG + (size_t)r * DM + k) = (u32x2){cvt_pk_bf16(z[0], z[1]), cvt_pk_bf16(z[2], z[3])}; }
            if (lane == 0) *(f32x4*)(RSQ1 + (size_t)r * 4) = (f32x4){ssv[0], ssv[1], ssv[2], ssv[3]};
        }
    }
    GRID_BAR(PH_P0B);
    for (int l = 0; l < DEPTH; ++l) {
        const int pb = PH_L0 + l * PH_PER_LAYER; const int Mrows = (l == 0) ? R : RL;
        const bf16_t* WB = (const bf16_t*)(ws + WS_WB + (size_t)l * 22 * MiB); const float* modl = MOD + (size_t)l * 5 * NMOD * DM;
        if (IN(pb + PH_G1)) {
            pg8::Gemm g{XG, WB + WL_IN, R, 1280, DM}; pg8::StaticOrder S; S.init(R, 1280, G, (int)blockIdx.x);
            EpiG1 E{RSQ1, (const float*)(ws + WS_BIAS1P) + (size_t)l * 5 * 1280, a.in[9] + l * 256, a.in[14] + l * 256, a.in[16] + l * 128,
                    (bf16_t*)(ws + WS_U), (bf16_t*)(ws + WS_VT), (bf16_t*)(ws + WS_BW), (bf16_t*)(ws + WS_QA), (bf16_t*)(ws + WS_KVA), (float*)(ws + WS_KR)};
            pg8::gemm_phase(lds, xl, g, S, E);
        }
        GRID_BAR(pb + PH_G1);
        if (IN(pb + PH_G2)) {
            const bf16_t* Uq = (const bf16_t*)(ws + WS_U); const bf16_t* VTq = (const bf16_t*)(ws + WS_VT); const bf16_t* BWq = (const bf16_t*)(ws + WS_BW); const bf16_t* QAq = (const bf16_t*)(ws + WS_QA);
            const bf16_t* KVAq = (const bf16_t*)(ws + WS_KVA); const float* KRq = (const float*)(ws + WS_KR); const float* ROPEq = (const float*)(ws + WS_ROPE);
            bf16_t* Qo = (bf16_t*)(ws + WS_Q); bf16_t* Ko = (bf16_t*)(ws + WS_K); bf16_t* Vo = (bf16_t*)(ws + WS_V);
            const int nQ = (Mrows / 64) * NH, nKV = (R / 32) * NH, nSP = (Mrows / 128) * 8, nPL = Mrows / 2, nAll = nQ + nKV + nSP + nPL;
            for (int it = gw; it < nAll; it += NGW) { int r = it; int ln = lane; asm volatile("" : "+v"(ln));
                if (r < nQ) { g2::q_item(QAq, WB + WL_QB, a.in[18] + l * QKH, ROPEq, Qo, (r >> 3) * 64, r & 7, ln); continue; } r -= nQ;
                if (r < nKV) { g2::kv_item(KVAq, KRq, WB + WL_KVB, a.in[19] + l * QKH, ROPEq, Ko, Vo, (r >> 3) * 32, r & 7, ln); continue; } r -= nKV;
                if (r < nSP) { g2::sp_item(VTq, WB + WL_SP, a.in[11] + l * 4 * 128, Uq, MIX, r >> 3, (r >> 1) & 3, r & 1, ln); continue; } r -= nSP;
                g2::pool_item(BWq, a.in[13] + l * 256, MIX, r * 2, ln);
            }
        }
        GRID_BAR(pb + PH_G2);
        if (IN(pb + PH_G3)) {
            const bf16_t* Qp = (const bf16_t*)(ws + WS_Q); const bf16_t* Kp = (const bf16_t*)(ws + WS_K); const bf16_t* Vp = (const bf16_t*)(ws + WS_V);
            const int vcu = (G % 8 == 0) ? ((int)blockIdx.x % 8) * (G / 8) + (int)blockIdx.x / 8 : (int)blockIdx.x;
            const int nun = NB * NH * 16 + (l == 0 ? NB * NH : 0);
            for (int un = vcu; un < nun; un += G) {
                int bh, row0, seq;
                if (un < NB * NH * 16) { const int per = ((NB * NH * 16) % G == 0) ? (NB * NH * 16) / G : 0; const int v = per ? (un % G) * per + un / G : un; bh = v >> 4; row0 = (bh >> 3) * SEQ + (v & 15) * 256; seq = NKEY; }
                else { bh = un - NB * NH * 16; row0 = RL + (bh >> 3) * CTXL; seq = CTXL; }
                const int h = bh & 7;
                att::attn_unit(Qp + ((size_t)row0 * NH + h) * QKH, Kp + (size_t)bh * NKEY * QKH, Vp + (size_t)bh * NKEY * VD, MIX + (size_t)row0 * DM + 512 + h * 64, seq, lds);
            }
        }
        GRID_BAR(pb + PH_G3);
        if (IN(pb + PH_G4)) {
            pg8::Gemm g{MIX, WB + WL_OUT, Mrows, DM, DM}; pg8::StaticOrder S; S.init(Mrows, DM, G, (int)blockIdx.x);
            EpiRes E{XL, XC, modl + 2 * DM, RSQ2, XG, norm2_g + l * DM, modl + 4 * DM, 1, 0};
            pg8::gemm_phase(lds, xl, g, S, E);
        }
        GRID_BAR(pb + PH_G4);
        if (IN(pb + PH_G5)) {
            pg8::Gemm g{XG, WB + WL_GU, Mrows, 2 * DFF, DM}; pg8::StaticOrder S; S.init(Mrows, 2 * DFF, G, (int)blockIdx.x);
            EpiGU E{ACT, RSQ2, BIAS2P + (size_t)l * 5 * 2 * DFF};
            pg8::gemm_phase(lds, xl, g, S, E);
        }
        GRID_BAR(pb + PH_G5);
        if (IN(pb + PH_G6)) {
            pg8::Gemm g{ACT, WB + WL_DN, Mrows, DM, DFF}; pg8::StaticOrder S; S.init(Mrows, DM, G, (int)blockIdx.x);
            const int nx = l + 1 < DEPTH;
            EpiRes E{XL, XC, modl + 5 * DM, RSQ1, XG, norm1_g + (nx ? (l + 1) * DM : 0), MOD + (size_t)(nx ? l + 1 : 0) * 5 * NMOD * DM + 1 * DM, nx, 0};
            pg8::gemm_phase(lds, xl, g, S, E);
        }
        GRID_BAR(pb + PH_G6);
    }
#undef IN
}

extern "C" void kernel_launch(void* const* d_in, const int* in_sizes, int n_in, void* d_out, int out_size, void* d_ws, size_t ws_size, hipStream_t stream) {
    if (n_in != 23 || ws_size < 256 * MiB || out_size != RL * DM) { fprintf(stderr, "kernel_launch: unexpected shapes (n_in %d, out %d, ws %zu)\n", n_in, out_size, ws_size); return; }
    unsigned char* ws = (unsigned char*)d_ws;
    static int grid = 0;
    if (grid == 0) {
        int dev = 0, cus = 0, per_cu = 0;
        if (hipGetDevice(&dev) != hipSuccess || hipDeviceGetAttribute(&cus, hipDeviceAttributeMultiprocessorCount, dev) != hipSuccess) { fprintf(stderr, "device query failed\n"); return; }
        if (hipFuncSetAttribute((const void*)mk_fwd, hipFuncAttributeMaxDynamicSharedMemorySize, MK_LDS) != hipSuccess) { fprintf(stderr, "hipFuncSetAttribute failed\n"); return; }
        if (hipOccupancyMaxActiveBlocksPerMultiprocessor(&per_cu, (const void*)mk_fwd, 512, MK_LDS) != hipSuccess || per_cu < 1) { fprintf(stderr, "occupancy query: %d\n", per_cu); (void)hipGetLastError(); return; }
        grid = cus;
    }
    MkArgs ma{}; for (int i = 0; i < 23; ++i) ma.in[i] = (const float*)d_in[i]; ma.out = (float*)d_out; ma.ws = ws;
#define MK(lo, hi) do { ma.ph_lo = (lo); ma.ph_hi = (hi); hipLaunchKernelGGL(mk_fwd, dim3(grid), dim3(512), MK_LDS, stream, ma); } while (0)
    if (hipMemsetAsync(ws, 0, 65536, stream) != hipSuccess) { fprintf(stderr, "memset failed\n"); return; }
#if FUSED
    MK(0, PH_END);
#else
    for (int ph = 0; ph < PH_END; ++ph) { MK(ph, ph + 1); if (ph == DUPH || ph == DUPH2) MK(ph, ph + 1); }
#endif
}
```

```cpp
#include <hip/hip_runtime.h>
#include <cstdint>
#include <cstdio>
#define FUSED 1
#ifndef DUPH
#define DUPH -1
#endif
#ifndef DRYPH
#define DRYPH -1
#endif
#ifndef DUPH2
#define DUPH2 -1
#endif

constexpr int DM = 1024, NB = 4, SEQ = 4096, CTXL = 256, DEPTH = 2;
constexpr int RL = NB * SEQ;
constexpr int RC = NB * CTXL;
constexpr int R = RL + RC;
constexpr int WA = 256, DIN = 1184, DFF = 2816, NMOD = 6;
constexpr int NH = 8, QKH = 96, QKN = 64, QKR = 32, VD = 64, QRANK = 256, KVRANK = 128;
constexpr int NKEY = CTXL + SEQ;
constexpr float EPS = 1e-6f;
constexpr float QSCALE = 0.10206207261596577f * 1.4426950408889634f;

typedef unsigned short bf16_t;
__device__ __forceinline__ float bf2f(bf16_t v) { return __uint_as_float(((unsigned)v) << 16); }
__device__ __forceinline__ bf16_t f2bf(float f) { unsigned u = __float_as_uint(f); return (bf16_t)((u + 0x7fffu + ((u >> 16) & 1u)) >> 16); }
__device__ __forceinline__ int mrow_of(int r) { return r < RL ? (r >> 12) : 4; }
__device__ __forceinline__ float wave_sum(float v) {
#pragma unroll
    for (int o = 1; o < 64; o <<= 1) v += __shfl_xor(v, o);
    return v;
}
__device__ __forceinline__ float silu_f(float x) { return x / (1.f + __expf(-x)); }
__device__ __forceinline__ float gelu_f(float x) { return 0.5f * x * (1.f + erff(x * 0.70710678118654752f)); }

constexpr size_t MiB = 1u << 20;
constexpr size_t WS_MOD = 1 * MiB;
constexpr size_t WS_BIAS1 = WS_MOD + 256 * 1024;
constexpr size_t WS_BIAS2 = WS_BIAS1 + 64 * 1024;
constexpr size_t WS_ROPE = WS_BIAS2 + 256 * 1024;
constexpr size_t WS_RSQ1 = 2 * MiB;
constexpr size_t WS_RSQ2 = 2 * MiB + 512 * 1024;
constexpr size_t WS_XC = 4 * MiB;
constexpr size_t WS_XG = 8 * MiB;
constexpr size_t WS_MIX = 42 * MiB;
constexpr size_t WS_W = 76 * MiB;
constexpr size_t WS_OV = 120 * MiB;
constexpr size_t WS_ACT = WS_OV;
constexpr size_t WS_U = WS_OV;
constexpr size_t WS_VT = WS_U + (size_t)R * 256 * 2;
constexpr size_t WS_BW = WS_VT + (size_t)R * 256 * 2;
constexpr size_t WS_QA = WS_BW + (size_t)R * 256 * 2;
constexpr size_t WS_KVA = WS_QA + (size_t)R * 256 * 2;
constexpr size_t WS_KR = WS_KVA + (size_t)R * 128 * 2;
constexpr size_t WS_Q = 161 * MiB;
constexpr size_t WS_K = WS_Q + (size_t)R * 768 * 2;
constexpr size_t WS_V = WS_K + (size_t)NB * NH * NKEY * QKH * 2;
constexpr size_t WS_P = 161 * MiB;
static_assert(WS_KR + (size_t)R * 32 * 4 <= WS_Q, "map");
static_assert(WS_V + (size_t)NB * NH * NKEY * VD * 2 <= 256 * MiB, "map");
static_assert(WS_P + (size_t)R * DIN * 4 <= 256 * MiB, "map");
static_assert(WS_ACT + (size_t)R * DFF * 2 <= 256 * MiB, "map");

__device__ void sincos_d(double x, double& s, double& c) {
    const double k = rint(x * 0.63661977236758134308); const double r = fma(-k, 1.5707963267948966192, x) - k * 6.123233995736766e-17;
    const double r2 = r * r;
    double sp = -7.6471637318198164759e-13; sp = sp * r2 + 1.6059043836821614599e-10; sp = sp * r2 - 2.5052108385441718775e-08; sp = sp * r2 + 2.7557319223985890653e-06; sp = sp * r2 - 1.9841269841269841270e-04; sp = sp * r2 + 8.3333333333333333333e-03; sp = sp * r2 - 1.6666666666666666667e-01; sp = r + r * r2 * sp;
    double cp = 4.7794773323873852974e-14; cp = cp * r2 - 1.1470745597729724714e-11; cp = cp * r2 + 2.0876756987868098979e-09; cp = cp * r2 - 2.7557319223985890653e-07; cp = cp * r2 + 2.4801587301587301587e-05; cp = cp * r2 - 1.3888888888888888889e-03; cp = cp * r2 + 4.1666666666666666667e-02; cp = cp * r2 - 0.5; cp = 1.0 + r2 * cp;
    const int q = ((int)k) & 3;
    s = (q == 0) ? sp : (q == 1) ? cp : (q == 2) ? -sp : -cp;
    c = (q == 0) ? cp : (q == 1) ? -sp : (q == 2) ? -cp : sp;
}
__device__ __forceinline__ float rstd_of(const float* RSQ, int r) { const float4 p = *(const float4*)(RSQ + (size_t)r * 4); return rsqrtf(((p.x + p.y) + (p.z + p.w)) * (1.f / DM) + EPS); }

#define LAS __attribute__((address_space(3)))
#define GAS __attribute__((address_space(1)))
typedef short bf16x8 __attribute__((ext_vector_type(8)));
typedef float f32x4 __attribute__((ext_vector_type(4)));
typedef float f32x2 __attribute__((ext_vector_type(2)));
typedef unsigned u32x4 __attribute__((ext_vector_type(4)));
typedef unsigned u32x2 __attribute__((ext_vector_type(2)));
__device__ __forceinline__ unsigned cvt_pk_bf16(float lo, float hi) { unsigned r; asm volatile("v_cvt_pk_bf16_f32 %0, %1, %2" : "=v"(r) : "v"(lo), "v"(hi)); return r; }
__device__ __forceinline__ float fast_silu(float x) { return x * __builtin_amdgcn_rcpf(1.f + __builtin_amdgcn_exp2f(-1.4426950408889634f * x)); }

constexpr size_t WL_IN = 0;
constexpr size_t WL_OUT = WL_IN + (size_t)1280 * 1024;
constexpr size_t WL_GU = WL_OUT + (size_t)1024 * 1024;
constexpr size_t WL_DN = WL_GU + (size_t)5632 * 1024;
constexpr size_t WL_QB = WL_DN + (size_t)1024 * 2816;
constexpr size_t WL_KVB = WL_QB + (size_t)768 * 256;
constexpr size_t WL_SP = WL_KVB + (size_t)1024 * 128;
constexpr size_t WL_END = WL_SP + (size_t)4 * 128 * 128;
static_assert(WL_END * 2 <= 22 * MiB, "weights per layer");
constexpr size_t WS_WB = WS_W;
constexpr size_t WS_BIAS2P = 3 * MiB;
constexpr size_t WS_BIAS1P = 3 * MiB + 256 * 1024;

namespace pg8 {
constexpr int BM = 256, BK = 64, HALF = 128, HTB = HALF * BK * 2, STAGE_BYTES = 8 * HTB, NXCD = 8, WGM = 8;
__host__ __device__ __forceinline__ int lds_byte(int r, int c) { const int st = (r >> 4) * 2 + (c >> 5), rr = r & 15, cc = c & 31, ob = rr * 64 + cc * 2; return st * 1024 + (ob ^ (((ob >> 9) & 1) << 5)); }
__host__ __device__ __forceinline__ void stage_rc(int b, int& Rr, int& C) { const int st = b / 1024, sb = b % 1024, swz = sb ^ (((sb >> 9) & 1) << 5); Rr = (st >> 1) * 16 + swz / 64; C = (st & 1) * 32 + (swz % 64) / 2; }
__host__ __device__ __forceinline__ int perm32(int rho) { const int n = rho >> 4, i = rho & 15; return 8 * (i >> 2) + 4 * n + (i & 3); }
struct Unit { int pm, pn; };
struct Gemm { const bf16_t* A; const bf16_t* Bt; int M, N, K; };
struct StaticOrder {
    int nM, nN, nwg, G, c;
    __device__ void init(int M, int N, int G_, int c_) { nM = M / BM; nN = N / BM; nwg = nM * nN; G = G_; c = c_; }
    __device__ bool next(int i, Unit& u) const {
        const long L = (long)i * G + c; if (L >= nwg) return false;
        int wgid = (int)L; { const int q = nwg / NXCD, r = nwg % NXCD, xcd = wgid % NXCD, off = wgid / NXCD; wgid = (xcd < r ? xcd * (q + 1) : r * (q + 1) + (xcd - r) * q) + off; }
        const int nig = WGM * nN, gid = wgid / nig, fm = gid * WGM, gsz = (nM - fm) < WGM ? (nM - fm) : WGM;
        u.pm = fm + ((wgid % nig) % gsz); u.pn = (wgid % nig) / gsz; return true;
    }
};
template <class Epi, class Sched>
__device__ __forceinline__ void gemm_phase(LAS unsigned char* lds, LAS unsigned char* xl, const Gemm g, const Sched& S, const Epi& E) {
    int tid = threadIdx.x; asm volatile("" : "+v"(tid));
    const int wid = __builtin_amdgcn_readfirstlane(tid >> 6), lane = tid & 63, wr = wid >> 2, wc = wid & 3, fr = lane & 15, fq = lane >> 4;
    const int K = g.K, nt = K / BK;
    unsigned voffA[2], voffB[2];
#pragma unroll
    for (int i = 0; i < 2; ++i) { int Rr, C; stage_rc(tid * 16 + i * 8192, Rr, C); const int Rb = (Rr & ~31) + perm32(Rr & 31);
        voffA[i] = (unsigned)(Rr * K + C) * 2u; voffB[i] = (unsigned)(Rb * K + C) * 2u; }
    const size_t kstep = (size_t)(BK * 2);
    const size_t hstep = (size_t)HALF * K * 2;
    const size_t tstep = 2 * hstep;
    const unsigned ldsw = (unsigned)wid * 1024u;
    const int aoff = lds_byte(wr * 64 + fr, fq * 8), boff = lds_byte(wc * 32 + fr, fq * 8);
#define PG8_SA(b, h) (((b) * 2 + (h)) * HTB)
#define PG8_SB(b, h) ((4 + (b) * 2 + (h)) * HTB)
#define PG8_STAGE(bufoff, gbase, voff) do { _Pragma("unroll") for (int _i = 0; _i < 2; ++_i) \
        __builtin_amdgcn_global_load_lds((const unsigned*)((const char*)(gbase) + (voff)[_i]), (LAS unsigned*)(lds + (bufoff) + ldsw + _i * 8192), 16, 0, 0); } while (0)
#define PG8_LDA(dst, b, h) do { _Pragma("unroll") for (int m = 0; m < 4; ++m) _Pragma("unroll") for (int k = 0; k < 2; ++k) dst[m][k] = *(const LAS bf16x8*)(lds + PG8_SA(b, h) + aoff + m * 2048 + k * 1024); } while (0)
#define PG8_LDB(dst, b, h) do { _Pragma("unroll") for (int n = 0; n < 2; ++n) _Pragma("unroll") for (int k = 0; k < 2; ++k) dst[n][k] = *(const LAS bf16x8*)(lds + PG8_SB(b, h) + boff + n * 2048 + k * 1024); } while (0)
#define PG8_MMA(ai, bj, At, Bt) do { __builtin_amdgcn_s_setprio(1); _Pragma("unroll") for (int m = 0; m < 4; ++m) _Pragma("unroll") for (int n = 0; n < 2; ++n) _Pragma("unroll") for (int k = 0; k < 2; ++k) \
        acc[ai][bj][m][n] = __builtin_amdgcn_mfma_f32_16x16x32_bf16(Bt[n][k], At[m][k], acc[ai][bj][m][n], 0, 0, 0); __builtin_amdgcn_s_setprio(0); } while (0)
#define PG8_WAIT_V(n) asm volatile("s_waitcnt vmcnt(" #n ")" ::: "memory")
#define PG8_WAIT_L(n) asm volatile("s_waitcnt lgkmcnt(" #n ")" ::: "memory")
#define PG8_BAR __builtin_amdgcn_s_barrier()
#define PG8_SCHED __builtin_amdgcn_sched_barrier(0)
    Unit cur, nxt; int ui = 0;
    if (!S.next(0, cur)) return;
    f32x4 acc[2][2][4][2];
#pragma unroll
    for (int a = 0; a < 2; ++a)
#pragma unroll
        for (int b = 0; b < 2; ++b)
#pragma unroll
            for (int m = 0; m < 4; ++m)
#pragma unroll
                for (int n = 0; n < 2; ++n) acc[a][b][m][n] = (f32x4){0.f, 0.f, 0.f, 0.f};
    bf16x8 At[4][2], B0[2][2], B1[2][2];
    const char* cA = (const char*)g.A + (size_t)cur.pm * tstep; const char* cB = (const char*)g.Bt + (size_t)cur.pn * tstep;
    PG8_STAGE(PG8_SB(0, 0), cB, voffB); PG8_STAGE(PG8_SB(0, 1), cB + hstep, voffB); PG8_STAGE(PG8_SA(0, 0), cA, voffA); PG8_STAGE(PG8_SA(0, 1), cA + hstep, voffA);
    if (wr == 1) PG8_BAR;
    PG8_WAIT_V(2); PG8_BAR;
    PG8_STAGE(PG8_SB(1, 0), cB + kstep, voffB); PG8_STAGE(PG8_SA(1, 0), cA + kstep, voffA); PG8_STAGE(PG8_SB(1, 1), cB + hstep + kstep, voffB);
    PG8_WAIT_V(6); PG8_BAR;
    for (;;) {
        const bool has_next = S.next(ui + 1, nxt);
        const char* nA = has_next ? (const char*)g.A + (size_t)nxt.pm * tstep : cA; const char* nB = has_next ? (const char*)g.Bt + (size_t)nxt.pn * tstep : cB;
        for (int t = 0; t < nt; t += 2) {
            const bool last = (t == nt - 2);
            const char* a1 = cA + (size_t)(t + 1) * kstep;
            const char* a2 = last ? nA : cA + (size_t)(t + 2) * kstep; const char* b2 = last ? nB : cB + (size_t)(t + 2) * kstep;
            const char* a3 = a2 + kstep; const char* b3 = b2 + kstep;
            PG8_LDB(B0, 0, 0); PG8_LDB(B1, 0, 1); PG8_SCHED; PG8_LDA(At, 0, 0); PG8_STAGE(PG8_SA(1, 1), a1 + hstep, voffA);
            PG8_WAIT_V(8); PG8_WAIT_L(0); PG8_BAR; PG8_MMA(0, 0, At, B0); PG8_MMA(0, 1, At, B1); PG8_BAR; PG8_SCHED;
            PG8_LDA(At, 0, 1); PG8_STAGE(PG8_SB(0, 0), b2, voffB); PG8_STAGE(PG8_SB(0, 1), b2 + hstep, voffB); PG8_STAGE(PG8_SA(0, 0), a2, voffA);
            PG8_WAIT_V(8); PG8_WAIT_L(0); PG8_BAR; PG8_MMA(1, 0, At, B0); PG8_MMA(1, 1, At, B1); PG8_BAR; PG8_SCHED;
            PG8_LDB(B0, 1, 0); PG8_LDB(B1, 1, 1); PG8_SCHED; PG8_LDA(At, 1, 0); PG8_STAGE(PG8_SA(0, 1), a2 + hstep, voffA);
            PG8_WAIT_V(8); PG8_WAIT_L(0); PG8_BAR; PG8_MMA(0, 0, At, B0); PG8_MMA(0, 1, At, B1); PG8_BAR; PG8_SCHED;
            PG8_LDA(At, 1, 1); PG8_STAGE(PG8_SB(1, 0), b3, voffB); PG8_STAGE(PG8_SB(1, 1), b3 + hstep, voffB); PG8_STAGE(PG8_SA(1, 0), a3, voffA);
            PG8_WAIT_V(8); PG8_WAIT_L(0); PG8_BAR; PG8_MMA(1, 0, At, B0); PG8_MMA(1, 1, At, B1); PG8_BAR; PG8_SCHED;
        }
        if (wr == 0) PG8_BAR;
        { int fr_ = fr, fq_ = fq; asm volatile("" : "+v"(fr_), "+v"(fq_)); E(acc, cur, wr, wc, fr_, fq_, xl); }
        if (!has_next) break;
#pragma unroll
        for (int a = 0; a < 2; ++a)
#pragma unroll
            for (int b = 0; b < 2; ++b)
#pragma unroll
                for (int m = 0; m < 4; ++m)
#pragma unroll
                    for (int n = 0; n < 2; ++n) acc[a][b][m][n] = (f32x4){0.f, 0.f, 0.f, 0.f};
        cur = nxt; cA = nA; cB = nB; ++ui;
        if (wr == 1) PG8_BAR;
    }
    PG8_WAIT_V(0);
    PG8_BAR;
#undef PG8_SA
#undef PG8_SB
#undef PG8_STAGE
#undef PG8_LDA
#undef PG8_LDB
#undef PG8_MMA
}
}

__device__ __forceinline__ f32x4 ld4(const float* p) { return *(const f32x4*)p; }
struct EpiGU {
    bf16_t* ACT; const float* RSQ; const float* BIAS;
    __device__ __forceinline__ void operator()(f32x4 (&acc)[2][2][4][2], const pg8::Unit& u, int wr, int wc, int fr, int fq, LAS unsigned char*) const {
        const int row0 = u.pm * 256 + wr * 64 + fr; const int mr = mrow_of(u.pm * 256);
        const float* bb = BIAS + (size_t)mr * (2 * DFF) + u.pn * 256 + wc * 32 + 8 * fq;
        const f32x4 bg0 = ld4(bb), bg1 = ld4(bb + 4), bu0 = ld4(bb + 128), bu1 = ld4(bb + 132);
        bf16_t* ob = ACT + u.pn * 128 + wc * 32 + 8 * fq;
#pragma unroll
        for (int ai = 0; ai < 2; ++ai)
#pragma unroll
            for (int m = 0; m < 4; ++m) { const int row = row0 + ai * 128 + m * 16; const float rs = rstd_of(RSQ, row);
                const f32x4 g0 = acc[ai][0][m][0] * rs + bg0, g1 = acc[ai][0][m][1] * rs + bg1, u0 = acc[ai][1][m][0] * rs + bu0, u1 = acc[ai][1][m][1] * rs + bu1;
                u32x4 w; w.x = cvt_pk_bf16(fast_silu(g0[0]) * u0[0], fast_silu(g0[1]) * u0[1]); w.y = cvt_pk_bf16(fast_silu(g0[2]) * u0[2], fast_silu(g0[3]) * u0[3]);
                w.z = cvt_pk_bf16(fast_silu(g1[0]) * u1[0], fast_silu(g1[1]) * u1[1]); w.w = cvt_pk_bf16(fast_silu(g1[2]) * u1[2], fast_silu(g1[3]) * u1[3]);
                *(u32x4*)(ob + (size_t)row * DFF) = w; }
    }
};
struct EpiRes {
    float* XL; float* XC; const float* gate; float* RSQ; bf16_t* XG; const float* ng; const float* nsc; int do_next; int dry;
    __device__ __forceinline__ void operator()(f32x4 (&acc)[2][2][4][2], const pg8::Unit& u, int wr, int wc, int fr, int fq, LAS unsigned char* xl) const {
        if (dry) { asm volatile("" :: "v"(acc[0][0][0][0]), "v"(acc[1][1][3][1])); return; }
        const int mr = mrow_of(u.pm * 256); const int col0 = u.pn * 256 + wc * 32 + 8 * fq; const int rl0 = wr * 64 + fr;
        float* xbase = u.pm < 64 ? XL + (size_t)(u.pm * 256) * DM : XC + (size_t)(u.pm * 256 - RL) * DM;
        LAS float* P = (LAS float*)xl;
        float ss[8];
#pragma unroll
        for (int q = 0; q < 8; ++q) ss[q] = 0.f;
#pragma unroll
        for (int bj = 0; bj < 2; ++bj) {
            f32x4 gt[2], gm[2];
#pragma unroll
            for (int n = 0; n < 2; ++n) { const int c = col0 + bj * 128 + 4 * n; gt[n] = ld4(gate + (size_t)mr * (NMOD * DM) + c);
                if (do_next) gm[n] = ld4(ng + c) * (ld4(nsc + (size_t)mr * (NMOD * DM) + c) + 1.f); else gm[n] = (f32x4){0.f, 0.f, 0.f, 0.f}; }
#pragma unroll
            for (int ai = 0; ai < 2; ++ai) {
                f32x4 xv[4][2];
#pragma unroll
                for (int m = 0; m < 4; ++m) { const float* xp = xbase + (size_t)(rl0 + ai * 128 + m * 16) * DM + col0 + bj * 128; xv[m][0] = ld4(xp); xv[m][1] = ld4(xp + 4); }
#pragma unroll
                for (int m = 0; m < 4; ++m) { const int q = ai * 4 + m; const int rl = rl0 + ai * 128 + m * 16; float* xp = xbase + (size_t)rl * DM + col0 + bj * 128;
                    const f32x4 y0 = xv[m][0] + gt[0] * acc[ai][bj][m][0], y1 = xv[m][1] + gt[1] * acc[ai][bj][m][1];
                    *(f32x4*)(xp) = y0; *(f32x4*)(xp + 4) = y1;
                    if (do_next) { ss[q] += (y0[0] * y0[0] + y0[1] * y0[1]) + (y0[2] * y0[2] + y0[3] * y0[3]) + (y1[0] * y1[0] + y1[1] * y1[1]) + (y1[2] * y1[2] + y1[3] * y1[3]);
                        const f32x4 z0 = y0 * gm[0], z1 = y1 * gm[1]; u32x4 w; w.x = cvt_pk_bf16(z0[0], z0[1]); w.y = cvt_pk_bf16(z0[2], z0[3]); w.z = cvt_pk_bf16(z1[0], z1[1]); w.w = cvt_pk_bf16(z1[2], z1[3]);
                        *(u32x4*)(XG + (size_t)(u.pm * 256 + rl) * DM + col0 + bj * 128) = w; } }
                asm volatile("" ::: "memory");
            }
        }
        if (do_next) {
#pragma unroll
            for (int q = 0; q < 8; ++q) { float t = ss[q]; t += __shfl_xor(t, 16); t += __shfl_xor(t, 32); if (fq == 0) P[(rl0 + (q >> 2) * 128 + (q & 3) * 16) * 4 + wc] = t; }
        }
        if (do_next) {
            asm volatile("s_waitcnt lgkmcnt(0)" ::: "memory"); __builtin_amdgcn_s_barrier(); asm volatile("" ::: "memory");
            const int tid = threadIdx.x;
            if (tid < 256) { const f32x4 p = *(const LAS f32x4*)(P + tid * 4); RSQ[(size_t)(u.pm * 256 + tid) * 4 + u.pn] = (p[0] + p[1]) + (p[2] + p[3]); }
        }
    }
};


__device__ __forceinline__ float gelu_fast(float v) {
    const float av = fabsf(v), d = av * 0.2316418882f + 1.0f, t = __builtin_amdgcn_rcpf(d);
    float q = t * 0.5307027145f + (-0.7265760135f); q = q * t + 0.7107068705f; q = q * t + (-0.142248368f); q = q * t + 0.127414796f; q = q * t;
    const float e = __builtin_amdgcn_exp2f((v * v) * (-0.72134752044f));
    const float m = v * (q * e), r = v - m; return v < 0.f ? m : r;
}
struct EpiG1 {
    const float* RSQ; const float* BIAS; const float* sgu_g; const float* qa_g; const float* kva_g;
    bf16_t* U; bf16_t* VT; bf16_t* BW; bf16_t* QA; bf16_t* KVA; float* KR;
#define G1_PACK(v0, v1) (u32x4){cvt_pk_bf16((v0)[0], (v0)[1]), cvt_pk_bf16((v0)[2], (v0)[3]), cvt_pk_bf16((v1)[0], (v1)[1]), cvt_pk_bf16((v1)[2], (v1)[3])}
#define G1_SS(v) (((v)[0] * (v)[0] + (v)[1] * (v)[1]) + ((v)[2] * (v)[2] + (v)[3] * (v)[3]))
    __device__ __forceinline__ void operator()(f32x4 (&acc)[2][2][4][2], const pg8::Unit& u, int wr, int wc, int fr, int fq, LAS unsigned char* xl) const {
        const int mr = mrow_of(u.pm * 256); const int cl = wc * 32 + 8 * fq; const int rl0 = wr * 64 + fr; const int pn = u.pn;
        LAS float* P = (LAS float*)xl;
        {   f32x4 bv[2][2];
#pragma unroll
            for (int bj = 0; bj < 2; ++bj)
#pragma unroll
                for (int n = 0; n < 2; ++n) bv[bj][n] = ld4(BIAS + (size_t)mr * 1280 + pn * 256 + bj * 128 + cl + 4 * n);
            const bool act = (pn <= 1);
#pragma unroll
            for (int ai = 0; ai < 2; ++ai)
#pragma unroll
                for (int m = 0; m < 4; ++m) { const float rs = rstd_of(RSQ, u.pm * 256 + rl0 + ai * 128 + m * 16);
#pragma unroll
                    for (int bj = 0; bj < 2; ++bj)
#pragma unroll
                        for (int n = 0; n < 2; ++n) { f32x4 v = acc[ai][bj][m][n] * rs + bv[bj][n];
                            if (act) v = (f32x4){gelu_fast(v[0]), gelu_fast(v[1]), gelu_fast(v[2]), gelu_fast(v[3])};
                            acc[ai][bj][m][n] = v; }
                    if (m & 1) asm volatile("" ::: "memory"); }
        }
        if (pn == 0) {
#pragma unroll
            for (int ai = 0; ai < 2; ++ai)
#pragma unroll
                for (int m = 0; m < 4; ++m) { const int row = u.pm * 256 + rl0 + ai * 128 + m * 16;
#pragma unroll
                    for (int bj = 0; bj < 2; ++bj) *(u32x4*)(U + (size_t)row * 256 + bj * 128 + cl) = G1_PACK(acc[ai][bj][m][0], acc[ai][bj][m][1]); }
            return;
        }
        if (pn == 2) {
#pragma unroll
            for (int ai = 0; ai < 2; ++ai)
#pragma unroll
                for (int m = 0; m < 4; ++m) { const int row = u.pm * 256 + rl0 + ai * 128 + m * 16;
#pragma unroll
                    for (int bj = 0; bj < 2; ++bj) *(u32x4*)(BW + (size_t)row * 256 + bj * 128 + cl) = G1_PACK(acc[ai][bj][m][0], acc[ai][bj][m][1]); }
            return;
        }
#pragma unroll
        for (int ai = 0; ai < 2; ++ai)
#pragma unroll
            for (int m = 0; m < 4; ++m) { float ss = G1_SS(acc[ai][0][m][0]) + G1_SS(acc[ai][0][m][1]);
                if (pn != 4) ss += G1_SS(acc[ai][1][m][0]) + G1_SS(acc[ai][1][m][1]);
                ss += __shfl_xor(ss, 16); ss += __shfl_xor(ss, 32);
                if (fq == 0) P[(rl0 + ai * 128 + m * 16) * 4 + wc] = ss; }
        asm volatile("s_waitcnt lgkmcnt(0)" ::: "memory"); __builtin_amdgcn_s_barrier(); asm volatile("" ::: "memory");
        if (pn == 1) {
#pragma unroll
            for (int bj = 0; bj < 2; ++bj) { const f32x4 g0 = ld4(sgu_g + bj * 128 + cl), g1 = ld4(sgu_g + bj * 128 + cl + 4);
#pragma unroll
                for (int ai = 0; ai < 2; ++ai)
#pragma unroll
                    for (int m = 0; m < 4; ++m) { const int rl = rl0 + ai * 128 + m * 16; const int row = u.pm * 256 + rl;
                        const f32x4 p = *(const LAS f32x4*)(P + rl * 4); const float rn = rsqrtf(((p[0] + p[1]) + (p[2] + p[3])) * (1.f / 256.f) + EPS);
                        const f32x4 v0 = acc[ai][bj][m][0] * rn * g0, v1 = acc[ai][bj][m][1] * rn * g1;
                        bf16_t* vt = VT + ((size_t)(row >> 7) * 256 + bj * 128 + cl) * 128 + (row & 127);
#pragma unroll
                        for (int i = 0; i < 4; ++i) { vt[(size_t)i * 128] = (bf16_t)(cvt_pk_bf16(v0[i], 0.f) & 0xffffu); vt[(size_t)(4 + i) * 128] = (bf16_t)(cvt_pk_bf16(v1[i], 0.f) & 0xffffu); } } }
        } else if (pn == 3) {
#pragma unroll
            for (int bj = 0; bj < 2; ++bj) { const f32x4 g0 = ld4(qa_g + bj * 128 + cl), g1 = ld4(qa_g + bj * 128 + cl + 4);
#pragma unroll
                for (int ai = 0; ai < 2; ++ai)
#pragma unroll
                    for (int m = 0; m < 4; ++m) { const int rl = rl0 + ai * 128 + m * 16; const int row = u.pm * 256 + rl;
                        const f32x4 p = *(const LAS f32x4*)(P + rl * 4); const float rn = rsqrtf(((p[0] + p[1]) + (p[2] + p[3])) * (1.f / 256.f) + EPS);
                        const f32x4 v0 = acc[ai][bj][m][0] * rn * g0, v1 = acc[ai][bj][m][1] * rn * g1;
                        *(u32x4*)(QA + (size_t)row * 256 + bj * 128 + cl) = G1_PACK(v0, v1); } }
        } else {
            const f32x4 g0 = ld4(kva_g + cl), g1 = ld4(kva_g + cl + 4);
#pragma unroll
            for (int ai = 0; ai < 2; ++ai)
#pragma unroll
                for (int m = 0; m < 4; ++m) { const int rl = rl0 + ai * 128 + m * 16; const int row = u.pm * 256 + rl;
                    const f32x4 p = *(const LAS f32x4*)(P + rl * 4); const float rn = rsqrtf(((p[0] + p[1]) + (p[2] + p[3])) * (1.f / 128.f) + EPS);
                    const f32x4 v0 = acc[ai][0][m][0] * rn * g0, v1 = acc[ai][0][m][1] * rn * g1;
                    *(u32x4*)(KVA + (size_t)row * 128 + cl) = G1_PACK(v0, v1);
                    if (wc == 0) { *(f32x4*)(KR + (size_t)row * 32 + 8 * fq) = acc[ai][1][m][0]; *(f32x4*)(KR + (size_t)row * 32 + 8 * fq + 4) = acc[ai][1][m][1]; } }
        }
    }
#undef G1_PACK
#undef G1_SS
};


namespace att {
using s16x4 = __attribute__((ext_vector_type(4))) short;
using f32x16 = __attribute__((ext_vector_type(16))) float;
constexpr int KROW = 208;
constexpr int SHM_V = 64 * 64 * 2, SHM_K = 64 * KROW, OFF_K = 2 * SHM_V, OFF_WS = OFF_K + 2 * SHM_K, SHM_ATTN = OFF_WS + 8 * 64 * 4;
constexpr float THRL = 8.f;
#define ASBAR() __builtin_amdgcn_sched_barrier(0)
__device__ __forceinline__ int crow(int r, int hi) { return (r & 3) + 8 * (r >> 2) + 4 * hi; }
__device__ __forceinline__ int v_st(int k, int c) { const int kk = (k & ~0xC) | ((k & 4) << 1) | ((k & 8) >> 1); return ((kk >> 3) * 2 + (c >> 5)) * 512 + ((kk & 7) * 32 + (c & 31)) * 2; }
__device__ __forceinline__ int v_rd_base(int lane) { return ((lane & 3) << 3) | (((lane >> 2) & 3) << 6) | (((lane >> 4) & 1) << 5) | (((lane >> 5) & 1) << 8); }
constexpr int v_rd_off(int d0, int ks, int half) { return d0 * 512 + ks * 2048 + half * 1024; }
template <int OFF> __device__ __forceinline__ s16x4 tr_read(int vb) { s16x4 r; asm volatile("ds_read_b64_tr_b16 %0, %1 offset:%2" : "=&v"(r) : "v"(vb), "i"(OFF) : "memory"); return r; }
__device__ __forceinline__ void partialSM(f32x16& p0, f32x16& p1, float& m_reg, float& mn, float& alpha) {
    float pmax = p0[0];
#pragma unroll
    for (int r = 1; r < 16; ++r) pmax = fmaxf(pmax, p0[r]);
#pragma unroll
    for (int r = 0; r < 16; ++r) pmax = fmaxf(pmax, p1[r]);
    { auto rr = __builtin_amdgcn_permlane32_swap(__float_as_uint(pmax), __float_as_uint(pmax), false, false); pmax = fmaxf(__uint_as_float(rr[0]), __uint_as_float(rr[1])); }
    if (__builtin_expect(__all(pmax - m_reg <= THRL), 1)) { mn = m_reg; alpha = 1.f; }
    else { mn = fmaxf(m_reg, pmax); alpha = __builtin_amdgcn_exp2f(m_reg - mn); m_reg = mn; }
#pragma unroll
    for (int r = 0; r < 16; ++r) p0[r] = p0[r] - mn;
#pragma unroll
    for (int r = 0; r < 16; ++r) p1[r] = p1[r] - mn;
#pragma unroll
    for (int r = 0; r < 16; ++r) p0[r] = __builtin_amdgcn_exp2f(p0[r]);
}
__device__ __forceinline__ void finishSM(f32x16& p0, f32x16& p1, float alpha, float& l_reg, bf16x8& pa0, bf16x8& pa1, bf16x8& pa2, bf16x8& pa3) {
#pragma unroll
    for (int r = 0; r < 16; ++r) p1[r] = __builtin_amdgcn_exp2f(p1[r]);
    float ps = 0;
#pragma unroll
    for (int r = 0; r < 16; ++r) ps += p0[r];
#pragma unroll
    for (int r = 0; r < 16; ++r) ps += p1[r];
    { auto rr = __builtin_amdgcn_permlane32_swap(__float_as_uint(ps), __float_as_uint(ps), false, false); ps = __uint_as_float(rr[0]) + __uint_as_float(rr[1]); }
    l_reg = l_reg * alpha + ps;
#define PK4(P, BASE, OUT) do { unsigned a0 = cvt_pk_bf16(P[BASE + 0], P[BASE + 1]), a1 = cvt_pk_bf16(P[BASE + 2], P[BASE + 3]);   \
    unsigned b0 = cvt_pk_bf16(P[BASE + 4], P[BASE + 5]), b1 = cvt_pk_bf16(P[BASE + 6], P[BASE + 7]);                              \
    auto r0 = __builtin_amdgcn_permlane32_swap(a0, b0, false, false); auto r1 = __builtin_amdgcn_permlane32_swap(a1, b1, false, false); \
    u32x4 w = {r0[0], r1[0], r0[1], r1[1]}; OUT = *reinterpret_cast<bf16x8*>(&w); } while (0)
    PK4(p0, 0, pa0); PK4(p0, 8, pa1); PK4(p1, 0, pa2); PK4(p1, 8, pa3);
#undef PK4
}
__device__ __forceinline__ void qkt(f32x16& p0, f32x16& p1, LAS const unsigned char* Ks, const bf16x8 (&qr)[6], int r32, int hi) {
    p0 = f32x16{}; p1 = f32x16{};
#pragma unroll
    for (int d0 = 0; d0 < 6; ++d0) {
        const bf16x8 b0 = *(LAS const bf16x8*)(Ks + r32 * KROW + d0 * 32 + hi * 16);
        const bf16x8 b1 = *(LAS const bf16x8*)(Ks + (32 + r32) * KROW + d0 * 32 + hi * 16);
        p0 = __builtin_amdgcn_mfma_f32_32x32x16_bf16(b0, qr[d0], p0, 0, 0, 0);
        p1 = __builtin_amdgcn_mfma_f32_32x32x16_bf16(b1, qr[d0], p1, 0, 0, 0); }
}
template <int D0> __device__ __forceinline__ void pv_one(f32x16& od, int vb, bf16x8 pa0, bf16x8 pa1, bf16x8 pa2, bf16x8 pa3) {
    const s16x4 l0 = tr_read<v_rd_off(D0, 0, 0)>(vb), h0 = tr_read<v_rd_off(D0, 0, 1)>(vb), l1 = tr_read<v_rd_off(D0, 1, 0)>(vb), h1 = tr_read<v_rd_off(D0, 1, 1)>(vb);
    const s16x4 l2 = tr_read<v_rd_off(D0, 2, 0)>(vb), h2 = tr_read<v_rd_off(D0, 2, 1)>(vb), l3 = tr_read<v_rd_off(D0, 3, 0)>(vb), h3 = tr_read<v_rd_off(D0, 3, 1)>(vb);
    asm volatile("s_waitcnt lgkmcnt(0)" ::: "memory"); ASBAR();
#define PK(L, H) (bf16x8){L[0], L[1], L[2], L[3], H[0], H[1], H[2], H[3]}
    od = __builtin_amdgcn_mfma_f32_32x32x16_bf16(pa0, PK(l0, h0), od, 0, 0, 0);
    od = __builtin_amdgcn_mfma_f32_32x32x16_bf16(pa1, PK(l1, h1), od, 0, 0, 0);
    od = __builtin_amdgcn_mfma_f32_32x32x16_bf16(pa2, PK(l2, h2), od, 0, 0, 0);
    od = __builtin_amdgcn_mfma_f32_32x32x16_bf16(pa3, PK(l3, h3), od, 0, 0, 0);
#undef PK
}
__device__ __forceinline__ void attn_unit(const bf16_t* __restrict__ Qb, const bf16_t* __restrict__ Kh, const bf16_t* __restrict__ Vh, bf16_t* __restrict__ Ob, int seq, LAS unsigned char* lds) {
    int tid = threadIdx.x; asm volatile("" : "+v"(tid));
    const int wid = __builtin_amdgcn_readfirstlane(tid >> 6), lane = tid & 63, r32 = lane & 31, hi = lane >> 5;
    LAS float* wsf = (LAS float*)(lds + OFF_WS) + wid * 64; LAS float* li_l = wsf; LAS float* al_l = wsf + 32;
    float m_reg = -1e30f, l_reg = 0; f32x16 o[2] = {}; bf16x8 qr[6];
    const bf16_t* Qw = Qb + (size_t)(wid * 32 + r32) * 768 + hi * 8;
#pragma unroll
    for (int d0 = 0; d0 < 6; ++d0) qr[d0] = *(const bf16x8*)(Qw + d0 * 16);
    const bool isK = wid < 4; const int t = tid & 255;
    const unsigned char* gbase = isK ? (const unsigned char*)Kh : (const unsigned char*)Vh; const int tstride = isK ? 64 * 96 * 2 : 64 * 64 * 2;
    int loff0, loff1, loff2;
    { const int c0 = t, c1 = t + 256, c2 = t + 512;
      loff0 = isK ? (c0 / 12) * KROW + (c0 % 12) * 16 : v_st(c0 >> 3, (c0 & 7) * 8);
      loff1 = isK ? (c1 / 12) * KROW + (c1 % 12) * 16 : v_st(c1 >> 3, (c1 & 7) * 8);
      loff2 = (c2 / 12) * KROW + (c2 % 12) * 16; }
    const int vb0 = (int)(uintptr_t)(lds) + v_rd_base(lane);
    bf16x8 sA0, sA1, sA2, sB0, sB1, sB2;
#define SLOAD(S, tile) do { const unsigned char* p_ = gbase + (size_t)(tile) * tstride + t * 16; S##0 = *(const bf16x8*)(p_); S##1 = *(const bf16x8*)(p_ + 4096); if (isK) S##2 = *(const bf16x8*)(p_ + 8192); } while (0)
#define SWRITE(b, S) do { LAS unsigned char* d_ = lds + (isK ? OFF_K + (b) * SHM_K : (b) * SHM_V); *(LAS bf16x8*)(d_ + loff0) = S##0; *(LAS bf16x8*)(d_ + loff1) = S##1; if (isK) *(LAS bf16x8*)(d_ + loff2) = S##2; } while (0)
#define RESC(a) do { if (__any((a) < 1.f)) { if (hi == 0) al_l[r32] = (a); asm volatile("s_waitcnt lgkmcnt(0)" ::: "memory"); \
    _Pragma("unroll") for (int d = 0; d < 2; ++d) _Pragma("unroll") for (int r = 0; r < 16; ++r) o[d][r] *= al_l[crow(r, hi)]; } } while (0)
    f32x16 pA0, pA1, pB0, pB1; float mnA, mnB, alA, alB; bf16x8 pa0, pa1, pa2, pa3; const int NT = seq / 64;
    LAS const unsigned char* K0 = lds + OFF_K; LAS const unsigned char* K1 = lds + OFF_K + SHM_K;
    SLOAD(sA, 0); SWRITE(0, sA); __syncthreads();
    qkt(pA0, pA1, K0, qr, r32, hi); partialSM(pA0, pA1, m_reg, mnA, alA);
    SLOAD(sB, 1); if (2 < NT) SLOAD(sA, 2);
    SWRITE(1, sB); __syncthreads();
    for (int j = 1; j + 1 < NT; j += 2) {
        ASBAR(); qkt(pB0, pB1, K1, qr, r32, hi);
        finishSM(pA0, pA1, alA, l_reg, pa0, pa1, pa2, pa3); ASBAR();
        SLOAD(sB, j + 2); ASBAR();
        pv_one<0>(o[0], vb0, pa0, pa1, pa2, pa3); pv_one<1>(o[1], vb0, pa0, pa1, pa2, pa3); partialSM(pB0, pB1, m_reg, mnB, alB);
        __syncthreads(); SWRITE(0, sA);
        RESC(alB); __syncthreads();
        ASBAR(); qkt(pA0, pA1, K0, qr, r32, hi);
        finishSM(pB0, pB1, alB, l_reg, pa0, pa1, pa2, pa3); ASBAR();
        if (j + 3 < NT) SLOAD(sA, j + 3); ASBAR();
        pv_one<0>(o[0], vb0 + SHM_V, pa0, pa1, pa2, pa3); pv_one<1>(o[1], vb0 + SHM_V, pa0, pa1, pa2, pa3); partialSM(pA0, pA1, m_reg, mnA, alA);
        __syncthreads(); SWRITE(1, sB);
        RESC(alA); __syncthreads();
    }
    ASBAR(); qkt(pB0, pB1, K1, qr, r32, hi);
    finishSM(pA0, pA1, alA, l_reg, pa0, pa1, pa2, pa3); ASBAR();
    pv_one<0>(o[0], vb0, pa0, pa1, pa2, pa3); pv_one<1>(o[1], vb0, pa0, pa1, pa2, pa3); partialSM(pB0, pB1, m_reg, mnB, alB);
    __syncthreads(); RESC(alB);
    finishSM(pB0, pB1, alB, l_reg, pa0, pa1, pa2, pa3); ASBAR();
    pv_one<0>(o[0], vb0 + SHM_V, pa0, pa1, pa2, pa3); pv_one<1>(o[1], vb0 + SHM_V, pa0, pa1, pa2, pa3);
    if (hi == 0) li_l[r32] = l_reg; asm volatile("s_waitcnt lgkmcnt(0)" ::: "memory");
    int hi_e = hi, r32_e = r32; asm volatile("" : "+v"(hi_e), "+v"(r32_e));
    bf16_t* Ow = Ob + (size_t)(wid * 32 + 4 * hi_e) * DM + r32_e;
#pragma unroll
    for (int r = 0; r < 16; ++r) { const int orow = (r & 3) + 8 * (r >> 2); const float rl = __builtin_amdgcn_rcpf(li_l[orow + 4 * hi_e]);
#pragma unroll
        for (int d0 = 0; d0 < 2; ++d0) Ow[(size_t)orow * DM + d0 * 32] = (bf16_t)(cvt_pk_bf16(o[d0][r] * rl, 0.f) & 0xffffu); }
    __syncthreads();
#undef SLOAD
#undef SWRITE
#undef RESC
}
#undef ASBAR
}


namespace g2 {
using f32x16 = __attribute__((ext_vector_type(16))) float;
__device__ __forceinline__ int crow(int r, int hi) { return (r & 3) + 8 * (r >> 2) + 4 * hi; }
__device__ __forceinline__ float half_swap_sum(float v) { auto rr = __builtin_amdgcn_permlane32_swap(__float_as_uint(v), __float_as_uint(v), false, false); return __uint_as_float(rr[0]) + __uint_as_float(rr[1]); }
__device__ __forceinline__ void rope_pair(const float* __restrict__ ROPE, int t, int pp, float& x1, float& x2) {
    const int pos = pp < 8 ? (t >> 6) : (t & 63); const f32x2 cs = *(const f32x2*)(ROPE + (pos * 8 + (pp & 7)) * 2);
    const float y1 = x1 * cs[0] - x2 * cs[1], y2 = x1 * cs[1] + x2 * cs[0]; x1 = y1; x2 = y2;
}
__device__ __forceinline__ void q_item(const bf16_t* __restrict__ QA, const bf16_t* __restrict__ WQ, const float* __restrict__ qn_g, const float* __restrict__ ROPE, bf16_t* __restrict__ Q, int row0, int h, int lane) {
    const int r32 = lane & 31, hi = lane >> 5;
    f32x16 acc[2][3];
#pragma unroll
    for (int tg = 0; tg < 2; ++tg)
#pragma unroll
        for (int b = 0; b < 3; ++b) acc[tg][b] = f32x16{};
    const bf16_t* wp = WQ + (size_t)(96 * h + r32) * 256 + 8 * hi; const bf16_t* ap = QA + (size_t)(row0 + r32) * 256 + 8 * hi;
#pragma unroll 4
    for (int ks = 0; ks < 16; ++ks) {
        const bf16x8 b0 = *(const bf16x8*)(ap + ks * 16), b1 = *(const bf16x8*)(ap + 32 * 256 + ks * 16);
#pragma unroll
        for (int b = 0; b < 3; ++b) { const bf16x8 wf = *(const bf16x8*)(wp + (size_t)b * 32 * 256 + ks * 16);
            acc[0][b] = __builtin_amdgcn_mfma_f32_32x32x16_bf16(wf, b0, acc[0][b], 0, 0, 0); acc[1][b] = __builtin_amdgcn_mfma_f32_32x32x16_bf16(wf, b1, acc[1][b], 0, 0, 0); } }
#pragma unroll
    for (int tg = 0; tg < 2; ++tg) { const int row = row0 + tg * 32 + r32; const bool lat = row < RL; const int t = row & 4095;
        float ss = 0.f;
#pragma unroll
        for (int b = 0; b < 3; ++b)
#pragma unroll
            for (int r = 0; r < 16; ++r) ss += acc[tg][b][r] * acc[tg][b][r];
        ss = half_swap_sum(ss); const float rn = rsqrtf(ss * (1.f / 96.f) + EPS) * QSCALE;
        bf16_t* qo = Q + ((size_t)row * NH + h) * QKH + 4 * hi;
#pragma unroll
        for (int b = 0; b < 3; ++b)
#pragma unroll
            for (int rq = 0; rq < 4; ++rq) { const int f0 = 32 * b + 8 * rq + 4 * hi; const f32x4 g = ld4(qn_g + f0);
                float v0 = acc[tg][b][4 * rq] * rn * g[0], v1 = acc[tg][b][4 * rq + 1] * rn * g[1], v2 = acc[tg][b][4 * rq + 2] * rn * g[2], v3 = acc[tg][b][4 * rq + 3] * rn * g[3];
                if (b == 2 && lat) { const int pp = 4 * rq + 2 * hi; rope_pair(ROPE, t, pp, v0, v1); rope_pair(ROPE, t, pp + 1, v2, v3); }
                *(u32x2*)(qo + 32 * b + 8 * rq) = (u32x2){cvt_pk_bf16(v0, v1), cvt_pk_bf16(v2, v3)}; } }
}
__device__ __forceinline__ void kv_item(const bf16_t* __restrict__ KVA, const float* __restrict__ KR, const bf16_t* __restrict__ WKV, const float* __restrict__ kn_g, const float* __restrict__ ROPE,
                                        bf16_t* __restrict__ Kb, bf16_t* __restrict__ Vb, int row0, int h, int lane) {
    const int r32 = lane & 31, hi = lane >> 5;
    f32x16 acc[4];
#pragma unroll
    for (int b = 0; b < 4; ++b) acc[b] = f32x16{};
    const bf16_t* wp = WKV + (size_t)(128 * h + r32) * 128 + 8 * hi; const bf16_t* ap = KVA + (size_t)(row0 + r32) * 128 + 8 * hi;
#pragma unroll 4
    for (int ks = 0; ks < 8; ++ks) { const bf16x8 b0 = *(const bf16x8*)(ap + ks * 16);
#pragma unroll
        for (int b = 0; b < 4; ++b) { const bf16x8 wf = *(const bf16x8*)(wp + (size_t)b * 32 * 128 + ks * 16); acc[b] = __builtin_amdgcn_mfma_f32_32x32x16_bf16(wf, b0, acc[b], 0, 0, 0); } }
    const int row = row0 + r32; const bool lat = row < RL; const int bb = lat ? (row >> 12) : ((row - RL) >> 8), t = lat ? (row & 4095) : ((row - RL) & 255), key = lat ? CTXL + t : t;
    float kr[16];
    { const float* krp = KR + (size_t)row * 32 + 16 * hi;
#pragma unroll
      for (int q = 0; q < 4; ++q) { const f32x4 v = ld4(krp + 4 * q); kr[4 * q] = v[0]; kr[4 * q + 1] = v[1]; kr[4 * q + 2] = v[2]; kr[4 * q + 3] = v[3]; } }
    float ss = 0.f;
#pragma unroll
    for (int b = 0; b < 2; ++b)
#pragma unroll
        for (int r = 0; r < 16; ++r) ss += acc[b][r] * acc[b][r];
#pragma unroll
    for (int i = 0; i < 16; ++i) ss += kr[i] * kr[i];
    ss = half_swap_sum(ss); const float rn = rsqrtf(ss * (1.f / 96.f) + EPS);
    bf16_t* ko = Kb + (((size_t)bb * NH + h) * NKEY + key) * QKH; bf16_t* vo = Vb + (((size_t)bb * NH + h) * NKEY + key) * VD;
#pragma unroll
    for (int b = 0; b < 2; ++b)
#pragma unroll
        for (int rq = 0; rq < 4; ++rq) { const int f0 = 32 * b + 8 * rq + 4 * hi; const f32x4 g = ld4(kn_g + f0);
            *(u32x2*)(ko + f0) = (u32x2){cvt_pk_bf16(acc[b][4 * rq] * rn * g[0], acc[b][4 * rq + 1] * rn * g[1]), cvt_pk_bf16(acc[b][4 * rq + 2] * rn * g[2], acc[b][4 * rq + 3] * rn * g[3])};
            *(u32x2*)(vo + f0) = (u32x2){cvt_pk_bf16(acc[2 + b][4 * rq], acc[2 + b][4 * rq + 1]), cvt_pk_bf16(acc[2 + b][4 * rq + 2], acc[2 + b][4 * rq + 3])}; }
    unsigned pk[8];
#pragma unroll
    for (int q = 0; q < 8; ++q) { float x1 = kr[2 * q] * rn * kn_g[64 + 16 * hi + 2 * q], x2 = kr[2 * q + 1] * rn * kn_g[65 + 16 * hi + 2 * q];
        if (lat) rope_pair(ROPE, t, 8 * hi + q, x1, x2);
        pk[q] = cvt_pk_bf16(x1, x2); }
    *(u32x4*)(ko + 64 + 16 * hi) = (u32x4){pk[0], pk[1], pk[2], pk[3]}; *(u32x4*)(ko + 72 + 16 * hi) = (u32x4){pk[4], pk[5], pk[6], pk[7]};
}
__device__ __forceinline__ void sp_item(const bf16_t* __restrict__ VT, const bf16_t* __restrict__ WSP, const float* __restrict__ bsp, const bf16_t* __restrict__ U, bf16_t* __restrict__ MIX, int chunk, int h, int ih, int lane) {
    const int r32 = lane & 31, hi = lane >> 5;
    f32x16 acc[2][2];
#pragma unroll
    for (int cb = 0; cb < 2; ++cb)
#pragma unroll
        for (int ib = 0; ib < 2; ++ib) acc[cb][ib] = f32x16{};
    const bf16_t* vp = VT + ((size_t)chunk * 256 + 64 * h + r32) * 128 + 8 * hi; const bf16_t* wp = WSP + ((size_t)h * 128 + 64 * ih + r32) * 128 + 8 * hi;
#pragma unroll 4
    for (int ks = 0; ks < 8; ++ks) { const bf16x8 a0 = *(const bf16x8*)(vp + ks * 16), a1 = *(const bf16x8*)(vp + 32 * 128 + ks * 16), b0 = *(const bf16x8*)(wp + ks * 16), b1 = *(const bf16x8*)(wp + 32 * 128 + ks * 16);
        acc[0][0] = __builtin_amdgcn_mfma_f32_32x32x16_bf16(a0, b0, acc[0][0], 0, 0, 0); acc[0][1] = __builtin_amdgcn_mfma_f32_32x32x16_bf16(a0, b1, acc[0][1], 0, 0, 0);
        acc[1][0] = __builtin_amdgcn_mfma_f32_32x32x16_bf16(a1, b0, acc[1][0], 0, 0, 0); acc[1][1] = __builtin_amdgcn_mfma_f32_32x32x16_bf16(a1, b1, acc[1][1], 0, 0, 0); }
#pragma unroll
    for (int ib = 0; ib < 2; ++ib) { const int i = 64 * ih + 32 * ib + r32; const float bias = bsp[h * 128 + i]; const size_t row = (size_t)chunk * 128 + i;
#pragma unroll
        for (int cb = 0; cb < 2; ++cb)
#pragma unroll
            for (int rq = 0; rq < 4; ++rq) { const int c = 64 * h + 32 * cb + 8 * rq + 4 * hi; const u32x2 uu = *(const u32x2*)(U + row * 256 + c);
                const float u0 = __uint_as_float(uu[0] << 16), u1 = __uint_as_float(uu[0] & 0xffff0000u), u2 = __uint_as_float(uu[1] << 16), u3 = __uint_as_float(uu[1] & 0xffff0000u);
                *(u32x2*)(MIX + row * DM + c) = (u32x2){cvt_pk_bf16(u0 * (acc[cb][ib][4 * rq] + bias), u1 * (acc[cb][ib][4 * rq + 1] + bias)), cvt_pk_bf16(u2 * (acc[cb][ib][4 * rq + 2] + bias), u3 * (acc[cb][ib][4 * rq + 3] + bias))}; } }
}
__device__ __forceinline__ void pool_block(const bf16_t* __restrict__ BW, const float* __restrict__ pscale, bf16_t* __restrict__ MIX, int row0, LAS unsigned char* lds, int tid) {
    int t0, ntok; if (row0 < RL) { t0 = row0 & 4095; ntok = SEQ; } else { t0 = (row0 - RL) & 255; ntok = CTXL; }
    const int base = row0 - t0;
    __syncthreads();
#pragma unroll
    for (int j = 0; j < 5; ++j) { const int idx = tid + 512 * j; const int rr = idx >> 5, ch = idx & 31; const int t = t0 - 8 + rr;
        u32x4 v = (u32x4){0u, 0u, 0u, 0u}; if (t >= 0 && t < ntok) v = *(const u32x4*)(BW + (size_t)(base + t) * 256 + ch * 8);
        *(LAS u32x4*)(lds + rr * 512 + ch * 16) = v; }
    __syncthreads();
#pragma unroll
    for (int j = 0; j < 4; ++j) { const int idx = tid + 512 * j; const int rr = idx >> 5, ch = idx & 31, n0 = ch * 8, g = n0 >> 6, hw = 1 << g; const int t = t0 + rr;
        const int lo = max(t - hw, 0), hi = min(t + hw, ntok);
        float sm[8];
#pragma unroll
        for (int q = 0; q < 8; ++q) sm[q] = 0.f;
#pragma unroll
        for (int d = -8; d < 8; ++d) { if (d >= -hw && d < hw) { const u32x4 v = *(const LAS u32x4*)(lds + (rr + 8 + d) * 512 + ch * 16);
#pragma unroll
                for (int q = 0; q < 4; ++q) { sm[2 * q] += __uint_as_float(v[q] << 16); sm[2 * q + 1] += __uint_as_float(v[q] & 0xffff0000u); } } }
        const float inv = 1.f / (float)(hi - lo); const u32x4 v = *(const LAS u32x4*)(lds + (rr + 8) * 512 + ch * 16); const f32x4 p0 = ld4(pscale + n0), p1 = ld4(pscale + n0 + 4);
        float z[8];
#pragma unroll
        for (int q = 0; q < 4; ++q) { z[2 * q] = sm[2 * q] * inv - __uint_as_float(v[q] << 16); z[2 * q + 1] = sm[2 * q + 1] * inv - __uint_as_float(v[q] & 0xffff0000u); }
        *(u32x4*)(MIX + (size_t)(row0 + rr) * DM + 256 + n0) = (u32x4){cvt_pk_bf16(z[0] * p0[0], z[1] * p0[1]), cvt_pk_bf16(z[2] * p0[2], z[3] * p0[3]), cvt_pk_bf16(z[4] * p1[0], z[5] * p1[1]), cvt_pk_bf16(z[6] * p1[2], z[7] * p1[3])}; }
}
}

__device__ __forceinline__ void transpose_item(const float* W, int ldw, int K, bf16_t* WT, int k0, int n0, int dst_row0, LAS float* scr, int lane) {
    float tv[32];
#pragma unroll
    for (int i = 0; i < 32; ++i) tv[i] = W[(size_t)(k0 + 2 * i + (lane >> 5)) * ldw + n0 + (lane & 31)];
#pragma unroll
    for (int i = 0; i < 32; ++i) scr[(2 * i + (lane >> 5)) * 33 + (lane & 31)] = tv[i];
    asm volatile("s_waitcnt lgkmcnt(0)" ::: "memory");
    const int c = lane & 7;
#pragma unroll
    for (int j = 0; j < 4; ++j) { const int n = (lane >> 3) + 8 * j; const LAS float* sp = scr + (8 * c) * 33 + n;
        u32x4 o; o.x = cvt_pk_bf16(sp[0 * 33], sp[1 * 33]); o.y = cvt_pk_bf16(sp[2 * 33], sp[3 * 33]); o.z = cvt_pk_bf16(sp[4 * 33], sp[5 * 33]); o.w = cvt_pk_bf16(sp[6 * 33], sp[7 * 33]);
        *(u32x4*)(WT + (size_t)(dst_row0 + n) * K + k0 + 8 * c) = o; }
    asm volatile("s_waitcnt lgkmcnt(0)" ::: "memory");
}


__device__ __forceinline__ void fold_item(const float* w_in_l, const float* w_pool_l, bf16_t* WT, int k0, int g, int dh, LAS float* scr, int lane) {
    {   f32x4 av[16];
#pragma unroll
        for (int i = 0; i < 16; ++i) av[i] = ld4(w_in_l + (size_t)(k0 + i * 4 + (lane >> 4)) * DIN + 512 + 64 * g + (lane & 15) * 4);
#pragma unroll
        for (int i = 0; i < 16; ++i) { const int k = i * 4 + (lane >> 4), c0 = (lane & 15) * 4;
#pragma unroll
            for (int j = 0; j < 4; ++j) scr[k * 64 + ((c0 + j + k) & 63)] = av[i][j]; }
    }
    asm volatile("s_waitcnt lgkmcnt(0)" ::: "memory");
    float acc[32];
#pragma unroll
    for (int d = 0; d < 32; ++d) acc[d] = 0.f;
    const float* wp = w_pool_l + (size_t)g * 64 * 64 + 32 * dh;
#pragma unroll 4
    for (int cc = 0; cc < 64; ++cc) { const float av = scr[lane * 64 + ((cc + lane) & 63)];
#pragma unroll
        for (int d = 0; d < 32; ++d) acc[d] += av * wp[cc * 64 + d]; }
    asm volatile("s_waitcnt lgkmcnt(0)" ::: "memory");
#pragma unroll
    for (int d = 0; d < 32; ++d) scr[lane * 33 + d] = acc[d];
    asm volatile("s_waitcnt lgkmcnt(0)" ::: "memory");
    const int c = lane & 7;
#pragma unroll
    for (int j = 0; j < 4; ++j) { const int n = (lane >> 3) + 8 * j; const LAS float* sp = scr + (8 * c) * 33 + n;
        u32x4 o; o.x = cvt_pk_bf16(sp[0 * 33], sp[1 * 33]); o.y = cvt_pk_bf16(sp[2 * 33], sp[3 * 33]); o.z = cvt_pk_bf16(sp[4 * 33], sp[5 * 33]); o.w = cvt_pk_bf16(sp[6 * 33], sp[7 * 33]);
        *(u32x4*)(WT + (size_t)(512 + 64 * g + 32 * dh + n) * DM + k0 + 8 * c) = o; }
    asm volatile("s_waitcnt lgkmcnt(0)" ::: "memory");
}

#define XB_TMO      128
#define XB_XCNT(j)  (256  + 64 * (j))
#define XB_XSUB(j)  (1280 + 64 * (j))
#define XB_XGEN(j)  (2304 + 64 * (j))
#define XB_TOP      3328
#define XB_TOPGEN   3392
#define XCD_BAR_WORDS 3456
#define XB_SPIN_CAP (1u << 18)
__device__ __forceinline__ unsigned xb_ld(unsigned* p)              { return __hip_atomic_load(p, __ATOMIC_RELAXED, __HIP_MEMORY_SCOPE_AGENT); }
__device__ __forceinline__ unsigned xb_add(unsigned* p, unsigned v) { return __hip_atomic_fetch_add(p, v, __ATOMIC_RELAXED, __HIP_MEMORY_SCOPE_AGENT); }
__device__ __forceinline__ unsigned xb_xcc_id() { return (unsigned)__builtin_amdgcn_s_getreg((3 << 11) | 20) & 0xFu; }
#define XB_SPIN(cond, bar) do { unsigned _sp = 0; while (cond) { __builtin_amdgcn_s_sleep(1); \
    if ((++_sp & 255u) == 0u) { if (xb_ld(&(bar)[XB_TMO])) break; if (_sp > XB_SPIN_CAP) { atomicAdd(&(bar)[XB_TMO], 1u); break; } } } } while (0)
struct XcdBarrier { unsigned* bar; unsigned x; volatile LAS unsigned* st; };
__device__ __forceinline__ XcdBarrier xcd_barrier_post(unsigned* bar, volatile LAS unsigned* st) {
    XcdBarrier b; b.bar = bar; b.x = xb_xcc_id(); b.st = st;
    if (threadIdx.x == 0) (void)xb_add(&bar[XB_XCNT(b.x)], 1u);
    return b;
}
__device__ __forceinline__ void xcd_barrier_complete(unsigned* bar, unsigned x, unsigned& nloc, unsigned& nx) {
    const unsigned G = gridDim.x * gridDim.y * gridDim.z;
    unsigned sum, cnt, mine, sp = 0u;
    for (;;) {
        sum = 0u; cnt = 0u; mine = 0u;
#pragma unroll
        for (unsigned j = 0; j < 16; ++j) { const unsigned c = xb_ld(&bar[XB_XCNT(j)]); sum += c; cnt += (c > 0u) ? 1u : 0u; mine = (j == x) ? c : mine; }
        if (sum == G) break;
        __builtin_amdgcn_s_sleep(1);
        if ((++sp & 255u) == 0u) { if (xb_ld(&bar[XB_TMO])) break; if (sp > XB_SPIN_CAP) { atomicAdd(&bar[XB_TMO], 1u); break; } }
    }
    nloc = mine > 0u ? mine : 1u; nx = cnt > 0u ? cnt : 1u;
}
__device__ __forceinline__ void xcd_barrier(const XcdBarrier& b) {
    asm volatile("s_waitcnt vmcnt(0)" ::: "memory");
    __syncthreads();
    if (threadIdx.x == 0) {
        unsigned* bar = b.bar;
        __builtin_amdgcn_s_waitcnt(0);
        unsigned nloc = b.st[0], nx = b.st[1];
        if (nloc == 0u) { xcd_barrier_complete(bar, b.x, nloc, nx); b.st[0] = nloc; b.st[1] = nx; }
        const unsigned old = xb_add(&bar[XB_XSUB(b.x)], 1u);
        const unsigned gen = old / nloc;
        if (old + 1u == (gen + 1u) * nloc) {
            __builtin_amdgcn_fence(__ATOMIC_RELEASE, "agent");
            asm volatile("s_waitcnt vmcnt(0)" ::: "memory");
            const unsigned og = xb_add(&bar[XB_TOP], 1u);
            const unsigned tg = og / nx;
            if (og + 1u == (tg + 1u) * nx) xb_add(&bar[XB_TOPGEN], 1u);
            else XB_SPIN(xb_ld(&bar[XB_TOPGEN]) == tg, bar);
            __builtin_amdgcn_fence(__ATOMIC_ACQUIRE, "agent");
            xb_add(&bar[XB_XGEN(b.x)], 1u);
            asm volatile("s_waitcnt vmcnt(0)" ::: "memory");
        } else {
            XB_SPIN(xb_ld(&bar[XB_XGEN(b.x)]) == gen, bar);
            __builtin_amdgcn_fence(__ATOMIC_ACQUIRE, "agent");
            asm volatile("s_waitcnt vmcnt(0)" ::: "memory");
        }
    }
    __syncthreads();
}

struct MkArgs { const float* in[23]; float* out; unsigned char* ws; int ph_lo, ph_hi; int dry, pad; };
constexpr int MK_LDS = 147456;
constexpr int MK_XL_OFF = 131072;
enum { PH_P0A = 0, PH_P0B = 1, PH_L0 = 2, PH_PER_LAYER = 6, PH_G1 = 0, PH_G2 = 1, PH_G3 = 2, PH_G4 = 3, PH_G5 = 4, PH_G6 = 5, PH_END = 14 };

typedef const __attribute__((address_space(4))) MkArgs* KargPtr;
#define KARG() ({ KargPtr p_ = (KargPtr)__builtin_amdgcn_kernarg_segment_ptr(); asm volatile("" : "+s"(p_)); p_; })
#define WSP(kp, off) ((kp)->ws + (off))

__global__ void __launch_bounds__(512, 2) mk_fwd(MkArgs a) {
    extern __shared__ __attribute__((aligned(16))) unsigned char lds_raw[];
    LAS unsigned char* lds = (LAS unsigned char*)lds_raw; LAS unsigned char* xl = lds + MK_XL_OFF;
    const int ph_lo = a.ph_lo, ph_hi = a.ph_hi;
#define IN(k) (ph_lo <= (k) && (k) < ph_hi)
    volatile LAS unsigned* bst = (volatile LAS unsigned*)(lds + MK_XL_OFF + 8192);
    if (threadIdx.x < 4) bst[threadIdx.x] = 0u;
    __syncthreads();
    XcdBarrier gbar; gbar.bar = (unsigned*)a.ws; gbar.x = 0; gbar.st = bst;
    if (ph_hi - ph_lo > 1) gbar = xcd_barrier_post((unsigned*)a.ws, bst);
#define GRID_BAR(k) do { if (IN(k) && IN((k) + 1)) xcd_barrier(gbar); } while (0)
#define LANE_IDS() int tid = threadIdx.x; asm volatile("" : "+v"(tid)); const int lane = tid & 63, wave = __builtin_amdgcn_readfirstlane(tid >> 6); const int G = gridDim.x; const int gw = blockIdx.x * 8 + wave, NGW = G * 8; (void)lane; (void)gw; (void)NGW
    if (IN(PH_P0A)) {
        LANE_IDS(); KargPtr kp = KARG(); unsigned char* ws = kp->ws;
        {   LAS float* sl = (LAS float*)lds; LAS float* part = (LAS float*)(lds + 20480);
            float* MOD = (float*)(ws + WS_MOD); const float* cc = kp->in[1]; const float* cctx = kp->in[3]; const float* w_ada = kp->in[6]; const float* b_ada = kp->in[7];
            for (int i = tid; i < 5 * DM; i += 512) { const int mr = i >> 10, k = i & 1023; const float v = mr < 4 ? cc[mr * DM + k] : cctx[k]; sl[i] = silu_f(v); }
            __syncthreads();
            for (int strip = blockIdx.x; strip < DEPTH * 128; strip += G) { const int l = strip >> 7, n0 = (strip & 127) * 48;
                const int kg = tid / 12, c4 = tid % 12;
                if (tid < 504) { f32x4 acc[5];
#pragma unroll
                    for (int r = 0; r < 5; ++r) acc[r] = (f32x4){0.f, 0.f, 0.f, 0.f};
                    const float* wp = w_ada + (size_t)l * DM * (NMOD * DM) + n0 + c4 * 4;
#pragma unroll 13
                    for (int k = kg; k < DM; k += 42) { const f32x4 w = ld4(wp + (size_t)k * (NMOD * DM));
#pragma unroll
                        for (int r = 0; r < 5; ++r) acc[r] += w * sl[r * DM + k]; }
#pragma unroll
                    for (int r = 0; r < 5; ++r) *(LAS f32x4*)(part + (kg * 5 + r) * 48 + c4 * 4) = acc[r]; }
                __syncthreads();
                if (tid < 240) { const int r = tid / 48, c = tid % 48; float sum = 0.f;
#pragma unroll 6
                    for (int q = 0; q < 42; ++q) sum += part[(q * 5 + r) * 48 + c];
                    MOD[((size_t)l * 5 + r) * (NMOD * DM) + n0 + c] = sum + b_ada[l * NMOD * DM + n0 + c]; }
                __syncthreads(); }
        }
        if (blockIdx.x == 0) { float* ROPE = (float*)(ws + WS_ROPE); const int pos = tid >> 3, i = tid & 7;
            const float inv = (float)exp2(-(double)i / 8.0 * 13.287712379549449); const float ang = (float)pos * inv;
            double sn, cs; sincos_d((double)ang, sn, cs); ROPE[tid * 2] = (float)cs; ROPE[tid * 2 + 1] = (float)sn; }
        LAS float* scr = (LAS float*)(lds + wave * 16384);
        for (int l = 0; l < DEPTH; ++l) {
            bf16_t* WB = (bf16_t*)(ws + WS_WB + (size_t)l * 22 * MiB);
            constexpr int I_OUT = 16 * 32, I_GU = 16 * 176, I_DN = 44 * 32, I_IN = 16 * 29, I_FOLD = 16 * 8, I_Z = 96 * DM / 512, I_QB = 4 * 24, I_KVB = 2 * 32, I_SP = 4 * 128 * 128 / 512;
            constexpr int I_ALL = I_OUT + I_GU + I_DN + I_IN + I_FOLD + I_Z + I_QB + I_KVB + I_SP;
            for (int it = gw; it < I_ALL; it += NGW) { int r = it;
                if (r < I_FOLD) { const int kb = r >> 3, g = (r >> 1) & 3, dh = r & 1; fold_item(kp->in[8] + (size_t)l * DM * DIN, kp->in[12] + (size_t)l * 4 * 64 * 64, WB + WL_IN, kb * 64, g, dh, scr, lane); continue; } r -= I_FOLD;
                if (r < I_QB) { const int kb = r / 24, nb = r % 24; transpose_item(kp->in[15] + (size_t)l * 256 * 768, 768, 256, WB + WL_QB, kb * 64, nb * 32, nb * 32, scr, lane); continue; } r -= I_QB;
                if (r < I_KVB) { const int kb = r / 32, nb = r % 32; transpose_item(kp->in[17] + (size_t)l * 128 * 1024, 1024, 128, WB + WL_KVB, kb * 64, nb * 32, nb * 32, scr, lane); continue; } r -= I_KVB;
                if (r < I_SP) { const float* sp_ = kp->in[10] + (size_t)l * 4 * 128 * 128 + (size_t)r * 512 + lane * 8; const f32x4 x0 = ld4(sp_), x1 = ld4(sp_ + 4);
                    *(u32x4*)(WB + WL_SP + (size_t)r * 512 + lane * 8) = (u32x4){cvt_pk_bf16(x0[0], x0[1]), cvt_pk_bf16(x0[2], x0[3]), cvt_pk_bf16(x1[0], x1[1]), cvt_pk_bf16(x1[2], x1[3])}; continue; } r -= I_SP;
                if (r < I_IN) { const int kb = r / 29, nq = r % 29, nb = nq < 16 ? nq : nq + 8; transpose_item(kp->in[8] + (size_t)l * DM * DIN, DIN, DM, WB + WL_IN, kb * 64, nb * 32, nb * 32, scr, lane); continue; } r -= I_IN;
                if (r < I_Z) { *(u32x4*)(WB + WL_IN + (size_t)DIN * DM + (size_t)r * 512 + lane * 8) = (u32x4){0u, 0u, 0u, 0u}; continue; } r -= I_Z;
                if (r < I_OUT) { const int kb = r / 32, nb = r % 32; transpose_item(kp->in[20] + (size_t)l * DM * DM, DM, DM, WB + WL_OUT, kb * 64, nb * 32, nb * 32, scr, lane); continue; } r -= I_OUT;
                if (r < I_GU) { const int kb = r / 176, nb = r % 176; const int n0 = nb * 32, f = n0 % DFF, isup = n0 / DFF; transpose_item(kp->in[21] + (size_t)l * DM * 2 * DFF, 2 * DFF, DM, WB + WL_GU, kb * 64, n0, 256 * (f / 128) + 128 * isup + (f % 128), scr, lane); continue; } r -= I_GU;
                { const int kb = r / 32, nb = r % 32; transpose_item(kp->in[22] + (size_t)l * DFF * DM, DM, DFF, WB + WL_DN, kb * 64, nb * 32, nb * 32, scr, lane); }
            }
        }
    }
    GRID_BAR(PH_P0A);
    if (IN(PH_P0B)) {
        LANE_IDS(); KargPtr kp = KARG(); unsigned char* ws = kp->ws;
        const float* MOD = (const float*)(ws + WS_MOD); float* BIAS1P = (float*)(ws + WS_BIAS1P); float* BIAS2P = (float*)(ws + WS_BIAS2P);
        constexpr int NB_ROWS = 2 * DFF + 1280;
        for (int it = gw; it < DEPTH * NB_ROWS; it += NGW) { const int l = it / NB_ROWS; int n = it % NB_ROWS; const bool isgu = n < 2 * DFF; if (!isgu) n -= 2 * DFF;
            const bf16_t* wrow = (const bf16_t*)(ws + WS_WB + (size_t)l * 22 * MiB) + (isgu ? WL_GU : WL_IN) + (size_t)n * DM; const float* sh = MOD + (size_t)l * 5 * NMOD * DM + (isgu ? 3 : 0) * DM;
            float* outp = isgu ? BIAS2P + (size_t)l * 5 * 2 * DFF + n : BIAS1P + (size_t)l * 5 * 1280 + n; const int ldo = isgu ? 2 * DFF : 1280;
            float w[16]; { const u32x4 q0 = *(const u32x4*)(wrow + lane * 16), q1 = *(const u32x4*)(wrow + lane * 16 + 8);
#pragma unroll
                for (int j = 0; j < 4; ++j) { w[2 * j] = __uint_as_float(q0[j] << 16); w[2 * j + 1] = __uint_as_float(q0[j] & 0xffff0000u); w[8 + 2 * j] = __uint_as_float(q1[j] << 16); w[9 + 2 * j] = __uint_as_float(q1[j] & 0xffff0000u); } }
            float accr[5];
#pragma unroll
            for (int r = 0; r < 5; ++r) { const float* sv = sh + (size_t)r * NMOD * DM + lane * 16; float acc = 0.f;
#pragma unroll
                for (int j = 0; j < 4; ++j) { const f32x4 s4 = ld4(sv + 4 * j); acc += (s4[0] * w[4 * j] + s4[1] * w[4 * j + 1]) + (s4[2] * w[4 * j + 2] + s4[3] * w[4 * j + 3]); }
                accr[r] = acc; }
#pragma unroll
            for (int r = 0; r < 5; ++r) { const float t = wave_sum(accr[r]); if (lane == 0) outp[(size_t)r * ldo] = t; }
        }
        float* XL = kp->out; float* XC = (float*)(ws + WS_XC); float* RSQ1 = (float*)(ws + WS_RSQ1); bf16_t* XG = (bf16_t*)(ws + WS_XG);
        const float* xin = kp->in[0]; const float* cin = kp->in[2]; const float* norm1_g = kp->in[4]; const float* sc = MOD + 1 * DM;
        for (int r = gw; r < R; r += NGW) {
            const float* xr = r < RL ? xin + (size_t)r * DM : cin + (size_t)(r - RL) * DM; float* xo = r < RL ? XL + (size_t)r * DM : XC + (size_t)(r - RL) * DM;
            const float* scr_ = sc + (size_t)mrow_of(r) * (NMOD * DM); float ssv[4]; f32x4 v[4], gg[4], s4[4];
#pragma unroll
            for (int j = 0; j < 4; ++j) { const int k = j * 256 + lane * 4; v[j] = ld4(xr + k); gg[j] = ld4(norm1_g + k); s4[j] = ld4(scr_ + k); }
#pragma unroll
            for (int j = 0; j < 4; ++j) { const int k = j * 256 + lane * 4;
                *(f32x4*)(xo + k) = v[j]; ssv[j] = (v[j][0] * v[j][0] + v[j][1] * v[j][1]) + (v[j][2] * v[j][2] + v[j][3] * v[j][3]);
                const f32x4 z = v[j] * gg[j] * (s4[j] + 1.f); *(u32x2*)(XG + (size_t)r * DM + k) = (u32x2){cvt_pk_bf16(z[0], z[1]), cvt_pk_bf16(z[2], z[3])}; }
#pragma unroll
            for (int j = 0; j < 4; ++j) ssv[j] = wave_sum(ssv[j]);
            if (lane == 0) *(f32x4*)(RSQ1 + (size_t)r * 4) = (f32x4){ssv[0], ssv[1], ssv[2], ssv[3]};
        }
    }
    GRID_BAR(PH_P0B);
#pragma unroll 1
    for (int l = 0; l < DEPTH; ++l) {
        const int pb = PH_L0 + l * PH_PER_LAYER; const int Mrows = (l == 0) ? R : RL;
        if (IN(pb + PH_G1)) {
            KargPtr kp = KARG(); unsigned char* ws = kp->ws; const bf16_t* WB = (const bf16_t*)(ws + WS_WB + (size_t)l * 22 * MiB); const int G = gridDim.x;
            pg8::Gemm g{(const bf16_t*)(ws + WS_XG), WB + WL_IN, R, 1280, DM}; pg8::StaticOrder S; S.init(R, 1280, G, (int)blockIdx.x);
            EpiG1 E{(const float*)(ws + WS_RSQ1), (const float*)(ws + WS_BIAS1P) + (size_t)l * 5 * 1280, kp->in[9] + l * 256, kp->in[14] + l * 256, kp->in[16] + l * 128,
                    (bf16_t*)(ws + WS_U), (bf16_t*)(ws + WS_VT), (bf16_t*)(ws + WS_BW), (bf16_t*)(ws + WS_QA), (bf16_t*)(ws + WS_KVA), (float*)(ws + WS_KR)};
            pg8::gemm_phase(lds, xl, g, S, E);
        }
        GRID_BAR(pb + PH_G1);
        if (IN(pb + PH_G2)) {
            LANE_IDS(); KargPtr kp = KARG(); unsigned char* ws = kp->ws; const bf16_t* WB = (const bf16_t*)(ws + WS_WB + (size_t)l * 22 * MiB);
            const bf16_t* Uq = (const bf16_t*)(ws + WS_U); const bf16_t* VTq = (const bf16_t*)(ws + WS_VT); const bf16_t* BWq = (const bf16_t*)(ws + WS_BW); const bf16_t* QAq = (const bf16_t*)(ws + WS_QA);
            const bf16_t* KVAq = (const bf16_t*)(ws + WS_KVA); const float* KRq = (const float*)(ws + WS_KR); const float* ROPEq = (const float*)(ws + WS_ROPE);
            bf16_t* Qo = (bf16_t*)(ws + WS_Q); bf16_t* Ko = (bf16_t*)(ws + WS_K); bf16_t* Vo = (bf16_t*)(ws + WS_V); bf16_t* MIX = (bf16_t*)(ws + WS_MIX);
            for (int pi = blockIdx.x; pi < Mrows / 64; pi += G) g2::pool_block(BWq, kp->in[13] + l * 256, MIX, pi * 64, lds, tid);
            const int nQ = (Mrows / 64) * NH, nKV = (R / 32) * NH, nSP = (Mrows / 128) * 8, nAll = nQ + nKV + nSP;
            for (int it = gw; it < nAll; it += NGW) { int r = it; int ln = lane; asm volatile("" : "+v"(ln));
                if (r < nQ) { g2::q_item(QAq, WB + WL_QB, kp->in[18] + l * QKH, ROPEq, Qo, (r >> 3) * 64, r & 7, ln); continue; } r -= nQ;
                if (r < nKV) { g2::kv_item(KVAq, KRq, WB + WL_KVB, kp->in[19] + l * QKH, ROPEq, Ko, Vo, (r >> 3) * 32, r & 7, ln); continue; } r -= nKV;
                g2::sp_item(VTq, WB + WL_SP, kp->in[11] + l * 4 * 128, Uq, MIX, r >> 3, (r >> 1) & 3, r & 1, ln);
            }
        }
        GRID_BAR(pb + PH_G2);
        if (IN(pb + PH_G3)) {
            KargPtr kp = KARG(); unsigned char* ws = kp->ws; const int G = gridDim.x;
            const bf16_t* Qp = (const bf16_t*)(ws + WS_Q); const bf16_t* Kp = (const bf16_t*)(ws + WS_K); const bf16_t* Vp = (const bf16_t*)(ws + WS_V); bf16_t* MIX = (bf16_t*)(ws + WS_MIX);
            const int vcu = (G % 8 == 0) ? ((int)blockIdx.x % 8) * (G / 8) + (int)blockIdx.x / 8 : (int)blockIdx.x;
            const int nun = NB * NH * 16 + (l == 0 ? NB * NH : 0);
            for (int un = vcu; un < nun; un += G) {
                int bh, row0, seq;
                if (un < NB * NH * 16) { const int per = ((NB * NH * 16) % G == 0) ? (NB * NH * 16) / G : 0; const int v = per ? (un % G) * per + un / G : un; bh = v >> 4; row0 = (bh >> 3) * SEQ + (v & 15) * 256; seq = NKEY; }
                else { bh = un - NB * NH * 16; row0 = RL + (bh >> 3) * CTXL; seq = CTXL; }
                const int h = bh & 7;
                att::attn_unit(Qp + ((size_t)row0 * NH + h) * QKH, Kp + (size_t)bh * NKEY * QKH, Vp + (size_t)bh * NKEY * VD, MIX + (size_t)row0 * DM + 512 + h * 64, seq, lds);
            }
        }
        GRID_BAR(pb + PH_G3);
        if (IN(pb + PH_G4)) {
            KargPtr kp = KARG(); unsigned char* ws = kp->ws; const bf16_t* WB = (const bf16_t*)(ws + WS_WB + (size_t)l * 22 * MiB); const int G = gridDim.x;
            const float* modl = (const float*)(ws + WS_MOD) + (size_t)l * 5 * NMOD * DM;
            pg8::Gemm g{(const bf16_t*)(ws + WS_MIX), WB + WL_OUT, Mrows, DM, DM}; pg8::StaticOrder S; S.init(Mrows, DM, G, (int)blockIdx.x);
            EpiRes E{kp->out, (float*)(ws + WS_XC), modl + 2 * DM, (float*)(ws + WS_RSQ2), (bf16_t*)(ws + WS_XG), kp->in[5] + l * DM, modl + 4 * DM, 1, kp->dry};
            pg8::gemm_phase(lds, xl, g, S, E);
        }
        GRID_BAR(pb + PH_G4);
        if (IN(pb + PH_G5)) {
            KargPtr kp = KARG(); unsigned char* ws = kp->ws; const bf16_t* WB = (const bf16_t*)(ws + WS_WB + (size_t)l * 22 * MiB); const int G = gridDim.x;
            pg8::Gemm g{(const bf16_t*)(ws + WS_XG), WB + WL_GU, Mrows, 2 * DFF, DM}; pg8::StaticOrder S; S.init(Mrows, 2 * DFF, G, (int)blockIdx.x);
            EpiGU E{(bf16_t*)(ws + WS_ACT), (const float*)(ws + WS_RSQ2), (const float*)(ws + WS_BIAS2P) + (size_t)l * 5 * 2 * DFF};
            pg8::gemm_phase(lds, xl, g, S, E);
        }
        GRID_BAR(pb + PH_G5);
        if (IN(pb + PH_G6)) {
            KargPtr kp = KARG(); unsigned char* ws = kp->ws; const bf16_t* WB = (const bf16_t*)(ws + WS_WB + (size_t)l * 22 * MiB); const int G = gridDim.x;
            const float* MOD = (const float*)(ws + WS_MOD); const float* modl = MOD + (size_t)l * 5 * NMOD * DM;
            pg8::Gemm g{(const bf16_t*)(ws + WS_ACT), WB + WL_DN, Mrows, DM, DFF}; pg8::StaticOrder S; S.init(Mrows, DM, G, (int)blockIdx.x);
            const int nx = l + 1 < DEPTH;
            EpiRes E{kp->out, (float*)(ws + WS_XC), modl + 5 * DM, (float*)(ws + WS_RSQ1), (bf16_t*)(ws + WS_XG), kp->in[4] + (nx ? (l + 1) * DM : 0), MOD + (size_t)(nx ? l + 1 : 0) * 5 * NMOD * DM + 1 * DM, nx, kp->dry};
            pg8::gemm_phase(lds, xl, g, S, E);
        }
        GRID_BAR(pb + PH_G6);
    }
#undef IN
}

extern "C" void kernel_launch(void* const* d_in, const int* in_sizes, int n_in, void* d_out, int out_size, void* d_ws, size_t ws_size, hipStream_t stream) {
    if (n_in != 23 || ws_size < 256 * MiB || out_size != RL * DM) { fprintf(stderr, "kernel_launch: unexpected shapes (n_in %d, out %d, ws %zu)\n", n_in, out_size, ws_size); return; }
    unsigned char* ws = (unsigned char*)d_ws;
    static int grid = 0;
    if (grid == 0) {
        int dev = 0, cus = 0, per_cu = 0;
        if (hipGetDevice(&dev) != hipSuccess || hipDeviceGetAttribute(&cus, hipDeviceAttributeMultiprocessorCount, dev) != hipSuccess) { fprintf(stderr, "device query failed\n"); return; }
        if (hipFuncSetAttribute((const void*)mk_fwd, hipFuncAttributeMaxDynamicSharedMemorySize, MK_LDS) != hipSuccess) { fprintf(stderr, "hipFuncSetAttribute failed\n"); return; }
        if (hipOccupancyMaxActiveBlocksPerMultiprocessor(&per_cu, (const void*)mk_fwd, 512, MK_LDS) != hipSuccess || per_cu < 1) { fprintf(stderr, "occupancy query: %d\n", per_cu); (void)hipGetLastError(); return; }
        grid = cus;
    }
    MkArgs ma{}; for (int i = 0; i < 23; ++i) ma.in[i] = (const float*)d_in[i]; ma.out = (float*)d_out; ma.ws = ws;
#define MK(lo, hi) do { ma.ph_lo = (lo); ma.ph_hi = (hi); hipLaunchKernelGGL(mk_fwd, dim3(grid), dim3(512), MK_LDS, stream, ma); } while (0)
    if (hipMemsetAsync(ws, 0, 65536, stream) != hipSuccess) { fprintf(stderr, "memset failed\n"); return; }
#if FUSED
    MK(0, PH_END);
#else
    for (int ph = 0; ph < PH_END; ++ph) { MK(ph, ph + 1); if (ph == DUPH || ph == DUPH2) MK(ph, ph + 1); }
    if (DRYPH >= 0) { ma.dry = 1; MK(DRYPH, DRYPH + 1); ma.dry = 0; }
#endif
}
```

```cpp
#include <hip/hip_runtime.h>
#include <cstdint>
#include <cstdio>

constexpr int DM = 1024, NB = 4, SEQ = 4096, CTXL = 256, DEPTH = 2;
constexpr int RL = NB * SEQ;
constexpr int RC = NB * CTXL;
constexpr int R = RL + RC;
constexpr int WA = 256, DIN = 1184, DFF = 2816, NMOD = 6;
constexpr int NH = 8, QKH = 96, QKN = 64, QKR = 32, VD = 64, QRANK = 256, KVRANK = 128;
constexpr int NKEY = CTXL + SEQ;
constexpr float EPS = 1e-6f;
constexpr float QSCALE = 0.10206207261596577f * 1.4426950408889634f;

typedef unsigned short bf16_t;
__device__ __forceinline__ float bf2f(bf16_t v) { return __uint_as_float(((unsigned)v) << 16); }
__device__ __forceinline__ bf16_t f2bf(float f) { unsigned u = __float_as_uint(f); return (bf16_t)((u + 0x7fffu + ((u >> 16) & 1u)) >> 16); }
__device__ __forceinline__ int mrow_of(int r) { return r < RL ? (r >> 12) : 4; }
__device__ __forceinline__ float wave_sum(float v) {
#pragma unroll
    for (int o = 1; o < 64; o <<= 1) v += __shfl_xor(v, o);
    return v;
}
__device__ __forceinline__ float silu_f(float x) { return x / (1.f + __expf(-x)); }
__device__ __forceinline__ float gelu_f(float x) { return 0.5f * x * (1.f + erff(x * 0.70710678118654752f)); }

constexpr size_t MiB = 1u << 20;
constexpr size_t WS_MOD = 1 * MiB;
constexpr size_t WS_BIAS1 = WS_MOD + 256 * 1024;
constexpr size_t WS_BIAS2 = WS_BIAS1 + 64 * 1024;
constexpr size_t WS_ROPE = WS_BIAS2 + 256 * 1024;
constexpr size_t WS_RSQ1 = 2 * MiB;
constexpr size_t WS_RSQ2 = 2 * MiB + 512 * 1024;
constexpr size_t WS_XC = 4 * MiB;
constexpr size_t WS_XG = 8 * MiB;
constexpr size_t WS_MIX = 42 * MiB;
constexpr size_t WS_W = 76 * MiB;
constexpr size_t WS_OV = 120 * MiB;
constexpr size_t WS_ACT = WS_OV;
constexpr size_t WS_U = WS_OV;
constexpr size_t WS_VT = WS_U + (size_t)R * 256 * 2;
constexpr size_t WS_BW = WS_VT + (size_t)R * 256 * 2;
constexpr size_t WS_QA = WS_BW + (size_t)R * 256 * 2;
constexpr size_t WS_KVA = WS_QA + (size_t)R * 256 * 2;
constexpr size_t WS_KR = WS_KVA + (size_t)R * 128 * 2;
constexpr size_t WS_Q = 161 * MiB;
constexpr size_t WS_K = WS_Q + (size_t)R * 768 * 2;
constexpr size_t WS_V = WS_K + (size_t)NB * NH * NKEY * QKH * 2;
constexpr size_t WS_P = 161 * MiB;
static_assert(WS_KR + (size_t)R * 32 * 4 <= WS_Q, "map");
static_assert(WS_V + (size_t)NB * NH * NKEY * VD * 2 <= 256 * MiB, "map");
static_assert(WS_P + (size_t)R * DIN * 4 <= 256 * MiB, "map");
static_assert(WS_ACT + (size_t)R * DFF * 2 <= 256 * MiB, "map");

__device__ __forceinline__ void sincos_d(double x, double& s, double& c) {
    const double k = rint(x * 0.63661977236758134308); const double r = fma(-k, 1.5707963267948966192, x) - k * 6.123233995736766e-17;
    const double r2 = r * r;
    double sp = -7.6471637318198164759e-13; sp = sp * r2 + 1.6059043836821614599e-10; sp = sp * r2 - 2.5052108385441718775e-08; sp = sp * r2 + 2.7557319223985890653e-06; sp = sp * r2 - 1.9841269841269841270e-04; sp = sp * r2 + 8.3333333333333333333e-03; sp = sp * r2 - 1.6666666666666666667e-01; sp = r + r * r2 * sp;
    double cp = 4.7794773323873852974e-14; cp = cp * r2 - 1.1470745597729724714e-11; cp = cp * r2 + 2.0876756987868098979e-09; cp = cp * r2 - 2.7557319223985890653e-07; cp = cp * r2 + 2.4801587301587301587e-05; cp = cp * r2 - 1.3888888888888888889e-03; cp = cp * r2 + 4.1666666666666666667e-02; cp = cp * r2 - 0.5; cp = 1.0 + r2 * cp;
    const int q = ((int)k) & 3;
    s = (q == 0) ? sp : (q == 1) ? cp : (q == 2) ? -sp : -cp;
    c = (q == 0) ? cp : (q == 1) ? -sp : (q == 2) ? -cp : sp;
}
__device__ __forceinline__ float rstd_of(const float* RSQ, int r) { const float4 p = *(const float4*)(RSQ + (size_t)r * 4); return rsqrtf(((p.x + p.y) + (p.z + p.w)) * (1.f / DM) + EPS); }

#define LAS __attribute__((address_space(3)))
#define GAS __attribute__((address_space(1)))
typedef short bf16x8 __attribute__((ext_vector_type(8)));
typedef float f32x4 __attribute__((ext_vector_type(4)));
typedef float f32x2 __attribute__((ext_vector_type(2)));
typedef unsigned u32x4 __attribute__((ext_vector_type(4)));
typedef unsigned u32x2 __attribute__((ext_vector_type(2)));
__device__ __forceinline__ unsigned cvt_pk_bf16(float lo, float hi) { unsigned r; asm volatile("v_cvt_pk_bf16_f32 %0, %1, %2" : "=v"(r) : "v"(lo), "v"(hi)); return r; }
__device__ __forceinline__ float fast_silu(float x) { return x * __builtin_amdgcn_rcpf(1.f + __builtin_amdgcn_exp2f(-1.4426950408889634f * x)); }

constexpr size_t WL_IN = 0;
constexpr size_t WL_OUT = WL_IN + (size_t)1280 * 1024;
constexpr size_t WL_GU = WL_OUT + (size_t)1024 * 1024;
constexpr size_t WL_DN = WL_GU + (size_t)5632 * 1024;
constexpr size_t WL_QB = WL_DN + (size_t)1024 * 2816;
constexpr size_t WL_KVB = WL_QB + (size_t)768 * 256;
constexpr size_t WL_SP = WL_KVB + (size_t)1024 * 128;
constexpr size_t WL_END = WL_SP + (size_t)4 * 128 * 128;
static_assert(WL_END * 2 <= 22 * MiB, "weights per layer");
constexpr size_t WS_WB = WS_W;
constexpr size_t WS_BIAS2P = 3 * MiB;
constexpr size_t WS_BIAS1P = 3 * MiB + 256 * 1024;

namespace pg8 {
constexpr int BM = 256, BK = 64, HALF = 128, HTB = HALF * BK * 2, STAGE_BYTES = 8 * HTB, NXCD = 8, WGM = 4;
__host__ __device__ __forceinline__ int lds_byte(int r, int c) { const int st = (r >> 4) * 2 + (c >> 5), rr = r & 15, cc = c & 31, ob = rr * 64 + cc * 2; return st * 1024 + (ob ^ (((ob >> 9) & 1) << 5)); }
__host__ __device__ __forceinline__ void stage_rc(int b, int& Rr, int& C) { const int st = b / 1024, sb = b % 1024, swz = sb ^ (((sb >> 9) & 1) << 5); Rr = (st >> 1) * 16 + swz / 64; C = (st & 1) * 32 + (swz % 64) / 2; }
__host__ __device__ __forceinline__ int perm32(int rho) { const int n = rho >> 4, i = rho & 15; return 8 * (i >> 2) + 4 * n + (i & 3); }
struct Unit { int pm, pn; };
struct Gemm { const bf16_t* A; const bf16_t* Bt; int M, N, K; };
struct ListOrder {
    int cu0, ncu, nunits, base_pm, npm, base_pn;
    __device__ bool next(int i, Unit& u) const {
        const int j = (int)blockIdx.x - cu0; if (j < 0 || j >= ncu) return false;
        const int idx = i * ncu + j; if (idx >= nunits) return false;
        u.pm = base_pm + idx % npm; u.pn = base_pn + idx / npm; return true;
    }
};
struct StaticOrder {
    int nM, nN, nwg, G, c;
    __device__ void init(int M, int N, int G_, int c_) { nM = M / BM; nN = N / BM; nwg = nM * nN; G = G_; c = c_; }
    __device__ bool next(int i, Unit& u) const {
        if (c < 0) return false; const long L = (long)i * G + c; if (L >= nwg) return false;
        int wgid = (int)L; { const int q = nwg / NXCD, r = nwg % NXCD, xcd = wgid % NXCD, off = wgid / NXCD; wgid = (xcd < r ? xcd * (q + 1) : r * (q + 1) + (xcd - r) * q) + off; }
        const int nig = WGM * nN, gid = wgid / nig, fm = gid * WGM, gsz = (nM - fm) < WGM ? (nM - fm) : WGM;
        u.pm = fm + ((wgid % nig) % gsz); u.pn = (wgid % nig) / gsz; return true;
    }
};
template <class Epi, class Sched>
__device__ __forceinline__ void gemm_phase(LAS unsigned char* lds, LAS unsigned char* xl, const Gemm g, const Sched& S, const Epi& E) {
    int tid = threadIdx.x; asm volatile("" : "+v"(tid));
    const int wid = __builtin_amdgcn_readfirstlane(tid >> 6), lane = tid & 63, wr = wid >> 2, wc = wid & 3, fr = lane & 15, fq = lane >> 4;
    const int K = g.K, nt = K / BK;
    unsigned voffA[2], voffB[2];
#pragma unroll
    for (int i = 0; i < 2; ++i) { int Rr, C; stage_rc(tid * 16 + i * 8192, Rr, C); const int Rb = (Rr & ~31) + perm32(Rr & 31);
        voffA[i] = (unsigned)(Rr * K + C) * 2u; voffB[i] = (unsigned)(Rb * K + C) * 2u; }
    const size_t kstep = (size_t)(BK * 2);
    const size_t hstep = (size_t)HALF * K * 2;
    const size_t tstep = 2 * hstep;
    const unsigned ldsw = (unsigned)wid * 1024u;
    const int aoff = lds_byte(wr * 64 + fr, fq * 8), boff = lds_byte(wc * 32 + fr, fq * 8);
#define PG8_SA(b, h) (((b) * 2 + (h)) * HTB)
#define PG8_SB(b, h) ((4 + (b) * 2 + (h)) * HTB)
#define PG8_STAGE(bufoff, gbase, voff) do { _Pragma("unroll") for (int _i = 0; _i < 2; ++_i) \
        __builtin_amdgcn_global_load_lds((const unsigned*)((const char*)(gbase) + (voff)[_i]), (LAS unsigned*)(lds + (bufoff) + ldsw + _i * 8192), 16, 0, 0); } while (0)
#define PG8_LDA(dst, b, h) do { _Pragma("unroll") for (int m = 0; m < 4; ++m) _Pragma("unroll") for (int k = 0; k < 2; ++k) dst[m][k] = *(const LAS bf16x8*)(lds + PG8_SA(b, h) + aoff + m * 2048 + k * 1024); } while (0)
#define PG8_LDB(dst, b, h) do { _Pragma("unroll") for (int n = 0; n < 2; ++n) _Pragma("unroll") for (int k = 0; k < 2; ++k) dst[n][k] = *(const LAS bf16x8*)(lds + PG8_SB(b, h) + boff + n * 2048 + k * 1024); } while (0)
#define PG8_MMA(ai, bj, At, Bt) do { __builtin_amdgcn_s_setprio(1); _Pragma("unroll") for (int m = 0; m < 4; ++m) _Pragma("unroll") for (int n = 0; n < 2; ++n) _Pragma("unroll") for (int k = 0; k < 2; ++k) \
        acc[ai][bj][m][n] = __builtin_amdgcn_mfma_f32_16x16x32_bf16(Bt[n][k], At[m][k], acc[ai][bj][m][n], 0, 0, 0); __builtin_amdgcn_s_setprio(0); } while (0)
#define PG8_WAIT_V(n) asm volatile("s_waitcnt vmcnt(" #n ")" ::: "memory")
#define PG8_WAIT_L(n) asm volatile("s_waitcnt lgkmcnt(" #n ")" ::: "memory")
#define PG8_BAR __builtin_amdgcn_s_barrier()
#define PG8_SCHED __builtin_amdgcn_sched_barrier(0)
    Unit cur, nxt; int ui = 0;
    if (!S.next(0, cur)) return;
    E.prefetch(cur, tid, xl + 8192 + 256 + wid * 256);
    f32x4 acc[2][2][4][2];
#pragma unroll
    for (int a = 0; a < 2; ++a)
#pragma unroll
        for (int b = 0; b < 2; ++b)
#pragma unroll
            for (int m = 0; m < 4; ++m)
#pragma unroll
                for (int n = 0; n < 2; ++n) acc[a][b][m][n] = (f32x4){0.f, 0.f, 0.f, 0.f};
    bf16x8 At[4][2], B0[2][2], B1[2][2];
    const char* cA = (const char*)g.A + (size_t)cur.pm * tstep; const char* cB = (const char*)g.Bt + (size_t)cur.pn * tstep;
    PG8_STAGE(PG8_SB(0, 0), cB, voffB); PG8_STAGE(PG8_SB(0, 1), cB + hstep, voffB); PG8_STAGE(PG8_SA(0, 0), cA, voffA); PG8_STAGE(PG8_SA(0, 1), cA + hstep, voffA);
    if (wr == 1) PG8_BAR;
    PG8_WAIT_V(2); PG8_BAR;
    PG8_STAGE(PG8_SB(1, 0), cB + kstep, voffB); PG8_STAGE(PG8_SA(1, 0), cA + kstep, voffA); PG8_STAGE(PG8_SB(1, 1), cB + hstep + kstep, voffB);
    PG8_WAIT_V(6); PG8_BAR;
    for (;;) {
        const bool has_next = S.next(ui + 1, nxt);
        const char* nA = has_next ? (const char*)g.A + (size_t)nxt.pm * tstep : cA; const char* nB = has_next ? (const char*)g.Bt + (size_t)nxt.pn * tstep : cB;
        for (int t = 0; t < nt; t += 2) {
            const bool last = (t == nt - 2);
            const char* a1 = cA + (size_t)(t + 1) * kstep;
            const char* a2 = last ? nA : cA + (size_t)(t + 2) * kstep; const char* b2 = last ? nB : cB + (size_t)(t + 2) * kstep;
            const char* a3 = a2 + kstep; const char* b3 = b2 + kstep;
            PG8_LDB(B0, 0, 0); PG8_LDB(B1, 0, 1); PG8_SCHED; PG8_LDA(At, 0, 0); PG8_STAGE(PG8_SA(1, 1), a1 + hstep, voffA);
            PG8_WAIT_V(8); PG8_WAIT_L(0); PG8_BAR; PG8_MMA(0, 0, At, B0); PG8_MMA(0, 1, At, B1); PG8_BAR; PG8_SCHED;
            PG8_LDA(At, 0, 1); PG8_STAGE(PG8_SB(0, 0), b2, voffB); PG8_STAGE(PG8_SB(0, 1), b2 + hstep, voffB); PG8_STAGE(PG8_SA(0, 0), a2, voffA);
            PG8_WAIT_V(8); PG8_WAIT_L(0); PG8_BAR; PG8_MMA(1, 0, At, B0); PG8_MMA(1, 1, At, B1); PG8_BAR; PG8_SCHED;
            PG8_LDB(B0, 1, 0); PG8_LDB(B1, 1, 1); PG8_SCHED; PG8_LDA(At, 1, 0); PG8_STAGE(PG8_SA(0, 1), a2 + hstep, voffA);
            PG8_WAIT_V(8); PG8_WAIT_L(0); PG8_BAR; PG8_MMA(0, 0, At, B0); PG8_MMA(0, 1, At, B1); PG8_BAR; PG8_SCHED;
            PG8_LDA(At, 1, 1); PG8_STAGE(PG8_SB(1, 0), b3, voffB); PG8_STAGE(PG8_SB(1, 1), b3 + hstep, voffB); PG8_STAGE(PG8_SA(1, 0), a3, voffA);
            PG8_WAIT_V(8); PG8_WAIT_L(0); PG8_BAR; PG8_MMA(1, 0, At, B0); PG8_MMA(1, 1, At, B1); PG8_BAR; PG8_SCHED;
        }
        if (wr == 0) PG8_BAR;
        { int fr_ = fr, fq_ = fq; asm volatile("" : "+v"(fr_), "+v"(fq_)); E(acc, cur, wr, wc, fr_, fq_, xl); }
        if (!has_next) break;
#pragma unroll
        for (int a = 0; a < 2; ++a)
#pragma unroll
            for (int b = 0; b < 2; ++b)
#pragma unroll
                for (int m = 0; m < 4; ++m)
#pragma unroll
                    for (int n = 0; n < 2; ++n) acc[a][b][m][n] = (f32x4){0.f, 0.f, 0.f, 0.f};
        cur = nxt; cA = nA; cB = nB; ++ui;
        if (wr == 1) PG8_BAR;
    }
    PG8_WAIT_V(0);
    PG8_BAR;
#undef PG8_SA
#undef PG8_SB
#undef PG8_STAGE
#undef PG8_LDA
#undef PG8_LDB
#undef PG8_MMA
}
}

__device__ __forceinline__ f32x4 ld4(const float* p) { return *(const f32x4*)p; }
struct EpiGU {
    bf16_t* ACT; const float* RSQ; const float* BIAS;
    __device__ __forceinline__ void prefetch(const pg8::Unit&, int, LAS unsigned char*) const {}
    __device__ __forceinline__ void operator()(f32x4 (&acc)[2][2][4][2], const pg8::Unit& u, int wr, int wc, int fr, int fq, LAS unsigned char*) const {
        const int row0 = u.pm * 256 + wr * 64 + fr; const int mr = mrow_of(u.pm * 256);
        const float* bb = BIAS + (size_t)mr * (2 * DFF) + u.pn * 256 + wc * 32 + 8 * fq;
        const f32x4 bg0 = ld4(bb), bg1 = ld4(bb + 4), bu0 = ld4(bb + 128), bu1 = ld4(bb + 132);
        bf16_t* ob = ACT + u.pn * 128 + wc * 32 + 8 * fq;
        float rsv[8];
        { f32x4 pq_[8];
#pragma unroll
          for (int q = 0; q < 8; ++q) pq_[q] = ld4(RSQ + (size_t)(row0 + (q >> 2) * 128 + (q & 3) * 16) * 4);
          __builtin_amdgcn_sched_barrier(0);
#pragma unroll
          for (int q = 0; q < 8; ++q) rsv[q] = rsqrtf(((pq_[q][0] + pq_[q][1]) + (pq_[q][2] + pq_[q][3])) * (1.f / DM) + EPS); }
#pragma unroll
        for (int ai = 0; ai < 2; ++ai)
#pragma unroll
            for (int m = 0; m < 4; ++m) { const int row = row0 + ai * 128 + m * 16; const float rs = rsv[ai * 4 + m];
                const f32x4 g0 = acc[ai][0][m][0] * rs + bg0, g1 = acc[ai][0][m][1] * rs + bg1, u0 = acc[ai][1][m][0] * rs + bu0, u1 = acc[ai][1][m][1] * rs + bu1;
                u32x4 w; w.x = cvt_pk_bf16(fast_silu(g0[0]) * u0[0], fast_silu(g0[1]) * u0[1]); w.y = cvt_pk_bf16(fast_silu(g0[2]) * u0[2], fast_silu(g0[3]) * u0[3]);
                w.z = cvt_pk_bf16(fast_silu(g1[0]) * u1[0], fast_silu(g1[1]) * u1[1]); w.w = cvt_pk_bf16(fast_silu(g1[2]) * u1[2], fast_silu(g1[3]) * u1[3]);
                *(u32x4*)(ob + (size_t)row * DFF) = w; }
    }
};
struct EpiRes {
    float* XL; float* XC; const float* XLr; const float* XCr; const float* gate; float* RSQ; bf16_t* XG; const float* ng; const float* nsc; int do_next; int pad;
    __device__ __forceinline__ void prefetch(const pg8::Unit& u, int tid, LAS unsigned char* dump) const {
        const float* xrbase = u.pm < 64 ? XLr + (size_t)(u.pm * 256) * DM : XCr + (size_t)(u.pm * 256 - RL) * DM;
#pragma unroll
        for (int j = 0; j < 4; ++j) { const int id = j * 512 + tid; __builtin_amdgcn_global_load_lds((const unsigned*)(xrbase + (size_t)(id >> 3) * DM + u.pn * 256 + (id & 7) * 32), (LAS unsigned*)dump, 4, 0, 0); }
    }
    __device__ __forceinline__ void operator()(f32x4 (&acc)[2][2][4][2], const pg8::Unit& u, int wr, int wc, int fr, int fq, LAS unsigned char* xl) const {
        const int mr = mrow_of(u.pm * 256); const int col0 = u.pn * 256 + wc * 32 + 8 * fq; const int rl0 = wr * 64 + fr;
        float* xbase = u.pm < 64 ? XL + (size_t)(u.pm * 256) * DM : XC + (size_t)(u.pm * 256 - RL) * DM;
        const float* xrbase = u.pm < 64 ? XLr + (size_t)(u.pm * 256) * DM : XCr + (size_t)(u.pm * 256 - RL) * DM;
        LAS float* P = (LAS float*)xl;
        float ss[8];
#pragma unroll
        for (int q = 0; q < 8; ++q) ss[q] = 0.f;
#pragma unroll
        for (int bj = 0; bj < 2; ++bj) {
            f32x4 gt[2], gm[2];
#pragma unroll
            for (int n = 0; n < 2; ++n) { const int c = col0 + bj * 128 + 4 * n; gt[n] = ld4(gate + (size_t)mr * (NMOD * DM) + c);
                if (do_next) gm[n] = ld4(ng + c) * (ld4(nsc + (size_t)mr * (NMOD * DM) + c) + 1.f); else gm[n] = (f32x4){0.f, 0.f, 0.f, 0.f}; }
#pragma unroll
            for (int ai = 0; ai < 2; ++ai) {
                f32x4 xv[4][2];
#pragma unroll
                for (int m = 0; m < 4; ++m) { const unsigned off = (unsigned)((rl0 + ai * 128 + m * 16) * DM + col0 + bj * 128) * 4u;
                    const float* xp = (const float*)((const char*)xrbase + off); xv[m][0] = ld4(xp); xv[m][1] = ld4(xp + 4); }
#pragma unroll
                for (int m = 0; m < 4; ++m) { const int q = ai * 4 + m; const int rl = rl0 + ai * 128 + m * 16; const unsigned off = (unsigned)(rl * DM + col0 + bj * 128) * 4u; float* xp = (float*)((char*)xbase + off);
                    const f32x4 y0 = xv[m][0] + gt[0] * acc[ai][bj][m][0], y1 = xv[m][1] + gt[1] * acc[ai][bj][m][1];
                    *(f32x4*)(xp) = y0; *(f32x4*)(xp + 4) = y1;
                    if (do_next) { ss[q] += (y0[0] * y0[0] + y0[1] * y0[1]) + (y0[2] * y0[2] + y0[3] * y0[3]) + (y1[0] * y1[0] + y1[1] * y1[1]) + (y1[2] * y1[2] + y1[3] * y1[3]);
                        const f32x4 z0 = y0 * gm[0], z1 = y1 * gm[1]; u32x4 w; w.x = cvt_pk_bf16(z0[0], z0[1]); w.y = cvt_pk_bf16(z0[2], z0[3]); w.z = cvt_pk_bf16(z1[0], z1[1]); w.w = cvt_pk_bf16(z1[2], z1[3]);
                        *(u32x4*)((char*)(XG + (size_t)(u.pm * 256) * DM) + (off >> 1)) = w; } }
                asm volatile("" ::: "memory");
            }
        }
        if (do_next) {
#pragma unroll
            for (int q = 0; q < 8; ++q) { float t = ss[q]; t += __shfl_xor(t, 16); t += __shfl_xor(t, 32); if (fq == 0) P[(rl0 + (q >> 2) * 128 + (q & 3) * 16) * 4 + wc] = t; }
        }
        if (do_next) {
            asm volatile("s_waitcnt lgkmcnt(0)" ::: "memory"); __builtin_amdgcn_s_barrier(); asm volatile("" ::: "memory");
            const int tid = threadIdx.x;
            if (tid < 256) { const f32x4 p = *(const LAS f32x4*)(P + tid * 4); RSQ[(size_t)(u.pm * 256 + tid) * 4 + u.pn] = (p[0] + p[1]) + (p[2] + p[3]); }
        }
    }
};


__device__ __forceinline__ float gelu_fast(float v) {
    const float av = fabsf(v), d = av * 0.2316418882f + 1.0f, t = __builtin_amdgcn_rcpf(d);
    float q = t * 0.5307027145f + (-0.7265760135f); q = q * t + 0.7107068705f; q = q * t + (-0.142248368f); q = q * t + 0.127414796f; q = q * t;
    const float e = __builtin_amdgcn_exp2f((v * v) * (-0.72134752044f));
    const float m = v * (q * e), r = v - m; return v < 0.f ? m : r;
}
struct EpiG1 {
    const float* RSQ; const float* BIAS; const float* sgu_g; const float* qa_g; const float* kva_g;
    bf16_t* U; bf16_t* VT; bf16_t* BW; bf16_t* QA; bf16_t* KVA; float* KR;
    __device__ __forceinline__ void prefetch(const pg8::Unit&, int, LAS unsigned char*) const {}
#define G1_PACK(v0, v1) (u32x4){cvt_pk_bf16((v0)[0], (v0)[1]), cvt_pk_bf16((v0)[2], (v0)[3]), cvt_pk_bf16((v1)[0], (v1)[1]), cvt_pk_bf16((v1)[2], (v1)[3])}
#define G1_SS(v) (((v)[0] * (v)[0] + (v)[1] * (v)[1]) + ((v)[2] * (v)[2] + (v)[3] * (v)[3]))
    __device__ __forceinline__ void operator()(f32x4 (&acc)[2][2][4][2], const pg8::Unit& u, int wr, int wc, int fr, int fq, LAS unsigned char* xl) const {
        const int mr = mrow_of(u.pm * 256); const int cl = wc * 32 + 8 * fq; const int rl0 = wr * 64 + fr; const int pn = u.pn;
        LAS float* P = (LAS float*)xl;
        {   f32x4 bv[2][2];
#pragma unroll
            for (int bj = 0; bj < 2; ++bj)
#pragma unroll
                for (int n = 0; n < 2; ++n) bv[bj][n] = ld4(BIAS + (size_t)mr * 1280 + pn * 256 + bj * 128 + cl + 4 * n);
            const bool act = (pn <= 1);
            float rsv[8];
            { f32x4 pq_[8];
#pragma unroll
              for (int q = 0; q < 8; ++q) pq_[q] = ld4(RSQ + (size_t)(u.pm * 256 + rl0 + (q >> 2) * 128 + (q & 3) * 16) * 4);
              __builtin_amdgcn_sched_barrier(0);
#pragma unroll
              for (int q = 0; q < 8; ++q) rsv[q] = rsqrtf(((pq_[q][0] + pq_[q][1]) + (pq_[q][2] + pq_[q][3])) * (1.f / DM) + EPS); }
#pragma unroll
            for (int ai = 0; ai < 2; ++ai)
#pragma unroll
                for (int m = 0; m < 4; ++m) { const float rs = rsv[ai * 4 + m];
#pragma unroll
                    for (int bj = 0; bj < 2; ++bj)
#pragma unroll
                        for (int n = 0; n < 2; ++n) { f32x4 v = acc[ai][bj][m][n] * rs + bv[bj][n];
                            if (act) v = (f32x4){gelu_fast(v[0]), gelu_fast(v[1]), gelu_fast(v[2]), gelu_fast(v[3])};
                            acc[ai][bj][m][n] = v; }
                    if (m & 1) asm volatile("" ::: "memory"); }
        }
        if (pn == 0) {
#pragma unroll
            for (int ai = 0; ai < 2; ++ai)
#pragma unroll
                for (int m = 0; m < 4; ++m) { const int row = u.pm * 256 + rl0 + ai * 128 + m * 16;
#pragma unroll
                    for (int bj = 0; bj < 2; ++bj) *(u32x4*)(U + (size_t)row * 256 + bj * 128 + cl) = G1_PACK(acc[ai][bj][m][0], acc[ai][bj][m][1]); }
            return;
        }
        if (pn == 2) {
#pragma unroll
            for (int ai = 0; ai < 2; ++ai)
#pragma unroll
                for (int m = 0; m < 4; ++m) { const int row = u.pm * 256 + rl0 + ai * 128 + m * 16;
#pragma unroll
                    for (int bj = 0; bj < 2; ++bj) *(u32x4*)(BW + (size_t)row * 256 + bj * 128 + cl) = G1_PACK(acc[ai][bj][m][0], acc[ai][bj][m][1]); }
            return;
        }
#pragma unroll
        for (int ai = 0; ai < 2; ++ai)
#pragma unroll
            for (int m = 0; m < 4; ++m) { float ss = G1_SS(acc[ai][0][m][0]) + G1_SS(acc[ai][0][m][1]);
                if (pn != 4) ss += G1_SS(acc[ai][1][m][0]) + G1_SS(acc[ai][1][m][1]);
                ss += __shfl_xor(ss, 16); ss += __shfl_xor(ss, 32);
                if (fq == 0) P[(rl0 + ai * 128 + m * 16) * 4 + wc] = ss; }
        asm volatile("s_waitcnt lgkmcnt(0)" ::: "memory"); __builtin_amdgcn_s_barrier(); asm volatile("" ::: "memory");
        if (pn == 1) {
#pragma unroll
            for (int bj = 0; bj < 2; ++bj) { const f32x4 g0 = ld4(sgu_g + bj * 128 + cl), g1 = ld4(sgu_g + bj * 128 + cl + 4);
#pragma unroll
                for (int ai = 0; ai < 2; ++ai)
#pragma unroll
                    for (int m = 0; m < 4; ++m) { const int rl = rl0 + ai * 128 + m * 16; const int row = u.pm * 256 + rl;
                        const f32x4 p = *(const LAS f32x4*)(P + rl * 4); const float rn = rsqrtf(((p[0] + p[1]) + (p[2] + p[3])) * (1.f / 256.f) + EPS);
                        const f32x4 v0 = acc[ai][bj][m][0] * rn * g0, v1 = acc[ai][bj][m][1] * rn * g1;
                        const int jrow = row & 127; bf16_t* vt = VT + ((((size_t)(row >> 7) * 8 + ((bj * 128 + cl) >> 5)) * 8 + (jrow >> 4)) * 64 + ((jrow >> 3) & 1) * 32 + ((bj * 128 + cl) & 31)) * 8 + (jrow & 7);
#pragma unroll
                        for (int i = 0; i < 4; ++i) { vt[(size_t)i * 8] = (bf16_t)(cvt_pk_bf16(v0[i], 0.f) & 0xffffu); vt[(size_t)(4 + i) * 8] = (bf16_t)(cvt_pk_bf16(v1[i], 0.f) & 0xffffu); } } }
        } else if (pn == 3) {
#pragma unroll
            for (int bj = 0; bj < 2; ++bj) { const f32x4 g0 = ld4(qa_g + bj * 128 + cl), g1 = ld4(qa_g + bj * 128 + cl + 4);
#pragma unroll
                for (int ai = 0; ai < 2; ++ai)
#pragma unroll
                    for (int m = 0; m < 4; ++m) { const int rl = rl0 + ai * 128 + m * 16; const int row = u.pm * 256 + rl;
                        const f32x4 p = *(const LAS f32x4*)(P + rl * 4); const float rn = rsqrtf(((p[0] + p[1]) + (p[2] + p[3])) * (1.f / 256.f) + EPS);
                        const f32x4 v0 = acc[ai][bj][m][0] * rn * g0, v1 = acc[ai][bj][m][1] * rn * g1;
                        { const int c8 = bj * 16 + wc * 4 + fq; *(u32x4*)(QA + ((((size_t)(row >> 5) * 16 + (c8 >> 1)) * 64 + (c8 & 1) * 32 + (row & 31)) * 8)) = G1_PACK(v0, v1); } } }
        } else {
            const f32x4 g0 = ld4(kva_g + cl), g1 = ld4(kva_g + cl + 4);
#pragma unroll
            for (int ai = 0; ai < 2; ++ai)
#pragma unroll
                for (int m = 0; m < 4; ++m) { const int rl = rl0 + ai * 128 + m * 16; const int row = u.pm * 256 + rl;
                    const f32x4 p = *(const LAS f32x4*)(P + rl * 4); const float rn = rsqrtf(((p[0] + p[1]) + (p[2] + p[3])) * (1.f / 128.f) + EPS);
                    const f32x4 v0 = acc[ai][0][m][0] * rn * g0, v1 = acc[ai][0][m][1] * rn * g1;
                    { const int c8 = wc * 4 + fq; *(u32x4*)(KVA + ((((size_t)(row >> 5) * 8 + (c8 >> 1)) * 64 + (c8 & 1) * 32 + (row & 31)) * 8)) = G1_PACK(v0, v1); }
                    if (wc == 0) { *(f32x4*)(KR + (size_t)row * 32 + 8 * fq) = acc[ai][1][m][0]; *(f32x4*)(KR + (size_t)row * 32 + 8 * fq + 4) = acc[ai][1][m][1]; } }
        }
    }
#undef G1_PACK
#undef G1_SS
};


namespace att {
using s16x4 = __attribute__((ext_vector_type(4))) short;
using f32x16 = __attribute__((ext_vector_type(16))) float;
constexpr int KROW = 208;
constexpr int NBUF = 3, SHM_V = 64 * 64 * 2, SHM_K = 64 * KROW, OFF_K = NBUF * SHM_V, OFF_WS = OFF_K + NBUF * SHM_K, SHM_ATTN = OFF_WS + 8 * 64 * 4;
#define ASBAR() __builtin_amdgcn_sched_barrier(0)
__device__ __forceinline__ int crow(int r, int hi) { return (r & 3) + 8 * (r >> 2) + 4 * hi; }
__device__ __forceinline__ int v_st(int k, int c) { const int kk = (k & ~0xC) | ((k & 4) << 1) | ((k & 8) >> 1); return ((kk >> 3) * 2 + (c >> 5)) * 512 + ((kk & 7) * 32 + (c & 31)) * 2; }
__device__ __forceinline__ int v_rd_base(int lane) { return ((lane & 3) << 3) | (((lane >> 2) & 3) << 6) | (((lane >> 4) & 1) << 5) | (((lane >> 5) & 1) << 8); }
constexpr int v_rd_off(int d0, int ks, int half) { return d0 * 512 + ks * 2048 + half * 1024; }
template <int OFF> __device__ __forceinline__ s16x4 tr_read(int vb) { s16x4 r; asm volatile("ds_read_b64_tr_b16 %0, %1 offset:%2" : "=&v"(r) : "v"(vb), "i"(OFF) : "memory"); return r; }
__device__ __forceinline__ void partialSM(f32x16& p0, f32x16& p1) {
#pragma unroll
    for (int r = 0; r < 16; ++r) p0[r] = __builtin_amdgcn_exp2f(p0[r]);
}
__device__ __forceinline__ void finishSM(f32x16& p0, f32x16& p1, float& l_reg, bf16x8& pa0, bf16x8& pa1, bf16x8& pa2, bf16x8& pa3) {
#pragma unroll
    for (int r = 0; r < 16; ++r) p1[r] = __builtin_amdgcn_exp2f(p1[r]);
    f32x2 s2a = {p0[0], p0[1]}, s2b = {p1[0], p1[1]};
#pragma unroll
    for (int r = 2; r < 16; r += 2) { s2a += (f32x2){p0[r], p0[r + 1]}; s2b += (f32x2){p1[r], p1[r + 1]}; }
    s2a += s2b; l_reg += s2a[0] + s2a[1];
#define PK4(P, BASE, OUT) do { unsigned a0 = cvt_pk_bf16(P[BASE + 0], P[BASE + 1]), a1 = cvt_pk_bf16(P[BASE + 2], P[BASE + 3]);   \
    unsigned b0 = cvt_pk_bf16(P[BASE + 4], P[BASE + 5]), b1 = cvt_pk_bf16(P[BASE + 6], P[BASE + 7]);                              \
    auto r0 = __builtin_amdgcn_permlane32_swap(a0, b0, false, false); auto r1 = __builtin_amdgcn_permlane32_swap(a1, b1, false, false); \
    u32x4 w = {r0[0], r1[0], r0[1], r1[1]}; OUT = *reinterpret_cast<bf16x8*>(&w); } while (0)
    PK4(p0, 0, pa0); PK4(p0, 8, pa1); PK4(p1, 0, pa2); PK4(p1, 8, pa3);
#undef PK4
}
__device__ __forceinline__ void qkt(f32x16& p0, f32x16& p1, LAS const unsigned char* Ks, const bf16x8 (&qr)[6], int r32, int hi) {
    p0 = f32x16{}; p1 = f32x16{};
#pragma unroll
    for (int d0 = 0; d0 < 6; ++d0) {
        const bf16x8 b0 = *(LAS const bf16x8*)(Ks + r32 * KROW + d0 * 32 + hi * 16);
        const bf16x8 b1 = *(LAS const bf16x8*)(Ks + (32 + r32) * KROW + d0 * 32 + hi * 16);
        p0 = __builtin_amdgcn_mfma_f32_32x32x16_bf16(b0, qr[d0], p0, 0, 0, 0);
        p1 = __builtin_amdgcn_mfma_f32_32x32x16_bf16(b1, qr[d0], p1, 0, 0, 0); }
}
template <int D0> __device__ __forceinline__ void pv_one(f32x16& od, int vb, bf16x8 pa0, bf16x8 pa1, bf16x8 pa2, bf16x8 pa3) {
    const s16x4 l0 = tr_read<v_rd_off(D0, 0, 0)>(vb), h0 = tr_read<v_rd_off(D0, 0, 1)>(vb), l1 = tr_read<v_rd_off(D0, 1, 0)>(vb), h1 = tr_read<v_rd_off(D0, 1, 1)>(vb);
    const s16x4 l2 = tr_read<v_rd_off(D0, 2, 0)>(vb), h2 = tr_read<v_rd_off(D0, 2, 1)>(vb), l3 = tr_read<v_rd_off(D0, 3, 0)>(vb), h3 = tr_read<v_rd_off(D0, 3, 1)>(vb);
    asm volatile("s_waitcnt lgkmcnt(0)" ::: "memory"); ASBAR();
#define PK(L, H) (bf16x8){L[0], L[1], L[2], L[3], H[0], H[1], H[2], H[3]}
    od = __builtin_amdgcn_mfma_f32_32x32x16_bf16(pa0, PK(l0, h0), od, 0, 0, 0);
    od = __builtin_amdgcn_mfma_f32_32x32x16_bf16(pa1, PK(l1, h1), od, 0, 0, 0);
    od = __builtin_amdgcn_mfma_f32_32x32x16_bf16(pa2, PK(l2, h2), od, 0, 0, 0);
    od = __builtin_amdgcn_mfma_f32_32x32x16_bf16(pa3, PK(l3, h3), od, 0, 0, 0);
#undef PK
}
template <int BASE> __device__ __forceinline__ bf16x8 pack8(const f32x16& P) {
    unsigned a0 = cvt_pk_bf16(P[BASE + 0], P[BASE + 1]), a1 = cvt_pk_bf16(P[BASE + 2], P[BASE + 3]), b0 = cvt_pk_bf16(P[BASE + 4], P[BASE + 5]), b1 = cvt_pk_bf16(P[BASE + 6], P[BASE + 7]);
    auto r0 = __builtin_amdgcn_permlane32_swap(a0, b0, false, false); auto r1 = __builtin_amdgcn_permlane32_swap(a1, b1, false, false);
    u32x4 w = {r0[0], r1[0], r0[1], r1[1]}; return *reinterpret_cast<bf16x8*>(&w);
}
__device__ __forceinline__ void arope(const float* __restrict__ ROPE, int t, int pp, float& x1, float& x2) {
    const int pos = pp < 8 ? (t >> 6) : (t & 63); const f32x2 cs = *(const f32x2*)(ROPE + (pos * 8 + (pp & 7)) * 2);
    const float y1 = x1 * cs[0] - x2 * cs[1], y2 = x1 * cs[1] + x2 * cs[0]; x1 = y1; x2 = y2;
}
__device__ __forceinline__ void attn_unit(const bf16_t* __restrict__ QA, const bf16_t* __restrict__ WQh, const float* __restrict__ qn_g, const float* __restrict__ ROPE, int row0, const bf16_t* __restrict__ Kh, const bf16_t* __restrict__ Vh, bf16_t* __restrict__ Ob, int seq, LAS unsigned char* lds) {
    int tid = threadIdx.x; asm volatile("" : "+v"(tid));
    const int wid = __builtin_amdgcn_readfirstlane(tid >> 6), lane = tid & 63, r32 = lane & 31, hi = lane >> 5;
    LAS float* wsf = (LAS float*)(lds + OFF_WS) + wid * 64; LAS float* li_l = wsf;
    float l_reg = 0; f32x16 o[2] = {}; bf16x8 qr[6];
    const bool isK = wid < 4; const int t = tid & 255;
    const unsigned char* gbase = isK ? (const unsigned char*)Kh : (const unsigned char*)Vh; const int tstride = isK ? 64 * 96 * 2 : 64 * 64 * 2;
    int loff0, loff1, loff2;
    { const int c0 = t, c1 = t + 256, c2 = t + 512;
      loff0 = isK ? (c0 / 12) * KROW + (c0 % 12) * 16 : v_st(c0 >> 3, (c0 & 7) * 8);
      loff1 = isK ? (c1 / 12) * KROW + (c1 % 12) * 16 : v_st(c1 >> 3, (c1 & 7) * 8);
      loff2 = (c2 / 12) * KROW + (c2 % 12) * 16; }
    const int vb0 = (int)(uintptr_t)(lds) + v_rd_base(lane);
    bf16x8 sA0, sA1, sA2, sB0, sB1, sB2;
#define SLOAD(S, tile) do { const unsigned char* p_ = gbase + (size_t)(tile) * tstride + t * 16; S##0 = *(const bf16x8*)(p_); S##1 = *(const bf16x8*)(p_ + 4096); if (isK) S##2 = *(const bf16x8*)(p_ + 8192); } while (0)
#define SWRITE(b, S) do { LAS unsigned char* d_ = lds + (isK ? OFF_K + (b) * SHM_K : (b) * SHM_V); *(LAS bf16x8*)(d_ + loff0) = S##0; *(LAS bf16x8*)(d_ + loff1) = S##1; if (isK) *(LAS bf16x8*)(d_ + loff2) = S##2; } while (0)
    f32x16 pA0, pA1, pB0, pB1; bf16x8 pa0, pa1, pa2, pa3; const int NT = seq / 64;
    int b_prev = 0, b_cur = 1, b_next = 2;
#define ROT3() do { b_prev = b_cur; b_cur = b_next; b_next = (b_next == NBUF - 1) ? 0 : b_next + 1; } while (0)
#define STEP(PC0, PC1, PP0, PP1, SW, SL, i) do { \
        ASBAR(); qkt(PC0, PC1, lds + OFF_K + b_cur * SHM_K, qr, r32, hi); \
        finishSM(PP0, PP1, l_reg, pa0, pa1, pa2, pa3); ASBAR(); \
        if ((i) + 1 < NT) SWRITE(b_next, SW); \
        if ((i) + 2 < NT) SLOAD(SL, (i) + 2); ASBAR(); \
        pv_one<0>(o[0], vb0 + b_prev * SHM_V, pa0, pa1, pa2, pa3); pv_one<1>(o[1], vb0 + b_prev * SHM_V, pa0, pa1, pa2, pa3); partialSM(PC0, PC1); \
        __syncthreads(); ROT3(); } while (0)
    SLOAD(sA, 0);
    {
        f32x16 qa_[3];
#pragma unroll
        for (int b = 0; b < 3; ++b) qa_[b] = f32x16{};
        const bf16_t* ap = QA + ((size_t)((row0 >> 5) + wid) * 16 * 64 + lane) * 8; const bf16_t* wp = WQh + (size_t)lane * 8;
        bf16x8 fr[2][2][4];
#define AQLOAD(S, g) do { _Pragma("unroll") for (int kk = 0; kk < 2; ++kk) { const int ks = 2 * (g) + kk; fr[S][kk][0] = *(const bf16x8*)(ap + (size_t)ks * 512); \
            _Pragma("unroll") for (int b = 0; b < 3; ++b) fr[S][kk][1 + b] = *(const bf16x8*)(wp + (size_t)(b * 16 + ks) * 512); } } while (0)
        AQLOAD(0, 0);
#pragma unroll
        for (int g = 0; g < 8; ++g) {
            if (g + 1 < 8) { if (g & 1) AQLOAD(0, g + 1); else AQLOAD(1, g + 1); }
            __builtin_amdgcn_sched_barrier(0);
#pragma unroll
            for (int kk = 0; kk < 2; ++kk)
#pragma unroll
                for (int b = 0; b < 3; ++b) qa_[b] = __builtin_amdgcn_mfma_f32_32x32x16_bf16(fr[g & 1][kk][1 + b], fr[g & 1][kk][0], qa_[b], 0, 0, 0);
            __builtin_amdgcn_sched_barrier(0);
        }
#undef AQLOAD
        const int row = row0 + wid * 32 + r32; const bool lat = row < RL; const int tq = row & 4095;
        float ss = 0.f;
#pragma unroll
        for (int b = 0; b < 3; ++b)
#pragma unroll
            for (int r = 0; r < 16; ++r) ss += qa_[b][r] * qa_[b][r];
        { auto rr = __builtin_amdgcn_permlane32_swap(__float_as_uint(ss), __float_as_uint(ss), false, false); ss = __uint_as_float(rr[0]) + __uint_as_float(rr[1]); }
        const float rn = rsqrtf(ss * (1.f / 96.f) + EPS) * QSCALE;
#pragma unroll
        for (int b = 0; b < 3; ++b)
#pragma unroll
            for (int rq = 0; rq < 4; ++rq) { const f32x4 g = ld4(qn_g + 32 * b + 8 * rq + 4 * hi);
                float v0 = qa_[b][4 * rq] * rn * g[0], v1 = qa_[b][4 * rq + 1] * rn * g[1], v2 = qa_[b][4 * rq + 2] * rn * g[2], v3 = qa_[b][4 * rq + 3] * rn * g[3];
                if (b == 2 && lat) { const int pp = 4 * rq + 2 * hi; arope(ROPE, tq, pp, v0, v1); arope(ROPE, tq, pp + 1, v2, v3); }
                qa_[b][4 * rq] = v0; qa_[b][4 * rq + 1] = v1; qa_[b][4 * rq + 2] = v2; qa_[b][4 * rq + 3] = v3; }
        qr[0] = pack8<0>(qa_[0]); qr[1] = pack8<8>(qa_[0]); qr[2] = pack8<0>(qa_[1]); qr[3] = pack8<8>(qa_[1]); qr[4] = pack8<0>(qa_[2]); qr[5] = pack8<8>(qa_[2]);
    }
    SWRITE(0, sA); SLOAD(sB, 1); if (2 < NT) SLOAD(sA, 2); __syncthreads();
    qkt(pA0, pA1, lds + OFF_K, qr, r32, hi); partialSM(pA0, pA1);
    SWRITE(1, sB); __syncthreads();
    for (int i = 1; i + 1 < NT; i += 2) {
        STEP(pB0, pB1, pA0, pA1, sA, sB, i);
        STEP(pA0, pA1, pB0, pB1, sB, sA, i + 1);
    }
    ASBAR(); qkt(pB0, pB1, lds + OFF_K + b_cur * SHM_K, qr, r32, hi);
    finishSM(pA0, pA1, l_reg, pa0, pa1, pa2, pa3); ASBAR();
    pv_one<0>(o[0], vb0 + b_prev * SHM_V, pa0, pa1, pa2, pa3); pv_one<1>(o[1], vb0 + b_prev * SHM_V, pa0, pa1, pa2, pa3); partialSM(pB0, pB1);
    finishSM(pB0, pB1, l_reg, pa0, pa1, pa2, pa3); ASBAR();
    pv_one<0>(o[0], vb0 + b_cur * SHM_V, pa0, pa1, pa2, pa3); pv_one<1>(o[1], vb0 + b_cur * SHM_V, pa0, pa1, pa2, pa3);
    { auto rr = __builtin_amdgcn_permlane32_swap(__float_as_uint(l_reg), __float_as_uint(l_reg), false, false); l_reg = __uint_as_float(rr[0]) + __uint_as_float(rr[1]); }
#undef STEP
#undef ROT3
    if (hi == 0) li_l[r32] = l_reg; asm volatile("s_waitcnt lgkmcnt(0)" ::: "memory");
    int hi_e = hi, r32_e = r32; asm volatile("" : "+v"(hi_e), "+v"(r32_e));
    bf16_t* Ow = Ob + (size_t)(wid * 32 + 4 * hi_e) * DM + r32_e;
#pragma unroll
    for (int r = 0; r < 16; ++r) { const int orow = (r & 3) + 8 * (r >> 2); const float rl = __builtin_amdgcn_rcpf(li_l[orow + 4 * hi_e]);
#pragma unroll
        for (int d0 = 0; d0 < 2; ++d0) Ow[(size_t)orow * DM + d0 * 32] = (bf16_t)(cvt_pk_bf16(o[d0][r] * rl, 0.f) & 0xffffu); }
    __syncthreads();
#undef SLOAD
#undef SWRITE
}
#undef ASBAR
}


namespace g2 {
using f32x16 = __attribute__((ext_vector_type(16))) float;
__device__ __forceinline__ int crow(int r, int hi) { return (r & 3) + 8 * (r >> 2) + 4 * hi; }
__device__ __forceinline__ float half_swap_sum(float v) { auto rr = __builtin_amdgcn_permlane32_swap(__float_as_uint(v), __float_as_uint(v), false, false); return __uint_as_float(rr[0]) + __uint_as_float(rr[1]); }
__device__ __forceinline__ void rope_pair(const float* __restrict__ ROPE, int t, int pp, float& x1, float& x2) {
    const int pos = pp < 8 ? (t >> 6) : (t & 63); const f32x2 cs = *(const f32x2*)(ROPE + (pos * 8 + (pp & 7)) * 2);
    const float y1 = x1 * cs[0] - x2 * cs[1], y2 = x1 * cs[1] + x2 * cs[0]; x1 = y1; x2 = y2;
}
template <int NTG>
__device__ __forceinline__ void q_item(const bf16_t* __restrict__ QA, const bf16_t* __restrict__ WQ, const float* __restrict__ qn_g, const float* __restrict__ ROPE, bf16_t* __restrict__ Q, int row0, int h, int lane) {
    const int r32 = lane & 31, hi = lane >> 5;
    f32x16 acc[NTG][3];
#pragma unroll
    for (int tg = 0; tg < NTG; ++tg)
#pragma unroll
        for (int b = 0; b < 3; ++b) acc[tg][b] = f32x16{};
    const bf16_t* wp = WQ + ((size_t)(h * 3) * 16 * 64 + lane) * 8; const bf16_t* ap = QA + ((size_t)(row0 >> 5) * 16 * 64 + lane) * 8;
    bf16x8 fr[2][2][5];
#define G2_QLOAD(S, g) do { _Pragma("unroll") for (int kk = 0; kk < 2; ++kk) { const int ks = 2 * (g) + kk; _Pragma("unroll") for (int tg = 0; tg < NTG; ++tg) fr[S][kk][tg] = *(const bf16x8*)(ap + (size_t)(16 * tg + ks) * 512); \
        _Pragma("unroll") for (int b = 0; b < 3; ++b) fr[S][kk][2 + b] = *(const bf16x8*)(wp + (size_t)(b * 16 + ks) * 512); } } while (0)
    G2_QLOAD(0, 0);
#pragma unroll
    for (int g = 0; g < 8; ++g) {
        if (g + 1 < 8) { if (g & 1) G2_QLOAD(0, g + 1); else G2_QLOAD(1, g + 1); }
        __builtin_amdgcn_sched_barrier(0);
#pragma unroll
        for (int kk = 0; kk < 2; ++kk)
#pragma unroll
            for (int b = 0; b < 3; ++b)
#pragma unroll
                for (int tg = 0; tg < NTG; ++tg) acc[tg][b] = __builtin_amdgcn_mfma_f32_32x32x16_bf16(fr[g & 1][kk][2 + b], fr[g & 1][kk][tg], acc[tg][b], 0, 0, 0);
        __builtin_amdgcn_sched_barrier(0);
    }
#undef G2_QLOAD
#pragma unroll
    for (int tg = 0; tg < NTG; ++tg) { const int row = row0 + tg * 32 + r32; const bool lat = row < RL; const int t = row & 4095;
        float ss = 0.f;
#pragma unroll
        for (int b = 0; b < 3; ++b)
#pragma unroll
            for (int r = 0; r < 16; ++r) ss += acc[tg][b][r] * acc[tg][b][r];
        ss = half_swap_sum(ss); const float rn = rsqrtf(ss * (1.f / 96.f) + EPS) * QSCALE;
        bf16_t* qo = Q + ((size_t)row * NH + h) * QKH + 4 * hi;
#pragma unroll
        for (int b = 0; b < 3; ++b)
#pragma unroll
            for (int rq = 0; rq < 4; ++rq) { const int f0 = 32 * b + 8 * rq + 4 * hi; const f32x4 g = ld4(qn_g + f0);
                float v0 = acc[tg][b][4 * rq] * rn * g[0], v1 = acc[tg][b][4 * rq + 1] * rn * g[1], v2 = acc[tg][b][4 * rq + 2] * rn * g[2], v3 = acc[tg][b][4 * rq + 3] * rn * g[3];
                if (b == 2 && lat) { const int pp = 4 * rq + 2 * hi; rope_pair(ROPE, t, pp, v0, v1); rope_pair(ROPE, t, pp + 1, v2, v3); }
                *(u32x2*)(qo + 32 * b + 8 * rq) = (u32x2){cvt_pk_bf16(v0, v1), cvt_pk_bf16(v2, v3)}; } }
}
__device__ __forceinline__ void kv_item(const bf16_t* __restrict__ KVA, const float* __restrict__ KR, const bf16_t* __restrict__ WKV, const float* __restrict__ kn_g, const float* __restrict__ ROPE,
                                        bf16_t* __restrict__ Kb, bf16_t* __restrict__ Vb, int row0, int h, int lane) {
    const int r32 = lane & 31, hi = lane >> 5;
    f32x16 acc[4];
#pragma unroll
    for (int b = 0; b < 4; ++b) acc[b] = f32x16{};
    const bf16_t* wp = WKV + ((size_t)(h * 4) * 8 * 64 + lane) * 8; const bf16_t* ap = KVA + ((size_t)(row0 >> 5) * 8 * 64 + lane) * 8;
    bf16x8 fr[2][2][5];
#define G2_KLOAD(S, g) do { _Pragma("unroll") for (int kk = 0; kk < 2; ++kk) { const int ks = 2 * (g) + kk; fr[S][kk][0] = *(const bf16x8*)(ap + (size_t)ks * 512); \
        _Pragma("unroll") for (int b = 0; b < 4; ++b) fr[S][kk][1 + b] = *(const bf16x8*)(wp + (size_t)(b * 8 + ks) * 512); } } while (0)
    G2_KLOAD(0, 0);
#pragma unroll
    for (int g = 0; g < 4; ++g) {
        if (g + 1 < 4) { if (g & 1) G2_KLOAD(0, g + 1); else G2_KLOAD(1, g + 1); }
        __builtin_amdgcn_sched_barrier(0);
#pragma unroll
        for (int kk = 0; kk < 2; ++kk)
#pragma unroll
            for (int b = 0; b < 4; ++b) acc[b] = __builtin_amdgcn_mfma_f32_32x32x16_bf16(fr[g & 1][kk][1 + b], fr[g & 1][kk][0], acc[b], 0, 0, 0);
        __builtin_amdgcn_sched_barrier(0);
    }
#undef G2_KLOAD
    const int row = row0 + r32; const bool lat = row < RL; const int bb = lat ? (row >> 12) : ((row - RL) >> 8), t = lat ? (row & 4095) : ((row - RL) & 255), key = lat ? CTXL + t : t;
    float kr[16];
    { const float* krp = KR + (size_t)row * 32 + 16 * hi;
#pragma unroll
      for (int q = 0; q < 4; ++q) { const f32x4 v = ld4(krp + 4 * q); kr[4 * q] = v[0]; kr[4 * q + 1] = v[1]; kr[4 * q + 2] = v[2]; kr[4 * q + 3] = v[3]; } }
    float ss = 0.f;
#pragma unroll
    for (int b = 0; b < 2; ++b)
#pragma unroll
        for (int r = 0; r < 16; ++r) ss += acc[b][r] * acc[b][r];
#pragma unroll
    for (int i = 0; i < 16; ++i) ss += kr[i] * kr[i];
    ss = half_swap_sum(ss); const float rn = rsqrtf(ss * (1.f / 96.f) + EPS);
    bf16_t* ko = Kb + (((size_t)bb * NH + h) * NKEY + key) * QKH; bf16_t* vo = Vb + (((size_t)bb * NH + h) * NKEY + key) * VD;
#pragma unroll
    for (int b = 0; b < 2; ++b)
#pragma unroll
        for (int rq = 0; rq < 4; ++rq) { const int f0 = 32 * b + 8 * rq + 4 * hi; const f32x4 g = ld4(kn_g + f0);
            *(u32x2*)(ko + f0) = (u32x2){cvt_pk_bf16(acc[b][4 * rq] * rn * g[0], acc[b][4 * rq + 1] * rn * g[1]), cvt_pk_bf16(acc[b][4 * rq + 2] * rn * g[2], acc[b][4 * rq + 3] * rn * g[3])};
            *(u32x2*)(vo + f0) = (u32x2){cvt_pk_bf16(acc[2 + b][4 * rq], acc[2 + b][4 * rq + 1]), cvt_pk_bf16(acc[2 + b][4 * rq + 2], acc[2 + b][4 * rq + 3])}; }
    unsigned pk[8];
#pragma unroll
    for (int q = 0; q < 8; ++q) { float x1 = kr[2 * q] * rn * kn_g[64 + 16 * hi + 2 * q], x2 = kr[2 * q + 1] * rn * kn_g[65 + 16 * hi + 2 * q];
        if (lat) rope_pair(ROPE, t, 8 * hi + q, x1, x2);
        pk[q] = cvt_pk_bf16(x1, x2); }
    *(u32x4*)(ko + 64 + 16 * hi) = (u32x4){pk[0], pk[1], pk[2], pk[3]}; *(u32x4*)(ko + 72 + 16 * hi) = (u32x4){pk[4], pk[5], pk[6], pk[7]};
}
__device__ __forceinline__ void sp_item(const bf16_t* __restrict__ VT, const bf16_t* __restrict__ WSP, const float* __restrict__ bsp, const bf16_t* __restrict__ U, bf16_t* __restrict__ MIX, int chunk, int h, int ih, int lane) {
    const int r32 = lane & 31, hi = lane >> 5;
    f32x16 acc[2][2];
#pragma unroll
    for (int cb = 0; cb < 2; ++cb)
#pragma unroll
        for (int ib = 0; ib < 2; ++ib) acc[cb][ib] = f32x16{};
    const bf16_t* vp = VT + (((size_t)chunk * 8 + 2 * h) * 8 * 64 + lane) * 8;     const bf16_t* wp = WSP + ((size_t)(h * 4 + 2 * ih) * 8 * 64 + lane) * 8;
    bf16x8 fr[2][2][4];
#define G2_SLOAD(S, g) do { _Pragma("unroll") for (int kk = 0; kk < 2; ++kk) { const int ks = 2 * (g) + kk; fr[S][kk][0] = *(const bf16x8*)(vp + (size_t)ks * 512); fr[S][kk][1] = *(const bf16x8*)(vp + (size_t)(8 + ks) * 512); \
        fr[S][kk][2] = *(const bf16x8*)(wp + (size_t)ks * 512); fr[S][kk][3] = *(const bf16x8*)(wp + (size_t)(8 + ks) * 512); } } while (0)
    G2_SLOAD(0, 0);
#pragma unroll
    for (int g = 0; g < 4; ++g) {
        if (g + 1 < 4) { if (g & 1) G2_SLOAD(0, g + 1); else G2_SLOAD(1, g + 1); }
        __builtin_amdgcn_sched_barrier(0);
#pragma unroll
        for (int kk = 0; kk < 2; ++kk) {
            acc[0][0] = __builtin_amdgcn_mfma_f32_32x32x16_bf16(fr[g & 1][kk][0], fr[g & 1][kk][2], acc[0][0], 0, 0, 0); acc[0][1] = __builtin_amdgcn_mfma_f32_32x32x16_bf16(fr[g & 1][kk][0], fr[g & 1][kk][3], acc[0][1], 0, 0, 0);
            acc[1][0] = __builtin_amdgcn_mfma_f32_32x32x16_bf16(fr[g & 1][kk][1], fr[g & 1][kk][2], acc[1][0], 0, 0, 0); acc[1][1] = __builtin_amdgcn_mfma_f32_32x32x16_bf16(fr[g & 1][kk][1], fr[g & 1][kk][3], acc[1][1], 0, 0, 0); }
        __builtin_amdgcn_sched_barrier(0);
    }
#undef G2_SLOAD
#pragma unroll
    for (int ib = 0; ib < 2; ++ib) { const int i = 64 * ih + 32 * ib + r32; const float bias = bsp[h * 128 + i]; const size_t row = (size_t)chunk * 128 + i;
#pragma unroll
        for (int cb = 0; cb < 2; ++cb)
#pragma unroll
            for (int rq = 0; rq < 4; ++rq) { const int c = 64 * h + 32 * cb + 8 * rq + 4 * hi; const u32x2 uu = *(const u32x2*)(U + row * 256 + c);
                const float u0 = __uint_as_float(uu[0] << 16), u1 = __uint_as_float(uu[0] & 0xffff0000u), u2 = __uint_as_float(uu[1] << 16), u3 = __uint_as_float(uu[1] & 0xffff0000u);
                *(u32x2*)(MIX + row * DM + c) = (u32x2){cvt_pk_bf16(u0 * (acc[cb][ib][4 * rq] + bias), u1 * (acc[cb][ib][4 * rq + 1] + bias)), cvt_pk_bf16(u2 * (acc[cb][ib][4 * rq + 2] + bias), u3 * (acc[cb][ib][4 * rq + 3] + bias))}; } }
}
__device__ __forceinline__ void pool_block(const bf16_t* __restrict__ BW, const float* __restrict__ pscale, bf16_t* __restrict__ MIX, int row0, LAS unsigned char* lds, int tid) {
    int t0, ntok; if (row0 < RL) { t0 = row0 & 4095; ntok = SEQ; } else { t0 = (row0 - RL) & 255; ntok = CTXL; }
    const int base = row0 - t0;
    __syncthreads();
#pragma unroll
    for (int j = 0; j < 5; ++j) { const int idx = tid + 512 * j; const int rr = idx >> 5, ch = idx & 31; const int t = t0 - 8 + rr;
        u32x4 v = (u32x4){0u, 0u, 0u, 0u}; if (t >= 0 && t < ntok) v = *(const u32x4*)(BW + (size_t)(base + t) * 256 + ch * 8);
        *(LAS u32x4*)(lds + rr * 512 + ch * 16) = v; }
    __syncthreads();
#pragma unroll
    for (int j = 0; j < 4; ++j) { const int idx = tid + 512 * j; const int rr = idx >> 5, ch = idx & 31, n0 = ch * 8, g = n0 >> 6, hw = 1 << g; const int t = t0 + rr;
        const int lo = max(t - hw, 0), hi = min(t + hw, ntok);
        float sm[8];
#pragma unroll
        for (int q = 0; q < 8; ++q) sm[q] = 0.f;
#pragma unroll
        for (int d = -8; d < 8; ++d) { if (d >= -hw && d < hw) { const u32x4 v = *(const LAS u32x4*)(lds + (rr + 8 + d) * 512 + ch * 16);
#pragma unroll
                for (int q = 0; q < 4; ++q) { sm[2 * q] += __uint_as_float(v[q] << 16); sm[2 * q + 1] += __uint_as_float(v[q] & 0xffff0000u); } } }
        const float inv = 1.f / (float)(hi - lo); const u32x4 v = *(const LAS u32x4*)(lds + (rr + 8) * 512 + ch * 16); const f32x4 p0 = ld4(pscale + n0), p1 = ld4(pscale + n0 + 4);
        float z[8];
#pragma unroll
        for (int q = 0; q < 4; ++q) { z[2 * q] = sm[2 * q] * inv - __uint_as_float(v[q] << 16); z[2 * q + 1] = sm[2 * q + 1] * inv - __uint_as_float(v[q] & 0xffff0000u); }
        *(u32x4*)(MIX + (size_t)(row0 + rr) * DM + 256 + n0) = (u32x4){cvt_pk_bf16(z[0] * p0[0], z[1] * p0[1]), cvt_pk_bf16(z[2] * p0[2], z[3] * p0[3]), cvt_pk_bf16(z[4] * p1[0], z[5] * p1[1]), cvt_pk_bf16(z[6] * p1[2], z[7] * p1[3])}; }
}
}

__device__ __forceinline__ void transpose_item(const float* W, int ldw, int K, bf16_t* WT, int k0, int n0, int dst_row0, LAS float* scr, int lane) {
    float tv[32];
#pragma unroll
    for (int i = 0; i < 32; ++i) tv[i] = W[(size_t)(k0 + 2 * i + (lane >> 5)) * ldw + n0 + (lane & 31)];
#pragma unroll
    for (int i = 0; i < 32; ++i) scr[(2 * i + (lane >> 5)) * 33 + (lane & 31)] = tv[i];
    asm volatile("s_waitcnt lgkmcnt(0)" ::: "memory");
    const int c = lane & 7;
#pragma unroll
    for (int j = 0; j < 4; ++j) { const int n = (lane >> 3) + 8 * j; const LAS float* sp = scr + (8 * c) * 33 + n;
        u32x4 o; o.x = cvt_pk_bf16(sp[0 * 33], sp[1 * 33]); o.y = cvt_pk_bf16(sp[2 * 33], sp[3 * 33]); o.z = cvt_pk_bf16(sp[4 * 33], sp[5 * 33]); o.w = cvt_pk_bf16(sp[6 * 33], sp[7 * 33]);
        *(u32x4*)(WT + (size_t)(dst_row0 + n) * K + k0 + 8 * c) = o; }
    asm volatile("s_waitcnt lgkmcnt(0)" ::: "memory");
}


__device__ __forceinline__ void fold_item(const float* w_in_l, const float* w_pool_l, bf16_t* WT, int k0, int g, int dh, LAS float* scr, int lane) {
    {   f32x4 av[8], wv[8];
#pragma unroll
        for (int i = 0; i < 8; ++i) av[i] = ld4(w_in_l + (size_t)(k0 + i * 4 + (lane >> 4)) * DIN + 512 + 64 * g + (lane & 15) * 4);
#pragma unroll
        for (int i = 0; i < 8; ++i) wv[i] = ld4(w_pool_l + (size_t)g * 64 * 64 + (size_t)(i * 8 + (lane >> 3)) * 64 + 32 * dh + (lane & 7) * 4);
#pragma unroll
        for (int i = 0; i < 8; ++i) { *(LAS f32x4*)(scr + (i * 4 + (lane >> 4)) * 64 + (lane & 15) * 4) = av[i]; *(LAS f32x4*)(scr + 2048 + (i * 8 + (lane >> 3)) * 32 + (lane & 7) * 4) = wv[i]; }
    }
    asm volatile("s_waitcnt lgkmcnt(0)" ::: "memory");
    const int ch = lane >> 5, d = lane & 31;
    float acc[32];
#pragma unroll
    for (int j = 0; j < 32; ++j) acc[j] = 0.f;
#pragma unroll 2
    for (int cc = 0; cc < 32; ++cc) { const float wvv = scr[2048 + (ch * 32 + cc) * 32 + d];
#pragma unroll
        for (int j = 0; j < 32; ++j) acc[j] += scr[j * 64 + ch * 32 + cc] * wvv; }
    asm volatile("s_waitcnt lgkmcnt(0)" ::: "memory");
#pragma unroll
    for (int j = 0; j < 32; ++j) { auto rr = __builtin_amdgcn_permlane32_swap(__float_as_uint(acc[j]), __float_as_uint(acc[j]), false, false); acc[j] = __uint_as_float(rr[0]) + __uint_as_float(rr[1]); }
    if (ch == 0) {
#pragma unroll
        for (int j = 0; j < 32; ++j) scr[j * 33 + d] = acc[j]; }
    asm volatile("s_waitcnt lgkmcnt(0)" ::: "memory");
    const int c = lane & 3;
#pragma unroll
    for (int jj = 0; jj < 2; ++jj) { const int n = (lane >> 2) + 16 * jj; const LAS float* sp = scr + (8 * c) * 33 + n;
        u32x4 o; o.x = cvt_pk_bf16(sp[0 * 33], sp[1 * 33]); o.y = cvt_pk_bf16(sp[2 * 33], sp[3 * 33]); o.z = cvt_pk_bf16(sp[4 * 33], sp[5 * 33]); o.w = cvt_pk_bf16(sp[6 * 33], sp[7 * 33]);
        *(u32x4*)(WT + (size_t)(512 + 64 * g + 32 * dh + n) * DM + k0 + 8 * c) = o; }
    asm volatile("s_waitcnt lgkmcnt(0)" ::: "memory");
}

template <bool GU>
__device__ __forceinline__ void transpose_block(const float* __restrict__ W, int ldw, int Kdim, bf16_t* __restrict__ WT, int k0, int n0, int width, LAS float* tile, int tid) {
    const int wave = tid >> 6, lane = tid & 63;
    __syncthreads();
    { const int col4 = lane * 4; f32x4 v[8];
      if (col4 < width) {
#pragma unroll
        for (int i = 0; i < 8; ++i) v[i] = ld4(W + (size_t)(k0 + 8 * i + wave) * ldw + n0 + col4);
#pragma unroll
        for (int i = 0; i < 8; ++i) { LAS float* t_ = tile + (8 * i + wave) * 257 + col4; t_[0] = v[i][0]; t_[1] = v[i][1]; t_[2] = v[i][2]; t_[3] = v[i][3]; } } }
    __syncthreads();
    const int c = lane & 7;
#pragma unroll
    for (int jj = 0; jj < 4; ++jj) { const int nl = 32 * wave + (lane >> 3) + 8 * jj;
        if (nl < width) { const LAS float* sp = tile + (8 * c) * 257 + nl;
            u32x4 o; o.x = cvt_pk_bf16(sp[0 * 257], sp[1 * 257]); o.y = cvt_pk_bf16(sp[2 * 257], sp[3 * 257]); o.z = cvt_pk_bf16(sp[4 * 257], sp[5 * 257]); o.w = cvt_pk_bf16(sp[6 * 257], sp[7 * 257]);
            const int n = n0 + nl; int dst = n; if (GU) { const int f = n % DFF, isup = n / DFF; dst = 256 * (f / 128) + 128 * isup + (f % 128); }
            *(u32x4*)(WT + (size_t)dst * Kdim + k0 + 8 * c) = o; } }
}

#define XB_TMO      128
#define XB_XCNT(j)  (256  + 64 * (j))
#define XB_XSUB(j)  (1280 + 64 * (j))
#define XB_XGEN(j)  (2304 + 64 * (j))
#define XB_TOP      3328
#define XB_TOPGEN   3392
#define XCD_BAR_WORDS 3456
#define XB_SPIN_CAP (1u << 18)
__device__ __forceinline__ unsigned xb_ld(unsigned* p)              { return __hip_atomic_load(p, __ATOMIC_RELAXED, __HIP_MEMORY_SCOPE_AGENT); }
__device__ __forceinline__ unsigned xb_add(unsigned* p, unsigned v) { return __hip_atomic_fetch_add(p, v, __ATOMIC_RELAXED, __HIP_MEMORY_SCOPE_AGENT); }
__device__ __forceinline__ unsigned xb_xcc_id() { return (unsigned)__builtin_amdgcn_s_getreg((3 << 11) | 20) & 0xFu; }
#define XB_SPIN(cond, bar) do { unsigned _sp = 0; while (cond) { __builtin_amdgcn_s_sleep(1); \
    if ((++_sp & 255u) == 0u) { if (xb_ld(&(bar)[XB_TMO])) break; if (_sp > XB_SPIN_CAP) { atomicAdd(&(bar)[XB_TMO], 1u); break; } } } } while (0)
struct XcdBarrier { unsigned* bar; unsigned x; volatile LAS unsigned* st; };
__device__ __forceinline__ XcdBarrier xcd_barrier_post(unsigned* bar, volatile LAS unsigned* st) {
    XcdBarrier b; b.bar = bar; b.x = xb_xcc_id(); b.st = st;
    if (threadIdx.x == 0) (void)xb_add(&bar[XB_XCNT(b.x)], 1u);
    return b;
}
__device__ __forceinline__ void xcd_barrier_complete(unsigned* bar, unsigned x, unsigned& nloc, unsigned& nx) {
    const unsigned G = gridDim.x * gridDim.y * gridDim.z;
    unsigned sum, cnt, mine, sp = 0u;
    for (;;) {
        sum = 0u; cnt = 0u; mine = 0u;
#pragma unroll
        for (unsigned j = 0; j < 16; ++j) { const unsigned c = xb_ld(&bar[XB_XCNT(j)]); sum += c; cnt += (c > 0u) ? 1u : 0u; mine = (j == x) ? c : mine; }
        if (sum == G) break;
        __builtin_amdgcn_s_sleep(1);
        if ((++sp & 255u) == 0u) { if (xb_ld(&bar[XB_TMO])) break; if (sp > XB_SPIN_CAP) { atomicAdd(&bar[XB_TMO], 1u); break; } }
    }
    nloc = mine > 0u ? mine : 1u; nx = cnt > 0u ? cnt : 1u;
}
__device__ __forceinline__ void xcd_barrier(const XcdBarrier& b) {
    asm volatile("s_waitcnt vmcnt(0)" ::: "memory");
    __syncthreads();
    if (threadIdx.x == 0) {
        unsigned* bar = b.bar;
        __builtin_amdgcn_s_waitcnt(0);
        unsigned nloc = b.st[0], nx = b.st[1];
        if (nloc == 0u) { xcd_barrier_complete(bar, b.x, nloc, nx); b.st[0] = nloc; b.st[1] = nx; }
        const unsigned old = xb_add(&bar[XB_XSUB(b.x)], 1u);
        const unsigned gen = old / nloc;
        if (old + 1u == (gen + 1u) * nloc) {
            __builtin_amdgcn_fence(__ATOMIC_RELEASE, "agent");
            asm volatile("s_waitcnt vmcnt(0)" ::: "memory");
            const unsigned og = xb_add(&bar[XB_TOP], 1u);
            const unsigned tg = og / nx;
            if (og + 1u == (tg + 1u) * nx) xb_add(&bar[XB_TOPGEN], 1u);
            else XB_SPIN(xb_ld(&bar[XB_TOPGEN]) == tg, bar);
            __builtin_amdgcn_fence(__ATOMIC_ACQUIRE, "agent");
            xb_add(&bar[XB_XGEN(b.x)], 1u);
            asm volatile("s_waitcnt vmcnt(0)" ::: "memory");
        } else {
            XB_SPIN(xb_ld(&bar[XB_XGEN(b.x)]) == gen, bar);
            __builtin_amdgcn_fence(__ATOMIC_ACQUIRE, "agent");
            asm volatile("s_waitcnt vmcnt(0)" ::: "memory");
        }
    }
    __syncthreads();
}

struct MkArgs { const float* in[23]; float* out; unsigned char* ws; int ph_lo, ph_hi; int dry, pad; };
constexpr int MK_LDS = 147456;
constexpr int MK_XL_OFF = 131072;
enum { PH_P0A = 0, PH_P0B = 1, PH_L0 = 2, PH_PER_LAYER = 6, PH_G1 = 0, PH_G2 = 1, PH_G3 = 2, PH_G4 = 3, PH_G5 = 4, PH_G6 = 5, PH_END = 14 };

typedef const __attribute__((address_space(4))) MkArgs* KargPtr;
#define KARG() ({ KargPtr p_ = (KargPtr)__builtin_amdgcn_kernarg_segment_ptr(); asm volatile("" : "+s"(p_)); p_; })
#define WSP(kp, off) ((kp)->ws + (off))
#define BLK() ({ int b_ = (int)blockIdx.x; asm volatile("" : "+s"(b_)); b_; })

__device__ __forceinline__ void weight_prep(KargPtr kp, unsigned char* ws, int l, int bi, int nb, LAS unsigned char* lds, int tid, int parts) {
    const int lane = tid & 63, wave = __builtin_amdgcn_readfirstlane(tid >> 6);
    bf16_t* WB = (bf16_t*)(ws + WS_WB + (size_t)l * 22 * MiB);
    {   LAS float* tile = (LAS float*)lds;
        constexpr int B_IN = 16 * 4, B_OUT = 16 * 4, B_GU = 16 * 22, B_DN = 44 * 4, B_L = B_IN + B_OUT + B_GU + B_DN;
        for (int it = bi; it < B_L; it += nb) { int r = it; const int part = (r >= B_GU + B_DN && r < B_GU + B_DN + B_IN) ? 1 : 2; if (!(parts & part)) continue;
            if (r < B_GU) { transpose_block<true>(kp->in[21] + (size_t)l * DM * 2 * DFF, 2 * DFF, DM, WB + WL_GU, (r / 22) * 64, (r % 22) * 256, 256, tile, tid); continue; } r -= B_GU;
            if (r < B_DN) { transpose_block<false>(kp->in[22] + (size_t)l * DFF * DM, DM, DFF, WB + WL_DN, (r / 4) * 64, (r % 4) * 256, 256, tile, tid); continue; } r -= B_DN;
            if (r < B_IN) { const int nq = r % 4, n0 = (nq < 2 ? nq : nq + 1) * 256; transpose_block<false>(kp->in[8] + (size_t)l * DM * DIN, DIN, DM, WB + WL_IN, (r / 4) * 64, n0, n0 == 1024 ? 160 : 256, tile, tid); continue; } r -= B_IN;
            transpose_block<false>(kp->in[20] + (size_t)l * DM * DM, DM, DM, WB + WL_OUT, (r / 4) * 64, (r % 4) * 256, 256, tile, tid);
        }
        __syncthreads();
    }
    LAS float* scr = (LAS float*)(lds + wave * 16384);
    constexpr int I_FOLD = 32 * 8, I_Z = 96 * DM / 512, I_SP = 4 * 4 * 8, I_QF = 8 * 3 * 16, I_KF = 8 * 4 * 8, I_ALL = I_FOLD + I_Z + I_SP + I_QF + I_KF;
    if (parts & 1)
    for (int it = bi * 8 + wave; it < I_ALL; it += nb * 8) { int r = it;
        if (r < I_FOLD) { const int kb = r >> 3, g = (r >> 1) & 3, dh = r & 1; fold_item(kp->in[8] + (size_t)l * DM * DIN, kp->in[12] + (size_t)l * 4 * 64 * 64, WB + WL_IN, kb * 32, g, dh, scr, lane); continue; } r -= I_FOLD;
        if (r < I_SP) {
            const int h = r >> 5, ib = (r >> 3) & 3, ks = r & 7; const float* sp_ = kp->in[10] + (size_t)l * 4 * 128 * 128 + ((size_t)h * 128 + 32 * ib + (lane & 31)) * 128 + 16 * ks + 8 * (lane >> 5); const f32x4 x0 = ld4(sp_), x1 = ld4(sp_ + 4);
            *(u32x4*)(WB + WL_SP + ((size_t)r * 64 + lane) * 8) = (u32x4){cvt_pk_bf16(x0[0], x0[1]), cvt_pk_bf16(x0[2], x0[3]), cvt_pk_bf16(x1[0], x1[1]), cvt_pk_bf16(x1[2], x1[3])}; continue; } r -= I_SP;
        if (r < I_QF) {
            const int h = r / 48, b = (r / 16) % 3, ks = r & 15; const float* src = kp->in[15] + (size_t)l * 256 * 768 + (size_t)(16 * ks + 8 * (lane >> 5)) * 768 + 96 * h + 32 * b + (lane & 31); float e_[8];
#pragma unroll
            for (int e = 0; e < 8; ++e) e_[e] = src[(size_t)e * 768];
            *(u32x4*)(WB + WL_QB + ((size_t)r * 64 + lane) * 8) = (u32x4){cvt_pk_bf16(e_[0], e_[1]), cvt_pk_bf16(e_[2], e_[3]), cvt_pk_bf16(e_[4], e_[5]), cvt_pk_bf16(e_[6], e_[7])}; continue; } r -= I_QF;
        if (r < I_KF) {
            const int h = r >> 5, b = (r >> 3) & 3, ks = r & 7; const float* src = kp->in[17] + (size_t)l * 128 * 1024 + (size_t)(16 * ks + 8 * (lane >> 5)) * 1024 + 128 * h + 32 * b + (lane & 31); float e_[8];
#pragma unroll
            for (int e = 0; e < 8; ++e) e_[e] = src[(size_t)e * 1024];
            *(u32x4*)(WB + WL_KVB + ((size_t)r * 64 + lane) * 8) = (u32x4){cvt_pk_bf16(e_[0], e_[1]), cvt_pk_bf16(e_[2], e_[3]), cvt_pk_bf16(e_[4], e_[5]), cvt_pk_bf16(e_[6], e_[7])}; continue; } r -= I_KF;
        { unsigned z_ = 0u; asm volatile("" : "+v"(z_)); *(u32x4*)(WB + WL_IN + (size_t)DIN * DM + (size_t)r * 512 + lane * 8) = (u32x4){z_, z_, z_, z_}; }
    }
}
__device__ __forceinline__ void bias_items(unsigned char* ws, int l, int bi, int nb, int tid, int which) {
    const int lane = tid & 63, wave = __builtin_amdgcn_readfirstlane(tid >> 6);
    const float* MOD = (const float*)(ws + WS_MOD); float* BIAS1P = (float*)(ws + WS_BIAS1P); float* BIAS2P = (float*)(ws + WS_BIAS2P);
    constexpr int NB_ROWS = 2 * DFF + 1280;
    const int r_lo = (which & 2) ? 0 : 2 * DFF, r_hi = (which & 1) ? NB_ROWS : 2 * DFF;
    for (int it0 = r_lo + (bi * 8 + wave) * 2; it0 < r_hi; it0 += nb * 8 * 2) {
        u32x4 q0[2], q1[2]; const float* shp[2]; float* outp[2]; int ldo[2];
#pragma unroll
        for (int e = 0; e < 2; ++e) { int n = it0 + e; const bool isgu = n < 2 * DFF; if (!isgu) n -= 2 * DFF;
            const bf16_t* wrow = (const bf16_t*)(ws + WS_WB + (size_t)l * 22 * MiB) + (isgu ? WL_GU : WL_IN) + (size_t)n * DM; shp[e] = MOD + (size_t)l * 5 * NMOD * DM + (isgu ? 3 : 0) * DM;
            outp[e] = isgu ? BIAS2P + (size_t)l * 5 * 2 * DFF + n : BIAS1P + (size_t)l * 5 * 1280 + n; ldo[e] = isgu ? 2 * DFF : 1280;
            q0[e] = *(const u32x4*)(wrow + lane * 16); q1[e] = *(const u32x4*)(wrow + lane * 16 + 8); }
        float accr[2][5];
#pragma unroll
        for (int e = 0; e < 2; ++e) { float w[16];
#pragma unroll
            for (int j = 0; j < 4; ++j) { w[2 * j] = __uint_as_float(q0[e][j] << 16); w[2 * j + 1] = __uint_as_float(q0[e][j] & 0xffff0000u); w[8 + 2 * j] = __uint_as_float(q1[e][j] << 16); w[9 + 2 * j] = __uint_as_float(q1[e][j] & 0xffff0000u); }
#pragma unroll
            for (int r = 0; r < 5; ++r) { const float* sv = shp[e] + (size_t)r * NMOD * DM + lane * 16; float acc = 0.f;
#pragma unroll
                for (int j = 0; j < 4; ++j) { const f32x4 s4 = ld4(sv + 4 * j); acc += (s4[0] * w[4 * j] + s4[1] * w[4 * j + 1]) + (s4[2] * w[4 * j + 2] + s4[3] * w[4 * j + 3]); }
                accr[e][r] = acc; } }
#pragma unroll
        for (int e = 0; e < 2; ++e)
#pragma unroll
            for (int r = 0; r < 5; ++r) { const float t = wave_sum(accr[e][r]); if (lane == 0) outp[e][(size_t)r * ldo[e]] = t; }
    }
}

__global__ void __launch_bounds__(512, 2) mk_fwd(MkArgs a) {
    extern __shared__ __attribute__((aligned(16))) unsigned char lds_raw[];
    LAS unsigned char* lds = (LAS unsigned char*)lds_raw; LAS unsigned char* xl = lds + MK_XL_OFF;
    const int ph_lo = a.ph_lo, ph_hi = a.ph_hi;
#define IN(k) (ph_lo <= (k) && (k) < ph_hi)
    volatile LAS unsigned* bst = (volatile LAS unsigned*)(lds + MK_XL_OFF + 8192);
    if (threadIdx.x < 4) bst[threadIdx.x] = 0u;
    __syncthreads();
    XcdBarrier gbar; gbar.bar = (unsigned*)a.ws; gbar.x = 0; gbar.st = bst;
    if (ph_hi - ph_lo > 1) gbar = xcd_barrier_post((unsigned*)a.ws, bst);
#define GRID_BAR(k) do { if (IN(k) && IN((k) + 1)) xcd_barrier(gbar); } while (0)
#define LANE_IDS() int tid = threadIdx.x; asm volatile("" : "+v"(tid)); const int lane = tid & 63, wave = __builtin_amdgcn_readfirstlane(tid >> 6); const int G = gridDim.x; const int gw = blockIdx.x * 8 + wave, NGW = G * 8; (void)lane; (void)gw; (void)NGW
    if (IN(PH_P0A)) {
        LANE_IDS(); KargPtr kp = KARG(); unsigned char* ws = kp->ws;
        {   LAS float* sl = (LAS float*)lds; LAS float* part = (LAS float*)(lds + 20480);
            float* MOD = (float*)(ws + WS_MOD); const float* cc = kp->in[1]; const float* cctx = kp->in[3]; const float* w_ada = kp->in[6]; const float* b_ada = kp->in[7];
            for (int i = tid; i < 5 * DM; i += 512) { const int mr = i >> 10, k = i & 1023; const float v = mr < 4 ? cc[mr * DM + k] : cctx[k]; sl[i] = silu_f(v); }
            __syncthreads();
            for (int strip = blockIdx.x; strip < DEPTH * 128; strip += G) { const int l = strip >> 7, n0 = (strip & 127) * 48;
                const int kg = tid / 12, c4 = tid % 12;
                if (tid < 504) { f32x4 acc[5];
#pragma unroll
                    for (int r = 0; r < 5; ++r) acc[r] = (f32x4){0.f, 0.f, 0.f, 0.f};
                    const float* wp = w_ada + (size_t)l * DM * (NMOD * DM) + n0 + c4 * 4;
#pragma unroll 13
                    for (int k = kg; k < DM; k += 42) { const f32x4 w = ld4(wp + (size_t)k * (NMOD * DM));
#pragma unroll
                        for (int r = 0; r < 5; ++r) acc[r] += w * sl[r * DM + k]; }
#pragma unroll
                    for (int r = 0; r < 5; ++r) *(LAS f32x4*)(part + (kg * 5 + r) * 48 + c4 * 4) = acc[r]; }
                __syncthreads();
                if (tid < 240) { const int r = tid / 48, c = tid % 48; float sum = 0.f;
#pragma unroll 6
                    for (int q = 0; q < 42; ++q) sum += part[(q * 5 + r) * 48 + c];
                    MOD[((size_t)l * 5 + r) * (NMOD * DM) + n0 + c] = sum + b_ada[l * NMOD * DM + n0 + c]; }
                __syncthreads(); }
        }
        if (blockIdx.x == 0) { float* ROPE = (float*)(ws + WS_ROPE); const int pos = tid >> 3, i = tid & 7;
            const float inv = (float)exp2(-(double)i / 8.0 * 13.287712379549449); const float ang = (float)pos * inv;
            double sn, cs; sincos_d((double)ang, sn, cs); ROPE[tid * 2] = (float)cs; ROPE[tid * 2 + 1] = (float)sn; }
        __syncthreads();
        weight_prep(kp, ws, 0, (int)blockIdx.x, G, lds, tid, 1);
    }
    GRID_BAR(PH_P0A);
    if (IN(PH_P0B)) {
        LANE_IDS(); KargPtr kp = KARG(); unsigned char* ws = kp->ws;
        const float* MOD = (const float*)(ws + WS_MOD);
        bias_items(ws, 0, (int)blockIdx.x, G, tid, 1);
        float* RSQ1 = (float*)(ws + WS_RSQ1); bf16_t* XG = (bf16_t*)(ws + WS_XG);
        const float* xin = kp->in[0]; const float* cin = kp->in[2]; const float* norm1_g = kp->in[4]; const float* sc = MOD + 1 * DM;
        for (int r0 = gw * 4; r0 < R; r0 += NGW * 4) {
            f32x4 v[4][4], gg[4], s4[4];
            const float* scr_ = sc + (size_t)mrow_of(r0) * (NMOD * DM);
#pragma unroll
            for (int j = 0; j < 4; ++j) { gg[j] = ld4(norm1_g + j * 256 + lane * 4); s4[j] = ld4(scr_ + j * 256 + lane * 4); }
#pragma unroll
            for (int e = 0; e < 4; ++e) { const int r = r0 + e; const float* xr = r < RL ? xin + (size_t)r * DM : cin + (size_t)(r - RL) * DM;
#pragma unroll
                for (int j = 0; j < 4; ++j) v[e][j] = ld4(xr + j * 256 + lane * 4); }
#pragma unroll
            for (int j = 0; j < 4; ++j) gg[j] = gg[j] * (s4[j] + 1.f);
            float ssv[4][4];
#pragma unroll
            for (int e = 0; e < 4; ++e) { const int r = r0 + e;
#pragma unroll
                for (int j = 0; j < 4; ++j) { const int k = j * 256 + lane * 4;
                    ssv[e][j] = (v[e][j][0] * v[e][j][0] + v[e][j][1] * v[e][j][1]) + (v[e][j][2] * v[e][j][2] + v[e][j][3] * v[e][j][3]);
                    const f32x4 z = v[e][j] * gg[j]; *(u32x2*)(XG + (size_t)r * DM + k) = (u32x2){cvt_pk_bf16(z[0], z[1]), cvt_pk_bf16(z[2], z[3])}; } }
#pragma unroll
            for (int e = 0; e < 4; ++e) {
#pragma unroll
                for (int j = 0; j < 4; ++j) ssv[e][j] = wave_sum(ssv[e][j]);
                if (lane == 0) *(f32x4*)(RSQ1 + (size_t)(r0 + e) * 4) = (f32x4){ssv[e][0], ssv[e][1], ssv[e][2], ssv[e][3]}; }
        }
    }
    GRID_BAR(PH_P0B);
    constexpr int NCTXU = 16;
#pragma unroll 1
    for (int l = 0; l < DEPTH; ++l) {
        const int pb = PH_L0 + l * PH_PER_LAYER; const int Mrows = (l == 0) ? R : RL;
        if (IN(pb + PH_G1)) {
            KargPtr kp = KARG(); unsigned char* ws = kp->ws; const bf16_t* WB = (const bf16_t*)(ws + WS_WB + (size_t)l * 22 * MiB); const int G = gridDim.x;
            EpiG1 E{(const float*)(ws + WS_RSQ1), (const float*)(ws + WS_BIAS1P) + (size_t)l * 5 * 1280, kp->in[9] + l * 256, kp->in[14] + l * 256, kp->in[16] + l * 128,
                    (bf16_t*)(ws + WS_U), (bf16_t*)(ws + WS_VT), (bf16_t*)(ws + WS_BW), (bf16_t*)(ws + WS_QA), (bf16_t*)(ws + WS_KVA), (float*)(ws + WS_KR)};
            if (l == 0) {
                pg8::Gemm g{(const bf16_t*)(ws + WS_XG), WB + WL_IN, R, 1280, DM}; pg8::StaticOrder S; S.init(R, 1280, G, BLK());
                pg8::gemm_phase(lds, xl, g, S, E);
                const int busy2 = (R / 256) * 5 > G ? (R / 256) * 5 - G : 0;
                if ((int)blockIdx.x >= busy2) { int tid_ = threadIdx.x; asm volatile("" : "+v"(tid_)); weight_prep(kp, ws, 0, (int)blockIdx.x - busy2, G - busy2, lds, tid_, 2); }
            } else {
                pg8::Gemm g{(const bf16_t*)(ws + WS_XG), WB + WL_IN, RL, 1280, DM}; pg8::StaticOrder S; S.init(RL, 1280, G - NCTXU, BLK() - NCTXU);
                pg8::gemm_phase(lds, xl, g, S, E);
                const bf16_t* WBp = (const bf16_t*)(ws + WS_WB + (size_t)(l - 1) * 22 * MiB); const float* MOD = (const float*)(ws + WS_MOD); const float* modp = MOD + (size_t)(l - 1) * 5 * NMOD * DM;
                pg8::Gemm g6{(const bf16_t*)(ws + WS_ACT), WBp + WL_DN, R, DM, DFF}; pg8::ListOrder S6{0, NCTXU, 16, 64, 4, 0};
                EpiRes E6{kp->out, (float*)(ws + WS_XC), (const float*)kp->out, (const float*)(ws + WS_XC), modp + 5 * DM, (float*)(ws + WS_RSQ1), (bf16_t*)(ws + WS_XG), kp->in[4] + l * DM, MOD + (size_t)l * 5 * NMOD * DM + 1 * DM, 1, 0};
                pg8::gemm_phase(lds, xl, g6, S6, E6);
            }
        }
        GRID_BAR(pb + PH_G1);
        if (IN(pb + PH_G2)) {
            LANE_IDS(); KargPtr kp = KARG(); unsigned char* ws = kp->ws; const bf16_t* WB = (const bf16_t*)(ws + WS_WB + (size_t)l * 22 * MiB);
            const bf16_t* Uq = (const bf16_t*)(ws + WS_U); const bf16_t* VTq = (const bf16_t*)(ws + WS_VT); const bf16_t* BWq = (const bf16_t*)(ws + WS_BW); const bf16_t* QAq = (const bf16_t*)(ws + WS_QA);
            const bf16_t* KVAq = (const bf16_t*)(ws + WS_KVA); const float* KRq = (const float*)(ws + WS_KR); const float* ROPEq = (const float*)(ws + WS_ROPE);
            bf16_t* Qo = (bf16_t*)(ws + WS_Q); bf16_t* Ko = (bf16_t*)(ws + WS_K); bf16_t* Vo = (bf16_t*)(ws + WS_V); bf16_t* MIX = (bf16_t*)(ws + WS_MIX);
            const int nc7 = (l > 0) ? 32 : 0;
            if ((int)blockIdx.x < nc7) {
                pg8::Gemm g{(const bf16_t*)(ws + WS_XG), WB + WL_IN, R, 1280, DM}; pg8::ListOrder S7{(int)blockIdx.x & ~3, 4, 4, 64, 4, 4};
                EpiG1 E7{(const float*)(ws + WS_RSQ1), (const float*)(ws + WS_BIAS1P) + (size_t)l * 5 * 1280, kp->in[9] + l * 256, kp->in[14] + l * 256, kp->in[16] + l * 128,
                         (bf16_t*)(ws + WS_U), (bf16_t*)(ws + WS_VT), (bf16_t*)(ws + WS_BW), (bf16_t*)(ws + WS_QA), (bf16_t*)(ws + WS_KVA), (float*)(ws + WS_KR)};
                pg8::gemm_phase(lds, xl, g, S7, E7);
                asm volatile("s_waitcnt vmcnt(0)" ::: "memory"); __syncthreads();
                __builtin_amdgcn_fence(__ATOMIC_ACQUIRE, "agent"); asm volatile("s_waitcnt vmcnt(0)" ::: "memory"); __syncthreads();
                { int ln = lane; asm volatile("" : "+v"(ln)); g2::kv_item(KVAq, KRq, WB + WL_KVB, kp->in[19] + l * QKH, ROPEq, Ko, Vo, RL + ((int)blockIdx.x & 3) * 256 + ((int)blockIdx.x >> 2) * 32, wave, ln); }
            } else {
            const int bi2 = (int)blockIdx.x - nc7, nb2 = G - nc7;
            for (int pi = bi2; pi < Mrows / 64; pi += nb2) g2::pool_block(BWq, kp->in[13] + l * 256, MIX, pi * 64, lds, tid);
            const int nQ = 0  , nKV = (Mrows / 32) * NH, nSP = (Mrows / 128) * 8, nAll = nQ + nKV + nSP;
            for (int it = bi2 * 8 + wave; it < nAll; it += nb2 * 8) { int r = it; int ln = lane; asm volatile("" : "+v"(ln));
                if (r < nQ) { g2::q_item<1>(QAq, WB + WL_QB, kp->in[18] + l * QKH, ROPEq, Qo, (r >> 3) * 32, r & 7, ln); continue; } r -= nQ;
                if (r < nKV) { g2::kv_item(KVAq, KRq, WB + WL_KVB, kp->in[19] + l * QKH, ROPEq, Ko, Vo, (r >> 3) * 32, r & 7, ln); continue; } r -= nKV;
                g2::sp_item(VTq, WB + WL_SP, kp->in[11] + l * 4 * 128, Uq, MIX, r >> 3, (r >> 1) & 3, r & 1, ln);
            }
            }
        }
        GRID_BAR(pb + PH_G2);
        if (IN(pb + PH_G3)) {
            KargPtr kp = KARG(); unsigned char* ws = kp->ws; const int G = gridDim.x;
            const bf16_t* WBq = (const bf16_t*)(ws + WS_WB + (size_t)l * 22 * MiB) + WL_QB; const bf16_t* Kp = (const bf16_t*)(ws + WS_K); const bf16_t* Vp = (const bf16_t*)(ws + WS_V); bf16_t* MIX = (bf16_t*)(ws + WS_MIX);
            const int vcu = (G % 8 == 0) ? ((int)blockIdx.x % 8) * (G / 8) + (int)blockIdx.x / 8 : (int)blockIdx.x;
            const int nun = NB * NH * 16 + (l == 0 ? NB * NH : 0);
            for (int un = vcu; un < nun; un += G) {
                int bh, row0, seq;
                if (un < NB * NH * 16) { int v;
                    if (G == 256) { const int c_ = un % G, st = un / G; v = ((4 * (c_ >> 5) + 2 * st + ((c_ & 31) >> 4)) << 4) | (c_ & 15); }
                    else { const int per = ((NB * NH * 16) % G == 0) ? (NB * NH * 16) / G : 0; v = per ? (un % G) * per + un / G : un; }
                    bh = v >> 4; row0 = (bh >> 3) * SEQ + (v & 15) * 256; seq = NKEY; }
                else { bh = un - NB * NH * 16; row0 = RL + (bh >> 3) * CTXL; seq = CTXL; }
                const int h = bh & 7;
                att::attn_unit((const bf16_t*)(ws + WS_QA), WBq + ((size_t)(h * 3) * 16 * 64) * 8, kp->in[18] + l * QKH, (const float*)(ws + WS_ROPE), row0, Kp + (size_t)bh * NKEY * QKH, Vp + (size_t)bh * NKEY * VD, MIX + (size_t)row0 * DM + 512 + h * 64, seq, lds);
            }
            if (l == 0 && vcu >= NB * NH && G > NB * NH) { int tid_ = threadIdx.x; asm volatile("" : "+v"(tid_)); bias_items(ws, 0, vcu - NB * NH, G - NB * NH, tid_, 2); }
        }
        GRID_BAR(pb + PH_G3);
        if (IN(pb + PH_G4)) {
            KargPtr kp = KARG(); unsigned char* ws = kp->ws; const bf16_t* WB = (const bf16_t*)(ws + WS_WB + (size_t)l * 22 * MiB); const int G = gridDim.x;
            const float* modl = (const float*)(ws + WS_MOD) + (size_t)l * 5 * NMOD * DM;
            pg8::Gemm g{(const bf16_t*)(ws + WS_MIX), WB + WL_OUT, RL, DM, DM}; pg8::StaticOrder S; S.init(RL, DM, G, BLK());
            EpiRes E{kp->out, (float*)(ws + WS_XC), l == 0 ? kp->in[0] : (const float*)kp->out, l == 0 ? kp->in[2] : (const float*)(ws + WS_XC), modl + 2 * DM, (float*)(ws + WS_RSQ2), (bf16_t*)(ws + WS_XG), kp->in[5] + l * DM, modl + 4 * DM, 1, 0};
            pg8::gemm_phase(lds, xl, g, S, E);
        }
        GRID_BAR(pb + PH_G4);
        if (IN(pb + PH_G5)) {
            KargPtr kp = KARG(); unsigned char* ws = kp->ws; const bf16_t* WB = (const bf16_t*)(ws + WS_WB + (size_t)l * 22 * MiB); const int G = gridDim.x;
            pg8::Gemm g{(const bf16_t*)(ws + WS_XG), WB + WL_GU, RL, 2 * DFF, DM}; pg8::StaticOrder S; S.init(RL, 2 * DFF, G, BLK());
            EpiGU E{(bf16_t*)(ws + WS_ACT), (const float*)(ws + WS_RSQ2), (const float*)(ws + WS_BIAS2P) + (size_t)l * 5 * 2 * DFF};
            pg8::gemm_phase(lds, xl, g, S, E);
            if (l == 0) {
                const float* modl = (const float*)(ws + WS_MOD) + (size_t)l * 5 * NMOD * DM;
                pg8::Gemm g4{(const bf16_t*)(ws + WS_MIX), WB + WL_OUT, R, DM, DM}; pg8::ListOrder S4{G - NCTXU, NCTXU, 16, 64, 4, 0};
                EpiRes E4{kp->out, (float*)(ws + WS_XC), kp->in[0], kp->in[2], modl + 2 * DM, (float*)(ws + WS_RSQ2), (bf16_t*)(ws + WS_XG), kp->in[5] + l * DM, modl + 4 * DM, 1, 0};
                pg8::gemm_phase(lds, xl, g4, S4, E4);
                const int nun5 = (RL / 256) * 22, rem = nun5 % G; const int lo = (rem > 0 && rem < G - NCTXU) ? rem : 0;
                if ((int)blockIdx.x >= lo && (int)blockIdx.x < G - NCTXU) { int tid_ = threadIdx.x; asm volatile("" : "+v"(tid_)); weight_prep(kp, ws, l + 1, (int)blockIdx.x - lo, G - NCTXU - lo, lds, tid_, 3); }
            }
        }
        GRID_BAR(pb + PH_G5);
        if (IN(pb + PH_G6)) {
            KargPtr kp = KARG(); unsigned char* ws = kp->ws; const bf16_t* WB = (const bf16_t*)(ws + WS_WB + (size_t)l * 22 * MiB); const int G = gridDim.x;
            const float* MOD = (const float*)(ws + WS_MOD); const float* modl = MOD + (size_t)l * 5 * NMOD * DM;
            pg8::Gemm g{(const bf16_t*)(ws + WS_ACT), WB + WL_DN, RL, DM, DFF}; pg8::StaticOrder S; S.init(RL, DM, G, BLK());
            const int nx = l + 1 < DEPTH;
            EpiRes E{kp->out, (float*)(ws + WS_XC), (const float*)kp->out, (const float*)(ws + WS_XC), modl + 5 * DM, (float*)(ws + WS_RSQ1), (bf16_t*)(ws + WS_XG), kp->in[4] + (nx ? (l + 1) * DM : 0), MOD + (size_t)(nx ? l + 1 : 0) * 5 * NMOD * DM + 1 * DM, nx, 0};
            pg8::gemm_phase(lds, xl, g, S, E);
            if (nx) {
                const int n5 = 88 < G ? 88 : G;
                pg8::Gemm g5{(const bf16_t*)(ws + WS_XG), WB + WL_GU, R, 2 * DFF, DM}; pg8::ListOrder S5{0, n5, 88, 64, 4, 0};
                EpiGU E5{(bf16_t*)(ws + WS_ACT), (const float*)(ws + WS_RSQ2), (const float*)(ws + WS_BIAS2P) + (size_t)l * 5 * 2 * DFF};
                pg8::gemm_phase(lds, xl, g5, S5, E5);
                const int lo = n5 < G ? n5 : 0;
                if ((int)blockIdx.x >= lo) { int tid_ = threadIdx.x; asm volatile("" : "+v"(tid_)); bias_items(ws, l + 1, (int)blockIdx.x - lo, G - lo, tid_, 3); }
            }
        }
        GRID_BAR(pb + PH_G6);
    }
#undef IN
}

extern "C" void kernel_launch(void* const* d_in, const int* in_sizes, int n_in, void* d_out, int out_size, void* d_ws, size_t ws_size, hipStream_t stream) {
    if (n_in != 23 || ws_size < 256 * MiB || out_size != RL * DM) { fprintf(stderr, "kernel_launch: unexpected shapes (n_in %d, out %d, ws %zu)\n", n_in, out_size, ws_size); return; }
    unsigned char* ws = (unsigned char*)d_ws;
    static int grid = 0;
    if (grid == 0) {
        int dev = 0, cus = 0, per_cu = 0;
        if (hipGetDevice(&dev) != hipSuccess || hipDeviceGetAttribute(&cus, hipDeviceAttributeMultiprocessorCount, dev) != hipSuccess) { fprintf(stderr, "device query failed\n"); return; }
        if (hipFuncSetAttribute((const void*)mk_fwd, hipFuncAttributeMaxDynamicSharedMemorySize, MK_LDS) != hipSuccess) { fprintf(stderr, "hipFuncSetAttribute failed\n"); return; }
        if (hipOccupancyMaxActiveBlocksPerMultiprocessor(&per_cu, (const void*)mk_fwd, 512, MK_LDS) != hipSuccess || per_cu < 1) { fprintf(stderr, "occupancy query: %d\n", per_cu); (void)hipGetLastError(); return; }
        if (cus < 64) { fprintf(stderr, "kernel_launch: %d CUs: the phase program needs at least 64 workgroups\n", cus); return; }
        grid = cus;
    }
    MkArgs ma{}; for (int i = 0; i < 23; ++i) ma.in[i] = (const float*)d_in[i]; ma.out = (float*)d_out; ma.ws = ws;
#define MK(lo, hi) do { ma.ph_lo = (lo); ma.ph_hi = (hi); hipLaunchKernelGGL(mk_fwd, dim3(grid), dim3(512), MK_LDS, stream, ma); } while (0)
    if (hipMemsetAsync(ws, 0, 65536, stream) != hipSuccess) { fprintf(stderr, "memset failed\n"); return; }
    MK(0, PH_END);
}
```

```cpp
#include <hip/hip_runtime.h>
#include <cstdint>
#include <cstdio>

constexpr int DM = 1024, NB = 4, SEQ = 4096, CTXL = 256, DEPTH = 2;
constexpr int RL = NB * SEQ;
constexpr int RC = NB * CTXL;
constexpr int R = RL + RC;
constexpr int WA = 256, DIN = 1184, DFF = 2816, NMOD = 6;
constexpr int NH = 8, QKH = 96, QKN = 64, QKR = 32, VD = 64, QRANK = 256, KVRANK = 128;
constexpr int NKEY = CTXL + SEQ;
constexpr float EPS = 1e-6f;
constexpr float QSCALE = 0.10206207261596577f * 1.4426950408889634f;

typedef unsigned short bf16_t;
__device__ __forceinline__ float bf2f(bf16_t v) { return __uint_as_float(((unsigned)v) << 16); }
__device__ __forceinline__ bf16_t f2bf(float f) { unsigned u = __float_as_uint(f); return (bf16_t)((u + 0x7fffu + ((u >> 16) & 1u)) >> 16); }
__device__ __forceinline__ int mrow_of(int r) { return r < RL ? (r >> 12) : 4; }
__device__ __forceinline__ float wave_sum(float v) {
#pragma unroll
    for (int o = 1; o < 64; o <<= 1) v += __shfl_xor(v, o);
    return v;
}
__device__ __forceinline__ float silu_f(float x) { return x / (1.f + __expf(-x)); }
__device__ __forceinline__ float gelu_f(float x) { return 0.5f * x * (1.f + erff(x * 0.70710678118654752f)); }

constexpr size_t MiB = 1u << 20;
constexpr size_t WS_MOD = 1 * MiB;
constexpr size_t WS_BIAS1 = WS_MOD + 256 * 1024;
constexpr size_t WS_BIAS2 = WS_BIAS1 + 64 * 1024;
constexpr size_t WS_ROPE = WS_BIAS2 + 256 * 1024;
constexpr size_t WS_RSQ1 = 2 * MiB;
constexpr size_t WS_RSQ2 = 2 * MiB + 512 * 1024;
constexpr size_t WS_XC = 4 * MiB;
constexpr size_t WS_XG = 8 * MiB;
constexpr size_t WS_MIX = 42 * MiB;
constexpr size_t WS_W = 76 * MiB;
constexpr size_t WS_OV = 120 * MiB;
constexpr size_t WS_ACT = WS_OV;
constexpr size_t WS_U = WS_OV;
constexpr size_t WS_VT = WS_U + (size_t)R * 256 * 2;
constexpr size_t WS_BW = WS_VT + (size_t)R * 256 * 2;
constexpr size_t WS_QA = WS_BW + (size_t)R * 256 * 2;
constexpr size_t WS_KVA = WS_QA + (size_t)R * 256 * 2;
constexpr size_t WS_KR = WS_KVA + (size_t)R * 128 * 2;
constexpr size_t WS_Q = 161 * MiB;
constexpr size_t WS_K = WS_Q + (size_t)R * 768 * 2;
constexpr size_t WS_V = WS_K + (size_t)NB * NH * NKEY * QKH * 2;
constexpr size_t WS_P = 161 * MiB;
static_assert(WS_KR + (size_t)R * 32 * 4 <= WS_Q, "map");
static_assert(WS_V + (size_t)NB * NH * NKEY * VD * 2 <= 256 * MiB, "map");
static_assert(WS_P + (size_t)R * DIN * 4 <= 256 * MiB, "map");
static_assert(WS_ACT + (size_t)R * DFF * 2 <= 256 * MiB, "map");

__device__ __forceinline__ void sincos_d(double x, double& s, double& c) {
    const double k = rint(x * 0.63661977236758134308); const double r = fma(-k, 1.5707963267948966192, x) - k * 6.123233995736766e-17;
    const double r2 = r * r;
    double sp = -7.6471637318198164759e-13; sp = sp * r2 + 1.6059043836821614599e-10; sp = sp * r2 - 2.5052108385441718775e-08; sp = sp * r2 + 2.7557319223985890653e-06; sp = sp * r2 - 1.9841269841269841270e-04; sp = sp * r2 + 8.3333333333333333333e-03; sp = sp * r2 - 1.6666666666666666667e-01; sp = r + r * r2 * sp;
    double cp = 4.7794773323873852974e-14; cp = cp * r2 - 1.1470745597729724714e-11; cp = cp * r2 + 2.0876756987868098979e-09; cp = cp * r2 - 2.7557319223985890653e-07; cp = cp * r2 + 2.4801587301587301587e-05; cp = cp * r2 - 1.3888888888888888889e-03; cp = cp * r2 + 4.1666666666666666667e-02; cp = cp * r2 - 0.5; cp = 1.0 + r2 * cp;
    const int q = ((int)k) & 3;
    s = (q == 0) ? sp : (q == 1) ? cp : (q == 2) ? -sp : -cp;
    c = (q == 0) ? cp : (q == 1) ? -sp : (q == 2) ? -cp : sp;
}
__device__ __forceinline__ float rstd_of(const float* RSQ, int r) { const float4 p = *(const float4*)(RSQ + (size_t)r * 4); return rsqrtf(((p.x + p.y) + (p.z + p.w)) * (1.f / DM) + EPS); }

#define LAS __attribute__((address_space(3)))
#define GAS __attribute__((address_space(1)))
typedef short bf16x8 __attribute__((ext_vector_type(8)));
typedef float f32x4 __attribute__((ext_vector_type(4)));
typedef float f32x2 __attribute__((ext_vector_type(2)));
typedef unsigned u32x4 __attribute__((ext_vector_type(4)));
typedef unsigned u32x2 __attribute__((ext_vector_type(2)));
__device__ __forceinline__ unsigned cvt_pk_bf16(float lo, float hi) { unsigned r; asm volatile("v_cvt_pk_bf16_f32 %0, %1, %2" : "=v"(r) : "v"(lo), "v"(hi)); return r; }
__device__ __forceinline__ float fast_silu(float x) { return x * __builtin_amdgcn_rcpf(1.f + __builtin_amdgcn_exp2f(-1.4426950408889634f * x)); }

constexpr size_t WL_IN = 0;
constexpr size_t WL_OUT = WL_IN + (size_t)1280 * 1024;
constexpr size_t WL_GU = WL_OUT + (size_t)1024 * 1024;
constexpr size_t WL_DN = WL_GU + (size_t)5632 * 1024;
constexpr size_t WL_QB = WL_DN + (size_t)1024 * 2816;
constexpr size_t WL_KVB = WL_QB + (size_t)768 * 256;
constexpr size_t WL_SP = WL_KVB + (size_t)1024 * 128;
constexpr size_t WL_END = WL_SP + (size_t)4 * 128 * 128;
static_assert(WL_END * 2 <= 22 * MiB, "weights per layer");
constexpr size_t WS_WB = WS_W;
constexpr size_t WS_BIAS2P = 3 * MiB;
constexpr size_t WS_BIAS1P = 3 * MiB + 256 * 1024;

namespace pg8 {
constexpr int BM = 256, BK = 64, HALF = 128, HTB = HALF * BK * 2, STAGE_BYTES = 8 * HTB, NXCD = 8, WGM = 4;
__host__ __device__ __forceinline__ int lds_byte(int r, int c) { const int st = (r >> 4) * 2 + (c >> 5), rr = r & 15, cc = c & 31, ob = rr * 64 + cc * 2; return st * 1024 + (ob ^ (((ob >> 9) & 1) << 5)); }
__host__ __device__ __forceinline__ void stage_rc(int b, int& Rr, int& C) { const int st = b / 1024, sb = b % 1024, swz = sb ^ (((sb >> 9) & 1) << 5); Rr = (st >> 1) * 16 + swz / 64; C = (st & 1) * 32 + (swz % 64) / 2; }
__host__ __device__ __forceinline__ int perm32(int rho) { const int n = rho >> 4, i = rho & 15; return 8 * (i >> 2) + 4 * n + (i & 3); }
struct Unit { int pm, pn; };
struct Gemm { const bf16_t* A; const bf16_t* Bt; int M, N, K; };
struct ListOrder {
    int cu0, ncu, nunits, base_pm, npm, base_pn;
    __device__ bool next(int i, Unit& u) const {
        const int j = (int)blockIdx.x - cu0; if (j < 0 || j >= ncu) return false;
        const int idx = i * ncu + j; if (idx >= nunits) return false;
        u.pm = base_pm + idx % npm; u.pn = base_pn + idx / npm; return true;
    }
};
struct StaticOrder {
    int nM, nN, nwg, G, c;
    __device__ void init(int M, int N, int G_, int c_) { nM = M / BM; nN = N / BM; nwg = nM * nN; G = G_; c = c_; }
    __device__ bool next(int i, Unit& u) const {
        if (c < 0) return false; const long L = (long)i * G + c; if (L >= nwg) return false;
        int wgid = (int)L; { const int q = nwg / NXCD, r = nwg % NXCD, xcd = wgid % NXCD, off = wgid / NXCD; wgid = (xcd < r ? xcd * (q + 1) : r * (q + 1) + (xcd - r) * q) + off; }
        const int nig = WGM * nN, gid = wgid / nig, fm = gid * WGM, gsz = (nM - fm) < WGM ? (nM - fm) : WGM;
        u.pm = fm + ((wgid % nig) % gsz); u.pn = (wgid % nig) / gsz; return true;
    }
};
template <class Epi, class Sched>
__device__ __forceinline__ void gemm_phase(LAS unsigned char* lds, LAS unsigned char* xl, const Gemm g, const Sched& S, const Epi& E) {
    int tid = threadIdx.x; asm volatile("" : "+v"(tid));
    const int wid = __builtin_amdgcn_readfirstlane(tid >> 6), lane = tid & 63, wr = wid >> 2, wc = wid & 3, fr = lane & 15, fq = lane >> 4;
    const int K = g.K, nt = K / BK;
    unsigned voffA[2], voffB[2];
#pragma unroll
    for (int i = 0; i < 2; ++i) { int Rr, C; stage_rc(tid * 16 + i * 8192, Rr, C); const int Rb = (Rr & ~31) + perm32(Rr & 31);
        voffA[i] = (unsigned)(Rr * K + C) * 2u; voffB[i] = (unsigned)(Rb * K + C) * 2u; }
    const size_t kstep = (size_t)(BK * 2);
    const size_t hstep = (size_t)HALF * K * 2;
    const size_t tstep = 2 * hstep;
    const unsigned ldsw = (unsigned)wid * 1024u;
    const int aoff = lds_byte(wr * 64 + fr, fq * 8), boff = lds_byte(wc * 32 + fr, fq * 8);
#define PG8_SA(b, h) (((b) * 2 + (h)) * HTB)
#define PG8_SB(b, h) ((4 + (b) * 2 + (h)) * HTB)
#define PG8_STAGE(bufoff, gbase, voff) do { _Pragma("unroll") for (int _i = 0; _i < 2; ++_i) \
        __builtin_amdgcn_global_load_lds((const unsigned*)((const char*)(gbase) + (voff)[_i]), (LAS unsigned*)(lds + (bufoff) + ldsw + _i * 8192), 16, 0, 0); } while (0)
#define PG8_LDA(dst, b, h) do { _Pragma("unroll") for (int m = 0; m < 4; ++m) _Pragma("unroll") for (int k = 0; k < 2; ++k) dst[m][k] = *(const LAS bf16x8*)(lds + PG8_SA(b, h) + aoff + m * 2048 + k * 1024); } while (0)
#define PG8_LDB(dst, b, h) do { _Pragma("unroll") for (int n = 0; n < 2; ++n) _Pragma("unroll") for (int k = 0; k < 2; ++k) dst[n][k] = *(const LAS bf16x8*)(lds + PG8_SB(b, h) + boff + n * 2048 + k * 1024); } while (0)
#define PG8_MMA(ai, bj, At, Bt) do { __builtin_amdgcn_s_setprio(1); _Pragma("unroll") for (int m = 0; m < 4; ++m) _Pragma("unroll") for (int n = 0; n < 2; ++n) _Pragma("unroll") for (int k = 0; k < 2; ++k) \
        acc[ai][bj][m][n] = __builtin_amdgcn_mfma_f32_16x16x32_bf16(Bt[n][k], At[m][k], acc[ai][bj][m][n], 0, 0, 0); __builtin_amdgcn_s_setprio(0); } while (0)
#define PG8_WAIT_V(n) asm volatile("s_waitcnt vmcnt(" #n ")" ::: "memory")
#define PG8_WAIT_L(n) asm volatile("s_waitcnt lgkmcnt(" #n ")" ::: "memory")
#define PG8_BAR __builtin_amdgcn_s_barrier()
#define PG8_SCHED __builtin_amdgcn_sched_barrier(0)
    Unit cur, nxt; int ui = 0;
    if (!S.next(0, cur)) return;
    f32x4 acc[2][2][4][2];
#pragma unroll
    for (int a = 0; a < 2; ++a)
#pragma unroll
        for (int b = 0; b < 2; ++b)
#pragma unroll
            for (int m = 0; m < 4; ++m)
#pragma unroll
                for (int n = 0; n < 2; ++n) acc[a][b][m][n] = (f32x4){0.f, 0.f, 0.f, 0.f};
    bf16x8 At[4][2], B0[2][2], B1[2][2];
    const char* cA = (const char*)g.A + (size_t)cur.pm * tstep; const char* cB = (const char*)g.Bt + (size_t)cur.pn * tstep;
    PG8_STAGE(PG8_SB(0, 0), cB, voffB); PG8_STAGE(PG8_SB(0, 1), cB + hstep, voffB); PG8_STAGE(PG8_SA(0, 0), cA, voffA); PG8_STAGE(PG8_SA(0, 1), cA + hstep, voffA);
    if (wr == 1) PG8_BAR;
    PG8_WAIT_V(2); PG8_BAR;
    PG8_STAGE(PG8_SB(1, 0), cB + kstep, voffB); PG8_STAGE(PG8_SA(1, 0), cA + kstep, voffA); PG8_STAGE(PG8_SB(1, 1), cB + hstep + kstep, voffB);
    PG8_WAIT_V(6); PG8_BAR;
    for (;;) {
        const bool has_next = S.next(ui + 1, nxt);
        const char* nA = has_next ? (const char*)g.A + (size_t)nxt.pm * tstep : cA; const char* nB = has_next ? (const char*)g.Bt + (size_t)nxt.pn * tstep : cB;
        for (int t = 0; t < nt; t += 2) {
            const bool last = (t == nt - 2);
            const char* a1 = cA + (size_t)(t + 1) * kstep;
            const char* a2 = last ? nA : cA + (size_t)(t + 2) * kstep; const char* b2 = last ? nB : cB + (size_t)(t + 2) * kstep;
            const char* a3 = a2 + kstep; const char* b3 = b2 + kstep;
            PG8_LDB(B0, 0, 0); PG8_LDB(B1, 0, 1); PG8_SCHED; PG8_LDA(At, 0, 0); PG8_STAGE(PG8_SA(1, 1), a1 + hstep, voffA);
            PG8_WAIT_V(8); PG8_WAIT_L(0); PG8_BAR; PG8_MMA(0, 0, At, B0); PG8_MMA(0, 1, At, B1); PG8_BAR; PG8_SCHED;
            PG8_LDA(At, 0, 1); PG8_STAGE(PG8_SB(0, 0), b2, voffB); PG8_STAGE(PG8_SB(0, 1), b2 + hstep, voffB); PG8_STAGE(PG8_SA(0, 0), a2, voffA);
            PG8_WAIT_V(8); PG8_WAIT_L(0); PG8_BAR; PG8_MMA(1, 0, At, B0); PG8_MMA(1, 1, At, B1); PG8_BAR; PG8_SCHED;
            PG8_LDB(B0, 1, 0); PG8_LDB(B1, 1, 1); PG8_SCHED; PG8_LDA(At, 1, 0); PG8_STAGE(PG8_SA(0, 1), a2 + hstep, voffA);
            PG8_WAIT_V(8); PG8_WAIT_L(0); PG8_BAR; PG8_MMA(0, 0, At, B0); PG8_MMA(0, 1, At, B1); PG8_BAR; PG8_SCHED;
            PG8_LDA(At, 1, 1); PG8_STAGE(PG8_SB(1, 0), b3, voffB); PG8_STAGE(PG8_SB(1, 1), b3 + hstep, voffB); PG8_STAGE(PG8_SA(1, 0), a3, voffA);
            PG8_WAIT_V(8); PG8_WAIT_L(0); PG8_BAR; PG8_MMA(1, 0, At, B0); PG8_MMA(1, 1, At, B1); PG8_BAR; PG8_SCHED;
        }
        if (wr == 0) PG8_BAR;
        { int fr_ = fr, fq_ = fq; asm volatile("" : "+v"(fr_), "+v"(fq_)); E(acc, cur, wr, wc, fr_, fq_, xl); }
        if (!has_next) break;
#pragma unroll
        for (int a = 0; a < 2; ++a)
#pragma unroll
            for (int b = 0; b < 2; ++b)
#pragma unroll
                for (int m = 0; m < 4; ++m)
#pragma unroll
                    for (int n = 0; n < 2; ++n) acc[a][b][m][n] = (f32x4){0.f, 0.f, 0.f, 0.f};
        cur = nxt; cA = nA; cB = nB; ++ui;
        if (wr == 1) PG8_BAR;
    }
    PG8_WAIT_V(0);
    PG8_BAR;
#undef PG8_SA
#undef PG8_SB
#undef PG8_STAGE
#undef PG8_LDA
#undef PG8_LDB
#undef PG8_MMA
}
}

__device__ __forceinline__ f32x4 ld4(const float* p) { return *(const f32x4*)p; }
struct EpiGU {
    bf16_t* ACT; const float* RSQ; const float* BIAS;
    __device__ __forceinline__ void operator()(f32x4 (&acc)[2][2][4][2], const pg8::Unit& u, int wr, int wc, int fr, int fq, LAS unsigned char*) const {
        const int row0 = u.pm * 256 + wr * 64 + fr; const int mr = mrow_of(u.pm * 256);
        const float* bb = BIAS + (size_t)mr * (2 * DFF) + u.pn * 256 + wc * 32 + 8 * fq;
        const f32x4 bg0 = ld4(bb), bg1 = ld4(bb + 4), bu0 = ld4(bb + 128), bu1 = ld4(bb + 132);
        bf16_t* ob = ACT + u.pn * 128 + wc * 32 + 8 * fq;
        float rsv[8];
        { f32x4 pq_[8];
#pragma unroll
          for (int q = 0; q < 8; ++q) pq_[q] = ld4(RSQ + (size_t)(row0 + (q >> 2) * 128 + (q & 3) * 16) * 4);
          __builtin_amdgcn_sched_barrier(0);
#pragma unroll
          for (int q = 0; q < 8; ++q) rsv[q] = rsqrtf(((pq_[q][0] + pq_[q][1]) + (pq_[q][2] + pq_[q][3])) * (1.f / DM) + EPS); }
#pragma unroll
        for (int ai = 0; ai < 2; ++ai)
#pragma unroll
            for (int m = 0; m < 4; ++m) { const int row = row0 + ai * 128 + m * 16; const float rs = rsv[ai * 4 + m];
                const f32x4 g0 = acc[ai][0][m][0] * rs + bg0, g1 = acc[ai][0][m][1] * rs + bg1, u0 = acc[ai][1][m][0] * rs + bu0, u1 = acc[ai][1][m][1] * rs + bu1;
                u32x4 w; w.x = cvt_pk_bf16(fast_silu(g0[0]) * u0[0], fast_silu(g0[1]) * u0[1]); w.y = cvt_pk_bf16(fast_silu(g0[2]) * u0[2], fast_silu(g0[3]) * u0[3]);
                w.z = cvt_pk_bf16(fast_silu(g1[0]) * u1[0], fast_silu(g1[1]) * u1[1]); w.w = cvt_pk_bf16(fast_silu(g1[2]) * u1[2], fast_silu(g1[3]) * u1[3]);
                *(u32x4*)(ob + (size_t)row * DFF) = w; }
    }
};
struct EpiRes {
    float* XL; float* XC; const float* XLr; const float* XCr; const float* gate; float* RSQ; bf16_t* XG; const float* ng; const float* nsc; int do_next; int pad;
    __device__ __forceinline__ void operator()(f32x4 (&acc)[2][2][4][2], const pg8::Unit& u, int wr, int wc, int fr, int fq, LAS unsigned char* xl) const {
        const int mr = mrow_of(u.pm * 256); const int col0 = u.pn * 256 + wc * 32 + 8 * fq; const int rl0 = wr * 64 + fr;
        float* xbase = u.pm < 64 ? XL + (size_t)(u.pm * 256) * DM : XC + (size_t)(u.pm * 256 - RL) * DM;
        const float* xrbase = u.pm < 64 ? XLr + (size_t)(u.pm * 256) * DM : XCr + (size_t)(u.pm * 256 - RL) * DM;
        LAS float* P = (LAS float*)xl;
        float ss[8];
#pragma unroll
        for (int q = 0; q < 8; ++q) ss[q] = 0.f;
#pragma unroll
        for (int bj = 0; bj < 2; ++bj) {
            f32x4 gt[2], gm[2];
#pragma unroll
            for (int n = 0; n < 2; ++n) { const int c = col0 + bj * 128 + 4 * n; gt[n] = ld4(gate + (size_t)mr * (NMOD * DM) + c);
                if (do_next) gm[n] = ld4(ng + c) * (ld4(nsc + (size_t)mr * (NMOD * DM) + c) + 1.f); else gm[n] = (f32x4){0.f, 0.f, 0.f, 0.f}; }
#pragma unroll
            for (int ai = 0; ai < 2; ++ai) {
                f32x4 xv[4][2];
#pragma unroll
                for (int m = 0; m < 4; ++m) { const unsigned off = (unsigned)((rl0 + ai * 128 + m * 16) * DM + col0 + bj * 128) * 4u;
                    const float* xp = (const float*)((const char*)xrbase + off); xv[m][0] = ld4(xp); xv[m][1] = ld4(xp + 4); }
#pragma unroll
                for (int m = 0; m < 4; ++m) { const int q = ai * 4 + m; const int rl = rl0 + ai * 128 + m * 16; const unsigned off = (unsigned)(rl * DM + col0 + bj * 128) * 4u; float* xp = (float*)((char*)xbase + off);
                    const f32x4 y0 = xv[m][0] + gt[0] * acc[ai][bj][m][0], y1 = xv[m][1] + gt[1] * acc[ai][bj][m][1];
                    *(f32x4*)(xp) = y0; *(f32x4*)(xp + 4) = y1;
                    if (do_next) { ss[q] += (y0[0] * y0[0] + y0[1] * y0[1]) + (y0[2] * y0[2] + y0[3] * y0[3]) + (y1[0] * y1[0] + y1[1] * y1[1]) + (y1[2] * y1[2] + y1[3] * y1[3]);
                        const f32x4 z0 = y0 * gm[0], z1 = y1 * gm[1]; u32x4 w; w.x = cvt_pk_bf16(z0[0], z0[1]); w.y = cvt_pk_bf16(z0[2], z0[3]); w.z = cvt_pk_bf16(z1[0], z1[1]); w.w = cvt_pk_bf16(z1[2], z1[3]);
                        *(u32x4*)((char*)(XG + (size_t)(u.pm * 256) * DM) + (off >> 1)) = w; } }
                asm volatile("" ::: "memory");
            }
        }
        if (do_next) {
#pragma unroll
            for (int q = 0; q < 8; ++q) { float t = ss[q]; t += __shfl_xor(t, 16); t += __shfl_xor(t, 32); if (fq == 0) P[(rl0 + (q >> 2) * 128 + (q & 3) * 16) * 4 + wc] = t; }
        }
        if (do_next) {
            asm volatile("s_waitcnt lgkmcnt(0)" ::: "memory"); __builtin_amdgcn_s_barrier(); asm volatile("" ::: "memory");
            const int tid = threadIdx.x;
            if (tid < 256) { const f32x4 p = *(const LAS f32x4*)(P + tid * 4); RSQ[(size_t)(u.pm * 256 + tid) * 4 + u.pn] = (p[0] + p[1]) + (p[2] + p[3]); }
        }
    }
};


__device__ __forceinline__ float gelu_fast(float v) {
    const float av = fabsf(v), d = av * 0.2316418882f + 1.0f, t = __builtin_amdgcn_rcpf(d);
    float q = t * 0.5307027145f + (-0.7265760135f); q = q * t + 0.7107068705f; q = q * t + (-0.142248368f); q = q * t + 0.127414796f; q = q * t;
    const float e = __builtin_amdgcn_exp2f((v * v) * (-0.72134752044f));
    const float m = v * (q * e), r = v - m; return v < 0.f ? m : r;
}
struct EpiG1 {
    const float* RSQ; const float* BIAS; const float* sgu_g; const float* qa_g; const float* kva_g;
    bf16_t* U; bf16_t* VT; bf16_t* BW; bf16_t* QA; bf16_t* KVA; float* KR;
#define G1_PACK(v0, v1) (u32x4){cvt_pk_bf16((v0)[0], (v0)[1]), cvt_pk_bf16((v0)[2], (v0)[3]), cvt_pk_bf16((v1)[0], (v1)[1]), cvt_pk_bf16((v1)[2], (v1)[3])}
#define G1_SS(v) (((v)[0] * (v)[0] + (v)[1] * (v)[1]) + ((v)[2] * (v)[2] + (v)[3] * (v)[3]))
    __device__ __forceinline__ void operator()(f32x4 (&acc)[2][2][4][2], const pg8::Unit& u, int wr, int wc, int fr, int fq, LAS unsigned char* xl) const {
        const int mr = mrow_of(u.pm * 256); const int cl = wc * 32 + 8 * fq; const int rl0 = wr * 64 + fr; const int pn = u.pn;
        LAS float* P = (LAS float*)xl;
        {   f32x4 bv[2][2];
#pragma unroll
            for (int bj = 0; bj < 2; ++bj)
#pragma unroll
                for (int n = 0; n < 2; ++n) bv[bj][n] = ld4(BIAS + (size_t)mr * 1280 + pn * 256 + bj * 128 + cl + 4 * n);
            const bool act = (pn <= 1);
            float rsv[8];
            { f32x4 pq_[8];
#pragma unroll
              for (int q = 0; q < 8; ++q) pq_[q] = ld4(RSQ + (size_t)(u.pm * 256 + rl0 + (q >> 2) * 128 + (q & 3) * 16) * 4);
              __builtin_amdgcn_sched_barrier(0);
#pragma unroll
              for (int q = 0; q < 8; ++q) rsv[q] = rsqrtf(((pq_[q][0] + pq_[q][1]) + (pq_[q][2] + pq_[q][3])) * (1.f / DM) + EPS); }
#pragma unroll
            for (int ai = 0; ai < 2; ++ai)
#pragma unroll
                for (int m = 0; m < 4; ++m) { const float rs = rsv[ai * 4 + m];
#pragma unroll
                    for (int bj = 0; bj < 2; ++bj)
#pragma unroll
                        for (int n = 0; n < 2; ++n) { f32x4 v = acc[ai][bj][m][n] * rs + bv[bj][n];
                            if (act) v = (f32x4){gelu_fast(v[0]), gelu_fast(v[1]), gelu_fast(v[2]), gelu_fast(v[3])};
                            acc[ai][bj][m][n] = v; }
                    if (m & 1) asm volatile("" ::: "memory"); }
        }
        if (pn == 0) {
#pragma unroll
            for (int ai = 0; ai < 2; ++ai)
#pragma unroll
                for (int m = 0; m < 4; ++m) { const int row = u.pm * 256 + rl0 + ai * 128 + m * 16;
#pragma unroll
                    for (int bj = 0; bj < 2; ++bj) *(u32x4*)(U + (size_t)row * 256 + bj * 128 + cl) = G1_PACK(acc[ai][bj][m][0], acc[ai][bj][m][1]); }
            return;
        }
        if (pn == 2) {
#pragma unroll
            for (int ai = 0; ai < 2; ++ai)
#pragma unroll
                for (int m = 0; m < 4; ++m) { const int row = u.pm * 256 + rl0 + ai * 128 + m * 16;
#pragma unroll
                    for (int bj = 0; bj < 2; ++bj) *(u32x4*)(BW + (size_t)row * 256 + bj * 128 + cl) = G1_PACK(acc[ai][bj][m][0], acc[ai][bj][m][1]); }
            return;
        }
#pragma unroll
        for (int ai = 0; ai < 2; ++ai)
#pragma unroll
            for (int m = 0; m < 4; ++m) { float ss = G1_SS(acc[ai][0][m][0]) + G1_SS(acc[ai][0][m][1]);
                if (pn != 4) ss += G1_SS(acc[ai][1][m][0]) + G1_SS(acc[ai][1][m][1]);
                ss += __shfl_xor(ss, 16); ss += __shfl_xor(ss, 32);
                if (fq == 0) P[(rl0 + ai * 128 + m * 16) * 4 + wc] = ss; }
        asm volatile("s_waitcnt lgkmcnt(0)" ::: "memory"); __builtin_amdgcn_s_barrier(); asm volatile("" ::: "memory");
        if (pn == 1) {
#pragma unroll
            for (int bj = 0; bj < 2; ++bj) { const f32x4 g0 = ld4(sgu_g + bj * 128 + cl), g1 = ld4(sgu_g + bj * 128 + cl + 4);
#pragma unroll
                for (int ai = 0; ai < 2; ++ai)
#pragma unroll
                    for (int m = 0; m < 4; ++m) { const int rl = rl0 + ai * 128 + m * 16; const int row = u.pm * 256 + rl;
                        const f32x4 p = *(const LAS f32x4*)(P + rl * 4); const float rn = rsqrtf(((p[0] + p[1]) + (p[2] + p[3])) * (1.f / 256.f) + EPS);
                        const f32x4 v0 = acc[ai][bj][m][0] * rn * g0, v1 = acc[ai][bj][m][1] * rn * g1;
                        const int jrow = row & 127; bf16_t* vt = VT + ((((size_t)(row >> 7) * 8 + ((bj * 128 + cl) >> 5)) * 8 + (jrow >> 4)) * 64 + ((jrow >> 3) & 1) * 32 + ((bj * 128 + cl) & 31)) * 8 + (jrow & 7);
#pragma unroll
                        for (int i = 0; i < 4; ++i) { vt[(size_t)i * 8] = (bf16_t)(cvt_pk_bf16(v0[i], 0.f) & 0xffffu); vt[(size_t)(4 + i) * 8] = (bf16_t)(cvt_pk_bf16(v1[i], 0.f) & 0xffffu); } } }
        } else if (pn == 3) {
#pragma unroll
            for (int bj = 0; bj < 2; ++bj) { const f32x4 g0 = ld4(qa_g + bj * 128 + cl), g1 = ld4(qa_g + bj * 128 + cl + 4);
#pragma unroll
                for (int ai = 0; ai < 2; ++ai)
#pragma unroll
                    for (int m = 0; m < 4; ++m) { const int rl = rl0 + ai * 128 + m * 16; const int row = u.pm * 256 + rl;
                        const f32x4 p = *(const LAS f32x4*)(P + rl * 4); const float rn = rsqrtf(((p[0] + p[1]) + (p[2] + p[3])) * (1.f / 256.f) + EPS);
                        const f32x4 v0 = acc[ai][bj][m][0] * rn * g0, v1 = acc[ai][bj][m][1] * rn * g1;
                        { const int c8 = bj * 16 + wc * 4 + fq; *(u32x4*)(QA + ((((size_t)(row >> 5) * 16 + (c8 >> 1)) * 64 + (c8 & 1) * 32 + (row & 31)) * 8)) = G1_PACK(v0, v1); } } }
        } else {
            const f32x4 g0 = ld4(kva_g + cl), g1 = ld4(kva_g + cl + 4);
#pragma unroll
            for (int ai = 0; ai < 2; ++ai)
#pragma unroll
                for (int m = 0; m < 4; ++m) { const int rl = rl0 + ai * 128 + m * 16; const int row = u.pm * 256 + rl;
                    const f32x4 p = *(const LAS f32x4*)(P + rl * 4); const float rn = rsqrtf(((p[0] + p[1]) + (p[2] + p[3])) * (1.f / 128.f) + EPS);
                    const f32x4 v0 = acc[ai][0][m][0] * rn * g0, v1 = acc[ai][0][m][1] * rn * g1;
                    { const int c8 = wc * 4 + fq; *(u32x4*)(KVA + ((((size_t)(row >> 5) * 8 + (c8 >> 1)) * 64 + (c8 & 1) * 32 + (row & 31)) * 8)) = G1_PACK(v0, v1); }
                    if (wc == 0) { *(f32x4*)(KR + (size_t)row * 32 + 8 * fq) = acc[ai][1][m][0]; *(f32x4*)(KR + (size_t)row * 32 + 8 * fq + 4) = acc[ai][1][m][1]; } }
        }
    }
#undef G1_PACK
#undef G1_SS
};


namespace att {
using s16x4 = __attribute__((ext_vector_type(4))) short;
using f32x16 = __attribute__((ext_vector_type(16))) float;
constexpr int KROW = 208;
constexpr int NBUF = 3, SHM_V = 64 * 64 * 2, SHM_K = 64 * KROW, OFF_K = NBUF * SHM_V, OFF_WS = OFF_K + NBUF * SHM_K, SHM_ATTN = OFF_WS + 8 * 64 * 4;
#define ASBAR() __builtin_amdgcn_sched_barrier(0)
__device__ __forceinline__ int crow(int r, int hi) { return (r & 3) + 8 * (r >> 2) + 4 * hi; }
__device__ __forceinline__ int v_st(int k, int c) { const int kk = (k & ~0xC) | ((k & 4) << 1) | ((k & 8) >> 1); return ((kk >> 3) * 2 + (c >> 5)) * 512 + ((kk & 7) * 32 + (c & 31)) * 2; }
__device__ __forceinline__ int v_rd_base(int lane) { return ((lane & 3) << 3) | (((lane >> 2) & 3) << 6) | (((lane >> 4) & 1) << 5) | (((lane >> 5) & 1) << 8); }
constexpr int v_rd_off(int d0, int ks, int half) { return d0 * 512 + ks * 2048 + half * 1024; }
template <int OFF> __device__ __forceinline__ s16x4 tr_read(int vb) { s16x4 r; asm volatile("ds_read_b64_tr_b16 %0, %1 offset:%2" : "=&v"(r) : "v"(vb), "i"(OFF) : "memory"); return r; }
__device__ __forceinline__ void partialSM(f32x16& p0, f32x16& p1) {
#pragma unroll
    for (int r = 0; r < 16; ++r) p0[r] = __builtin_amdgcn_exp2f(p0[r]);
}
__device__ __forceinline__ void finishSM(f32x16& p0, f32x16& p1, float& l_reg, bf16x8& pa0, bf16x8& pa1, bf16x8& pa2, bf16x8& pa3) {
#pragma unroll
    for (int r = 0; r < 16; ++r) p1[r] = __builtin_amdgcn_exp2f(p1[r]);
    f32x2 s2a = {p0[0], p0[1]}, s2b = {p1[0], p1[1]};
#pragma unroll
    for (int r = 2; r < 16; r += 2) { s2a += (f32x2){p0[r], p0[r + 1]}; s2b += (f32x2){p1[r], p1[r + 1]}; }
    s2a += s2b; l_reg += s2a[0] + s2a[1];
#define PK4(P, BASE, OUT) do { unsigned a0 = cvt_pk_bf16(P[BASE + 0], P[BASE + 1]), a1 = cvt_pk_bf16(P[BASE + 2], P[BASE + 3]);   \
    unsigned b0 = cvt_pk_bf16(P[BASE + 4], P[BASE + 5]), b1 = cvt_pk_bf16(P[BASE + 6], P[BASE + 7]);                              \
    auto r0 = __builtin_amdgcn_permlane32_swap(a0, b0, false, false); auto r1 = __builtin_amdgcn_permlane32_swap(a1, b1, false, false); \
    u32x4 w = {r0[0], r1[0], r0[1], r1[1]}; OUT = *reinterpret_cast<bf16x8*>(&w); } while (0)
    PK4(p0, 0, pa0); PK4(p0, 8, pa1); PK4(p1, 0, pa2); PK4(p1, 8, pa3);
#undef PK4
}
__device__ __forceinline__ void qkt(f32x16& p0, f32x16& p1, LAS const unsigned char* Ks, const bf16x8 (&qr)[6], int r32, int hi) {
    p0 = f32x16{}; p1 = f32x16{};
#pragma unroll
    for (int d0 = 0; d0 < 6; ++d0) {
        const bf16x8 b0 = *(LAS const bf16x8*)(Ks + r32 * KROW + d0 * 32 + hi * 16);
        const bf16x8 b1 = *(LAS const bf16x8*)(Ks + (32 + r32) * KROW + d0 * 32 + hi * 16);
        p0 = __builtin_amdgcn_mfma_f32_32x32x16_bf16(b0, qr[d0], p0, 0, 0, 0);
        p1 = __builtin_amdgcn_mfma_f32_32x32x16_bf16(b1, qr[d0], p1, 0, 0, 0); }
}
template <int D0> __device__ __forceinline__ void pv_one(f32x16& od, int vb, bf16x8 pa0, bf16x8 pa1, bf16x8 pa2, bf16x8 pa3) {
    const s16x4 l0 = tr_read<v_rd_off(D0, 0, 0)>(vb), h0 = tr_read<v_rd_off(D0, 0, 1)>(vb), l1 = tr_read<v_rd_off(D0, 1, 0)>(vb), h1 = tr_read<v_rd_off(D0, 1, 1)>(vb);
    const s16x4 l2 = tr_read<v_rd_off(D0, 2, 0)>(vb), h2 = tr_read<v_rd_off(D0, 2, 1)>(vb), l3 = tr_read<v_rd_off(D0, 3, 0)>(vb), h3 = tr_read<v_rd_off(D0, 3, 1)>(vb);
    asm volatile("s_waitcnt lgkmcnt(0)" ::: "memory"); ASBAR();
#define PK(L, H) (bf16x8){L[0], L[1], L[2], L[3], H[0], H[1], H[2], H[3]}
    od = __builtin_amdgcn_mfma_f32_32x32x16_bf16(pa0, PK(l0, h0), od, 0, 0, 0);
    od = __builtin_amdgcn_mfma_f32_32x32x16_bf16(pa1, PK(l1, h1), od, 0, 0, 0);
    od = __builtin_amdgcn_mfma_f32_32x32x16_bf16(pa2, PK(l2, h2), od, 0, 0, 0);
    od = __builtin_amdgcn_mfma_f32_32x32x16_bf16(pa3, PK(l3, h3), od, 0, 0, 0);
#undef PK
}
template <int BASE> __device__ __forceinline__ bf16x8 pack8(const f32x16& P) {
    unsigned a0 = cvt_pk_bf16(P[BASE + 0], P[BASE + 1]), a1 = cvt_pk_bf16(P[BASE + 2], P[BASE + 3]), b0 = cvt_pk_bf16(P[BASE + 4], P[BASE + 5]), b1 = cvt_pk_bf16(P[BASE + 6], P[BASE + 7]);
    auto r0 = __builtin_amdgcn_permlane32_swap(a0, b0, false, false); auto r1 = __builtin_amdgcn_permlane32_swap(a1, b1, false, false);
    u32x4 w = {r0[0], r1[0], r0[1], r1[1]}; return *reinterpret_cast<bf16x8*>(&w);
}
__device__ __forceinline__ void arope(const float* __restrict__ ROPE, int t, int pp, float& x1, float& x2) {
    const int pos = pp < 8 ? (t >> 6) : (t & 63); const f32x2 cs = *(const f32x2*)(ROPE + (pos * 8 + (pp & 7)) * 2);
    const float y1 = x1 * cs[0] - x2 * cs[1], y2 = x1 * cs[1] + x2 * cs[0]; x1 = y1; x2 = y2;
}
__device__ __forceinline__ void attn_unit(const bf16_t* __restrict__ QA, const bf16_t* __restrict__ WQh, const float* __restrict__ qn_g, const float* __restrict__ ROPE, int row0, const bf16_t* __restrict__ Kh, const bf16_t* __restrict__ Vh, bf16_t* __restrict__ Ob, int seq, LAS unsigned char* lds) {
    int tid = threadIdx.x; asm volatile("" : "+v"(tid));
    const int wid = __builtin_amdgcn_readfirstlane(tid >> 6), lane = tid & 63, r32 = lane & 31, hi = lane >> 5;
    LAS float* wsf = (LAS float*)(lds + OFF_WS) + wid * 64; LAS float* li_l = wsf;
    float l_reg = 0; f32x16 o[2] = {}; bf16x8 qr[6];
    const bool isK = wid < 4; const int t = tid & 255;
    const unsigned char* gbase = isK ? (const unsigned char*)Kh : (const unsigned char*)Vh; const int tstride = isK ? 64 * 96 * 2 : 64 * 64 * 2;
    int loff0, loff1, loff2;
    { const int c0 = t, c1 = t + 256, c2 = t + 512;
      loff0 = isK ? (c0 / 12) * KROW + (c0 % 12) * 16 : v_st(c0 >> 3, (c0 & 7) * 8);
      loff1 = isK ? (c1 / 12) * KROW + (c1 % 12) * 16 : v_st(c1 >> 3, (c1 & 7) * 8);
      loff2 = (c2 / 12) * KROW + (c2 % 12) * 16; }
    const int vb0 = (int)(uintptr_t)(lds) + v_rd_base(lane);
    bf16x8 sA0, sA1, sA2, sB0, sB1, sB2;
#define SLOAD(S, tile) do { const unsigned char* p_ = gbase + (size_t)(tile) * tstride + t * 16; S##0 = *(const bf16x8*)(p_); S##1 = *(const bf16x8*)(p_ + 4096); if (isK) S##2 = *(const bf16x8*)(p_ + 8192); } while (0)
#define SWRITE(b, S) do { LAS unsigned char* d_ = lds + (isK ? OFF_K + (b) * SHM_K : (b) * SHM_V); *(LAS bf16x8*)(d_ + loff0) = S##0; *(LAS bf16x8*)(d_ + loff1) = S##1; if (isK) *(LAS bf16x8*)(d_ + loff2) = S##2; } while (0)
    f32x16 pA0, pA1, pB0, pB1; bf16x8 pa0, pa1, pa2, pa3; const int NT = seq / 64;
    int b_prev = 0, b_cur = 1, b_next = 2;
#define ROT3() do { b_prev = b_cur; b_cur = b_next; b_next = (b_next == NBUF - 1) ? 0 : b_next + 1; } while (0)
#define STEP(PC0, PC1, PP0, PP1, SW, SL, i) do { \
        ASBAR(); qkt(PC0, PC1, lds + OFF_K + b_cur * SHM_K, qr, r32, hi); \
        finishSM(PP0, PP1, l_reg, pa0, pa1, pa2, pa3); ASBAR(); \
        if ((i) + 1 < NT) SWRITE(b_next, SW); \
        if ((i) + 2 < NT) SLOAD(SL, (i) + 2); ASBAR(); \
        pv_one<0>(o[0], vb0 + b_prev * SHM_V, pa0, pa1, pa2, pa3); pv_one<1>(o[1], vb0 + b_prev * SHM_V, pa0, pa1, pa2, pa3); partialSM(PC0, PC1); \
        __syncthreads(); ROT3(); } while (0)
    SLOAD(sA, 0);
    {
        f32x16 qa_[3];
#pragma unroll
        for (int b = 0; b < 3; ++b) qa_[b] = f32x16{};
        const bf16_t* ap = QA + ((size_t)((row0 >> 5) + wid) * 16 * 64 + lane) * 8; const bf16_t* wp = WQh + (size_t)lane * 8;
        bf16x8 fr[2][2][4];
#define AQLOAD(S, g) do { _Pragma("unroll") for (int kk = 0; kk < 2; ++kk) { const int ks = 2 * (g) + kk; fr[S][kk][0] = *(const bf16x8*)(ap + (size_t)ks * 512); \
            _Pragma("unroll") for (int b = 0; b < 3; ++b) fr[S][kk][1 + b] = *(const bf16x8*)(wp + (size_t)(b * 16 + ks) * 512); } } while (0)
        AQLOAD(0, 0);
#pragma unroll
        for (int g = 0; g < 8; ++g) {
            if (g + 1 < 8) { if (g & 1) AQLOAD(0, g + 1); else AQLOAD(1, g + 1); }
            __builtin_amdgcn_sched_barrier(0);
#pragma unroll
            for (int kk = 0; kk < 2; ++kk)
#pragma unroll
                for (int b = 0; b < 3; ++b) qa_[b] = __builtin_amdgcn_mfma_f32_32x32x16_bf16(fr[g & 1][kk][1 + b], fr[g & 1][kk][0], qa_[b], 0, 0, 0);
            __builtin_amdgcn_sched_barrier(0);
        }
#undef AQLOAD
        const int row = row0 + wid * 32 + r32; const bool lat = row < RL; const int tq = row & 4095;
        float ss = 0.f;
#pragma unroll
        for (int b = 0; b < 3; ++b)
#pragma unroll
            for (int r = 0; r < 16; ++r) ss += qa_[b][r] * qa_[b][r];
        { auto rr = __builtin_amdgcn_permlane32_swap(__float_as_uint(ss), __float_as_uint(ss), false, false); ss = __uint_as_float(rr[0]) + __uint_as_float(rr[1]); }
        const float rn = rsqrtf(ss * (1.f / 96.f) + EPS) * QSCALE;
#pragma unroll
        for (int b = 0; b < 3; ++b)
#pragma unroll
            for (int rq = 0; rq < 4; ++rq) { const f32x4 g = ld4(qn_g + 32 * b + 8 * rq + 4 * hi);
                float v0 = qa_[b][4 * rq] * rn * g[0], v1 = qa_[b][4 * rq + 1] * rn * g[1], v2 = qa_[b][4 * rq + 2] * rn * g[2], v3 = qa_[b][4 * rq + 3] * rn * g[3];
                if (b == 2 && lat) { const int pp = 4 * rq + 2 * hi; arope(ROPE, tq, pp, v0, v1); arope(ROPE, tq, pp + 1, v2, v3); }
                qa_[b][4 * rq] = v0; qa_[b][4 * rq + 1] = v1; qa_[b][4 * rq + 2] = v2; qa_[b][4 * rq + 3] = v3; }
        qr[0] = pack8<0>(qa_[0]); qr[1] = pack8<8>(qa_[0]); qr[2] = pack8<0>(qa_[1]); qr[3] = pack8<8>(qa_[1]); qr[4] = pack8<0>(qa_[2]); qr[5] = pack8<8>(qa_[2]);
    }
    SWRITE(0, sA); SLOAD(sB, 1); if (2 < NT) SLOAD(sA, 2); __syncthreads();
    qkt(pA0, pA1, lds + OFF_K, qr, r32, hi); partialSM(pA0, pA1);
    SWRITE(1, sB); __syncthreads();
    for (int i = 1; i + 1 < NT; i += 2) {
        STEP(pB0, pB1, pA0, pA1, sA, sB, i);
        STEP(pA0, pA1, pB0, pB1, sB, sA, i + 1);
    }
    ASBAR(); qkt(pB0, pB1, lds + OFF_K + b_cur * SHM_K, qr, r32, hi);
    finishSM(pA0, pA1, l_reg, pa0, pa1, pa2, pa3); ASBAR();
    pv_one<0>(o[0], vb0 + b_prev * SHM_V, pa0, pa1, pa2, pa3); pv_one<1>(o[1], vb0 + b_prev * SHM_V, pa0, pa1, pa2, pa3); partialSM(pB0, pB1);
    finishSM(pB0, pB1, l_reg, pa0, pa1, pa2, pa3); ASBAR();
    pv_one<0>(o[0], vb0 + b_cur * SHM_V, pa0, pa1, pa2, pa3); pv_one<1>(o[1], vb0 + b_cur * SHM_V, pa0, pa1, pa2, pa3);
    { auto rr = __builtin_amdgcn_permlane32_swap(__float_as_uint(l_reg), __float_as_uint(l_reg), false, false); l_reg = __uint_as_float(rr[0]) + __uint_as_float(rr[1]); }
#undef STEP
#undef ROT3
    if (hi == 0) li_l[r32] = l_reg; asm volatile("s_waitcnt lgkmcnt(0)" ::: "memory");
    int hi_e = hi, r32_e = r32; asm volatile("" : "+v"(hi_e), "+v"(r32_e));
    bf16_t* Ow = Ob + (size_t)(wid * 32 + 4 * hi_e) * DM + r32_e;
#pragma unroll
    for (int r = 0; r < 16; ++r) { const int orow = (r & 3) + 8 * (r >> 2); const float rl = __builtin_amdgcn_rcpf(li_l[orow + 4 * hi_e]);
#pragma unroll
        for (int d0 = 0; d0 < 2; ++d0) Ow[(size_t)orow * DM + d0 * 32] = (bf16_t)(cvt_pk_bf16(o[d0][r] * rl, 0.f) & 0xffffu); }
    __syncthreads();
#undef SLOAD
#undef SWRITE
}
#undef ASBAR
}


namespace g2 {
using f32x16 = __attribute__((ext_vector_type(16))) float;
__device__ __forceinline__ int crow(int r, int hi) { return (r & 3) + 8 * (r >> 2) + 4 * hi; }
__device__ __forceinline__ float half_swap_sum(float v) { auto rr = __builtin_amdgcn_permlane32_swap(__float_as_uint(v), __float_as_uint(v), false, false); return __uint_as_float(rr[0]) + __uint_as_float(rr[1]); }
__device__ __forceinline__ void rope_pair(const float* __restrict__ ROPE, int t, int pp, float& x1, float& x2) {
    const int pos = pp < 8 ? (t >> 6) : (t & 63); const f32x2 cs = *(const f32x2*)(ROPE + (pos * 8 + (pp & 7)) * 2);
    const float y1 = x1 * cs[0] - x2 * cs[1], y2 = x1 * cs[1] + x2 * cs[0]; x1 = y1; x2 = y2;
}
template <int NTG>
__device__ __forceinline__ void q_item(const bf16_t* __restrict__ QA, const bf16_t* __restrict__ WQ, const float* __restrict__ qn_g, const float* __restrict__ ROPE, bf16_t* __restrict__ Q, int row0, int h, int lane) {
    const int r32 = lane & 31, hi = lane >> 5;
    f32x16 acc[NTG][3];
#pragma unroll
    for (int tg = 0; tg < NTG; ++tg)
#pragma unroll
        for (int b = 0; b < 3; ++b) acc[tg][b] = f32x16{};
    const bf16_t* wp = WQ + ((size_t)(h * 3) * 16 * 64 + lane) * 8; const bf16_t* ap = QA + ((size_t)(row0 >> 5) * 16 * 64 + lane) * 8;
    bf16x8 fr[2][2][5];
#define G2_QLOAD(S, g) do { _Pragma("unroll") for (int kk = 0; kk < 2; ++kk) { const int ks = 2 * (g) + kk; _Pragma("unroll") for (int tg = 0; tg < NTG; ++tg) fr[S][kk][tg] = *(const bf16x8*)(ap + (size_t)(16 * tg + ks) * 512); \
        _Pragma("unroll") for (int b = 0; b < 3; ++b) fr[S][kk][2 + b] = *(const bf16x8*)(wp + (size_t)(b * 16 + ks) * 512); } } while (0)
    G2_QLOAD(0, 0);
#pragma unroll
    for (int g = 0; g < 8; ++g) {
        if (g + 1 < 8) { if (g & 1) G2_QLOAD(0, g + 1); else G2_QLOAD(1, g + 1); }
        __builtin_amdgcn_sched_barrier(0);
#pragma unroll
        for (int kk = 0; kk < 2; ++kk)
#pragma unroll
            for (int b = 0; b < 3; ++b)
#pragma unroll
                for (int tg = 0; tg < NTG; ++tg) acc[tg][b] = __builtin_amdgcn_mfma_f32_32x32x16_bf16(fr[g & 1][kk][2 + b], fr[g & 1][kk][tg], acc[tg][b], 0, 0, 0);
        __builtin_amdgcn_sched_barrier(0);
    }
#undef G2_QLOAD
#pragma unroll
    for (int tg = 0; tg < NTG; ++tg) { const int row = row0 + tg * 32 + r32; const bool lat = row < RL; const int t = row & 4095;
        float ss = 0.f;
#pragma unroll
        for (int b = 0; b < 3; ++b)
#pragma unroll
            for (int r = 0; r < 16; ++r) ss += acc[tg][b][r] * acc[tg][b][r];
        ss = half_swap_sum(ss); const float rn = rsqrtf(ss * (1.f / 96.f) + EPS) * QSCALE;
        bf16_t* qo = Q + ((size_t)row * NH + h) * QKH + 4 * hi;
#pragma unroll
        for (int b = 0; b < 3; ++b)
#pragma unroll
            for (int rq = 0; rq < 4; ++rq) { const int f0 = 32 * b + 8 * rq + 4 * hi; const f32x4 g = ld4(qn_g + f0);
                float v0 = acc[tg][b][4 * rq] * rn * g[0], v1 = acc[tg][b][4 * rq + 1] * rn * g[1], v2 = acc[tg][b][4 * rq + 2] * rn * g[2], v3 = acc[tg][b][4 * rq + 3] * rn * g[3];
                if (b == 2 && lat) { const int pp = 4 * rq + 2 * hi; rope_pair(ROPE, t, pp, v0, v1); rope_pair(ROPE, t, pp + 1, v2, v3); }
                *(u32x2*)(qo + 32 * b + 8 * rq) = (u32x2){cvt_pk_bf16(v0, v1), cvt_pk_bf16(v2, v3)}; } }
}
__device__ __forceinline__ void kv_item(const bf16_t* __restrict__ KVA, const float* __restrict__ KR, const bf16_t* __restrict__ WKV, const float* __restrict__ kn_g, const float* __restrict__ ROPE,
                                        bf16_t* __restrict__ Kb, bf16_t* __restrict__ Vb, int row0, int h, int lane) {
    const int r32 = lane & 31, hi = lane >> 5;
    f32x16 acc[4];
#pragma unroll
    for (int b = 0; b < 4; ++b) acc[b] = f32x16{};
    const bf16_t* wp = WKV + ((size_t)(h * 4) * 8 * 64 + lane) * 8; const bf16_t* ap = KVA + ((size_t)(row0 >> 5) * 8 * 64 + lane) * 8;
    bf16x8 fr[2][2][5];
#define G2_KLOAD(S, g) do { _Pragma("unroll") for (int kk = 0; kk < 2; ++kk) { const int ks = 2 * (g) + kk; fr[S][kk][0] = *(const bf16x8*)(ap + (size_t)ks * 512); \
        _Pragma("unroll") for (int b = 0; b < 4; ++b) fr[S][kk][1 + b] = *(const bf16x8*)(wp + (size_t)(b * 8 + ks) * 512); } } while (0)
    G2_KLOAD(0, 0);
#pragma unroll
    for (int g = 0; g < 4; ++g) {
        if (g + 1 < 4) { if (g & 1) G2_KLOAD(0, g + 1); else G2_KLOAD(1, g + 1); }
        __builtin_amdgcn_sched_barrier(0);
#pragma unroll
        for (int kk = 0; kk < 2; ++kk)
#pragma unroll
            for (int b = 0; b < 4; ++b) acc[b] = __builtin_amdgcn_mfma_f32_32x32x16_bf16(fr[g & 1][kk][1 + b], fr[g & 1][kk][0], acc[b], 0, 0, 0);
        __builtin_amdgcn_sched_barrier(0);
    }
#undef G2_KLOAD
    const int row = row0 + r32; const bool lat = row < RL; const int bb = lat ? (row >> 12) : ((row - RL) >> 8), t = lat ? (row & 4095) : ((row - RL) & 255), key = lat ? CTXL + t : t;
    float kr[16];
    { const float* krp = KR + (size_t)row * 32 + 16 * hi;
#pragma unroll
      for (int q = 0; q < 4; ++q) { const f32x4 v = ld4(krp + 4 * q); kr[4 * q] = v[0]; kr[4 * q + 1] = v[1]; kr[4 * q + 2] = v[2]; kr[4 * q + 3] = v[3]; } }
    float ss = 0.f;
#pragma unroll
    for (int b = 0; b < 2; ++b)
#pragma unroll
        for (int r = 0; r < 16; ++r) ss += acc[b][r] * acc[b][r];
#pragma unroll
    for (int i = 0; i < 16; ++i) ss += kr[i] * kr[i];
    ss = half_swap_sum(ss); const float rn = rsqrtf(ss * (1.f / 96.f) + EPS);
    bf16_t* ko = Kb + (((size_t)bb * NH + h) * NKEY + key) * QKH; bf16_t* vo = Vb + (((size_t)bb * NH + h) * NKEY + key) * VD;
#pragma unroll
    for (int b = 0; b < 2; ++b)
#pragma unroll
        for (int rq = 0; rq < 4; ++rq) { const int f0 = 32 * b + 8 * rq + 4 * hi; const f32x4 g = ld4(kn_g + f0);
            *(u32x2*)(ko + f0) = (u32x2){cvt_pk_bf16(acc[b][4 * rq] * rn * g[0], acc[b][4 * rq + 1] * rn * g[1]), cvt_pk_bf16(acc[b][4 * rq + 2] * rn * g[2], acc[b][4 * rq + 3] * rn * g[3])};
            *(u32x2*)(vo + f0) = (u32x2){cvt_pk_bf16(acc[2 + b][4 * rq], acc[2 + b][4 * rq + 1]), cvt_pk_bf16(acc[2 + b][4 * rq + 2], acc[2 + b][4 * rq + 3])}; }
    unsigned pk[8];
#pragma unroll
    for (int q = 0; q < 8; ++q) { float x1 = kr[2 * q] * rn * kn_g[64 + 16 * hi + 2 * q], x2 = kr[2 * q + 1] * rn * kn_g[65 + 16 * hi + 2 * q];
        if (lat) rope_pair(ROPE, t, 8 * hi + q, x1, x2);
        pk[q] = cvt_pk_bf16(x1, x2); }
    *(u32x4*)(ko + 64 + 16 * hi) = (u32x4){pk[0], pk[1], pk[2], pk[3]}; *(u32x4*)(ko + 72 + 16 * hi) = (u32x4){pk[4], pk[5], pk[6], pk[7]};
}
__device__ __forceinline__ void sp_item(const bf16_t* __restrict__ VT, const bf16_t* __restrict__ WSP, const float* __restrict__ bsp, const bf16_t* __restrict__ U, bf16_t* __restrict__ MIX, int chunk, int h, int ih, int lane) {
    const int r32 = lane & 31, hi = lane >> 5;
    f32x16 acc[2][2];
#pragma unroll
    for (int cb = 0; cb < 2; ++cb)
#pragma unroll
        for (int ib = 0; ib < 2; ++ib) acc[cb][ib] = f32x16{};
    const bf16_t* vp = VT + (((size_t)chunk * 8 + 2 * h) * 8 * 64 + lane) * 8;     const bf16_t* wp = WSP + ((size_t)(h * 4 + 2 * ih) * 8 * 64 + lane) * 8;
    bf16x8 fr[2][2][4];
#define G2_SLOAD(S, g) do { _Pragma("unroll") for (int kk = 0; kk < 2; ++kk) { const int ks = 2 * (g) + kk; fr[S][kk][0] = *(const bf16x8*)(vp + (size_t)ks * 512); fr[S][kk][1] = *(const bf16x8*)(vp + (size_t)(8 + ks) * 512); \
        fr[S][kk][2] = *(const bf16x8*)(wp + (size_t)ks * 512); fr[S][kk][3] = *(const bf16x8*)(wp + (size_t)(8 + ks) * 512); } } while (0)
    G2_SLOAD(0, 0);
#pragma unroll
    for (int g = 0; g < 4; ++g) {
        if (g + 1 < 4) { if (g & 1) G2_SLOAD(0, g + 1); else G2_SLOAD(1, g + 1); }
        __builtin_amdgcn_sched_barrier(0);
#pragma unroll
        for (int kk = 0; kk < 2; ++kk) {
            acc[0][0] = __builtin_amdgcn_mfma_f32_32x32x16_bf16(fr[g & 1][kk][0], fr[g & 1][kk][2], acc[0][0], 0, 0, 0); acc[0][1] = __builtin_amdgcn_mfma_f32_32x32x16_bf16(fr[g & 1][kk][0], fr[g & 1][kk][3], acc[0][1], 0, 0, 0);
            acc[1][0] = __builtin_amdgcn_mfma_f32_32x32x16_bf16(fr[g & 1][kk][1], fr[g & 1][kk][2], acc[1][0], 0, 0, 0); acc[1][1] = __builtin_amdgcn_mfma_f32_32x32x16_bf16(fr[g & 1][kk][1], fr[g & 1][kk][3], acc[1][1], 0, 0, 0); }
        __builtin_amdgcn_sched_barrier(0);
    }
#undef G2_SLOAD
#pragma unroll
    for (int ib = 0; ib < 2; ++ib) { const int i = 64 * ih + 32 * ib + r32; const float bias = bsp[h * 128 + i]; const size_t row = (size_t)chunk * 128 + i;
#pragma unroll
        for (int cb = 0; cb < 2; ++cb)
#pragma unroll
            for (int rq = 0; rq < 4; ++rq) { const int c = 64 * h + 32 * cb + 8 * rq + 4 * hi; const u32x2 uu = *(const u32x2*)(U + row * 256 + c);
                const float u0 = __uint_as_float(uu[0] << 16), u1 = __uint_as_float(uu[0] & 0xffff0000u), u2 = __uint_as_float(uu[1] << 16), u3 = __uint_as_float(uu[1] & 0xffff0000u);
                *(u32x2*)(MIX + row * DM + c) = (u32x2){cvt_pk_bf16(u0 * (acc[cb][ib][4 * rq] + bias), u1 * (acc[cb][ib][4 * rq + 1] + bias)), cvt_pk_bf16(u2 * (acc[cb][ib][4 * rq + 2] + bias), u3 * (acc[cb][ib][4 * rq + 3] + bias))}; } }
}
__device__ __forceinline__ void pool_block(const bf16_t* __restrict__ BW, const float* __restrict__ pscale, bf16_t* __restrict__ MIX, int row0, LAS unsigned char* lds, int tid) {
    int t0, ntok; if (row0 < RL) { t0 = row0 & 4095; ntok = SEQ; } else { t0 = (row0 - RL) & 255; ntok = CTXL; }
    const int base = row0 - t0;
    __syncthreads();
#pragma unroll
    for (int j = 0; j < 5; ++j) { const int idx = tid + 512 * j; const int rr = idx >> 5, ch = idx & 31; const int t = t0 - 8 + rr;
        u32x4 v = (u32x4){0u, 0u, 0u, 0u}; if (t >= 0 && t < ntok) v = *(const u32x4*)(BW + (size_t)(base + t) * 256 + ch * 8);
        *(LAS u32x4*)(lds + rr * 512 + ch * 16) = v; }
    __syncthreads();
#pragma unroll
    for (int j = 0; j < 4; ++j) { const int idx = tid + 512 * j; const int rr = idx >> 5, ch = idx & 31, n0 = ch * 8, g = n0 >> 6, hw = 1 << g; const int t = t0 + rr;
        const int lo = max(t - hw, 0), hi = min(t + hw, ntok);
        float sm[8];
#pragma unroll
        for (int q = 0; q < 8; ++q) sm[q] = 0.f;
#pragma unroll
        for (int d = -8; d < 8; ++d) { if (d >= -hw && d < hw) { const u32x4 v = *(const LAS u32x4*)(lds + (rr + 8 + d) * 512 + ch * 16);
#pragma unroll
                for (int q = 0; q < 4; ++q) { sm[2 * q] += __uint_as_float(v[q] << 16); sm[2 * q + 1] += __uint_as_float(v[q] & 0xffff0000u); } } }
        const float inv = 1.f / (float)(hi - lo); const u32x4 v = *(const LAS u32x4*)(lds + (rr + 8) * 512 + ch * 16); const f32x4 p0 = ld4(pscale + n0), p1 = ld4(pscale + n0 + 4);
        float z[8];
#pragma unroll
        for (int q = 0; q < 4; ++q) { z[2 * q] = sm[2 * q] * inv - __uint_as_float(v[q] << 16); z[2 * q + 1] = sm[2 * q + 1] * inv - __uint_as_float(v[q] & 0xffff0000u); }
        *(u32x4*)(MIX + (size_t)(row0 + rr) * DM + 256 + n0) = (u32x4){cvt_pk_bf16(z[0] * p0[0], z[1] * p0[1]), cvt_pk_bf16(z[2] * p0[2], z[3] * p0[3]), cvt_pk_bf16(z[4] * p1[0], z[5] * p1[1]), cvt_pk_bf16(z[6] * p1[2], z[7] * p1[3])}; }
}
}

__device__ __forceinline__ void transpose_item(const float* W, int ldw, int K, bf16_t* WT, int k0, int n0, int dst_row0, LAS float* scr, int lane) {
    float tv[32];
#pragma unroll
    for (int i = 0; i < 32; ++i) tv[i] = W[(size_t)(k0 + 2 * i + (lane >> 5)) * ldw + n0 + (lane & 31)];
#pragma unroll
    for (int i = 0; i < 32; ++i) scr[(2 * i + (lane >> 5)) * 33 + (lane & 31)] = tv[i];
    asm volatile("s_waitcnt lgkmcnt(0)" ::: "memory");
    const int c = lane & 7;
#pragma unroll
    for (int j = 0; j < 4; ++j) { const int n = (lane >> 3) + 8 * j; const LAS float* sp = scr + (8 * c) * 33 + n;
        u32x4 o; o.x = cvt_pk_bf16(sp[0 * 33], sp[1 * 33]); o.y = cvt_pk_bf16(sp[2 * 33], sp[3 * 33]); o.z = cvt_pk_bf16(sp[4 * 33], sp[5 * 33]); o.w = cvt_pk_bf16(sp[6 * 33], sp[7 * 33]);
        *(u32x4*)(WT + (size_t)(dst_row0 + n) * K + k0 + 8 * c) = o; }
    asm volatile("s_waitcnt lgkmcnt(0)" ::: "memory");
}


__device__ __forceinline__ void fold_item(const float* w_in_l, const float* w_pool_l, bf16_t* WT, int k0, int g, int dh, LAS float* scr, int lane) {
    {   f32x4 av[8], wv[8];
#pragma unroll
        for (int i = 0; i < 8; ++i) av[i] = ld4(w_in_l + (size_t)(k0 + i * 4 + (lane >> 4)) * DIN + 512 + 64 * g + (lane & 15) * 4);
#pragma unroll
        for (int i = 0; i < 8; ++i) wv[i] = ld4(w_pool_l + (size_t)g * 64 * 64 + (size_t)(i * 8 + (lane >> 3)) * 64 + 32 * dh + (lane & 7) * 4);
#pragma unroll
        for (int i = 0; i < 8; ++i) { *(LAS f32x4*)(scr + (i * 4 + (lane >> 4)) * 64 + (lane & 15) * 4) = av[i]; *(LAS f32x4*)(scr + 2048 + (i * 8 + (lane >> 3)) * 32 + (lane & 7) * 4) = wv[i]; }
    }
    asm volatile("s_waitcnt lgkmcnt(0)" ::: "memory");
    const int ch = lane >> 5, d = lane & 31;
    float acc[32];
#pragma unroll
    for (int j = 0; j < 32; ++j) acc[j] = 0.f;
#pragma unroll 2
    for (int cc = 0; cc < 32; ++cc) { const float wvv = scr[2048 + (ch * 32 + cc) * 32 + d];
#pragma unroll
        for (int j = 0; j < 32; ++j) acc[j] += scr[j * 64 + ch * 32 + cc] * wvv; }
    asm volatile("s_waitcnt lgkmcnt(0)" ::: "memory");
#pragma unroll
    for (int j = 0; j < 32; ++j) { auto rr = __builtin_amdgcn_permlane32_swap(__float_as_uint(acc[j]), __float_as_uint(acc[j]), false, false); acc[j] = __uint_as_float(rr[0]) + __uint_as_float(rr[1]); }
    if (ch == 0) {
#pragma unroll
        for (int j = 0; j < 32; ++j) scr[j * 33 + d] = acc[j]; }
    asm volatile("s_waitcnt lgkmcnt(0)" ::: "memory");
    const int c = lane & 3;
#pragma unroll
    for (int jj = 0; jj < 2; ++jj) { const int n = (lane >> 2) + 16 * jj; const LAS float* sp = scr + (8 * c) * 33 + n;
        u32x4 o; o.x = cvt_pk_bf16(sp[0 * 33], sp[1 * 33]); o.y = cvt_pk_bf16(sp[2 * 33], sp[3 * 33]); o.z = cvt_pk_bf16(sp[4 * 33], sp[5 * 33]); o.w = cvt_pk_bf16(sp[6 * 33], sp[7 * 33]);
        *(u32x4*)(WT + (size_t)(512 + 64 * g + 32 * dh + n) * DM + k0 + 8 * c) = o; }
    asm volatile("s_waitcnt lgkmcnt(0)" ::: "memory");
}

template <bool GU>
__device__ __forceinline__ void transpose_block(const float* __restrict__ W, int ldw, int Kdim, bf16_t* __restrict__ WT, int k0, int n0, int width, LAS float* tile, int tid) {
    const int wave = tid >> 6, lane = tid & 63;
    __syncthreads();
    { const int col4 = lane * 4; f32x4 v[8];
      if (col4 < width) {
#pragma unroll
        for (int i = 0; i < 8; ++i) v[i] = ld4(W + (size_t)(k0 + 8 * i + wave) * ldw + n0 + col4);
#pragma unroll
        for (int i = 0; i < 8; ++i) { LAS float* t_ = tile + (8 * i + wave) * 257 + col4; t_[0] = v[i][0]; t_[1] = v[i][1]; t_[2] = v[i][2]; t_[3] = v[i][3]; } } }
    __syncthreads();
    const int c = lane & 7;
#pragma unroll
    for (int jj = 0; jj < 4; ++jj) { const int nl = 32 * wave + (lane >> 3) + 8 * jj;
        if (nl < width) { const LAS float* sp = tile + (8 * c) * 257 + nl;
            u32x4 o; o.x = cvt_pk_bf16(sp[0 * 257], sp[1 * 257]); o.y = cvt_pk_bf16(sp[2 * 257], sp[3 * 257]); o.z = cvt_pk_bf16(sp[4 * 257], sp[5 * 257]); o.w = cvt_pk_bf16(sp[6 * 257], sp[7 * 257]);
            const int n = n0 + nl; int dst = n; if (GU) { const int f = n % DFF, isup = n / DFF; dst = 256 * (f / 128) + 128 * isup + (f % 128); }
            *(u32x4*)(WT + (size_t)dst * Kdim + k0 + 8 * c) = o; } }
}

#define XB_TMO      128
#define XB_XCNT(j)  (256  + 64 * (j))
#define XB_XSUB(j)  (1280 + 64 * (j))
#define XB_XGEN(j)  (2304 + 64 * (j))
#define XB_TOP      3328
#define XB_TOPGEN   3392
#define XCD_BAR_WORDS 3456
#define XB_SPIN_CAP (1u << 18)
__device__ __forceinline__ unsigned xb_ld(unsigned* p)              { return __hip_atomic_load(p, __ATOMIC_RELAXED, __HIP_MEMORY_SCOPE_AGENT); }
__device__ __forceinline__ unsigned xb_add(unsigned* p, unsigned v) { return __hip_atomic_fetch_add(p, v, __ATOMIC_RELAXED, __HIP_MEMORY_SCOPE_AGENT); }
__device__ __forceinline__ unsigned xb_xcc_id() { return (unsigned)__builtin_amdgcn_s_getreg((3 << 11) | 20) & 0xFu; }
#define XB_SPIN(cond, bar) do { unsigned _sp = 0; while (cond) { __builtin_amdgcn_s_sleep(1); \
    if ((++_sp & 255u) == 0u) { if (xb_ld(&(bar)[XB_TMO])) break; if (_sp > XB_SPIN_CAP) { atomicAdd(&(bar)[XB_TMO], 1u); break; } } } } while (0)
struct XcdBarrier { unsigned* bar; unsigned x; volatile LAS unsigned* st; };
__device__ __forceinline__ XcdBarrier xcd_barrier_post(unsigned* bar, volatile LAS unsigned* st) {
    XcdBarrier b; b.bar = bar; b.x = xb_xcc_id(); b.st = st;
    if (threadIdx.x == 0) (void)xb_add(&bar[XB_XCNT(b.x)], 1u);
    return b;
}
__device__ __forceinline__ void xcd_barrier_complete(unsigned* bar, unsigned x, unsigned& nloc, unsigned& nx) {
    const unsigned G = gridDim.x * gridDim.y * gridDim.z;
    unsigned sum, cnt, mine, sp = 0u;
    for (;;) {
        sum = 0u; cnt = 0u; mine = 0u;
#pragma unroll
        for (unsigned j = 0; j < 16; ++j) { const unsigned c = xb_ld(&bar[XB_XCNT(j)]); sum += c; cnt += (c > 0u) ? 1u : 0u; mine = (j == x) ? c : mine; }
        if (sum == G) break;
        __builtin_amdgcn_s_sleep(1);
        if ((++sp & 255u) == 0u) { if (xb_ld(&bar[XB_TMO])) break; if (sp > XB_SPIN_CAP) { atomicAdd(&bar[XB_TMO], 1u); break; } }
    }
    nloc = mine > 0u ? mine : 1u; nx = cnt > 0u ? cnt : 1u;
}
__device__ __forceinline__ void xcd_barrier(const XcdBarrier& b) {
    asm volatile("s_waitcnt vmcnt(0)" ::: "memory");
    __syncthreads();
    if (threadIdx.x == 0) {
        unsigned* bar = b.bar;
        __builtin_amdgcn_s_waitcnt(0);
        unsigned nloc = b.st[0], nx = b.st[1];
        if (nloc == 0u) { xcd_barrier_complete(bar, b.x, nloc, nx); b.st[0] = nloc; b.st[1] = nx; }
        const unsigned old = xb_add(&bar[XB_XSUB(b.x)], 1u);
        const unsigned gen = old / nloc;
        if (old + 1u == (gen + 1u) * nloc) {
            __builtin_amdgcn_fence(__ATOMIC_RELEASE, "agent");
            asm volatile("s_waitcnt vmcnt(0)" ::: "memory");
            const unsigned og = xb_add(&bar[XB_TOP], 1u);
            const unsigned tg = og / nx;
            if (og + 1u == (tg + 1u) * nx) xb_add(&bar[XB_TOPGEN], 1u);
            else XB_SPIN(xb_ld(&bar[XB_TOPGEN]) == tg, bar);
            __builtin_amdgcn_fence(__ATOMIC_ACQUIRE, "agent");
            xb_add(&bar[XB_XGEN(b.x)], 1u);
            asm volatile("s_waitcnt vmcnt(0)" ::: "memory");
        } else {
            XB_SPIN(xb_ld(&bar[XB_XGEN(b.x)]) == gen, bar);
            __builtin_amdgcn_fence(__ATOMIC_ACQUIRE, "agent");
            asm volatile("s_waitcnt vmcnt(0)" ::: "memory");
        }
    }
    __syncthreads();
}

struct MkArgs { const float* in[23]; float* out; unsigned char* ws; int ph_lo, ph_hi; int dry, pad; };
constexpr int MK_LDS = 147456;
constexpr int MK_XL_OFF = 131072;
enum { PH_P0A = 0, PH_P0B = 1, PH_L0 = 2, PH_PER_LAYER = 6, PH_G1 = 0, PH_G2 = 1, PH_G3 = 2, PH_G4 = 3, PH_G5 = 4, PH_G6 = 5, PH_END = 14 };

typedef const __attribute__((address_space(4))) MkArgs* KargPtr;
#define KARG() ({ KargPtr p_ = (KargPtr)__builtin_amdgcn_kernarg_segment_ptr(); asm volatile("" : "+s"(p_)); p_; })
#define WSP(kp, off) ((kp)->ws + (off))
#define BLK() ({ int b_ = (int)blockIdx.x; asm volatile("" : "+s"(b_)); b_; })

__device__ __forceinline__ void weight_prep(KargPtr kp, unsigned char* ws, int l, int bi, int nb, LAS unsigned char* lds, int tid, int parts) {
    const int lane = tid & 63, wave = __builtin_amdgcn_readfirstlane(tid >> 6);
    bf16_t* WB = (bf16_t*)(ws + WS_WB + (size_t)l * 22 * MiB);
    {
        LAS float* tile = (LAS float*)lds;
        const int cnt = parts == 1 ? 64 : parts == 2 ? 592 : 656;
#define PREP_R(j_) (parts == 1 ? 528 + (j_) : (parts == 2 && (j_) >= 528) ? (j_) + 64 : (j_))
#define PREP_DESC(r_) const float* W_; bf16_t* WT_; int ldw_, Kd_, k0_, n0_, wd_, gu_; { int q_ = (r_); \
            if (q_ < 352) { W_ = kp->in[21] + (size_t)l * DM * 2 * DFF; WT_ = WB + WL_GU; ldw_ = 2 * DFF; Kd_ = DM; k0_ = (q_ / 22) * 64; n0_ = (q_ % 22) * 256; wd_ = 256; gu_ = 1; } \
            else if (q_ < 528) { q_ -= 352; W_ = kp->in[22] + (size_t)l * DFF * DM; WT_ = WB + WL_DN; ldw_ = DM; Kd_ = DFF; k0_ = (q_ / 4) * 64; n0_ = (q_ % 4) * 256; wd_ = 256; gu_ = 0; } \
            else if (q_ < 592) { q_ -= 528; const int nq_ = q_ % 4; W_ = kp->in[8] + (size_t)l * DM * DIN; WT_ = WB + WL_IN; ldw_ = DIN; Kd_ = DM; k0_ = (q_ / 4) * 64; n0_ = (nq_ < 2 ? nq_ : nq_ + 1) * 256; wd_ = n0_ == 1024 ? 160 : 256; gu_ = 0; } \
            else { q_ -= 592; W_ = kp->in[20] + (size_t)l * DM * DM; WT_ = WB + WL_OUT; ldw_ = DM; Kd_ = DM; k0_ = (q_ / 4) * 64; n0_ = (q_ % 4) * 256; wd_ = 256; gu_ = 0; } } (void)WT_; (void)Kd_; (void)gu_
#define PREP_LOAD(V, j_) do { PREP_DESC(PREP_R(j_)); if (lane * 4 < wd_) { _Pragma("unroll") for (int i = 0; i < 8; ++i) V[i] = ld4(W_ + (size_t)(k0_ + 8 * i + wave) * ldw_ + n0_ + lane * 4); } } while (0)
        f32x4 v[8], vn[8];
#pragma unroll
        for (int i = 0; i < 8; ++i) { v[i] = (f32x4){0.f, 0.f, 0.f, 0.f}; vn[i] = v[i]; }
        int j = bi;
        if (j < cnt) PREP_LOAD(v, j);
        for (; j < cnt; j += nb) {
            if (j + nb < cnt) PREP_LOAD(vn, j + nb);
            __builtin_amdgcn_sched_barrier(0);
            PREP_DESC(PREP_R(j));
            __syncthreads();
            if (lane * 4 < wd_) {
#pragma unroll
                for (int i = 0; i < 8; ++i) { LAS float* t_ = tile + (8 * i + wave) * 263 + lane; t_[0] = v[i][0]; t_[66] = v[i][1]; t_[132] = v[i][2]; t_[198] = v[i][3]; } }
            __syncthreads();
            const int c = lane >> 3, q = lane & 7;
#pragma unroll
            for (int jj = 0; jj < 4; ++jj) { const int nl = 32 * wave + q + 8 * jj;
                if (nl < wd_) { const LAS float* sp = tile + (8 * c) * 263 + (nl & 3) * 66 + (nl >> 2);
                    u32x4 o; o.x = cvt_pk_bf16(sp[0 * 263], sp[1 * 263]); o.y = cvt_pk_bf16(sp[2 * 263], sp[3 * 263]); o.z = cvt_pk_bf16(sp[4 * 263], sp[5 * 263]); o.w = cvt_pk_bf16(sp[6 * 263], sp[7 * 263]);
                    const int n = n0_ + nl; int dst = n; if (gu_) { const int f = n % DFF, isup = n / DFF; dst = 256 * (f / 128) + 128 * isup + (f % 128); }
                    *(u32x4*)(WT_ + (size_t)dst * Kd_ + k0_ + 8 * c) = o; } }
#pragma unroll
            for (int i = 0; i < 8; ++i) v[i] = vn[i];
        }
#undef PREP_LOAD
#undef PREP_DESC
#undef PREP_R
        __syncthreads();
    }
    LAS float* scr = (LAS float*)(lds + wave * 16384);
    constexpr int I_FOLD = 32 * 8, I_Z = 96 * DM / 512, I_SP = 4 * 4 * 8, I_QF = 8 * 3 * 16, I_KF = 8 * 4 * 8, I_ALL = I_FOLD + I_Z + I_SP + I_QF + I_KF;
    if (parts & 1)
    for (int it = bi * 8 + wave; it < I_ALL; it += nb * 8) { int r = it;
        if (r < I_FOLD) { const int kb = r >> 3, g = (r >> 1) & 3, dh = r & 1; fold_item(kp->in[8] + (size_t)l * DM * DIN, kp->in[12] + (size_t)l * 4 * 64 * 64, WB + WL_IN, kb * 32, g, dh, scr, lane); continue; } r -= I_FOLD;
        if (r < I_SP) {
            const int h = r >> 5, ib = (r >> 3) & 3, ks = r & 7; const float* sp_ = kp->in[10] + (size_t)l * 4 * 128 * 128 + ((size_t)h * 128 + 32 * ib + (lane & 31)) * 128 + 16 * ks + 8 * (lane >> 5); const f32x4 x0 = ld4(sp_), x1 = ld4(sp_ + 4);
            *(u32x4*)(WB + WL_SP + ((size_t)r * 64 + lane) * 8) = (u32x4){cvt_pk_bf16(x0[0], x0[1]), cvt_pk_bf16(x0[2], x0[3]), cvt_pk_bf16(x1[0], x1[1]), cvt_pk_bf16(x1[2], x1[3])}; continue; } r -= I_SP;
        if (r < I_QF) {
            const int h = r / 48, b = (r / 16) % 3, ks = r & 15; const float* src = kp->in[15] + (size_t)l * 256 * 768 + (size_t)(16 * ks + 8 * (lane >> 5)) * 768 + 96 * h + 32 * b + (lane & 31); float e_[8];
#pragma unroll
            for (int e = 0; e < 8; ++e) e_[e] = src[(size_t)e * 768];
            *(u32x4*)(WB + WL_QB + ((size_t)r * 64 + lane) * 8) = (u32x4){cvt_pk_bf16(e_[0], e_[1]), cvt_pk_bf16(e_[2], e_[3]), cvt_pk_bf16(e_[4], e_[5]), cvt_pk_bf16(e_[6], e_[7])}; continue; } r -= I_QF;
        if (r < I_KF) {
            const int h = r >> 5, b = (r >> 3) & 3, ks = r & 7; const float* src = kp->in[17] + (size_t)l * 128 * 1024 + (size_t)(16 * ks + 8 * (lane >> 5)) * 1024 + 128 * h + 32 * b + (lane & 31); float e_[8];
#pragma unroll
            for (int e = 0; e < 8; ++e) e_[e] = src[(size_t)e * 1024];
            *(u32x4*)(WB + WL_KVB + ((size_t)r * 64 + lane) * 8) = (u32x4){cvt_pk_bf16(e_[0], e_[1]), cvt_pk_bf16(e_[2], e_[3]), cvt_pk_bf16(e_[4], e_[5]), cvt_pk_bf16(e_[6], e_[7])}; continue; } r -= I_KF;
        { unsigned z_ = 0u; asm volatile("" : "+v"(z_)); *(u32x4*)(WB + WL_IN + (size_t)DIN * DM + (size_t)r * 512 + lane * 8) = (u32x4){z_, z_, z_, z_}; }
    }
}
__device__ __forceinline__ void bias_items(unsigned char* ws, int l, int bi, int nb, int tid, int which) {
    const int lane = tid & 63, wave = __builtin_amdgcn_readfirstlane(tid >> 6);
    const float* MOD = (const float*)(ws + WS_MOD); float* BIAS1P = (float*)(ws + WS_BIAS1P); float* BIAS2P = (float*)(ws + WS_BIAS2P);
    constexpr int NB_ROWS = 2 * DFF + 1280;
    const int r_lo = (which & 2) ? 0 : 2 * DFF, r_hi = (which & 1) ? NB_ROWS : 2 * DFF;
    for (int it0 = r_lo + (bi * 8 + wave) * 2; it0 < r_hi; it0 += nb * 8 * 2) {
        u32x4 q0[2], q1[2]; const float* shp[2]; float* outp[2]; int ldo[2];
#pragma unroll
        for (int e = 0; e < 2; ++e) { int n = it0 + e; const bool isgu = n < 2 * DFF; if (!isgu) n -= 2 * DFF;
            const bf16_t* wrow = (const bf16_t*)(ws + WS_WB + (size_t)l * 22 * MiB) + (isgu ? WL_GU : WL_IN) + (size_t)n * DM; shp[e] = MOD + (size_t)l * 5 * NMOD * DM + (isgu ? 3 : 0) * DM;
            outp[e] = isgu ? BIAS2P + (size_t)l * 5 * 2 * DFF + n : BIAS1P + (size_t)l * 5 * 1280 + n; ldo[e] = isgu ? 2 * DFF : 1280;
            q0[e] = *(const u32x4*)(wrow + lane * 16); q1[e] = *(const u32x4*)(wrow + lane * 16 + 8); }
        float accr[2][5];
#pragma unroll
        for (int e = 0; e < 2; ++e) { float w[16];
#pragma unroll
            for (int j = 0; j < 4; ++j) { w[2 * j] = __uint_as_float(q0[e][j] << 16); w[2 * j + 1] = __uint_as_float(q0[e][j] & 0xffff0000u); w[8 + 2 * j] = __uint_as_float(q1[e][j] << 16); w[9 + 2 * j] = __uint_as_float(q1[e][j] & 0xffff0000u); }
#pragma unroll
            for (int r = 0; r < 5; ++r) { const float* sv = shp[e] + (size_t)r * NMOD * DM + lane * 16; float acc = 0.f;
#pragma unroll
                for (int j = 0; j < 4; ++j) { const f32x4 s4 = ld4(sv + 4 * j); acc += (s4[0] * w[4 * j] + s4[1] * w[4 * j + 1]) + (s4[2] * w[4 * j + 2] + s4[3] * w[4 * j + 3]); }
                accr[e][r] = acc; } }
#pragma unroll
        for (int e = 0; e < 2; ++e)
#pragma unroll
            for (int r = 0; r < 5; ++r) { const float t = wave_sum(accr[e][r]); if (lane == 0) outp[e][(size_t)r * ldo[e]] = t; }
    }
}

__global__ void __launch_bounds__(512, 2) mk_fwd(MkArgs a) {
    extern __shared__ __attribute__((aligned(16))) unsigned char lds_raw[];
    LAS unsigned char* lds = (LAS unsigned char*)lds_raw; LAS unsigned char* xl = lds + MK_XL_OFF;
    const int ph_lo = a.ph_lo, ph_hi = a.ph_hi;
#define IN(k) (ph_lo <= (k) && (k) < ph_hi)
    volatile LAS unsigned* bst = (volatile LAS unsigned*)(lds + MK_XL_OFF + 8192);
    if (threadIdx.x < 4) bst[threadIdx.x] = 0u;
    __syncthreads();
    XcdBarrier gbar; gbar.bar = (unsigned*)a.ws; gbar.x = 0; gbar.st = bst;
    if (ph_hi - ph_lo > 1) gbar = xcd_barrier_post((unsigned*)a.ws, bst);
#define GRID_BAR(k) do { if (IN(k) && IN((k) + 1)) xcd_barrier(gbar); } while (0)
#define LANE_IDS() int tid = threadIdx.x; asm volatile("" : "+v"(tid)); const int lane = tid & 63, wave = __builtin_amdgcn_readfirstlane(tid >> 6); const int G = gridDim.x; const int gw = blockIdx.x * 8 + wave, NGW = G * 8; (void)lane; (void)gw; (void)NGW
    if (IN(PH_P0A)) {
        LANE_IDS(); KargPtr kp = KARG(); unsigned char* ws = kp->ws;
        {   LAS float* sl = (LAS float*)lds; LAS float* part = (LAS float*)(lds + 20480);
            float* MOD = (float*)(ws + WS_MOD); const float* cc = kp->in[1]; const float* cctx = kp->in[3]; const float* w_ada = kp->in[6]; const float* b_ada = kp->in[7];
            for (int i = tid; i < 5 * DM; i += 512) { const int mr = i >> 10, k = i & 1023; const float v = mr < 4 ? cc[mr * DM + k] : cctx[k]; sl[i] = silu_f(v); }
            __syncthreads();
            for (int strip = blockIdx.x; strip < DEPTH * 128; strip += G) { const int l = strip >> 7, n0 = (strip & 127) * 48;
                const int kg = tid / 12, c4 = tid % 12;
                if (tid < 504) { f32x4 acc[5];
#pragma unroll
                    for (int r = 0; r < 5; ++r) acc[r] = (f32x4){0.f, 0.f, 0.f, 0.f};
                    const float* wp = w_ada + (size_t)l * DM * (NMOD * DM) + n0 + c4 * 4;
#pragma unroll 13
                    for (int k = kg; k < DM; k += 42) { const f32x4 w = ld4(wp + (size_t)k * (NMOD * DM));
#pragma unroll
                        for (int r = 0; r < 5; ++r) acc[r] += w * sl[r * DM + k]; }
#pragma unroll
                    for (int r = 0; r < 5; ++r) *(LAS f32x4*)(part + (kg * 5 + r) * 48 + c4 * 4) = acc[r]; }
                __syncthreads();
                if (tid < 240) { const int r = tid / 48, c = tid % 48; float sum = 0.f;
#pragma unroll 6
                    for (int q = 0; q < 42; ++q) sum += part[(q * 5 + r) * 48 + c];
                    MOD[((size_t)l * 5 + r) * (NMOD * DM) + n0 + c] = sum + b_ada[l * NMOD * DM + n0 + c]; }
                __syncthreads(); }
        }
        if (blockIdx.x == 0) { float* ROPE = (float*)(ws + WS_ROPE); const int pos = tid >> 3, i = tid & 7;
            const float inv = (float)exp2(-(double)i / 8.0 * 13.287712379549449); const float ang = (float)pos * inv;
            double sn, cs; sincos_d((double)ang, sn, cs); ROPE[tid * 2] = (float)cs; ROPE[tid * 2 + 1] = (float)sn; }
        __syncthreads();
        weight_prep(kp, ws, 0, (int)blockIdx.x, G, lds, tid, 1);
    }
    GRID_BAR(PH_P0A);
    if (IN(PH_P0B)) {
        LANE_IDS(); KargPtr kp = KARG(); unsigned char* ws = kp->ws;
        const float* MOD = (const float*)(ws + WS_MOD);
        bias_items(ws, 0, (int)blockIdx.x, G, tid, 1);
        float* RSQ1 = (float*)(ws + WS_RSQ1); bf16_t* XG = (bf16_t*)(ws + WS_XG);
        const float* xin = kp->in[0]; const float* cin = kp->in[2]; const float* norm1_g = kp->in[4]; const float* sc = MOD + 1 * DM;
        for (int r0 = gw * 4; r0 < R; r0 += NGW * 4) {
            f32x4 v[4][4], gg[4], s4[4];
            const float* scr_ = sc + (size_t)mrow_of(r0) * (NMOD * DM);
#pragma unroll
            for (int j = 0; j < 4; ++j) { gg[j] = ld4(norm1_g + j * 256 + lane * 4); s4[j] = ld4(scr_ + j * 256 + lane * 4); }
#pragma unroll
            for (int e = 0; e < 4; ++e) { const int r = r0 + e; const float* xr = r < RL ? xin + (size_t)r * DM : cin + (size_t)(r - RL) * DM;
#pragma unroll
                for (int j = 0; j < 4; ++j) v[e][j] = ld4(xr + j * 256 + lane * 4); }
#pragma unroll
            for (int j = 0; j < 4; ++j) gg[j] = gg[j] * (s4[j] + 1.f);
            float ssv[4][4];
#pragma unroll
            for (int e = 0; e < 4; ++e) { const int r = r0 + e;
#pragma unroll
                for (int j = 0; j < 4; ++j) { const int k = j * 256 + lane * 4;
                    ssv[e][j] = (v[e][j][0] * v[e][j][0] + v[e][j][1] * v[e][j][1]) + (v[e][j][2] * v[e][j][2] + v[e][j][3] * v[e][j][3]);
                    const f32x4 z = v[e][j] * gg[j]; *(u32x2*)(XG + (size_t)r * DM + k) = (u32x2){cvt_pk_bf16(z[0], z[1]), cvt_pk_bf16(z[2], z[3])}; } }
#pragma unroll
            for (int e = 0; e < 4; ++e) {
#pragma unroll
                for (int j = 0; j < 4; ++j) ssv[e][j] = wave_sum(ssv[e][j]);
                if (lane == 0) *(f32x4*)(RSQ1 + (size_t)(r0 + e) * 4) = (f32x4){ssv[e][0], ssv[e][1], ssv[e][2], ssv[e][3]}; }
        }
    }
    GRID_BAR(PH_P0B);
    constexpr int NCTXU = 16;
#pragma unroll 1
    for (int l = 0; l < DEPTH; ++l) {
        const int pb = PH_L0 + l * PH_PER_LAYER; const int Mrows = (l == 0) ? R : RL;
        if (IN(pb + PH_G1)) {
            KargPtr kp = KARG(); unsigned char* ws = kp->ws; const bf16_t* WB = (const bf16_t*)(ws + WS_WB + (size_t)l * 22 * MiB); const int G = gridDim.x;
            EpiG1 E{(const float*)(ws + WS_RSQ1), (const float*)(ws + WS_BIAS1P) + (size_t)l * 5 * 1280, kp->in[9] + l * 256, kp->in[14] + l * 256, kp->in[16] + l * 128,
                    (bf16_t*)(ws + WS_U), (bf16_t*)(ws + WS_VT), (bf16_t*)(ws + WS_BW), (bf16_t*)(ws + WS_QA), (bf16_t*)(ws + WS_KVA), (float*)(ws + WS_KR)};
            if (l == 0) {
                pg8::Gemm g{(const bf16_t*)(ws + WS_XG), WB + WL_IN, R, 1280, DM}; pg8::StaticOrder S; S.init(R, 1280, G, BLK());
                pg8::gemm_phase(lds, xl, g, S, E);
                const int busy2 = (R / 256) * 5 > G ? (R / 256) * 5 - G : 0;
                if ((int)blockIdx.x >= busy2) { int tid_ = threadIdx.x; asm volatile("" : "+v"(tid_)); weight_prep(kp, ws, 0, (int)blockIdx.x - busy2, G - busy2, lds, tid_, 2); }
            } else {
                pg8::Gemm g{(const bf16_t*)(ws + WS_XG), WB + WL_IN, RL, 1280, DM}; pg8::StaticOrder S; S.init(RL, 1280, G - NCTXU, BLK() - NCTXU);
                pg8::gemm_phase(lds, xl, g, S, E);
                const bf16_t* WBp = (const bf16_t*)(ws + WS_WB + (size_t)(l - 1) * 22 * MiB); const float* MOD = (const float*)(ws + WS_MOD); const float* modp = MOD + (size_t)(l - 1) * 5 * NMOD * DM;
                pg8::Gemm g6{(const bf16_t*)(ws + WS_ACT), WBp + WL_DN, R, DM, DFF}; pg8::ListOrder S6{0, NCTXU, 16, 64, 4, 0};
                EpiRes E6{kp->out, (float*)(ws + WS_XC), (const float*)kp->out, (const float*)(ws + WS_XC), modp + 5 * DM, (float*)(ws + WS_RSQ1), (bf16_t*)(ws + WS_XG), kp->in[4] + l * DM, MOD + (size_t)l * 5 * NMOD * DM + 1 * DM, 1, 0};
                pg8::gemm_phase(lds, xl, g6, S6, E6);
            }
        }
        GRID_BAR(pb + PH_G1);
        if (IN(pb + PH_G2)) {
            LANE_IDS(); KargPtr kp = KARG(); unsigned char* ws = kp->ws; const bf16_t* WB = (const bf16_t*)(ws + WS_WB + (size_t)l * 22 * MiB);
            const bf16_t* Uq = (const bf16_t*)(ws + WS_U); const bf16_t* VTq = (const bf16_t*)(ws + WS_VT); const bf16_t* BWq = (const bf16_t*)(ws + WS_BW); const bf16_t* QAq = (const bf16_t*)(ws + WS_QA);
            const bf16_t* KVAq = (const bf16_t*)(ws + WS_KVA); const float* KRq = (const float*)(ws + WS_KR); const float* ROPEq = (const float*)(ws + WS_ROPE);
            bf16_t* Qo = (bf16_t*)(ws + WS_Q); bf16_t* Ko = (bf16_t*)(ws + WS_K); bf16_t* Vo = (bf16_t*)(ws + WS_V); bf16_t* MIX = (bf16_t*)(ws + WS_MIX);
            const int nc7 = (l > 0) ? 32 : 0;
            if ((int)blockIdx.x < nc7) {
                pg8::Gemm g{(const bf16_t*)(ws + WS_XG), WB + WL_IN, R, 1280, DM}; pg8::ListOrder S7{(int)blockIdx.x & ~3, 4, 4, 64, 4, 4};
                EpiG1 E7{(const float*)(ws + WS_RSQ1), (const float*)(ws + WS_BIAS1P) + (size_t)l * 5 * 1280, kp->in[9] + l * 256, kp->in[14] + l * 256, kp->in[16] + l * 128,
                         (bf16_t*)(ws + WS_U), (bf16_t*)(ws + WS_VT), (bf16_t*)(ws + WS_BW), (bf16_t*)(ws + WS_QA), (bf16_t*)(ws + WS_KVA), (float*)(ws + WS_KR)};
                pg8::gemm_phase(lds, xl, g, S7, E7);
                asm volatile("s_waitcnt vmcnt(0)" ::: "memory"); __syncthreads();
                __builtin_amdgcn_fence(__ATOMIC_ACQUIRE, "agent"); asm volatile("s_waitcnt vmcnt(0)" ::: "memory"); __syncthreads();
                { int ln = lane; asm volatile("" : "+v"(ln)); g2::kv_item(KVAq, KRq, WB + WL_KVB, kp->in[19] + l * QKH, ROPEq, Ko, Vo, RL + ((int)blockIdx.x & 3) * 256 + ((int)blockIdx.x >> 2) * 32, wave, ln); }
            } else {
            const int bi2 = (int)blockIdx.x - nc7, nb2 = G - nc7;
            for (int pi = bi2; pi < Mrows / 64; pi += nb2) g2::pool_block(BWq, kp->in[13] + l * 256, MIX, pi * 64, lds, tid);
            const int nQ = 0  , nKV = (Mrows / 32) * NH, nSP = (Mrows / 128) * 8, nAll = nQ + nKV + nSP;
            for (int it = bi2 * 8 + wave; it < nAll; it += nb2 * 8) { int r = it; int ln = lane; asm volatile("" : "+v"(ln));
                if (r < nQ) { g2::q_item<1>(QAq, WB + WL_QB, kp->in[18] + l * QKH, ROPEq, Qo, (r >> 3) * 32, r & 7, ln); continue; } r -= nQ;
                if (r < nKV) { g2::kv_item(KVAq, KRq, WB + WL_KVB, kp->in[19] + l * QKH, ROPEq, Ko, Vo, (r >> 3) * 32, r & 7, ln); continue; } r -= nKV;
                g2::sp_item(VTq, WB + WL_SP, kp->in[11] + l * 4 * 128, Uq, MIX, r >> 3, (r >> 1) & 3, r & 1, ln);
            }
            }
        }
        GRID_BAR(pb + PH_G2);
        if (IN(pb + PH_G3)) {
            KargPtr kp = KARG(); unsigned char* ws = kp->ws; const int G = gridDim.x;
            const bf16_t* WBq = (const bf16_t*)(ws + WS_WB + (size_t)l * 22 * MiB) + WL_QB; const bf16_t* Kp = (const bf16_t*)(ws + WS_K); const bf16_t* Vp = (const bf16_t*)(ws + WS_V); bf16_t* MIX = (bf16_t*)(ws + WS_MIX);
            const int vcu = (G % 8 == 0) ? ((int)blockIdx.x % 8) * (G / 8) + (int)blockIdx.x / 8 : (int)blockIdx.x;
            const int nun = NB * NH * 16 + (l == 0 ? NB * NH : 0);
            for (int un = vcu; un < nun; un += G) {
                int bh, row0, seq;
                if (un < NB * NH * 16) { int v;
                    if (G == 256) { const int c_ = un % G, st = un / G; v = ((4 * (c_ >> 5) + 2 * st + ((c_ & 31) >> 4)) << 4) | (c_ & 15); }
                    else { const int per = ((NB * NH * 16) % G == 0) ? (NB * NH * 16) / G : 0; v = per ? (un % G) * per + un / G : un; }
                    bh = v >> 4; row0 = (bh >> 3) * SEQ + (v & 15) * 256; seq = NKEY; }
                else { bh = un - NB * NH * 16; row0 = RL + (bh >> 3) * CTXL; seq = CTXL; }
                const int h = bh & 7;
                att::attn_unit((const bf16_t*)(ws + WS_QA), WBq + ((size_t)(h * 3) * 16 * 64) * 8, kp->in[18] + l * QKH, (const float*)(ws + WS_ROPE), row0, Kp + (size_t)bh * NKEY * QKH, Vp + (size_t)bh * NKEY * VD, MIX + (size_t)row0 * DM + 512 + h * 64, seq, lds);
            }
            if (l == 0 && vcu >= NB * NH && G > NB * NH) { int tid_ = threadIdx.x; asm volatile("" : "+v"(tid_)); bias_items(ws, 0, vcu - NB * NH, G - NB * NH, tid_, 2); }
        }
        GRID_BAR(pb + PH_G3);
        if (IN(pb + PH_G4)) {
            KargPtr kp = KARG(); unsigned char* ws = kp->ws; const bf16_t* WB = (const bf16_t*)(ws + WS_WB + (size_t)l * 22 * MiB); const int G = gridDim.x;
            const float* modl = (const float*)(ws + WS_MOD) + (size_t)l * 5 * NMOD * DM;
            pg8::Gemm g{(const bf16_t*)(ws + WS_MIX), WB + WL_OUT, RL, DM, DM}; pg8::StaticOrder S; S.init(RL, DM, G, BLK());
            EpiRes E{kp->out, (float*)(ws + WS_XC), l == 0 ? kp->in[0] : (const float*)kp->out, l == 0 ? kp->in[2] : (const float*)(ws + WS_XC), modl + 2 * DM, (float*)(ws + WS_RSQ2), (bf16_t*)(ws + WS_XG), kp->in[5] + l * DM, modl + 4 * DM, 1, 0};
            pg8::gemm_phase(lds, xl, g, S, E);
        }
        GRID_BAR(pb + PH_G4);
        if (IN(pb + PH_G5)) {
            KargPtr kp = KARG(); unsigned char* ws = kp->ws; const bf16_t* WB = (const bf16_t*)(ws + WS_WB + (size_t)l * 22 * MiB); const int G = gridDim.x;
            pg8::Gemm g{(const bf16_t*)(ws + WS_XG), WB + WL_GU, RL, 2 * DFF, DM}; pg8::StaticOrder S; S.init(RL, 2 * DFF, G, BLK());
            EpiGU E{(bf16_t*)(ws + WS_ACT), (const float*)(ws + WS_RSQ2), (const float*)(ws + WS_BIAS2P) + (size_t)l * 5 * 2 * DFF};
            pg8::gemm_phase(lds, xl, g, S, E);
            if (l == 0) {
                const float* modl = (const float*)(ws + WS_MOD) + (size_t)l * 5 * NMOD * DM;
                pg8::Gemm g4{(const bf16_t*)(ws + WS_MIX), WB + WL_OUT, R, DM, DM}; pg8::ListOrder S4{G - NCTXU, NCTXU, 16, 64, 4, 0};
                EpiRes E4{kp->out, (float*)(ws + WS_XC), kp->in[0], kp->in[2], modl + 2 * DM, (float*)(ws + WS_RSQ2), (bf16_t*)(ws + WS_XG), kp->in[5] + l * DM, modl + 4 * DM, 1, 0};
                pg8::gemm_phase(lds, xl, g4, S4, E4);
                const int nun5 = (RL / 256) * 22, rem = nun5 % G; const int lo = (rem > 0 && rem < G - NCTXU) ? rem : 0;
                if ((int)blockIdx.x >= lo && (int)blockIdx.x < G - NCTXU) { int tid_ = threadIdx.x; asm volatile("" : "+v"(tid_)); weight_prep(kp, ws, l + 1, (int)blockIdx.x - lo, G - NCTXU - lo, lds, tid_, 3); }
            }
        }
        GRID_BAR(pb + PH_G5);
        if (IN(pb + PH_G6)) {
            KargPtr kp = KARG(); unsigned char* ws = kp->ws; const bf16_t* WB = (const bf16_t*)(ws + WS_WB + (size_t)l * 22 * MiB); const int G = gridDim.x;
            const float* MOD = (const float*)(ws + WS_MOD); const float* modl = MOD + (size_t)l * 5 * NMOD * DM;
            pg8::Gemm g{(const bf16_t*)(ws + WS_ACT), WB + WL_DN, RL, DM, DFF}; pg8::StaticOrder S; S.init(RL, DM, G, BLK());
            const int nx = l + 1 < DEPTH;
            EpiRes E{kp->out, (float*)(ws + WS_XC), (const float*)kp->out, (const float*)(ws + WS_XC), modl + 5 * DM, (float*)(ws + WS_RSQ1), (bf16_t*)(ws + WS_XG), kp->in[4] + (nx ? (l + 1) * DM : 0), MOD + (size_t)(nx ? l + 1 : 0) * 5 * NMOD * DM + 1 * DM, nx, 0};
            pg8::gemm_phase(lds, xl, g, S, E);
            if (nx) {
                const int n5 = 88 < G ? 88 : G;
                pg8::Gemm g5{(const bf16_t*)(ws + WS_XG), WB + WL_GU, R, 2 * DFF, DM}; pg8::ListOrder S5{0, n5, 88, 64, 4, 0};
                EpiGU E5{(bf16_t*)(ws + WS_ACT), (const float*)(ws + WS_RSQ2), (const float*)(ws + WS_BIAS2P) + (size_t)l * 5 * 2 * DFF};
                pg8::gemm_phase(lds, xl, g5, S5, E5);
                const int lo = n5 < G ? n5 : 0;
                if ((int)blockIdx.x >= lo) { int tid_ = threadIdx.x; asm volatile("" : "+v"(tid_)); bias_items(ws, l + 1, (int)blockIdx.x - lo, G - lo, tid_, 3); }
            }
        }
        GRID_BAR(pb + PH_G6);
    }
#undef IN
}

extern "C" void kernel_launch(void* const* d_in, const int* in_sizes, int n_in, void* d_out, int out_size, void* d_ws, size_t ws_size, hipStream_t stream) {
    if (n_in != 23 || ws_size < 256 * MiB || out_size != RL * DM) { fprintf(stderr, "kernel_launch: unexpected shapes (n_in %d, out %d, ws %zu)\n", n_in, out_size, ws_size); return; }
    unsigned char* ws = (unsigned char*)d_ws;
    static int grid = 0;
    if (grid == 0) {
        int dev = 0, cus = 0, per_cu = 0;
        if (hipGetDevice(&dev) != hipSuccess || hipDeviceGetAttribute(&cus, hipDeviceAttributeMultiprocessorCount, dev) != hipSuccess) { fprintf(stderr, "device query failed\n"); return; }
        if (hipFuncSetAttribute((const void*)mk_fwd, hipFuncAttributeMaxDynamicSharedMemorySize, MK_LDS) != hipSuccess) { fprintf(stderr, "hipFuncSetAttribute failed\n"); return; }
        if (hipOccupancyMaxActiveBlocksPerMultiprocessor(&per_cu, (const void*)mk_fwd, 512, MK_LDS) != hipSuccess || per_cu < 1) { fprintf(stderr, "occupancy query: %d\n", per_cu); (void)hipGetLastError(); return; }
        if (cus < 64) { fprintf(stderr, "kernel_launch: %d CUs: the phase program needs at least 64 workgroups\n", cus); return; }
        grid = cus;
    }
    MkArgs ma{}; for (int i = 0; i < 23; ++i) ma.in[i] = (const float*)d_in[i]; ma.out = (float*)d_out; ma.ws = ws;
#define MK(lo, hi) do { ma.ph_lo = (lo); ma.ph_hi = (hi); hipLaunchKernelGGL(mk_fwd, dim3(grid), dim3(512), MK_LDS, stream, ma); } while (0)
    if (hipMemsetAsync(ws, 0, 65536, stream) != hipSuccess) { fprintf(stderr, "memset failed\n"); return; }
    MK(0, PH_END);
}
```

```cpp
#include <hip/hip_runtime.h>
#include <cstdint>
#include <cstdio>

constexpr int DM = 1024, NB = 4, SEQ = 4096, CTXL = 256, DEPTH = 2;
constexpr int RL = NB * SEQ;
constexpr int RC = NB * CTXL;
constexpr int R = RL + RC;
constexpr int WA = 256, DIN = 1184, DFF = 2816, NMOD = 6;
constexpr int NH = 8, QKH = 96, QKN = 64, QKR = 32, VD = 64, QRANK = 256, KVRANK = 128;
constexpr int NKEY = CTXL + SEQ;
constexpr float EPS = 1e-6f;
constexpr float QSCALE = 0.10206207261596577f * 1.4426950408889634f;

typedef unsigned short bf16_t;
__device__ __forceinline__ float bf2f(bf16_t v) { return __uint_as_float(((unsigned)v) << 16); }
__device__ __forceinline__ bf16_t f2bf(float f) { unsigned u = __float_as_uint(f); return (bf16_t)((u + 0x7fffu + ((u >> 16) & 1u)) >> 16); }
__device__ __forceinline__ int mrow_of(int r) { return r < RL ? (r >> 12) : 4; }
__device__ __forceinline__ float wave_sum(float v) {
#pragma unroll
    for (int o = 1; o < 64; o <<= 1) v += __shfl_xor(v, o);
    return v;
}
__device__ __forceinline__ float silu_f(float x) { return x / (1.f + __expf(-x)); }
__device__ __forceinline__ float gelu_f(float x) { return 0.5f * x * (1.f + erff(x * 0.70710678118654752f)); }

constexpr size_t MiB = 1u << 20;
constexpr size_t WS_MOD = 1 * MiB;
constexpr size_t WS_BIAS1 = WS_MOD + 256 * 1024;
constexpr size_t WS_BIAS2 = WS_BIAS1 + 64 * 1024;
constexpr size_t WS_ROPE = WS_BIAS2 + 256 * 1024;
constexpr size_t WS_RSQ1 = 2 * MiB;
constexpr size_t WS_RSQ2 = 2 * MiB + 512 * 1024;
constexpr size_t WS_XC = 4 * MiB;
constexpr size_t WS_XG = 8 * MiB;
constexpr size_t WS_MIX = 42 * MiB;
constexpr size_t WS_W = 76 * MiB;
constexpr size_t WS_OV = 120 * MiB;
constexpr size_t WS_ACT = WS_OV;
constexpr size_t WS_U = WS_OV;
constexpr size_t WS_VT = WS_U + (size_t)R * 256 * 2;
constexpr size_t WS_BW = WS_VT + (size_t)R * 256 * 2;
constexpr size_t WS_QA = WS_BW + (size_t)R * 256 * 2;
constexpr size_t WS_KVA = WS_QA + (size_t)R * 256 * 2;
constexpr size_t WS_KR = WS_KVA + (size_t)R * 128 * 2;
constexpr size_t WS_Q = 161 * MiB;
constexpr size_t WS_K = WS_Q + (size_t)R * 768 * 2;
constexpr size_t WS_V = WS_K + (size_t)NB * NH * NKEY * QKH * 2;
constexpr size_t WS_P = 161 * MiB;
static_assert(WS_KR + (size_t)R * 32 * 4 <= WS_Q, "map");
static_assert(WS_V + (size_t)NB * NH * NKEY * VD * 2 <= 256 * MiB, "map");
static_assert(WS_P + (size_t)R * DIN * 4 <= 256 * MiB, "map");
static_assert(WS_ACT + (size_t)R * DFF * 2 <= 256 * MiB, "map");

__device__ __forceinline__ void sincos_d(double x, double& s, double& c) {
    const double k = rint(x * 0.63661977236758134308); const double r = fma(-k, 1.5707963267948966192, x) - k * 6.123233995736766e-17;
    const double r2 = r * r;
    double sp = -7.6471637318198164759e-13; sp = sp * r2 + 1.6059043836821614599e-10; sp = sp * r2 - 2.5052108385441718775e-08; sp = sp * r2 + 2.7557319223985890653e-06; sp = sp * r2 - 1.9841269841269841270e-04; sp = sp * r2 + 8.3333333333333333333e-03; sp = sp * r2 - 1.6666666666666666667e-01; sp = r + r * r2 * sp;
    double cp = 4.7794773323873852974e-14; cp = cp * r2 - 1.1470745597729724714e-11; cp = cp * r2 + 2.0876756987868098979e-09; cp = cp * r2 - 2.7557319223985890653e-07; cp = cp * r2 + 2.4801587301587301587e-05; cp = cp * r2 - 1.3888888888888888889e-03; cp = cp * r2 + 4.1666666666666666667e-02; cp = cp * r2 - 0.5; cp = 1.0 + r2 * cp;
    const int q = ((int)k) & 3;
    s = (q == 0) ? sp : (q == 1) ? cp : (q == 2) ? -sp : -cp;
    c = (q == 0) ? cp : (q == 1) ? -sp : (q == 2) ? -cp : sp;
}
__device__ __forceinline__ float rstd_of(const float* RSQ, int r) { const float4 p = *(const float4*)(RSQ + (size_t)r * 4); return rsqrtf(((p.x + p.y) + (p.z + p.w)) * (1.f / DM) + EPS); }

#define LAS __attribute__((address_space(3)))
#define GAS __attribute__((address_space(1)))
typedef short bf16x8 __attribute__((ext_vector_type(8)));
typedef float f32x4 __attribute__((ext_vector_type(4)));
typedef float f32x2 __attribute__((ext_vector_type(2)));
typedef unsigned u32x4 __attribute__((ext_vector_type(4)));
typedef unsigned u32x2 __attribute__((ext_vector_type(2)));
__device__ __forceinline__ unsigned cvt_pk_bf16(float lo, float hi) { unsigned r; asm volatile("v_cvt_pk_bf16_f32 %0, %1, %2" : "=v"(r) : "v"(lo), "v"(hi)); return r; }
__device__ __forceinline__ float fast_silu(float x) { return x * __builtin_amdgcn_rcpf(1.f + __builtin_amdgcn_exp2f(-1.4426950408889634f * x)); }

constexpr size_t WL_IN = 0;
constexpr size_t WL_OUT = WL_IN + (size_t)1280 * 1024;
constexpr size_t WL_GU = WL_OUT + (size_t)1024 * 1024;
constexpr size_t WL_DN = WL_GU + (size_t)5632 * 1024;
constexpr size_t WL_QB = WL_DN + (size_t)1024 * 2816;
constexpr size_t WL_KVB = WL_QB + (size_t)768 * 256;
constexpr size_t WL_SP = WL_KVB + (size_t)1024 * 128;
constexpr size_t WL_END = WL_SP + (size_t)4 * 128 * 128;
static_assert(WL_END * 2 <= 22 * MiB, "weights per layer");
constexpr size_t WS_WB = WS_W;
constexpr size_t WS_BIAS2P = 3 * MiB;
constexpr size_t WS_BIAS1P = 3 * MiB + 256 * 1024;

namespace pg8 {
constexpr int BM = 256, BK = 64, HALF = 128, HTB = HALF * BK * 2, STAGE_BYTES = 8 * HTB, NXCD = 8, WGM = 4;
__host__ __device__ __forceinline__ int lds_byte(int r, int c) { const int st = (r >> 4) * 2 + (c >> 5), rr = r & 15, cc = c & 31, ob = rr * 64 + cc * 2; return st * 1024 + (ob ^ (((ob >> 9) & 1) << 5)); }
__host__ __device__ __forceinline__ void stage_rc(int b, int& Rr, int& C) { const int st = b / 1024, sb = b % 1024, swz = sb ^ (((sb >> 9) & 1) << 5); Rr = (st >> 1) * 16 + swz / 64; C = (st & 1) * 32 + (swz % 64) / 2; }
__host__ __device__ __forceinline__ int perm32(int rho) { const int n = rho >> 4, i = rho & 15; return 8 * (i >> 2) + 4 * n + (i & 3); }
struct Unit { int pm, pn; };
struct Gemm { const bf16_t* A; const bf16_t* Bt; int M, N, K; };
struct ListOrder {
    int cu0, ncu, nunits, base_pm, npm, base_pn;
    __device__ bool next(int i, Unit& u) const {
        const int j = (int)blockIdx.x - cu0; if (j < 0 || j >= ncu) return false;
        const int idx = i * ncu + j; if (idx >= nunits) return false;
        u.pm = base_pm + idx % npm; u.pn = base_pn + idx / npm; return true;
    }
};
struct StaticOrder {
    int nM, nN, nwg, G, c;
    __device__ void init(int M, int N, int G_, int c_) { nM = M / BM; nN = N / BM; nwg = nM * nN; G = G_; c = c_; }
    __device__ bool next(int i, Unit& u) const {
        if (c < 0) return false; const long L = (long)i * G + c; if (L >= nwg) return false;
        int wgid = (int)L; { const int q = nwg / NXCD, r = nwg % NXCD, xcd = wgid % NXCD, off = wgid / NXCD; wgid = (xcd < r ? xcd * (q + 1) : r * (q + 1) + (xcd - r) * q) + off; }
        const int nig = WGM * nN, gid = wgid / nig, fm = gid * WGM, gsz = (nM - fm) < WGM ? (nM - fm) : WGM;
        u.pm = fm + ((wgid % nig) % gsz); u.pn = (wgid % nig) / gsz; return true;
    }
};
template <class Epi, class Sched>
__device__ __forceinline__ void gemm_phase(LAS unsigned char* lds, LAS unsigned char* xl, const Gemm g, const Sched& S, const Epi& E) {
    int tid = threadIdx.x; asm volatile("" : "+v"(tid));
    const int wid = __builtin_amdgcn_readfirstlane(tid >> 6), lane = tid & 63, wr = wid >> 2, wc = wid & 3, fr = lane & 15, fq = lane >> 4;
    const int K = g.K, nt = K / BK;
    unsigned voffA[2], voffB[2];
#pragma unroll
    for (int i = 0; i < 2; ++i) { int Rr, C; stage_rc(tid * 16 + i * 8192, Rr, C); const int Rb = (Rr & ~31) + perm32(Rr & 31);
        voffA[i] = (unsigned)(Rr * K + C) * 2u; voffB[i] = (unsigned)(Rb * K + C) * 2u; }
    const size_t kstep = (size_t)(BK * 2);
    const size_t hstep = (size_t)HALF * K * 2;
    const size_t tstep = 2 * hstep;
    const unsigned ldsw = (unsigned)wid * 1024u;
    const int aoff = lds_byte(wr * 64 + fr, fq * 8), boff = lds_byte(wc * 32 + fr, fq * 8);
#define PG8_SA(b, h) (((b) * 2 + (h)) * HTB)
#define PG8_SB(b, h) ((4 + (b) * 2 + (h)) * HTB)
#define PG8_STAGE(bufoff, gbase, voff) do { _Pragma("unroll") for (int _i = 0; _i < 2; ++_i) \
        __builtin_amdgcn_global_load_lds((const unsigned*)((const char*)(gbase) + (voff)[_i]), (LAS unsigned*)(lds + (bufoff) + ldsw + _i * 8192), 16, 0, 0); } while (0)
#define PG8_LDA(dst, b, h) do { _Pragma("unroll") for (int m = 0; m < 4; ++m) _Pragma("unroll") for (int k = 0; k < 2; ++k) dst[m][k] = *(const LAS bf16x8*)(lds + PG8_SA(b, h) + aoff + m * 2048 + k * 1024); } while (0)
#define PG8_LDB(dst, b, h) do { _Pragma("unroll") for (int n = 0; n < 2; ++n) _Pragma("unroll") for (int k = 0; k < 2; ++k) dst[n][k] = *(const LAS bf16x8*)(lds + PG8_SB(b, h) + boff + n * 2048 + k * 1024); } while (0)
#define PG8_MMA(ai, bj, At, Bt) do { __builtin_amdgcn_s_setprio(1); _Pragma("unroll") for (int m = 0; m < 4; ++m) _Pragma("unroll") for (int n = 0; n < 2; ++n) _Pragma("unroll") for (int k = 0; k < 2; ++k) \
        acc[ai][bj][m][n] = __builtin_amdgcn_mfma_f32_16x16x32_bf16(Bt[n][k], At[m][k], acc[ai][bj][m][n], 0, 0, 0); __builtin_amdgcn_s_setprio(0); } while (0)
#define PG8_WAIT_V(n) asm volatile("s_waitcnt vmcnt(" #n ")" ::: "memory")
#define PG8_WAIT_L(n) asm volatile("s_waitcnt lgkmcnt(" #n ")" ::: "memory")
#define PG8_BAR __builtin_amdgcn_s_barrier()
#define PG8_SCHED __builtin_amdgcn_sched_barrier(0)
    Unit cur, nxt; int ui = 0;
    if (!S.next(0, cur)) return;
    f32x4 acc[2][2][4][2];
#pragma unroll
    for (int a = 0; a < 2; ++a)
#pragma unroll
        for (int b = 0; b < 2; ++b)
#pragma unroll
            for (int m = 0; m < 4; ++m)
#pragma unroll
                for (int n = 0; n < 2; ++n) acc[a][b][m][n] = (f32x4){0.f, 0.f, 0.f, 0.f};
    bf16x8 At[4][2], B0[2][2], B1[2][2];
    const char* cA = (const char*)g.A + (size_t)cur.pm * tstep; const char* cB = (const char*)g.Bt + (size_t)cur.pn * tstep;
    PG8_STAGE(PG8_SB(0, 0), cB, voffB); PG8_STAGE(PG8_SB(0, 1), cB + hstep, voffB); PG8_STAGE(PG8_SA(0, 0), cA, voffA); PG8_STAGE(PG8_SA(0, 1), cA + hstep, voffA);
    if (wr == 1) PG8_BAR;
    PG8_WAIT_V(2); PG8_BAR;
    PG8_STAGE(PG8_SB(1, 0), cB + kstep, voffB); PG8_STAGE(PG8_SA(1, 0), cA + kstep, voffA); PG8_STAGE(PG8_SB(1, 1), cB + hstep + kstep, voffB);
    PG8_WAIT_V(6); PG8_BAR;
    for (;;) {
        const bool has_next = S.next(ui + 1, nxt);
        const char* nA = has_next ? (const char*)g.A + (size_t)nxt.pm * tstep : cA; const char* nB = has_next ? (const char*)g.Bt + (size_t)nxt.pn * tstep : cB;
        for (int t = 0; t < nt; t += 2) {
            const bool last = (t == nt - 2);
            const char* a1 = cA + (size_t)(t + 1) * kstep;
            const char* a2 = last ? nA : cA + (size_t)(t + 2) * kstep; const char* b2 = last ? nB : cB + (size_t)(t + 2) * kstep;
            const char* a3 = a2 + kstep; const char* b3 = b2 + kstep;
            PG8_LDB(B0, 0, 0); PG8_LDB(B1, 0, 1); PG8_SCHED; PG8_LDA(At, 0, 0); PG8_STAGE(PG8_SA(1, 1), a1 + hstep, voffA);
            PG8_WAIT_V(8); PG8_WAIT_L(0); PG8_BAR; PG8_MMA(0, 0, At, B0); PG8_MMA(0, 1, At, B1); PG8_BAR; PG8_SCHED;
            PG8_LDA(At, 0, 1); PG8_STAGE(PG8_SB(0, 0), b2, voffB); PG8_STAGE(PG8_SB(0, 1), b2 + hstep, voffB); PG8_STAGE(PG8_SA(0, 0), a2, voffA);
            PG8_WAIT_V(8); PG8_WAIT_L(0); PG8_BAR; PG8_MMA(1, 0, At, B0); PG8_MMA(1, 1, At, B1); PG8_BAR; PG8_SCHED;
            PG8_LDB(B0, 1, 0); PG8_LDB(B1, 1, 1); PG8_SCHED; PG8_LDA(At, 1, 0); PG8_STAGE(PG8_SA(0, 1), a2 + hstep, voffA);
            PG8_WAIT_V(8); PG8_WAIT_L(0); PG8_BAR; PG8_MMA(0, 0, At, B0); PG8_MMA(0, 1, At, B1); PG8_BAR; PG8_SCHED;
            PG8_LDA(At, 1, 1); PG8_STAGE(PG8_SB(1, 0), b3, voffB); PG8_STAGE(PG8_SB(1, 1), b3 + hstep, voffB); PG8_STAGE(PG8_SA(1, 0), a3, voffA);
            PG8_WAIT_V(8); PG8_WAIT_L(0); PG8_BAR; PG8_MMA(1, 0, At, B0); PG8_MMA(1, 1, At, B1); PG8_BAR; PG8_SCHED;
        }
        if (wr == 0) PG8_BAR;
        { int fr_ = fr, fq_ = fq; asm volatile("" : "+v"(fr_), "+v"(fq_)); E(acc, cur, wr, wc, fr_, fq_, xl); }
        if (!has_next) break;
#pragma unroll
        for (int a = 0; a < 2; ++a)
#pragma unroll
            for (int b = 0; b < 2; ++b)
#pragma unroll
                for (int m = 0; m < 4; ++m)
#pragma unroll
                    for (int n = 0; n < 2; ++n) acc[a][b][m][n] = (f32x4){0.f, 0.f, 0.f, 0.f};
        cur = nxt; cA = nA; cB = nB; ++ui;
        if (wr == 1) PG8_BAR;
    }
    PG8_WAIT_V(0);
    PG8_BAR;
#undef PG8_SA
#undef PG8_SB
#undef PG8_STAGE
#undef PG8_LDA
#undef PG8_LDB
#undef PG8_MMA
}
}

__device__ __forceinline__ f32x4 ld4(const float* p) { return *(const f32x4*)p; }
struct EpiGU {
    bf16_t* ACT; const float* RSQ; const float* BIAS;
    __device__ __forceinline__ void operator()(f32x4 (&acc)[2][2][4][2], const pg8::Unit& u, int wr, int wc, int fr, int fq, LAS unsigned char*) const {
        const int row0 = u.pm * 256 + wr * 64 + fr; const int mr = mrow_of(u.pm * 256);
        const float* bb = BIAS + (size_t)mr * (2 * DFF) + u.pn * 256 + wc * 32 + 8 * fq;
        const f32x4 bg0 = ld4(bb), bg1 = ld4(bb + 4), bu0 = ld4(bb + 128), bu1 = ld4(bb + 132);
        bf16_t* ob = ACT + u.pn * 128 + wc * 32 + 8 * fq;
        float rsv[8];
        { f32x4 pq_[8];
#pragma unroll
          for (int q = 0; q < 8; ++q) pq_[q] = ld4(RSQ + (size_t)(row0 + (q >> 2) * 128 + (q & 3) * 16) * 4);
          __builtin_amdgcn_sched_barrier(0);
#pragma unroll
          for (int q = 0; q < 8; ++q) rsv[q] = rsqrtf(((pq_[q][0] + pq_[q][1]) + (pq_[q][2] + pq_[q][3])) * (1.f / DM) + EPS); }
#pragma unroll
        for (int ai = 0; ai < 2; ++ai)
#pragma unroll
            for (int m = 0; m < 4; ++m) { const int row = row0 + ai * 128 + m * 16; const float rs = rsv[ai * 4 + m];
                const f32x4 g0 = acc[ai][0][m][0] * rs + bg0, g1 = acc[ai][0][m][1] * rs + bg1, u0 = acc[ai][1][m][0] * rs + bu0, u1 = acc[ai][1][m][1] * rs + bu1;
                u32x4 w; w.x = cvt_pk_bf16(fast_silu(g0[0]) * u0[0], fast_silu(g0[1]) * u0[1]); w.y = cvt_pk_bf16(fast_silu(g0[2]) * u0[2], fast_silu(g0[3]) * u0[3]);
                w.z = cvt_pk_bf16(fast_silu(g1[0]) * u1[0], fast_silu(g1[1]) * u1[1]); w.w = cvt_pk_bf16(fast_silu(g1[2]) * u1[2], fast_silu(g1[3]) * u1[3]);
                *(u32x4*)(ob + (size_t)row * DFF) = w; }
    }
};
struct EpiRes {
    float* XL; float* XC; const float* XLr; const float* XCr; const float* gate; float* RSQ; bf16_t* XG; const float* ng; const float* nsc; int do_next; int pad;
    __device__ __forceinline__ void operator()(f32x4 (&acc)[2][2][4][2], const pg8::Unit& u, int wr, int wc, int fr, int fq, LAS unsigned char* xl) const {
        const int mr = mrow_of(u.pm * 256); const int col0 = u.pn * 256 + wc * 32 + 8 * fq; const int rl0 = wr * 64 + fr;
        float* xbase = u.pm < 64 ? XL + (size_t)(u.pm * 256) * DM : XC + (size_t)(u.pm * 256 - RL) * DM;
        const float* xrbase = u.pm < 64 ? XLr + (size_t)(u.pm * 256) * DM : XCr + (size_t)(u.pm * 256 - RL) * DM;
        LAS float* P = (LAS float*)xl;
        float ss[8];
#pragma unroll
        for (int q = 0; q < 8; ++q) ss[q] = 0.f;
#pragma unroll
        for (int bj = 0; bj < 2; ++bj) {
            f32x4 gt[2], gm[2];
#pragma unroll
            for (int n = 0; n < 2; ++n) { const int c = col0 + bj * 128 + 4 * n; gt[n] = ld4(gate + (size_t)mr * (NMOD * DM) + c);
                if (do_next) gm[n] = ld4(ng + c) * (ld4(nsc + (size_t)mr * (NMOD * DM) + c) + 1.f); else gm[n] = (f32x4){0.f, 0.f, 0.f, 0.f}; }
#pragma unroll
            for (int ai = 0; ai < 2; ++ai) {
                f32x4 xv[4][2];
#pragma unroll
                for (int m = 0; m < 4; ++m) { const unsigned off = (unsigned)((rl0 + ai * 128 + m * 16) * DM + col0 + bj * 128) * 4u;
                    const float* xp = (const float*)((const char*)xrbase + off); xv[m][0] = ld4(xp); xv[m][1] = ld4(xp + 4); }
#pragma unroll
                for (int m = 0; m < 4; ++m) { const int q = ai * 4 + m; const int rl = rl0 + ai * 128 + m * 16; const unsigned off = (unsigned)(rl * DM + col0 + bj * 128) * 4u; float* xp = (float*)((char*)xbase + off);
                    const f32x4 y0 = xv[m][0] + gt[0] * acc[ai][bj][m][0], y1 = xv[m][1] + gt[1] * acc[ai][bj][m][1];
                    *(f32x4*)(xp) = y0; *(f32x4*)(xp + 4) = y1;
                    if (do_next) { ss[q] += (y0[0] * y0[0] + y0[1] * y0[1]) + (y0[2] * y0[2] + y0[3] * y0[3]) + (y1[0] * y1[0] + y1[1] * y1[1]) + (y1[2] * y1[2] + y1[3] * y1[3]);
                        const f32x4 z0 = y0 * gm[0], z1 = y1 * gm[1]; u32x4 w; w.x = cvt_pk_bf16(z0[0], z0[1]); w.y = cvt_pk_bf16(z0[2], z0[3]); w.z = cvt_pk_bf16(z1[0], z1[1]); w.w = cvt_pk_bf16(z1[2], z1[3]);
                        *(u32x4*)((char*)(XG + (size_t)(u.pm * 256) * DM) + (off >> 1)) = w; } }
                asm volatile("" ::: "memory");
            }
        }
        if (do_next) {
#pragma unroll
            for (int q = 0; q < 8; ++q) { float t = ss[q]; t += __shfl_xor(t, 16); t += __shfl_xor(t, 32); if (fq == 0) P[(rl0 + (q >> 2) * 128 + (q & 3) * 16) * 4 + wc] = t; }
        }
        if (do_next) {
            asm volatile("s_waitcnt lgkmcnt(0)" ::: "memory"); __builtin_amdgcn_s_barrier(); asm volatile("" ::: "memory");
            const int tid = threadIdx.x;
            if (tid < 256) { const f32x4 p = *(const LAS f32x4*)(P + tid * 4); RSQ[(size_t)(u.pm * 256 + tid) * 4 + u.pn] = (p[0] + p[1]) + (p[2] + p[3]); }
        }
    }
};


__device__ __forceinline__ float gelu_fast(float v) {
    const float av = fabsf(v), d = av * 0.2316418882f + 1.0f, t = __builtin_amdgcn_rcpf(d);
    float q = t * 0.5307027145f + (-0.7265760135f); q = q * t + 0.7107068705f; q = q * t + (-0.142248368f); q = q * t + 0.127414796f; q = q * t;
    const float e = __builtin_amdgcn_exp2f((v * v) * (-0.72134752044f));
    const float m = v * (q * e), r = v - m; return v < 0.f ? m : r;
}
struct EpiG1 {
    const float* RSQ; const float* BIAS; const float* sgu_g; const float* qa_g; const float* kva_g;
    bf16_t* U; bf16_t* VT; bf16_t* BW; bf16_t* QA; bf16_t* KVA; float* KR;
#define G1_PACK(v0, v1) (u32x4){cvt_pk_bf16((v0)[0], (v0)[1]), cvt_pk_bf16((v0)[2], (v0)[3]), cvt_pk_bf16((v1)[0], (v1)[1]), cvt_pk_bf16((v1)[2], (v1)[3])}
#define G1_SS(v) (((v)[0] * (v)[0] + (v)[1] * (v)[1]) + ((v)[2] * (v)[2] + (v)[3] * (v)[3]))
    __device__ __forceinline__ void operator()(f32x4 (&acc)[2][2][4][2], const pg8::Unit& u, int wr, int wc, int fr, int fq, LAS unsigned char* xl) const {
        const int mr = mrow_of(u.pm * 256); const int cl = wc * 32 + 8 * fq; const int rl0 = wr * 64 + fr; const int pn = u.pn;
        LAS float* P = (LAS float*)xl;
        {   f32x4 bv[2][2];
#pragma unroll
            for (int bj = 0; bj < 2; ++bj)
#pragma unroll
                for (int n = 0; n < 2; ++n) bv[bj][n] = ld4(BIAS + (size_t)mr * 1280 + pn * 256 + bj * 128 + cl + 4 * n);
            const bool act = (pn <= 1);
            float rsv[8];
            { f32x4 pq_[8];
#pragma unroll
              for (int q = 0; q < 8; ++q) pq_[q] = ld4(RSQ + (size_t)(u.pm * 256 + rl0 + (q >> 2) * 128 + (q & 3) * 16) * 4);
              __builtin_amdgcn_sched_barrier(0);
#pragma unroll
              for (int q = 0; q < 8; ++q) rsv[q] = rsqrtf(((pq_[q][0] + pq_[q][1]) + (pq_[q][2] + pq_[q][3])) * (1.f / DM) + EPS); }
#pragma unroll
            for (int ai = 0; ai < 2; ++ai)
#pragma unroll
                for (int m = 0; m < 4; ++m) { const float rs = rsv[ai * 4 + m];
#pragma unroll
                    for (int bj = 0; bj < 2; ++bj)
#pragma unroll
                        for (int n = 0; n < 2; ++n) { f32x4 v = acc[ai][bj][m][n] * rs + bv[bj][n];
                            if (act) v = (f32x4){gelu_fast(v[0]), gelu_fast(v[1]), gelu_fast(v[2]), gelu_fast(v[3])};
                            acc[ai][bj][m][n] = v; }
                    if (m & 1) asm volatile("" ::: "memory"); }
        }
        if (pn == 0) {
#pragma unroll
            for (int ai = 0; ai < 2; ++ai)
#pragma unroll
                for (int m = 0; m < 4; ++m) { const int row = u.pm * 256 + rl0 + ai * 128 + m * 16;
#pragma unroll
                    for (int bj = 0; bj < 2; ++bj) *(u32x4*)(U + (size_t)row * 256 + bj * 128 + cl) = G1_PACK(acc[ai][bj][m][0], acc[ai][bj][m][1]); }
            return;
        }
        if (pn == 2) {
#pragma unroll
            for (int ai = 0; ai < 2; ++ai)
#pragma unroll
                for (int m = 0; m < 4; ++m) { const int row = u.pm * 256 + rl0 + ai * 128 + m * 16;
#pragma unroll
                    for (int bj = 0; bj < 2; ++bj) *(u32x4*)(BW + (size_t)row * 256 + bj * 128 + cl) = G1_PACK(acc[ai][bj][m][0], acc[ai][bj][m][1]); }
            return;
        }
#pragma unroll
        for (int ai = 0; ai < 2; ++ai)
#pragma unroll
            for (int m = 0; m < 4; ++m) { float ss = G1_SS(acc[ai][0][m][0]) + G1_SS(acc[ai][0][m][1]);
                if (pn != 4) ss += G1_SS(acc[ai][1][m][0]) + G1_SS(acc[ai][1][m][1]);
                ss += __shfl_xor(ss, 16); ss += __shfl_xor(ss, 32);
                if (fq == 0) P[(rl0 + ai * 128 + m * 16) * 4 + wc] = ss; }
        asm volatile("s_waitcnt lgkmcnt(0)" ::: "memory"); __builtin_amdgcn_s_barrier(); asm volatile("" ::: "memory");
        if (pn == 1) {
#pragma unroll
            for (int bj = 0; bj < 2; ++bj) { const f32x4 g0 = ld4(sgu_g + bj * 128 + cl), g1 = ld4(sgu_g + bj * 128 + cl + 4);
#pragma unroll
                for (int ai = 0; ai < 2; ++ai)
#pragma unroll
                    for (int m = 0; m < 4; ++m) { const int rl = rl0 + ai * 128 + m * 16; const int row = u.pm * 256 + rl;
                        const f32x4 p = *(const LAS f32x4*)(P + rl * 4); const float rn = rsqrtf(((p[0] + p[1]) + (p[2] + p[3])) * (1.f / 256.f) + EPS);
                        const f32x4 v0 = acc[ai][bj][m][0] * rn * g0, v1 = acc[ai][bj][m][1] * rn * g1;
                        const int jrow = row & 127; bf16_t* vt = VT + ((((size_t)(row >> 7) * 8 + ((bj * 128 + cl) >> 5)) * 8 + (jrow >> 4)) * 64 + ((jrow >> 3) & 1) * 32 + ((bj * 128 + cl) & 31)) * 8 + (jrow & 7);
#pragma unroll
                        for (int i = 0; i < 4; ++i) { vt[(size_t)i * 8] = (bf16_t)(cvt_pk_bf16(v0[i], 0.f) & 0xffffu); vt[(size_t)(4 + i) * 8] = (bf16_t)(cvt_pk_bf16(v1[i], 0.f) & 0xffffu); } } }
        } else if (pn == 3) {
#pragma unroll
            for (int bj = 0; bj < 2; ++bj) { const f32x4 g0 = ld4(qa_g + bj * 128 + cl), g1 = ld4(qa_g + bj * 128 + cl + 4);
#pragma unroll
                for (int ai = 0; ai < 2; ++ai)
#pragma unroll
                    for (int m = 0; m < 4; ++m) { const int rl = rl0 + ai * 128 + m * 16; const int row = u.pm * 256 + rl;
                        const f32x4 p = *(const LAS f32x4*)(P + rl * 4); const float rn = rsqrtf(((p[0] + p[1]) + (p[2] + p[3])) * (1.f / 256.f) + EPS);
                        const f32x4 v0 = acc[ai][bj][m][0] * rn * g0, v1 = acc[ai][bj][m][1] * rn * g1;
                        { const int c8 = bj * 16 + wc * 4 + fq; *(u32x4*)(QA + ((((size_t)(row >> 5) * 16 + (c8 >> 1)) * 64 + (c8 & 1) * 32 + (row & 31)) * 8)) = G1_PACK(v0, v1); } } }
        } else {
            const f32x4 g0 = ld4(kva_g + cl), g1 = ld4(kva_g + cl + 4);
#pragma unroll
            for (int ai = 0; ai < 2; ++ai)
#pragma unroll
                for (int m = 0; m < 4; ++m) { const int rl = rl0 + ai * 128 + m * 16; const int row = u.pm * 256 + rl;
                    const f32x4 p = *(const LAS f32x4*)(P + rl * 4); const float rn = rsqrtf(((p[0] + p[1]) + (p[2] + p[3])) * (1.f / 128.f) + EPS);
                    const f32x4 v0 = acc[ai][0][m][0] * rn * g0, v1 = acc[ai][0][m][1] * rn * g1;
                    { const int c8 = wc * 4 + fq; *(u32x4*)(KVA + ((((size_t)(row >> 5) * 8 + (c8 >> 1)) * 64 + (c8 & 1) * 32 + (row & 31)) * 8)) = G1_PACK(v0, v1); }
                    if (wc == 0) { *(f32x4*)(KR + (size_t)row * 32 + 8 * fq) = acc[ai][1][m][0]; *(f32x4*)(KR + (size_t)row * 32 + 8 * fq + 4) = acc[ai][1][m][1]; } }
        }
    }
#undef G1_PACK
#undef G1_SS
};


namespace att {
using s16x4 = __attribute__((ext_vector_type(4))) short;
using f32x16 = __attribute__((ext_vector_type(16))) float;
constexpr int KROW = 208;
constexpr int NBUF = 3, SHM_V = 64 * 64 * 2, SHM_K = 64 * KROW, OFF_K = NBUF * SHM_V, OFF_WS = OFF_K + NBUF * SHM_K, SHM_ATTN = OFF_WS + 8 * 64 * 4;
#define ASBAR() __builtin_amdgcn_sched_barrier(0)
__device__ __forceinline__ int crow(int r, int hi) { return (r & 3) + 8 * (r >> 2) + 4 * hi; }
__device__ __forceinline__ int v_st(int k, int c) { const int kk = (k & ~0xC) | ((k & 4) << 1) | ((k & 8) >> 1); return ((kk >> 3) * 2 + (c >> 5)) * 512 + ((kk & 7) * 32 + (c & 31)) * 2; }
__device__ __forceinline__ int v_rd_base(int lane) { return ((lane & 3) << 3) | (((lane >> 2) & 3) << 6) | (((lane >> 4) & 1) << 5) | (((lane >> 5) & 1) << 8); }
constexpr int v_rd_off(int d0, int ks, int half) { return d0 * 512 + ks * 2048 + half * 1024; }
template <int OFF> __device__ __forceinline__ s16x4 tr_read(int vb) { s16x4 r; asm volatile("ds_read_b64_tr_b16 %0, %1 offset:%2" : "=&v"(r) : "v"(vb), "i"(OFF) : "memory"); return r; }
__device__ __forceinline__ void partialSM(f32x16& p0, f32x16& p1) {
#pragma unroll
    for (int r = 0; r < 16; ++r) p0[r] = __builtin_amdgcn_exp2f(p0[r]);
}
__device__ __forceinline__ void finishSM(f32x16& p0, f32x16& p1, float& l_reg, bf16x8& pa0, bf16x8& pa1, bf16x8& pa2, bf16x8& pa3) {
#pragma unroll
    for (int r = 0; r < 16; ++r) p1[r] = __builtin_amdgcn_exp2f(p1[r]);
    f32x2 s2a = {p0[0], p0[1]}, s2b = {p1[0], p1[1]};
#pragma unroll
    for (int r = 2; r < 16; r += 2) { s2a += (f32x2){p0[r], p0[r + 1]}; s2b += (f32x2){p1[r], p1[r + 1]}; }
    s2a += s2b; l_reg += s2a[0] + s2a[1];
#define PK4(P, BASE, OUT) do { unsigned a0 = cvt_pk_bf16(P[BASE + 0], P[BASE + 1]), a1 = cvt_pk_bf16(P[BASE + 2], P[BASE + 3]);   \
    unsigned b0 = cvt_pk_bf16(P[BASE + 4], P[BASE + 5]), b1 = cvt_pk_bf16(P[BASE + 6], P[BASE + 7]);                              \
    auto r0 = __builtin_amdgcn_permlane32_swap(a0, b0, false, false); auto r1 = __builtin_amdgcn_permlane32_swap(a1, b1, false, false); \
    u32x4 w = {r0[0], r1[0], r0[1], r1[1]}; OUT = *reinterpret_cast<bf16x8*>(&w); } while (0)
    PK4(p0, 0, pa0); PK4(p0, 8, pa1); PK4(p1, 0, pa2); PK4(p1, 8, pa3);
#undef PK4
}
__device__ __forceinline__ void qkt(f32x16& p0, f32x16& p1, LAS const unsigned char* Ks, const bf16x8 (&qr)[6], int r32, int hi) {
    p0 = f32x16{}; p1 = f32x16{};
#pragma unroll
    for (int d0 = 0; d0 < 6; ++d0) {
        const bf16x8 b0 = *(LAS const bf16x8*)(Ks + r32 * KROW + d0 * 32 + hi * 16);
        const bf16x8 b1 = *(LAS const bf16x8*)(Ks + (32 + r32) * KROW + d0 * 32 + hi * 16);
        p0 = __builtin_amdgcn_mfma_f32_32x32x16_bf16(b0, qr[d0], p0, 0, 0, 0);
        p1 = __builtin_amdgcn_mfma_f32_32x32x16_bf16(b1, qr[d0], p1, 0, 0, 0); }
}
template <int D0> __device__ __forceinline__ void pv_one(f32x16& od, int vb, bf16x8 pa0, bf16x8 pa1, bf16x8 pa2, bf16x8 pa3) {
    const s16x4 l0 = tr_read<v_rd_off(D0, 0, 0)>(vb), h0 = tr_read<v_rd_off(D0, 0, 1)>(vb), l1 = tr_read<v_rd_off(D0, 1, 0)>(vb), h1 = tr_read<v_rd_off(D0, 1, 1)>(vb);
    const s16x4 l2 = tr_read<v_rd_off(D0, 2, 0)>(vb), h2 = tr_read<v_rd_off(D0, 2, 1)>(vb), l3 = tr_read<v_rd_off(D0, 3, 0)>(vb), h3 = tr_read<v_rd_off(D0, 3, 1)>(vb);
    asm volatile("s_waitcnt lgkmcnt(0)" ::: "memory"); ASBAR();
#define PK(L, H) (bf16x8){L[0], L[1], L[2], L[3], H[0], H[1], H[2], H[3]}
    od = __builtin_amdgcn_mfma_f32_32x32x16_bf16(pa0, PK(l0, h0), od, 0, 0, 0);
    od = __builtin_amdgcn_mfma_f32_32x32x16_bf16(pa1, PK(l1, h1), od, 0, 0, 0);
    od = __builtin_amdgcn_mfma_f32_32x32x16_bf16(pa2, PK(l2, h2), od, 0, 0, 0);
    od = __builtin_amdgcn_mfma_f32_32x32x16_bf16(pa3, PK(l3, h3), od, 0, 0, 0);
#undef PK
}
template <int BASE> __device__ __forceinline__ bf16x8 pack8(const f32x16& P) {
    unsigned a0 = cvt_pk_bf16(P[BASE + 0], P[BASE + 1]), a1 = cvt_pk_bf16(P[BASE + 2], P[BASE + 3]), b0 = cvt_pk_bf16(P[BASE + 4], P[BASE + 5]), b1 = cvt_pk_bf16(P[BASE + 6], P[BASE + 7]);
    auto r0 = __builtin_amdgcn_permlane32_swap(a0, b0, false, false); auto r1 = __builtin_amdgcn_permlane32_swap(a1, b1, false, false);
    u32x4 w = {r0[0], r1[0], r0[1], r1[1]}; return *reinterpret_cast<bf16x8*>(&w);
}
__device__ __forceinline__ void arope(const float* __restrict__ ROPE, int t, int pp, float& x1, float& x2) {
    const int pos = pp < 8 ? (t >> 6) : (t & 63); const f32x2 cs = *(const f32x2*)(ROPE + (pos * 8 + (pp & 7)) * 2);
    const float y1 = x1 * cs[0] - x2 * cs[1], y2 = x1 * cs[1] + x2 * cs[0]; x1 = y1; x2 = y2;
}
__device__ __forceinline__ void attn_unit(const bf16_t* __restrict__ QA, const bf16_t* __restrict__ WQh, const float* __restrict__ qn_g, const float* __restrict__ ROPE, int row0, const bf16_t* __restrict__ Kh, const bf16_t* __restrict__ Vh, bf16_t* __restrict__ Ob, int seq, LAS unsigned char* lds) {
    int tid = threadIdx.x; asm volatile("" : "+v"(tid));
    const int wid = __builtin_amdgcn_readfirstlane(tid >> 6), lane = tid & 63, r32 = lane & 31, hi = lane >> 5;
    LAS float* wsf = (LAS float*)(lds + OFF_WS) + wid * 64; LAS float* li_l = wsf;
    float l_reg = 0; f32x16 o[2] = {}; bf16x8 qr[6];
    const bool isK = wid < 4; const int t = tid & 255;
    const unsigned char* gbase = isK ? (const unsigned char*)Kh : (const unsigned char*)Vh; const int tstride = isK ? 64 * 96 * 2 : 64 * 64 * 2;
    int loff0, loff1, loff2;
    { const int c0 = t, c1 = t + 256, c2 = t + 512;
      loff0 = isK ? (c0 / 12) * KROW + (c0 % 12) * 16 : v_st(c0 >> 3, (c0 & 7) * 8);
      loff1 = isK ? (c1 / 12) * KROW + (c1 % 12) * 16 : v_st(c1 >> 3, (c1 & 7) * 8);
      loff2 = (c2 / 12) * KROW + (c2 % 12) * 16; }
    const int vb0 = (int)(uintptr_t)(lds) + v_rd_base(lane);
    bf16x8 sA0, sA1, sA2, sB0, sB1, sB2;
#define SLOAD(S, tile) do { const unsigned char* p_ = gbase + (size_t)(tile) * tstride + t * 16; S##0 = *(const bf16x8*)(p_); S##1 = *(const bf16x8*)(p_ + 4096); if (isK) S##2 = *(const bf16x8*)(p_ + 8192); } while (0)
#define SWRITE(b, S) do { LAS unsigned char* d_ = lds + (isK ? OFF_K + (b) * SHM_K : (b) * SHM_V); *(LAS bf16x8*)(d_ + loff0) = S##0; *(LAS bf16x8*)(d_ + loff1) = S##1; if (isK) *(LAS bf16x8*)(d_ + loff2) = S##2; } while (0)
    f32x16 pA0, pA1, pB0, pB1; bf16x8 pa0, pa1, pa2, pa3; const int NT = seq / 64;
    int b_prev = 0, b_cur = 1, b_next = 2;
#define ROT3() do { b_prev = b_cur; b_cur = b_next; b_next = (b_next == NBUF - 1) ? 0 : b_next + 1; } while (0)
#define STEP(PC0, PC1, PP0, PP1, SW, SL, i) do { \
        ASBAR(); qkt(PC0, PC1, lds + OFF_K + b_cur * SHM_K, qr, r32, hi); \
        finishSM(PP0, PP1, l_reg, pa0, pa1, pa2, pa3); ASBAR(); \
        if ((i) + 1 < NT) SWRITE(b_next, SW); \
        if ((i) + 2 < NT) SLOAD(SL, (i) + 2); ASBAR(); \
        pv_one<0>(o[0], vb0 + b_prev * SHM_V, pa0, pa1, pa2, pa3); pv_one<1>(o[1], vb0 + b_prev * SHM_V, pa0, pa1, pa2, pa3); partialSM(PC0, PC1); \
        __syncthreads(); ROT3(); } while (0)
    SLOAD(sA, 0);
    {
        f32x16 qa_[3];
#pragma unroll
        for (int b = 0; b < 3; ++b) qa_[b] = f32x16{};
        const bf16_t* ap = QA + ((size_t)((row0 >> 5) + wid) * 16 * 64 + lane) * 8; const bf16_t* wp = WQh + (size_t)lane * 8;
        bf16x8 fr[2][2][4];
#define AQLOAD(S, g) do { _Pragma("unroll") for (int kk = 0; kk < 2; ++kk) { const int ks = 2 * (g) + kk; fr[S][kk][0] = *(const bf16x8*)(ap + (size_t)ks * 512); \
            _Pragma("unroll") for (int b = 0; b < 3; ++b) fr[S][kk][1 + b] = *(const bf16x8*)(wp + (size_t)(b * 16 + ks) * 512); } } while (0)
        AQLOAD(0, 0);
#pragma unroll
        for (int g = 0; g < 8; ++g) {
            if (g + 1 < 8) { if (g & 1) AQLOAD(0, g + 1); else AQLOAD(1, g + 1); }
            __builtin_amdgcn_sched_barrier(0);
#pragma unroll
            for (int kk = 0; kk < 2; ++kk)
#pragma unroll
                for (int b = 0; b < 3; ++b) qa_[b] = __builtin_amdgcn_mfma_f32_32x32x16_bf16(fr[g & 1][kk][1 + b], fr[g & 1][kk][0], qa_[b], 0, 0, 0);
            __builtin_amdgcn_sched_barrier(0);
        }
#undef AQLOAD
        const int row = row0 + wid * 32 + r32; const bool lat = row < RL; const int tq = row & 4095;
        float ss = 0.f;
#pragma unroll
        for (int b = 0; b < 3; ++b)
#pragma unroll
            for (int r = 0; r < 16; ++r) ss += qa_[b][r] * qa_[b][r];
        { auto rr = __builtin_amdgcn_permlane32_swap(__float_as_uint(ss), __float_as_uint(ss), false, false); ss = __uint_as_float(rr[0]) + __uint_as_float(rr[1]); }
        const float rn = rsqrtf(ss * (1.f / 96.f) + EPS) * QSCALE;
#pragma unroll
        for (int b = 0; b < 3; ++b)
#pragma unroll
            for (int rq = 0; rq < 4; ++rq) { const f32x4 g = ld4(qn_g + 32 * b + 8 * rq + 4 * hi);
                float v0 = qa_[b][4 * rq] * rn * g[0], v1 = qa_[b][4 * rq + 1] * rn * g[1], v2 = qa_[b][4 * rq + 2] * rn * g[2], v3 = qa_[b][4 * rq + 3] * rn * g[3];
                if (b == 2 && lat) { const int pp = 4 * rq + 2 * hi; arope(ROPE, tq, pp, v0, v1); arope(ROPE, tq, pp + 1, v2, v3); }
                qa_[b][4 * rq] = v0; qa_[b][4 * rq + 1] = v1; qa_[b][4 * rq + 2] = v2; qa_[b][4 * rq + 3] = v3; }
        qr[0] = pack8<0>(qa_[0]); qr[1] = pack8<8>(qa_[0]); qr[2] = pack8<0>(qa_[1]); qr[3] = pack8<8>(qa_[1]); qr[4] = pack8<0>(qa_[2]); qr[5] = pack8<8>(qa_[2]);
    }
    SWRITE(0, sA); SLOAD(sB, 1); if (2 < NT) SLOAD(sA, 2); __syncthreads();
    qkt(pA0, pA1, lds + OFF_K, qr, r32, hi); partialSM(pA0, pA1);
    SWRITE(1, sB); __syncthreads();
    for (int i = 1; i + 1 < NT; i += 2) {
        STEP(pB0, pB1, pA0, pA1, sA, sB, i);
        STEP(pA0, pA1, pB0, pB1, sB, sA, i + 1);
    }
    ASBAR(); qkt(pB0, pB1, lds + OFF_K + b_cur * SHM_K, qr, r32, hi);
    finishSM(pA0, pA1, l_reg, pa0, pa1, pa2, pa3); ASBAR();
    pv_one<0>(o[0], vb0 + b_prev * SHM_V, pa0, pa1, pa2, pa3); pv_one<1>(o[1], vb0 + b_prev * SHM_V, pa0, pa1, pa2, pa3); partialSM(pB0, pB1);
    finishSM(pB0, pB1, l_reg, pa0, pa1, pa2, pa3); ASBAR();
    pv_one<0>(o[0], vb0 + b_cur * SHM_V, pa0, pa1, pa2, pa3); pv_one<1>(o[1], vb0 + b_cur * SHM_V, pa0, pa1, pa2, pa3);
    { auto rr = __builtin_amdgcn_permlane32_swap(__float_as_uint(l_reg), __float_as_uint(l_reg), false, false); l_reg = __uint_as_float(rr[0]) + __uint_as_float(rr[1]); }
#undef STEP
#undef ROT3
    if (hi == 0) li_l[r32] = l_reg; asm volatile("s_waitcnt lgkmcnt(0)" ::: "memory");
    int hi_e = hi, r32_e = r32; asm volatile("" : "+v"(hi_e), "+v"(r32_e));
    bf16_t* Ow = Ob + (size_t)(wid * 32 + 4 * hi_e) * DM + r32_e;
#pragma unroll
    for (int r = 0; r < 16; ++r) { const int orow = (r & 3) + 8 * (r >> 2); const float rl = __builtin_amdgcn_rcpf(li_l[orow + 4 * hi_e]);
#pragma unroll
        for (int d0 = 0; d0 < 2; ++d0) Ow[(size_t)orow * DM + d0 * 32] = (bf16_t)(cvt_pk_bf16(o[d0][r] * rl, 0.f) & 0xffffu); }
    __syncthreads();
#undef SLOAD
#undef SWRITE
}
#undef ASBAR
}


namespace g2 {
using f32x16 = __attribute__((ext_vector_type(16))) float;
__device__ __forceinline__ int crow(int r, int hi) { return (r & 3) + 8 * (r >> 2) + 4 * hi; }
__device__ __forceinline__ float half_swap_sum(float v) { auto rr = __builtin_amdgcn_permlane32_swap(__float_as_uint(v), __float_as_uint(v), false, false); return __uint_as_float(rr[0]) + __uint_as_float(rr[1]); }
__device__ __forceinline__ void rope_pair(const float* __restrict__ ROPE, int t, int pp, float& x1, float& x2) {
    const int pos = pp < 8 ? (t >> 6) : (t & 63); const f32x2 cs = *(const f32x2*)(ROPE + (pos * 8 + (pp & 7)) * 2);
    const float y1 = x1 * cs[0] - x2 * cs[1], y2 = x1 * cs[1] + x2 * cs[0]; x1 = y1; x2 = y2;
}
template <int NTG>
__device__ __forceinline__ void q_item(const bf16_t* __restrict__ QA, const bf16_t* __restrict__ WQ, const float* __restrict__ qn_g, const float* __restrict__ ROPE, bf16_t* __restrict__ Q, int row0, int h, int lane) {
    const int r32 = lane & 31, hi = lane >> 5;
    f32x16 acc[NTG][3];
#pragma unroll
    for (int tg = 0; tg < NTG; ++tg)
#pragma unroll
        for (int b = 0; b < 3; ++b) acc[tg][b] = f32x16{};
    const bf16_t* wp = WQ + ((size_t)(h * 3) * 16 * 64 + lane) * 8; const bf16_t* ap = QA + ((size_t)(row0 >> 5) * 16 * 64 + lane) * 8;
    bf16x8 fr[2][2][5];
#define G2_QLOAD(S, g) do { _Pragma("unroll") for (int kk = 0; kk < 2; ++kk) { const int ks = 2 * (g) + kk; _Pragma("unroll") for (int tg = 0; tg < NTG; ++tg) fr[S][kk][tg] = *(const bf16x8*)(ap + (size_t)(16 * tg + ks) * 512); \
        _Pragma("unroll") for (int b = 0; b < 3; ++b) fr[S][kk][2 + b] = *(const bf16x8*)(wp + (size_t)(b * 16 + ks) * 512); } } while (0)
    G2_QLOAD(0, 0);
#pragma unroll
    for (int g = 0; g < 8; ++g) {
        if (g + 1 < 8) { if (g & 1) G2_QLOAD(0, g + 1); else G2_QLOAD(1, g + 1); }
        __builtin_amdgcn_sched_barrier(0);
#pragma unroll
        for (int kk = 0; kk < 2; ++kk)
#pragma unroll
            for (int b = 0; b < 3; ++b)
#pragma unroll
                for (int tg = 0; tg < NTG; ++tg) acc[tg][b] = __builtin_amdgcn_mfma_f32_32x32x16_bf16(fr[g & 1][kk][2 + b], fr[g & 1][kk][tg], acc[tg][b], 0, 0, 0);
        __builtin_amdgcn_sched_barrier(0);
    }
#undef G2_QLOAD
#pragma unroll
    for (int tg = 0; tg < NTG; ++tg) { const int row = row0 + tg * 32 + r32; const bool lat = row < RL; const int t = row & 4095;
        float ss = 0.f;
#pragma unroll
        for (int b = 0; b < 3; ++b)
#pragma unroll
            for (int r = 0; r < 16; ++r) ss += acc[tg][b][r] * acc[tg][b][r];
        ss = half_swap_sum(ss); const float rn = rsqrtf(ss * (1.f / 96.f) + EPS) * QSCALE;
        bf16_t* qo = Q + ((size_t)row * NH + h) * QKH + 4 * hi;
#pragma unroll
        for (int b = 0; b < 3; ++b)
#pragma unroll
            for (int rq = 0; rq < 4; ++rq) { const int f0 = 32 * b + 8 * rq + 4 * hi; const f32x4 g = ld4(qn_g + f0);
                float v0 = acc[tg][b][4 * rq] * rn * g[0], v1 = acc[tg][b][4 * rq + 1] * rn * g[1], v2 = acc[tg][b][4 * rq + 2] * rn * g[2], v3 = acc[tg][b][4 * rq + 3] * rn * g[3];
                if (b == 2 && lat) { const int pp = 4 * rq + 2 * hi; rope_pair(ROPE, t, pp, v0, v1); rope_pair(ROPE, t, pp + 1, v2, v3); }
                *(u32x2*)(qo + 32 * b + 8 * rq) = (u32x2){cvt_pk_bf16(v0, v1), cvt_pk_bf16(v2, v3)}; } }
}
__device__ __forceinline__ void kv_item(const bf16_t* __restrict__ KVA, const float* __restrict__ KR, const bf16_t* __restrict__ WKV, const float* __restrict__ kn_g, const float* __restrict__ ROPE,
                                        bf16_t* __restrict__ Kb, bf16_t* __restrict__ Vb, int row0, int h, int lane) {
    const int r32 = lane & 31, hi = lane >> 5;
    f32x16 acc[4];
#pragma unroll
    for (int b = 0; b < 4; ++b) acc[b] = f32x16{};
    const bf16_t* wp = WKV + ((size_t)(h * 4) * 8 * 64 + lane) * 8; const bf16_t* ap = KVA + ((size_t)(row0 >> 5) * 8 * 64 + lane) * 8;
    bf16x8 fr[2][2][5];
#define G2_KLOAD(S, g) do { _Pragma("unroll") for (int kk = 0; kk < 2; ++kk) { const int ks = 2 * (g) + kk; fr[S][kk][0] = *(const bf16x8*)(ap + (size_t)ks * 512); \
        _Pragma("unroll") for (int b = 0; b < 4; ++b) fr[S][kk][1 + b] = *(const bf16x8*)(wp + (size_t)(b * 8 + ks) * 512); } } while (0)
    G2_KLOAD(0, 0);
#pragma unroll
    for (int g = 0; g < 4; ++g) {
        if (g + 1 < 4) { if (g & 1) G2_KLOAD(0, g + 1); else G2_KLOAD(1, g + 1); }
        __builtin_amdgcn_sched_barrier(0);
#pragma unroll
        for (int kk = 0; kk < 2; ++kk)
#pragma unroll
            for (int b = 0; b < 4; ++b) acc[b] = __builtin_amdgcn_mfma_f32_32x32x16_bf16(fr[g & 1][kk][1 + b], fr[g & 1][kk][0], acc[b], 0, 0, 0);
        __builtin_amdgcn_sched_barrier(0);
    }
#undef G2_KLOAD
    const int row = row0 + r32; const bool lat = row < RL; const int bb = lat ? (row >> 12) : ((row - RL) >> 8), t = lat ? (row & 4095) : ((row - RL) & 255), key = lat ? CTXL + t : t;
    float kr[16];
    { const float* krp = KR + (size_t)row * 32 + 16 * hi;
#pragma unroll
      for (int q = 0; q < 4; ++q) { const f32x4 v = ld4(krp + 4 * q); kr[4 * q] = v[0]; kr[4 * q + 1] = v[1]; kr[4 * q + 2] = v[2]; kr[4 * q + 3] = v[3]; } }
    float ss = 0.f;
#pragma unroll
    for (int b = 0; b < 2; ++b)
#pragma unroll
        for (int r = 0; r < 16; ++r) ss += acc[b][r] * acc[b][r];
#pragma unroll
    for (int i = 0; i < 16; ++i) ss += kr[i] * kr[i];
    ss = half_swap_sum(ss); const float rn = rsqrtf(ss * (1.f / 96.f) + EPS);
    bf16_t* ko = Kb + (((size_t)bb * NH + h) * NKEY + key) * QKH; bf16_t* vo = Vb + (((size_t)bb * NH + h) * NKEY + key) * VD;
#pragma unroll
    for (int b = 0; b < 2; ++b)
#pragma unroll
        for (int rq = 0; rq < 4; ++rq) { const int f0 = 32 * b + 8 * rq + 4 * hi; const f32x4 g = ld4(kn_g + f0);
            *(u32x2*)(ko + f0) = (u32x2){cvt_pk_bf16(acc[b][4 * rq] * rn * g[0], acc[b][4 * rq + 1] * rn * g[1]), cvt_pk_bf16(acc[b][4 * rq + 2] * rn * g[2], acc[b][4 * rq + 3] * rn * g[3])};
            *(u32x2*)(vo + f0) = (u32x2){cvt_pk_bf16(acc[2 + b][4 * rq], acc[2 + b][4 * rq + 1]), cvt_pk_bf16(acc[2 + b][4 * rq + 2], acc[2 + b][4 * rq + 3])}; }
    unsigned pk[8];
#pragma unroll
    for (int q = 0; q < 8; ++q) { float x1 = kr[2 * q] * rn * kn_g[64 + 16 * hi + 2 * q], x2 = kr[2 * q + 1] * rn * kn_g[65 + 16 * hi + 2 * q];
        if (lat) rope_pair(ROPE, t, 8 * hi + q, x1, x2);
        pk[q] = cvt_pk_bf16(x1, x2); }
    *(u32x4*)(ko + 64 + 16 * hi) = (u32x4){pk[0], pk[1], pk[2], pk[3]}; *(u32x4*)(ko + 72 + 16 * hi) = (u32x4){pk[4], pk[5], pk[6], pk[7]};
}
__device__ __forceinline__ void sp_item(const bf16_t* __restrict__ VT, const bf16_t* __restrict__ WSP, const float* __restrict__ bsp, const bf16_t* __restrict__ U, bf16_t* __restrict__ MIX, int chunk, int h, int ih, int lane) {
    const int r32 = lane & 31, hi = lane >> 5;
    f32x16 acc[2][2];
#pragma unroll
    for (int cb = 0; cb < 2; ++cb)
#pragma unroll
        for (int ib = 0; ib < 2; ++ib) acc[cb][ib] = f32x16{};
    const bf16_t* vp = VT + (((size_t)chunk * 8 + 2 * h) * 8 * 64 + lane) * 8;     const bf16_t* wp = WSP + ((size_t)(h * 4 + 2 * ih) * 8 * 64 + lane) * 8;
    bf16x8 fr[2][2][4];
#define G2_SLOAD(S, g) do { _Pragma("unroll") for (int kk = 0; kk < 2; ++kk) { const int ks = 2 * (g) + kk; fr[S][kk][0] = *(const bf16x8*)(vp + (size_t)ks * 512); fr[S][kk][1] = *(const bf16x8*)(vp + (size_t)(8 + ks) * 512); \
        fr[S][kk][2] = *(const bf16x8*)(wp + (size_t)ks * 512); fr[S][kk][3] = *(const bf16x8*)(wp + (size_t)(8 + ks) * 512); } } while (0)
    G2_SLOAD(0, 0);
#pragma unroll
    for (int g = 0; g < 4; ++g) {
        if (g + 1 < 4) { if (g & 1) G2_SLOAD(0, g + 1); else G2_SLOAD(1, g + 1); }
        __builtin_amdgcn_sched_barrier(0);
#pragma unroll
        for (int kk = 0; kk < 2; ++kk) {
            acc[0][0] = __builtin_amdgcn_mfma_f32_32x32x16_bf16(fr[g & 1][kk][0], fr[g & 1][kk][2], acc[0][0], 0, 0, 0); acc[0][1] = __builtin_amdgcn_mfma_f32_32x32x16_bf16(fr[g & 1][kk][0], fr[g & 1][kk][3], acc[0][1], 0, 0, 0);
            acc[1][0] = __builtin_amdgcn_mfma_f32_32x32x16_bf16(fr[g & 1][kk][1], fr[g & 1][kk][2], acc[1][0], 0, 0, 0); acc[1][1] = __builtin_amdgcn_mfma_f32_32x32x16_bf16(fr[g & 1][kk][1], fr[g & 1][kk][3], acc[1][1], 0, 0, 0); }
        __builtin_amdgcn_sched_barrier(0);
    }
#undef G2_SLOAD
#pragma unroll
    for (int ib = 0; ib < 2; ++ib) { const int i = 64 * ih + 32 * ib + r32; const float bias = bsp[h * 128 + i]; const size_t row = (size_t)chunk * 128 + i;
#pragma unroll
        for (int cb = 0; cb < 2; ++cb)
#pragma unroll
            for (int rq = 0; rq < 4; ++rq) { const int c = 64 * h + 32 * cb + 8 * rq + 4 * hi; const u32x2 uu = *(const u32x2*)(U + row * 256 + c);
                const float u0 = __uint_as_float(uu[0] << 16), u1 = __uint_as_float(uu[0] & 0xffff0000u), u2 = __uint_as_float(uu[1] << 16), u3 = __uint_as_float(uu[1] & 0xffff0000u);
                *(u32x2*)(MIX + row * DM + c) = (u32x2){cvt_pk_bf16(u0 * (acc[cb][ib][4 * rq] + bias), u1 * (acc[cb][ib][4 * rq + 1] + bias)), cvt_pk_bf16(u2 * (acc[cb][ib][4 * rq + 2] + bias), u3 * (acc[cb][ib][4 * rq + 3] + bias))}; } }
}
__device__ __forceinline__ void pool_block(const bf16_t* __restrict__ BW, const float* __restrict__ pscale, bf16_t* __restrict__ MIX, int row0, LAS unsigned char* lds, int tid) {
    int t0, ntok; if (row0 < RL) { t0 = row0 & 4095; ntok = SEQ; } else { t0 = (row0 - RL) & 255; ntok = CTXL; }
    const int base = row0 - t0;
    __syncthreads();
#pragma unroll
    for (int j = 0; j < 5; ++j) { const int idx = tid + 512 * j; const int rr = idx >> 5, ch = idx & 31; const int t = t0 - 8 + rr;
        u32x4 v = (u32x4){0u, 0u, 0u, 0u}; if (t >= 0 && t < ntok) v = *(const u32x4*)(BW + (size_t)(base + t) * 256 + ch * 8);
        *(LAS u32x4*)(lds + rr * 512 + ch * 16) = v; }
    __syncthreads();
#pragma unroll
    for (int j = 0; j < 4; ++j) { const int idx = tid + 512 * j; const int rr = idx >> 5, ch = idx & 31, n0 = ch * 8, g = n0 >> 6, hw = 1 << g; const int t = t0 + rr;
        const int lo = max(t - hw, 0), hi = min(t + hw, ntok);
        float sm[8];
#pragma unroll
        for (int q = 0; q < 8; ++q) sm[q] = 0.f;
#pragma unroll
        for (int d = -8; d < 8; ++d) { if (d >= -hw && d < hw) { const u32x4 v = *(const LAS u32x4*)(lds + (rr + 8 + d) * 512 + ch * 16);
#pragma unroll
                for (int q = 0; q < 4; ++q) { sm[2 * q] += __uint_as_float(v[q] << 16); sm[2 * q + 1] += __uint_as_float(v[q] & 0xffff0000u); } } }
        const float inv = 1.f / (float)(hi - lo); const u32x4 v = *(const LAS u32x4*)(lds + (rr + 8) * 512 + ch * 16); const f32x4 p0 = ld4(pscale + n0), p1 = ld4(pscale + n0 + 4);
        float z[8];
#pragma unroll
        for (int q = 0; q < 4; ++q) { z[2 * q] = sm[2 * q] * inv - __uint_as_float(v[q] << 16); z[2 * q + 1] = sm[2 * q + 1] * inv - __uint_as_float(v[q] & 0xffff0000u); }
        *(u32x4*)(MIX + (size_t)(row0 + rr) * DM + 256 + n0) = (u32x4){cvt_pk_bf16(z[0] * p0[0], z[1] * p0[1]), cvt_pk_bf16(z[2] * p0[2], z[3] * p0[3]), cvt_pk_bf16(z[4] * p1[0], z[5] * p1[1]), cvt_pk_bf16(z[6] * p1[2], z[7] * p1[3])}; }
}
}

__device__ __forceinline__ void transpose_item(const float* W, int ldw, int K, bf16_t* WT, int k0, int n0, int dst_row0, LAS float* scr, int lane) {
    float tv[32];
#pragma unroll
    for (int i = 0; i < 32; ++i) tv[i] = W[(size_t)(k0 + 2 * i + (lane >> 5)) * ldw + n0 + (lane & 31)];
#pragma unroll
    for (int i = 0; i < 32; ++i) scr[(2 * i + (lane >> 5)) * 33 + (lane & 31)] = tv[i];
    asm volatile("s_waitcnt lgkmcnt(0)" ::: "memory");
    const int c = lane & 7;
#pragma unroll
    for (int j = 0; j < 4; ++j) { const int n = (lane >> 3) + 8 * j; const LAS float* sp = scr + (8 * c) * 33 + n;
        u32x4 o; o.x = cvt_pk_bf16(sp[0 * 33], sp[1 * 33]); o.y = cvt_pk_bf16(sp[2 * 33], sp[3 * 33]); o.z = cvt_pk_bf16(sp[4 * 33], sp[5 * 33]); o.w = cvt_pk_bf16(sp[6 * 33], sp[7 * 33]);
        *(u32x4*)(WT + (size_t)(dst_row0 + n) * K + k0 + 8 * c) = o; }
    asm volatile("s_waitcnt lgkmcnt(0)" ::: "memory");
}


__device__ __forceinline__ void fold_item(const float* w_in_l, const float* w_pool_l, bf16_t* WT, int k0, int g, int dh, LAS float* scr, int lane) {
    {   f32x4 av[8], wv[8];
#pragma unroll
        for (int i = 0; i < 8; ++i) av[i] = ld4(w_in_l + (size_t)(k0 + i * 4 + (lane >> 4)) * DIN + 512 + 64 * g + (lane & 15) * 4);
#pragma unroll
        for (int i = 0; i < 8; ++i) wv[i] = ld4(w_pool_l + (size_t)g * 64 * 64 + (size_t)(i * 8 + (lane >> 3)) * 64 + 32 * dh + (lane & 7) * 4);
#pragma unroll
        for (int i = 0; i < 8; ++i) { *(LAS f32x4*)(scr + (i * 4 + (lane >> 4)) * 64 + (lane & 15) * 4) = av[i]; *(LAS f32x4*)(scr + 2048 + (i * 8 + (lane >> 3)) * 32 + (lane & 7) * 4) = wv[i]; }
    }
    asm volatile("s_waitcnt lgkmcnt(0)" ::: "memory");
    const int ch = lane >> 5, d = lane & 31;
    float acc[32];
#pragma unroll
    for (int j = 0; j < 32; ++j) acc[j] = 0.f;
#pragma unroll 2
    for (int cc = 0; cc < 32; ++cc) { const float wvv = scr[2048 + (ch * 32 + cc) * 32 + d];
#pragma unroll
        for (int j = 0; j < 32; ++j) acc[j] += scr[j * 64 + ch * 32 + cc] * wvv; }
    asm volatile("s_waitcnt lgkmcnt(0)" ::: "memory");
#pragma unroll
    for (int j = 0; j < 32; ++j) { auto rr = __builtin_amdgcn_permlane32_swap(__float_as_uint(acc[j]), __float_as_uint(acc[j]), false, false); acc[j] = __uint_as_float(rr[0]) + __uint_as_float(rr[1]); }
    if (ch == 0) {
#pragma unroll
        for (int j = 0; j < 32; ++j) scr[j * 33 + d] = acc[j]; }
    asm volatile("s_waitcnt lgkmcnt(0)" ::: "memory");
    const int c = lane & 3;
#pragma unroll
    for (int jj = 0; jj < 2; ++jj) { const int n = (lane >> 2) + 16 * jj; const LAS float* sp = scr + (8 * c) * 33 + n;
        u32x4 o; o.x = cvt_pk_bf16(sp[0 * 33], sp[1 * 33]); o.y = cvt_pk_bf16(sp[2 * 33], sp[3 * 33]); o.z = cvt_pk_bf16(sp[4 * 33], sp[5 * 33]); o.w = cvt_pk_bf16(sp[6 * 33], sp[7 * 33]);
        *(u32x4*)(WT + (size_t)(512 + 64 * g + 32 * dh + n) * DM + k0 + 8 * c) = o; }
    asm volatile("s_waitcnt lgkmcnt(0)" ::: "memory");
}

template <bool GU>
__device__ __forceinline__ void transpose_block(const float* __restrict__ W, int ldw, int Kdim, bf16_t* __restrict__ WT, int k0, int n0, int width, LAS float* tile, int tid) {
    const int wave = tid >> 6, lane = tid & 63;
    __syncthreads();
    { const int col4 = lane * 4; f32x4 v[8];
      if (col4 < width) {
#pragma unroll
        for (int i = 0; i < 8; ++i) v[i] = ld4(W + (size_t)(k0 + 8 * i + wave) * ldw + n0 + col4);
#pragma unroll
        for (int i = 0; i < 8; ++i) { LAS float* t_ = tile + (8 * i + wave) * 257 + col4; t_[0] = v[i][0]; t_[1] = v[i][1]; t_[2] = v[i][2]; t_[3] = v[i][3]; } } }
    __syncthreads();
    const int c = lane & 7;
#pragma unroll
    for (int jj = 0; jj < 4; ++jj) { const int nl = 32 * wave + (lane >> 3) + 8 * jj;
        if (nl < width) { const LAS float* sp = tile + (8 * c) * 257 + nl;
            u32x4 o; o.x = cvt_pk_bf16(sp[0 * 257], sp[1 * 257]); o.y = cvt_pk_bf16(sp[2 * 257], sp[3 * 257]); o.z = cvt_pk_bf16(sp[4 * 257], sp[5 * 257]); o.w = cvt_pk_bf16(sp[6 * 257], sp[7 * 257]);
            const int n = n0 + nl; int dst = n; if (GU) { const int f = n % DFF, isup = n / DFF; dst = 256 * (f / 128) + 128 * isup + (f % 128); }
            *(u32x4*)(WT + (size_t)dst * Kdim + k0 + 8 * c) = o; } }
}

#define XB_TMO      128
#define XB_XCNT(j)  (256  + 64 * (j))
#define XB_XSUB(j)  (1280 + 64 * (j))
#define XB_XGEN(j)  (2304 + 64 * (j))
#define XB_TOP      3328
#define XB_TOPGEN   3392
#define XCD_BAR_WORDS 3456
#define XB_SPIN_CAP (1u << 18)
__device__ __forceinline__ unsigned xb_ld(unsigned* p)              { return __hip_atomic_load(p, __ATOMIC_RELAXED, __HIP_MEMORY_SCOPE_AGENT); }
__device__ __forceinline__ unsigned xb_add(unsigned* p, unsigned v) { return __hip_atomic_fetch_add(p, v, __ATOMIC_RELAXED, __HIP_MEMORY_SCOPE_AGENT); }
__device__ __forceinline__ unsigned xb_xcc_id() { return (unsigned)__builtin_amdgcn_s_getreg((3 << 11) | 20) & 0xFu; }
#define XB_SPIN(cond, bar) do { unsigned _sp = 0; while (cond) { __builtin_amdgcn_s_sleep(1); \
    if ((++_sp & 255u) == 0u) { if (xb_ld(&(bar)[XB_TMO])) break; if (_sp > XB_SPIN_CAP) { atomicAdd(&(bar)[XB_TMO], 1u); break; } } } } while (0)
struct XcdBarrier { unsigned* bar; unsigned x; volatile LAS unsigned* st; };
__device__ __forceinline__ XcdBarrier xcd_barrier_post(unsigned* bar, volatile LAS unsigned* st) {
    XcdBarrier b; b.bar = bar; b.x = xb_xcc_id(); b.st = st;
    if (threadIdx.x == 0) (void)xb_add(&bar[XB_XCNT(b.x)], 1u);
    return b;
}
__device__ __forceinline__ void xcd_barrier_complete(unsigned* bar, unsigned x, unsigned& nloc, unsigned& nx) {
    const unsigned G = gridDim.x * gridDim.y * gridDim.z;
    unsigned sum, cnt, mine, sp = 0u;
    for (;;) {
        sum = 0u; cnt = 0u; mine = 0u;
#pragma unroll
        for (unsigned j = 0; j < 16; ++j) { const unsigned c = xb_ld(&bar[XB_XCNT(j)]); sum += c; cnt += (c > 0u) ? 1u : 0u; mine = (j == x) ? c : mine; }
        if (sum == G) break;
        __builtin_amdgcn_s_sleep(1);
        if ((++sp & 255u) == 0u) { if (xb_ld(&bar[XB_TMO])) break; if (sp > XB_SPIN_CAP) { atomicAdd(&bar[XB_TMO], 1u); break; } }
    }
    nloc = mine > 0u ? mine : 1u; nx = cnt > 0u ? cnt : 1u;
}
__device__ __forceinline__ void xcd_barrier(const XcdBarrier& b) {
    asm volatile("s_waitcnt vmcnt(0)" ::: "memory");
    __syncthreads();
    if (threadIdx.x == 0) {
        unsigned* bar = b.bar;
        __builtin_amdgcn_s_waitcnt(0);
        unsigned nloc = b.st[0], nx = b.st[1];
        if (nloc == 0u) { xcd_barrier_complete(bar, b.x, nloc, nx); b.st[0] = nloc; b.st[1] = nx; }
        const unsigned old = xb_add(&bar[XB_XSUB(b.x)], 1u);
        const unsigned gen = old / nloc;
        if (old + 1u == (gen + 1u) * nloc) {
            __builtin_amdgcn_fence(__ATOMIC_RELEASE, "agent");
            asm volatile("s_waitcnt vmcnt(0)" ::: "memory");
            const unsigned og = xb_add(&bar[XB_TOP], 1u);
            const unsigned tg = og / nx;
            if (og + 1u == (tg + 1u) * nx) xb_add(&bar[XB_TOPGEN], 1u);
            else XB_SPIN(xb_ld(&bar[XB_TOPGEN]) == tg, bar);
            __builtin_amdgcn_fence(__ATOMIC_ACQUIRE, "agent");
            xb_add(&bar[XB_XGEN(b.x)], 1u);
            asm volatile("s_waitcnt vmcnt(0)" ::: "memory");
        } else {
            XB_SPIN(xb_ld(&bar[XB_XGEN(b.x)]) == gen, bar);
            __builtin_amdgcn_fence(__ATOMIC_ACQUIRE, "agent");
            asm volatile("s_waitcnt vmcnt(0)" ::: "memory");
        }
    }
    __syncthreads();
}

struct MkArgs { const float* in[23]; float* out; unsigned char* ws; int ph_lo, ph_hi; int dry, pad; };
constexpr int MK_LDS = 147456;
constexpr int MK_XL_OFF = 131072;
enum { PH_P0A = 0, PH_P0B = 1, PH_L0 = 2, PH_PER_LAYER = 6, PH_G1 = 0, PH_G2 = 1, PH_G3 = 2, PH_G4 = 3, PH_G5 = 4, PH_G6 = 5, PH_END = 14 };

typedef const __attribute__((address_space(4))) MkArgs* KargPtr;
#define KARG() ({ KargPtr p_ = (KargPtr)__builtin_amdgcn_kernarg_segment_ptr(); asm volatile("" : "+s"(p_)); p_; })
#define WSP(kp, off) ((kp)->ws + (off))
#define BLK() ({ int b_ = (int)blockIdx.x; asm volatile("" : "+s"(b_)); b_; })

__device__ __forceinline__ void weight_prep(KargPtr kp, unsigned char* ws, int l, int bi, int nb, LAS unsigned char* lds, int tid, int parts) {
    const int lane = tid & 63, wave = __builtin_amdgcn_readfirstlane(tid >> 6);
    bf16_t* WB = (bf16_t*)(ws + WS_WB + (size_t)l * 22 * MiB);
    {
        LAS float* tile = (LAS float*)lds;
        const int cnt = parts == 1 ? 64 : parts == 2 ? 592 : 656;
#define PREP_R(j_) (parts == 1 ? 528 + (j_) : (parts == 2 && (j_) >= 528) ? (j_) + 64 : (j_))
#define PREP_DESC(r_) const float* W_; bf16_t* WT_; int ldw_, Kd_, k0_, n0_, wd_, gu_; { int q_ = (r_); \
            if (q_ < 352) { W_ = kp->in[21] + (size_t)l * DM * 2 * DFF; WT_ = WB + WL_GU; ldw_ = 2 * DFF; Kd_ = DM; k0_ = (q_ / 22) * 64; n0_ = (q_ % 22) * 256; wd_ = 256; gu_ = 1; } \
            else if (q_ < 528) { q_ -= 352; W_ = kp->in[22] + (size_t)l * DFF * DM; WT_ = WB + WL_DN; ldw_ = DM; Kd_ = DFF; k0_ = (q_ / 4) * 64; n0_ = (q_ % 4) * 256; wd_ = 256; gu_ = 0; } \
            else if (q_ < 592) { q_ -= 528; const int nq_ = q_ % 4; W_ = kp->in[8] + (size_t)l * DM * DIN; WT_ = WB + WL_IN; ldw_ = DIN; Kd_ = DM; k0_ = (q_ / 4) * 64; n0_ = (nq_ < 2 ? nq_ : nq_ + 1) * 256; wd_ = n0_ == 1024 ? 160 : 256; gu_ = 0; } \
            else { q_ -= 592; W_ = kp->in[20] + (size_t)l * DM * DM; WT_ = WB + WL_OUT; ldw_ = DM; Kd_ = DM; k0_ = (q_ / 4) * 64; n0_ = (q_ % 4) * 256; wd_ = 256; gu_ = 0; } } (void)WT_; (void)Kd_; (void)gu_
#define PREP_LOAD(V, j_) do { PREP_DESC(PREP_R(j_)); if (lane * 4 < wd_) { _Pragma("unroll") for (int i = 0; i < 8; ++i) V[i] = ld4(W_ + (size_t)(k0_ + 8 * i + wave) * ldw_ + n0_ + lane * 4); } } while (0)
        f32x4 v[8], vn[8];
#pragma unroll
        for (int i = 0; i < 8; ++i) { v[i] = (f32x4){0.f, 0.f, 0.f, 0.f}; vn[i] = v[i]; }
        int j = bi;
        if (j < cnt) PREP_LOAD(v, j);
        for (; j < cnt; j += nb) {
            if (j + nb < cnt) PREP_LOAD(vn, j + nb);
            __builtin_amdgcn_sched_barrier(0);
            PREP_DESC(PREP_R(j));
            __syncthreads();
            if (lane * 4 < wd_) {
#pragma unroll
                for (int i = 0; i < 8; ++i) { LAS float* t_ = tile + (8 * i + wave) * 263 + lane; t_[0] = v[i][0]; t_[66] = v[i][1]; t_[132] = v[i][2]; t_[198] = v[i][3]; } }
            __syncthreads();
            const int c = lane >> 3, q = lane & 7;
#pragma unroll
            for (int jj = 0; jj < 4; ++jj) { const int nl = 32 * wave + q + 8 * jj;
                if (nl < wd_) { const LAS float* sp = tile + (8 * c) * 263 + (nl & 3) * 66 + (nl >> 2);
                    u32x4 o; o.x = cvt_pk_bf16(sp[0 * 263], sp[1 * 263]); o.y = cvt_pk_bf16(sp[2 * 263], sp[3 * 263]); o.z = cvt_pk_bf16(sp[4 * 263], sp[5 * 263]); o.w = cvt_pk_bf16(sp[6 * 263], sp[7 * 263]);
                    const int n = n0_ + nl; int dst = n; if (gu_) { const int f = n % DFF, isup = n / DFF; dst = 256 * (f / 128) + 128 * isup + (f % 128); }
                    *(u32x4*)(WT_ + (size_t)dst * Kd_ + k0_ + 8 * c) = o; } }
#pragma unroll
            for (int i = 0; i < 8; ++i) v[i] = vn[i];
        }
#undef PREP_LOAD
#undef PREP_DESC
#undef PREP_R
        __syncthreads();
    }
    LAS float* scr = (LAS float*)(lds + wave * 16384);
    constexpr int I_FOLD = 32 * 8, I_Z = 96 * DM / 512, I_SP = 4 * 4 * 8, I_QF = 8 * 3 * 16, I_KF = 8 * 4 * 8, I_ALL = I_FOLD + I_Z + I_SP + I_QF + I_KF;
    if (parts & 1)
    for (int it = bi * 8 + wave; it < I_ALL; it += nb * 8) { int r = it;
        if (r < I_FOLD) { const int kb = r >> 3, g = (r >> 1) & 3, dh = r & 1; fold_item(kp->in[8] + (size_t)l * DM * DIN, kp->in[12] + (size_t)l * 4 * 64 * 64, WB + WL_IN, kb * 32, g, dh, scr, lane); continue; } r -= I_FOLD;
        if (r < I_SP) {
            const int h = r >> 5, ib = (r >> 3) & 3, ks = r & 7; const float* sp_ = kp->in[10] + (size_t)l * 4 * 128 * 128 + ((size_t)h * 128 + 32 * ib + (lane & 31)) * 128 + 16 * ks + 8 * (lane >> 5); const f32x4 x0 = ld4(sp_), x1 = ld4(sp_ + 4);
            *(u32x4*)(WB + WL_SP + ((size_t)r * 64 + lane) * 8) = (u32x4){cvt_pk_bf16(x0[0], x0[1]), cvt_pk_bf16(x0[2], x0[3]), cvt_pk_bf16(x1[0], x1[1]), cvt_pk_bf16(x1[2], x1[3])}; continue; } r -= I_SP;
        if (r < I_QF) {
            const int h = r / 48, b = (r / 16) % 3, ks = r & 15; const float* src = kp->in[15] + (size_t)l * 256 * 768 + (size_t)(16 * ks + 8 * (lane >> 5)) * 768 + 96 * h + 32 * b + (lane & 31); float e_[8];
#pragma unroll
            for (int e = 0; e < 8; ++e) e_[e] = src[(size_t)e * 768];
            *(u32x4*)(WB + WL_QB + ((size_t)r * 64 + lane) * 8) = (u32x4){cvt_pk_bf16(e_[0], e_[1]), cvt_pk_bf16(e_[2], e_[3]), cvt_pk_bf16(e_[4], e_[5]), cvt_pk_bf16(e_[6], e_[7])}; continue; } r -= I_QF;
        if (r < I_KF) {
            const int h = r >> 5, b = (r >> 3) & 3, ks = r & 7; const float* src = kp->in[17] + (size_t)l * 128 * 1024 + (size_t)(16 * ks + 8 * (lane >> 5)) * 1024 + 128 * h + 32 * b + (lane & 31); float e_[8];
#pragma unroll
            for (int e = 0; e < 8; ++e) e_[e] = src[(size_t)e * 1024];
            *(u32x4*)(WB + WL_KVB + ((size_t)r * 64 + lane) * 8) = (u32x4){cvt_pk_bf16(e_[0], e_[1]), cvt_pk_bf16(e_[2], e_[3]), cvt_pk_bf16(e_[4], e_[5]), cvt_pk_bf16(e_[6], e_[7])}; continue; } r -= I_KF;
        { unsigned z_ = 0u; asm volatile("" : "+v"(z_)); *(u32x4*)(WB + WL_IN + (size_t)DIN * DM + (size_t)r * 512 + lane * 8) = (u32x4){z_, z_, z_, z_}; }
    }
}
__device__ __forceinline__ void bias_items(unsigned char* ws, int l, int bi, int nb, int tid, int which) {
    const int lane = tid & 63, wave = __builtin_amdgcn_readfirstlane(tid >> 6);
    const float* MOD = (const float*)(ws + WS_MOD); float* BIAS1P = (float*)(ws + WS_BIAS1P); float* BIAS2P = (float*)(ws + WS_BIAS2P);
    constexpr int NB_ROWS = 2 * DFF + 1280;
    const int r_lo = (which & 2) ? 0 : 2 * DFF, r_hi = (which & 1) ? NB_ROWS : 2 * DFF;
    for (int it0 = r_lo + (bi * 8 + wave) * 2; it0 < r_hi; it0 += nb * 8 * 2) {
        u32x4 q0[2], q1[2]; const float* shp[2]; float* outp[2]; int ldo[2];
#pragma unroll
        for (int e = 0; e < 2; ++e) { int n = it0 + e; const bool isgu = n < 2 * DFF; if (!isgu) n -= 2 * DFF;
            const bf16_t* wrow = (const bf16_t*)(ws + WS_WB + (size_t)l * 22 * MiB) + (isgu ? WL_GU : WL_IN) + (size_t)n * DM; shp[e] = MOD + (size_t)l * 5 * NMOD * DM + (isgu ? 3 : 0) * DM;
            outp[e] = isgu ? BIAS2P + (size_t)l * 5 * 2 * DFF + n : BIAS1P + (size_t)l * 5 * 1280 + n; ldo[e] = isgu ? 2 * DFF : 1280;
            q0[e] = *(const u32x4*)(wrow + lane * 16); q1[e] = *(const u32x4*)(wrow + lane * 16 + 8); }
        float accr[2][5];
#pragma unroll
        for (int e = 0; e < 2; ++e) { float w[16];
#pragma unroll
            for (int j = 0; j < 4; ++j) { w[2 * j] = __uint_as_float(q0[e][j] << 16); w[2 * j + 1] = __uint_as_float(q0[e][j] & 0xffff0000u); w[8 + 2 * j] = __uint_as_float(q1[e][j] << 16); w[9 + 2 * j] = __uint_as_float(q1[e][j] & 0xffff0000u); }
#pragma unroll
            for (int r = 0; r < 5; ++r) { const float* sv = shp[e] + (size_t)r * NMOD * DM + lane * 16; float acc = 0.f;
#pragma unroll
                for (int j = 0; j < 4; ++j) { const f32x4 s4 = ld4(sv + 4 * j); acc += (s4[0] * w[4 * j] + s4[1] * w[4 * j + 1]) + (s4[2] * w[4 * j + 2] + s4[3] * w[4 * j + 3]); }
                accr[e][r] = acc; } }
#pragma unroll
        for (int e = 0; e < 2; ++e)
#pragma unroll
            for (int r = 0; r < 5; ++r) { const float t = wave_sum(accr[e][r]); if (lane == 0) outp[e][(size_t)r * ldo[e]] = t; }
    }
}

__global__ void __launch_bounds__(512, 2) mk_fwd(MkArgs a) {
    extern __shared__ __attribute__((aligned(16))) unsigned char lds_raw[];
    LAS unsigned char* lds = (LAS unsigned char*)lds_raw; LAS unsigned char* xl = lds + MK_XL_OFF;
    const int ph_lo = a.ph_lo, ph_hi = a.ph_hi;
#define IN(k) (ph_lo <= (k) && (k) < ph_hi)
    volatile LAS unsigned* bst = (volatile LAS unsigned*)(lds + MK_XL_OFF + 8192);
    if (threadIdx.x < 4) bst[threadIdx.x] = 0u;
    __syncthreads();
    XcdBarrier gbar; gbar.bar = (unsigned*)a.ws; gbar.x = 0; gbar.st = bst;
    if (ph_hi - ph_lo > 1) gbar = xcd_barrier_post((unsigned*)a.ws, bst);
#define GRID_BAR(k) do { if (IN(k) && IN((k) + 1)) xcd_barrier(gbar); } while (0)
#define LANE_IDS() int tid = threadIdx.x; asm volatile("" : "+v"(tid)); const int lane = tid & 63, wave = __builtin_amdgcn_readfirstlane(tid >> 6); const int G = gridDim.x; const int gw = blockIdx.x * 8 + wave, NGW = G * 8; (void)lane; (void)gw; (void)NGW
    if (IN(PH_P0A)) {
        LANE_IDS(); KargPtr kp = KARG(); unsigned char* ws = kp->ws;
        {   LAS float* sl = (LAS float*)lds; LAS float* part = (LAS float*)(lds + 20480);
            float* MOD = (float*)(ws + WS_MOD); const float* cc = kp->in[1]; const float* cctx = kp->in[3]; const float* w_ada = kp->in[6]; const float* b_ada = kp->in[7];
            for (int i = tid; i < 5 * DM; i += 512) { const int mr = i >> 10, k = i & 1023; const float v = mr < 4 ? cc[mr * DM + k] : cctx[k]; sl[i] = silu_f(v); }
            __syncthreads();
            for (int strip = blockIdx.x; strip < DEPTH * 128; strip += G) { const int l = strip >> 7, n0 = (strip & 127) * 48;
                const int kg = tid / 12, c4 = tid % 12;
                if (tid < 504) { f32x4 acc[5];
#pragma unroll
                    for (int r = 0; r < 5; ++r) acc[r] = (f32x4){0.f, 0.f, 0.f, 0.f};
                    const float* wp = w_ada + (size_t)l * DM * (NMOD * DM) + n0 + c4 * 4;
#pragma unroll 13
                    for (int k = kg; k < DM; k += 42) { const f32x4 w = ld4(wp + (size_t)k * (NMOD * DM));
#pragma unroll
                        for (int r = 0; r < 5; ++r) acc[r] += w * sl[r * DM + k]; }
#pragma unroll
                    for (int r = 0; r < 5; ++r) *(LAS f32x4*)(part + (kg * 5 + r) * 48 + c4 * 4) = acc[r]; }
                __syncthreads();
                if (tid < 240) { const int r = tid / 48, c = tid % 48; float sum = 0.f;
#pragma unroll 6
                    for (int q = 0; q < 42; ++q) sum += part[(q * 5 + r) * 48 + c];
                    MOD[((size_t)l * 5 + r) * (NMOD * DM) + n0 + c] = sum + b_ada[l * NMOD * DM + n0 + c]; }
                __syncthreads(); }
        }
        if (blockIdx.x == 0) { float* ROPE = (float*)(ws + WS_ROPE); const int pos = tid >> 3, i = tid & 7;
            const float inv = (float)exp2(-(double)i / 8.0 * 13.287712379549449); const float ang = (float)pos * inv;
            double sn, cs; sincos_d((double)ang, sn, cs); ROPE[tid * 2] = (float)cs; ROPE[tid * 2 + 1] = (float)sn; }
        __syncthreads();
        weight_prep(kp, ws, 0, (int)blockIdx.x, G, lds, tid, 1);
    }
    GRID_BAR(PH_P0A);
    if (IN(PH_P0B)) {
        LANE_IDS(); KargPtr kp = KARG(); unsigned char* ws = kp->ws;
        const float* MOD = (const float*)(ws + WS_MOD);
        bias_items(ws, 0, (int)blockIdx.x, G, tid, 1);
        float* RSQ1 = (float*)(ws + WS_RSQ1); bf16_t* XG = (bf16_t*)(ws + WS_XG);
        const float* xin = kp->in[0]; const float* cin = kp->in[2]; const float* norm1_g = kp->in[4]; const float* sc = MOD + 1 * DM;
        for (int r0 = gw * 4; r0 < R; r0 += NGW * 4) {
            f32x4 v[4][4], gg[4], s4[4];
            const float* scr_ = sc + (size_t)mrow_of(r0) * (NMOD * DM);
#pragma unroll
            for (int j = 0; j < 4; ++j) { gg[j] = ld4(norm1_g + j * 256 + lane * 4); s4[j] = ld4(scr_ + j * 256 + lane * 4); }
#pragma unroll
            for (int e = 0; e < 4; ++e) { const int r = r0 + e; const float* xr = r < RL ? xin + (size_t)r * DM : cin + (size_t)(r - RL) * DM;
#pragma unroll
                for (int j = 0; j < 4; ++j) v[e][j] = ld4(xr + j * 256 + lane * 4); }
#pragma unroll
            for (int j = 0; j < 4; ++j) gg[j] = gg[j] * (s4[j] + 1.f);
            float ssv[4][4];
#pragma unroll
            for (int e = 0; e < 4; ++e) { const int r = r0 + e;
#pragma unroll
                for (int j = 0; j < 4; ++j) { const int k = j * 256 + lane * 4;
                    ssv[e][j] = (v[e][j][0] * v[e][j][0] + v[e][j][1] * v[e][j][1]) + (v[e][j][2] * v[e][j][2] + v[e][j][3] * v[e][j][3]);
                    const f32x4 z = v[e][j] * gg[j]; *(u32x2*)(XG + (size_t)r * DM + k) = (u32x2){cvt_pk_bf16(z[0], z[1]), cvt_pk_bf16(z[2], z[3])}; } }
#pragma unroll
            for (int e = 0; e < 4; ++e) {
#pragma unroll
                for (int j = 0; j < 4; ++j) ssv[e][j] = wave_sum(ssv[e][j]);
                if (lane == 0) *(f32x4*)(RSQ1 + (size_t)(r0 + e) * 4) = (f32x4){ssv[e][0], ssv[e][1], ssv[e][2], ssv[e][3]}; }
        }
    }
    GRID_BAR(PH_P0B);
    constexpr int NCTXU = 16;
#pragma unroll 1
    for (int l = 0; l < DEPTH; ++l) {
        const int pb = PH_L0 + l * PH_PER_LAYER; const int Mrows = (l == 0) ? R : RL;
        if (IN(pb + PH_G1)) {
            KargPtr kp = KARG(); unsigned char* ws = kp->ws; const bf16_t* WB = (const bf16_t*)(ws + WS_WB + (size_t)l * 22 * MiB); const int G = gridDim.x;
            EpiG1 E{(const float*)(ws + WS_RSQ1), (const float*)(ws + WS_BIAS1P) + (size_t)l * 5 * 1280, kp->in[9] + l * 256, kp->in[14] + l * 256, kp->in[16] + l * 128,
                    (bf16_t*)(ws + WS_U), (bf16_t*)(ws + WS_VT), (bf16_t*)(ws + WS_BW), (bf16_t*)(ws + WS_QA), (bf16_t*)(ws + WS_KVA), (float*)(ws + WS_KR)};
            if (l == 0) {
                pg8::Gemm g{(const bf16_t*)(ws + WS_XG), WB + WL_IN, R, 1280, DM}; pg8::StaticOrder S; S.init(R, 1280, G, BLK());
                pg8::gemm_phase(lds, xl, g, S, E);
                const int busy2 = (R / 256) * 5 > G ? (R / 256) * 5 - G : 0;
                if ((int)blockIdx.x >= busy2) { int tid_ = threadIdx.x; asm volatile("" : "+v"(tid_)); weight_prep(kp, ws, 0, (int)blockIdx.x - busy2, G - busy2, lds, tid_, 2); }
            } else {
                pg8::Gemm g{(const bf16_t*)(ws + WS_XG), WB + WL_IN, RL, 1280, DM}; pg8::StaticOrder S; S.init(RL, 1280, G - NCTXU, BLK() - NCTXU);
                pg8::gemm_phase(lds, xl, g, S, E);
                const bf16_t* WBp = (const bf16_t*)(ws + WS_WB + (size_t)(l - 1) * 22 * MiB); const float* MOD = (const float*)(ws + WS_MOD); const float* modp = MOD + (size_t)(l - 1) * 5 * NMOD * DM;
                pg8::Gemm g6{(const bf16_t*)(ws + WS_ACT), WBp + WL_DN, R, DM, DFF}; pg8::ListOrder S6{0, NCTXU, 16, 64, 4, 0};
                EpiRes E6{kp->out, (float*)(ws + WS_XC), (const float*)kp->out, (const float*)(ws + WS_XC), modp + 5 * DM, (float*)(ws + WS_RSQ1), (bf16_t*)(ws + WS_XG), kp->in[4] + l * DM, MOD + (size_t)l * 5 * NMOD * DM + 1 * DM, 1, 0};
                pg8::gemm_phase(lds, xl, g6, S6, E6);
            }
        }
        GRID_BAR(pb + PH_G1);
        if (IN(pb + PH_G2)) {
            LANE_IDS(); KargPtr kp = KARG(); unsigned char* ws = kp->ws; const bf16_t* WB = (const bf16_t*)(ws + WS_WB + (size_t)l * 22 * MiB);
            const bf16_t* Uq = (const bf16_t*)(ws + WS_U); const bf16_t* VTq = (const bf16_t*)(ws + WS_VT); const bf16_t* BWq = (const bf16_t*)(ws + WS_BW); const bf16_t* QAq = (const bf16_t*)(ws + WS_QA);
            const bf16_t* KVAq = (const bf16_t*)(ws + WS_KVA); const float* KRq = (const float*)(ws + WS_KR); const float* ROPEq = (const float*)(ws + WS_ROPE);
            bf16_t* Qo = (bf16_t*)(ws + WS_Q); bf16_t* Ko = (bf16_t*)(ws + WS_K); bf16_t* Vo = (bf16_t*)(ws + WS_V); bf16_t* MIX = (bf16_t*)(ws + WS_MIX);
            const int nc7 = (l > 0) ? 32 : 0;
            if ((int)blockIdx.x < nc7) {
                pg8::Gemm g{(const bf16_t*)(ws + WS_XG), WB + WL_IN, R, 1280, DM}; pg8::ListOrder S7{(int)blockIdx.x & ~3, 4, 4, 64, 4, 4};
                EpiG1 E7{(const float*)(ws + WS_RSQ1), (const float*)(ws + WS_BIAS1P) + (size_t)l * 5 * 1280, kp->in[9] + l * 256, kp->in[14] + l * 256, kp->in[16] + l * 128,
                         (bf16_t*)(ws + WS_U), (bf16_t*)(ws + WS_VT), (bf16_t*)(ws + WS_BW), (bf16_t*)(ws + WS_QA), (bf16_t*)(ws + WS_KVA), (float*)(ws + WS_KR)};
                pg8::gemm_phase(lds, xl, g, S7, E7);
                asm volatile("s_waitcnt vmcnt(0)" ::: "memory"); __syncthreads();
                __builtin_amdgcn_fence(__ATOMIC_ACQUIRE, "agent"); asm volatile("s_waitcnt vmcnt(0)" ::: "memory"); __syncthreads();
                { int ln = lane; asm volatile("" : "+v"(ln)); g2::kv_item(KVAq, KRq, WB + WL_KVB, kp->in[19] + l * QKH, ROPEq, Ko, Vo, RL + ((int)blockIdx.x & 3) * 256 + ((int)blockIdx.x >> 2) * 32, wave, ln); }
            } else {
            const int bi2 = (int)blockIdx.x - nc7, nb2 = G - nc7;
            for (int pi = bi2; pi < Mrows / 64; pi += nb2) g2::pool_block(BWq, kp->in[13] + l * 256, MIX, pi * 64, lds, tid);
            const int nQ = 0  , nKV = (Mrows / 32) * NH, nSP = (Mrows / 128) * 8, nAll = nQ + nKV + nSP;
            for (int it = bi2 * 8 + wave; it < nAll; it += nb2 * 8) { int r = it; int ln = lane; asm volatile("" : "+v"(ln));
                if (r < nQ) { g2::q_item<1>(QAq, WB + WL_QB, kp->in[18] + l * QKH, ROPEq, Qo, (r >> 3) * 32, r & 7, ln); continue; } r -= nQ;
                if (r < nKV) { g2::kv_item(KVAq, KRq, WB + WL_KVB, kp->in[19] + l * QKH, ROPEq, Ko, Vo, (r >> 3) * 32, r & 7, ln); continue; } r -= nKV;
                g2::sp_item(VTq, WB + WL_SP, kp->in[11] + l * 4 * 128, Uq, MIX, r >> 3, (r >> 1) & 3, r & 1, ln);
            }
            }
        }
        GRID_BAR(pb + PH_G2);
        if (IN(pb + PH_G3)) {
            KargPtr kp = KARG(); unsigned char* ws = kp->ws; const int G = gridDim.x;
            const bf16_t* WBq = (const bf16_t*)(ws + WS_WB + (size_t)l * 22 * MiB) + WL_QB; const bf16_t* Kp = (const bf16_t*)(ws + WS_K); const bf16_t* Vp = (const bf16_t*)(ws + WS_V); bf16_t* MIX = (bf16_t*)(ws + WS_MIX);
            const int vcu = (G % 8 == 0) ? ((int)blockIdx.x % 8) * (G / 8) + (int)blockIdx.x / 8 : (int)blockIdx.x;
            const int nun = NB * NH * 16 + (l == 0 ? NB * NH : 0);
            for (int un = vcu; un < nun; un += G) {
                int bh, row0, seq;
                if (un < NB * NH * 16) { int v;
                    if (G == 256) { const int c_ = un % G, st = un / G; v = ((4 * (c_ >> 5) + 2 * st + ((c_ & 31) >> 4)) << 4) | (c_ & 15); }
                    else { const int per = ((NB * NH * 16) % G == 0) ? (NB * NH * 16) / G : 0; v = per ? (un % G) * per + un / G : un; }
                    bh = v >> 4; row0 = (bh >> 3) * SEQ + (v & 15) * 256; seq = NKEY; }
                else { bh = un - NB * NH * 16; row0 = RL + (bh >> 3) * CTXL; seq = CTXL; }
                const int h = bh & 7;
                att::attn_unit((const bf16_t*)(ws + WS_QA), WBq + ((size_t)(h * 3) * 16 * 64) * 8, kp->in[18] + l * QKH, (const float*)(ws + WS_ROPE), row0, Kp + (size_t)bh * NKEY * QKH, Vp + (size_t)bh * NKEY * VD, MIX + (size_t)row0 * DM + 512 + h * 64, seq, lds);
            }
            if (l == 0 && vcu >= NB * NH && G > NB * NH) { int tid_ = threadIdx.x; asm volatile("" : "+v"(tid_)); bias_items(ws, 0, vcu - NB * NH, G - NB * NH, tid_, 2); }
        }
        GRID_BAR(pb + PH_G3);
        if (IN(pb + PH_G4)) {
            KargPtr kp = KARG(); unsigned char* ws = kp->ws; const bf16_t* WB = (const bf16_t*)(ws + WS_WB + (size_t)l * 22 * MiB); const int G = gridDim.x;
            const float* modl = (const float*)(ws + WS_MOD) + (size_t)l * 5 * NMOD * DM;
            pg8::Gemm g{(const bf16_t*)(ws + WS_MIX), WB + WL_OUT, RL, DM, DM}; pg8::StaticOrder S; S.init(RL, DM, G, BLK());
            EpiRes E{kp->out, (float*)(ws + WS_XC), l == 0 ? kp->in[0] : (const float*)kp->out, l == 0 ? kp->in[2] : (const float*)(ws + WS_XC), modl + 2 * DM, (float*)(ws + WS_RSQ2), (bf16_t*)(ws + WS_XG), kp->in[5] + l * DM, modl + 4 * DM, 1, 0};
            pg8::gemm_phase(lds, xl, g, S, E);
        }
        GRID_BAR(pb + PH_G4);
        if (IN(pb + PH_G5)) {
            KargPtr kp = KARG(); unsigned char* ws = kp->ws; const bf16_t* WB = (const bf16_t*)(ws + WS_WB + (size_t)l * 22 * MiB); const int G = gridDim.x;
            pg8::Gemm g{(const bf16_t*)(ws + WS_XG), WB + WL_GU, RL, 2 * DFF, DM}; pg8::StaticOrder S; S.init(RL, 2 * DFF, G, BLK());
            EpiGU E{(bf16_t*)(ws + WS_ACT), (const float*)(ws + WS_RSQ2), (const float*)(ws + WS_BIAS2P) + (size_t)l * 5 * 2 * DFF};
            if (l == 0) {
                const float* modl = (const float*)(ws + WS_MOD) + (size_t)l * 5 * NMOD * DM;
                pg8::Gemm g4{(const bf16_t*)(ws + WS_MIX), WB + WL_OUT, R, DM, DM}; pg8::ListOrder S4{G - NCTXU, NCTXU, 16, 64, 4, 0};
                EpiRes E4{kp->out, (float*)(ws + WS_XC), kp->in[0], kp->in[2], modl + 2 * DM, (float*)(ws + WS_RSQ2), (bf16_t*)(ws + WS_XG), kp->in[5] + l * DM, modl + 4 * DM, 1, 0};
                pg8::gemm_phase(lds, xl, g4, S4, E4);
            }
            pg8::gemm_phase(lds, xl, g, S, E);
            if (l == 0) {
                const int nun5 = (RL / 256) * 22, rem = nun5 % G; const int lo = (rem > 0 && rem < G - NCTXU) ? rem : 0;
                if ((int)blockIdx.x >= lo && (int)blockIdx.x < G - NCTXU) { int tid_ = threadIdx.x; asm volatile("" : "+v"(tid_)); weight_prep(kp, ws, l + 1, (int)blockIdx.x - lo, G - NCTXU - lo, lds, tid_, 3); }
            }
        }
        GRID_BAR(pb + PH_G5);
        if (IN(pb + PH_G6)) {
            KargPtr kp = KARG(); unsigned char* ws = kp->ws; const bf16_t* WB = (const bf16_t*)(ws + WS_WB + (size_t)l * 22 * MiB); const int G = gridDim.x;
            const float* MOD = (const float*)(ws + WS_MOD); const float* modl = MOD + (size_t)l * 5 * NMOD * DM;
            pg8::Gemm g{(const bf16_t*)(ws + WS_ACT), WB + WL_DN, RL, DM, DFF}; pg8::StaticOrder S; S.init(RL, DM, G, BLK());
            const int nx = l + 1 < DEPTH;
            EpiRes E{kp->out, (float*)(ws + WS_XC), (const float*)kp->out, (const float*)(ws + WS_XC), modl + 5 * DM, (float*)(ws + WS_RSQ1), (bf16_t*)(ws + WS_XG), kp->in[4] + (nx ? (l + 1) * DM : 0), MOD + (size_t)(nx ? l + 1 : 0) * 5 * NMOD * DM + 1 * DM, nx, 0};
            const int n5 = 88 < G ? 88 : G;
            if (nx) {
                pg8::Gemm g5{(const bf16_t*)(ws + WS_XG), WB + WL_GU, R, 2 * DFF, DM}; pg8::ListOrder S5{0, n5, 88, 64, 4, 0};
                EpiGU E5{(bf16_t*)(ws + WS_ACT), (const float*)(ws + WS_RSQ2), (const float*)(ws + WS_BIAS2P) + (size_t)l * 5 * 2 * DFF};
                pg8::gemm_phase(lds, xl, g5, S5, E5);
            }
            pg8::gemm_phase(lds, xl, g, S, E);
            if (nx) {
                const int lo = n5 < G ? n5 : 0;
                if ((int)blockIdx.x >= lo) { int tid_ = threadIdx.x; asm volatile("" : "+v"(tid_)); bias_items(ws, l + 1, (int)blockIdx.x - lo, G - lo, tid_, 3); }
            }
        }
        GRID_BAR(pb + PH_G6);
    }
#undef IN
}

extern "C" void kernel_launch(void* const* d_in, const int* in_sizes, int n_in, void* d_out, int out_size, void* d_ws, size_t ws_size, hipStream_t stream) {
    if (n_in != 23 || ws_size < 256 * MiB || out_size != RL * DM) { fprintf(stderr, "kernel_launch: unexpected shapes (n_in %d, out %d, ws %zu)\n", n_in, out_size, ws_size); return; }
    unsigned char* ws = (unsigned char*)d_ws;
    static int grid = 0;
    if (grid == 0) {
        int dev = 0, cus = 0, per_cu = 0;
        if (hipGetDevice(&dev) != hipSuccess || hipDeviceGetAttribute(&cus, hipDeviceAttributeMultiprocessorCount, dev) != hipSuccess) { fprintf(stderr, "device query failed\n"); return; }
        if (hipFuncSetAttribute((const void*)mk_fwd, hipFuncAttributeMaxDynamicSharedMemorySize, MK_LDS) != hipSuccess) { fprintf(stderr, "hipFuncSetAttribute failed\n"); return; }
        if (hipOccupancyMaxActiveBlocksPerMultiprocessor(&per_cu, (const void*)mk_fwd, 512, MK_LDS) != hipSuccess || per_cu < 1) { fprintf(stderr, "occupancy query: %d\n", per_cu); (void)hipGetLastError(); return; }
        if (cus < 64) { fprintf(stderr, "kernel_launch: %d CUs: the phase program needs at least 64 workgroups\n", cus); return; }
        grid = cus;
    }
    MkArgs ma{}; for (int i = 0; i < 23; ++i) ma.in[i] = (const float*)d_in[i]; ma.out = (float*)d_out; ma.ws = ws;
#define MK(lo, hi) do { ma.ph_lo = (lo); ma.ph_hi = (hi); hipLaunchKernelGGL(mk_fwd, dim3(grid), dim3(512), MK_LDS, stream, ma); } while (0)
    if (hipMemsetAsync(ws, 0, 65536, stream) != hipSuccess) { fprintf(stderr, "memset failed\n"); return; }
    MK(0, PH_END);
}
```

```cpp
#include <hip/hip_runtime.h>
#include <cstdint>
#include <cstdio>

constexpr int DM = 1024, NB = 4, SEQ = 4096, CTXL = 256, DEPTH = 2;
constexpr int RL = NB * SEQ;
constexpr int RC = NB * CTXL;
constexpr int R = RL + RC;
constexpr int WA = 256, DIN = 1184, DFF = 2816, NMOD = 6;
constexpr int NH = 8, QKH = 96, QKN = 64, QKR = 32, VD = 64, QRANK = 256, KVRANK = 128;
constexpr int NKEY = CTXL + SEQ;
constexpr float EPS = 1e-6f;
constexpr float QSCALE = 0.10206207261596577f * 1.4426950408889634f;

typedef unsigned short bf16_t;
__device__ __forceinline__ float bf2f(bf16_t v) { return __uint_as_float(((unsigned)v) << 16); }
__device__ __forceinline__ bf16_t f2bf(float f) { unsigned u = __float_as_uint(f); return (bf16_t)((u + 0x7fffu + ((u >> 16) & 1u)) >> 16); }
__device__ __forceinline__ int mrow_of(int r) { return r < RL ? (r >> 12) : 4; }
__device__ __forceinline__ float wave_sum(float v) {
#pragma unroll
    for (int o = 1; o < 64; o <<= 1) v += __shfl_xor(v, o);
    return v;
}
__device__ __forceinline__ float silu_f(float x) { return x / (1.f + __expf(-x)); }
__device__ __forceinline__ float gelu_f(float x) { return 0.5f * x * (1.f + erff(x * 0.70710678118654752f)); }

constexpr size_t MiB = 1u << 20;
constexpr size_t WS_MOD = 1 * MiB;
constexpr size_t WS_BIAS1 = WS_MOD + 256 * 1024;
constexpr size_t WS_BIAS2 = WS_BIAS1 + 64 * 1024;
constexpr size_t WS_ROPE = WS_BIAS2 + 256 * 1024;
constexpr size_t WS_RSQ1 = 2 * MiB;
constexpr size_t WS_RSQ2 = 2 * MiB + 512 * 1024;
constexpr size_t WS_XC = 4 * MiB;
constexpr size_t WS_XG = 8 * MiB;
constexpr size_t WS_MIX = 42 * MiB;
constexpr size_t WS_W = 76 * MiB;
constexpr size_t WS_OV = 120 * MiB;
constexpr size_t WS_ACT = WS_OV;
constexpr size_t WS_U = WS_OV;
constexpr size_t WS_VT = WS_U + (size_t)R * 256 * 2;
constexpr size_t WS_BW = WS_VT + (size_t)R * 256 * 2;
constexpr size_t WS_QA = WS_BW + (size_t)R * 256 * 2;
constexpr size_t WS_KVA = WS_QA + (size_t)R * 256 * 2;
constexpr size_t WS_KR = WS_KVA + (size_t)R * 128 * 2;
constexpr size_t WS_Q = 161 * MiB;
constexpr size_t WS_K = WS_Q + (size_t)R * 768 * 2;
constexpr size_t WS_V = WS_K + (size_t)NB * NH * NKEY * QKH * 2;
constexpr size_t WS_P = 161 * MiB;
static_assert(WS_KR + (size_t)R * 32 * 4 <= WS_Q, "map");
static_assert(WS_V + (size_t)NB * NH * NKEY * VD * 2 <= 256 * MiB, "map");
static_assert(WS_P + (size_t)R * DIN * 4 <= 256 * MiB, "map");
static_assert(WS_ACT + (size_t)R * DFF * 2 <= 256 * MiB, "map");

__device__ __forceinline__ void sincos_d(double x, double& s, double& c) {
    const double k = rint(x * 0.63661977236758134308); const double r = fma(-k, 1.5707963267948966192, x) - k * 6.123233995736766e-17;
    const double r2 = r * r;
    double sp = -7.6471637318198164759e-13; sp = sp * r2 + 1.6059043836821614599e-10; sp = sp * r2 - 2.5052108385441718775e-08; sp = sp * r2 + 2.7557319223985890653e-06; sp = sp * r2 - 1.9841269841269841270e-04; sp = sp * r2 + 8.3333333333333333333e-03; sp = sp * r2 - 1.6666666666666666667e-01; sp = r + r * r2 * sp;
    double cp = 4.7794773323873852974e-14; cp = cp * r2 - 1.1470745597729724714e-11; cp = cp * r2 + 2.0876756987868098979e-09; cp = cp * r2 - 2.7557319223985890653e-07; cp = cp * r2 + 2.4801587301587301587e-05; cp = cp * r2 - 1.3888888888888888889e-03; cp = cp * r2 + 4.1666666666666666667e-02; cp = cp * r2 - 0.5; cp = 1.0 + r2 * cp;
    const int q = ((int)k) & 3;
    s = (q == 0) ? sp : (q == 1) ? cp : (q == 2) ? -sp : -cp;
    c = (q == 0) ? cp : (q == 1) ? -sp : (q == 2) ? -cp : sp;
}
__device__ __forceinline__ float rstd_of(const float* RSQ, int r) { const float4 p = *(const float4*)(RSQ + (size_t)r * 4); return rsqrtf(((p.x + p.y) + (p.z + p.w)) * (1.f / DM) + EPS); }

#define LAS __attribute__((address_space(3)))
#define GAS __attribute__((address_space(1)))
typedef short bf16x8 __attribute__((ext_vector_type(8)));
typedef float f32x4 __attribute__((ext_vector_type(4)));
typedef float f32x2 __attribute__((ext_vector_type(2)));
typedef unsigned u32x4 __attribute__((ext_vector_type(4)));
typedef unsigned u32x2 __attribute__((ext_vector_type(2)));
__device__ __forceinline__ unsigned cvt_pk_bf16(float lo, float hi) { unsigned r; asm volatile("v_cvt_pk_bf16_f32 %0, %1, %2" : "=v"(r) : "v"(lo), "v"(hi)); return r; }
__device__ __forceinline__ float fast_silu(float x) { return x * __builtin_amdgcn_rcpf(1.f + __builtin_amdgcn_exp2f(-1.4426950408889634f * x)); }

constexpr size_t WL_IN = 0;
constexpr size_t WL_OUT = WL_IN + (size_t)1280 * 1024;
constexpr size_t WL_GU = WL_OUT + (size_t)1024 * 1024;
constexpr size_t WL_DN = WL_GU + (size_t)5632 * 1024;
constexpr size_t WL_QB = WL_DN + (size_t)1024 * 2816;
constexpr size_t WL_KVB = WL_QB + (size_t)768 * 256;
constexpr size_t WL_SP = WL_KVB + (size_t)1024 * 128;
constexpr size_t WL_END = WL_SP + (size_t)4 * 128 * 128;
static_assert(WL_END * 2 <= 22 * MiB, "weights per layer");
constexpr size_t WS_WB = WS_W;
constexpr size_t WS_BIAS2P = 3 * MiB;
constexpr size_t WS_BIAS1P = 3 * MiB + 256 * 1024;

namespace pg8 {
constexpr int BM = 256, BK = 64, HALF = 128, HTB = HALF * BK * 2, STAGE_BYTES = 8 * HTB, NXCD = 8, WGM = 4;
__host__ __device__ __forceinline__ int lds_byte(int r, int c) { const int st = (r >> 4) * 2 + (c >> 5), rr = r & 15, cc = c & 31, ob = rr * 64 + cc * 2; return st * 1024 + (ob ^ (((ob >> 9) & 1) << 5)); }
__host__ __device__ __forceinline__ void stage_rc(int b, int& Rr, int& C) { const int st = b / 1024, sb = b % 1024, swz = sb ^ (((sb >> 9) & 1) << 5); Rr = (st >> 1) * 16 + swz / 64; C = (st & 1) * 32 + (swz % 64) / 2; }
__host__ __device__ __forceinline__ int perm32(int rho) { const int n = rho >> 4, i = rho & 15; return 8 * (i >> 2) + 4 * n + (i & 3); }
struct Unit { int pm, pn; };
struct Gemm { const bf16_t* A; const bf16_t* Bt; int M, N, K; int ldk = 0; };
struct ListOrder {
    int cu0, ncu, nunits, base_pm, npm, base_pn;
    __device__ bool next(int i, Unit& u) const {
        const int j = (int)blockIdx.x - cu0; if (j < 0 || j >= ncu) return false;
        const int idx = i * ncu + j; if (idx >= nunits) return false;
        u.pm = base_pm + idx % npm; u.pn = base_pn + idx / npm; return true;
    }
};
struct StaticOrder {
    int nM, nN, nwg, G, c;
    __device__ void init(int M, int N, int G_, int c_) { nM = M / BM; nN = N / BM; nwg = nM * nN; G = G_; c = c_; }
    __device__ bool next(int i, Unit& u) const {
        if (c < 0) return false; const long L = (long)i * G + c; if (L >= nwg) return false;
        int wgid = (int)L; { const int q = nwg / NXCD, r = nwg % NXCD, xcd = wgid % NXCD, off = wgid / NXCD; wgid = (xcd < r ? xcd * (q + 1) : r * (q + 1) + (xcd - r) * q) + off; }
        const int nig = WGM * nN, gid = wgid / nig, fm = gid * WGM, gsz = (nM - fm) < WGM ? (nM - fm) : WGM;
        u.pm = fm + ((wgid % nig) % gsz); u.pn = (wgid % nig) / gsz; return true;
    }
};
template <class Epi, class Sched>
__device__ __forceinline__ void gemm_phase(LAS unsigned char* lds, LAS unsigned char* xl, const Gemm g, const Sched& S, const Epi& E) {
    int tid = threadIdx.x; asm volatile("" : "+v"(tid));
    const int wid = __builtin_amdgcn_readfirstlane(tid >> 6), lane = tid & 63, wr = wid >> 2, wc = wid & 3, fr = lane & 15, fq = lane >> 4;
    const int K = g.K, nt = K / BK, LD = g.ldk ? g.ldk : g.K;
    unsigned voffA[2], voffB[2];
#pragma unroll
    for (int i = 0; i < 2; ++i) { int Rr, C; stage_rc(tid * 16 + i * 8192, Rr, C); const int Rb = (Rr & ~31) + perm32(Rr & 31);
        voffA[i] = (unsigned)(Rr * LD + C) * 2u; voffB[i] = (unsigned)(Rb * LD + C) * 2u; }
    const size_t kstep = (size_t)(BK * 2);
    const size_t hstep = (size_t)HALF * LD * 2;
    const size_t tstep = 2 * hstep;
    const unsigned ldsw = (unsigned)wid * 1024u;
    const int aoff = lds_byte(wr * 64 + fr, fq * 8), boff = lds_byte(wc * 32 + fr, fq * 8);
#define PG8_SA(b, h) (((b) * 2 + (h)) * HTB)
#define PG8_SB(b, h) ((4 + (b) * 2 + (h)) * HTB)
#define PG8_STAGE(bufoff, gbase, voff) do { _Pragma("unroll") for (int _i = 0; _i < 2; ++_i) \
        __builtin_amdgcn_global_load_lds((const unsigned*)((const char*)(gbase) + (voff)[_i]), (LAS unsigned*)(lds + (bufoff) + ldsw + _i * 8192), 16, 0, 0); } while (0)
#define PG8_LDA(dst, b, h) do { _Pragma("unroll") for (int m = 0; m < 4; ++m) _Pragma("unroll") for (int k = 0; k < 2; ++k) dst[m][k] = *(const LAS bf16x8*)(lds + PG8_SA(b, h) + aoff + m * 2048 + k * 1024); } while (0)
#define PG8_LDB(dst, b, h) do { _Pragma("unroll") for (int n = 0; n < 2; ++n) _Pragma("unroll") for (int k = 0; k < 2; ++k) dst[n][k] = *(const LAS bf16x8*)(lds + PG8_SB(b, h) + boff + n * 2048 + k * 1024); } while (0)
#define PG8_MMA(ai, bj, At, Bt) do { __builtin_amdgcn_s_setprio(1); _Pragma("unroll") for (int m = 0; m < 4; ++m) _Pragma("unroll") for (int n = 0; n < 2; ++n) _Pragma("unroll") for (int k = 0; k < 2; ++k) \
        acc[ai][bj][m][n] = __builtin_amdgcn_mfma_f32_16x16x32_bf16(Bt[n][k], At[m][k], acc[ai][bj][m][n], 0, 0, 0); __builtin_amdgcn_s_setprio(0); } while (0)
#define PG8_WAIT_V(n) asm volatile("s_waitcnt vmcnt(" #n ")" ::: "memory")
#define PG8_WAIT_L(n) asm volatile("s_waitcnt lgkmcnt(" #n ")" ::: "memory")
#define PG8_BAR __builtin_amdgcn_s_barrier()
#define PG8_SCHED __builtin_amdgcn_sched_barrier(0)
    Unit cur, nxt; int ui = 0;
    if (!S.next(0, cur)) return;
    f32x4 acc[2][2][4][2];
#pragma unroll
    for (int a = 0; a < 2; ++a)
#pragma unroll
        for (int b = 0; b < 2; ++b)
#pragma unroll
            for (int m = 0; m < 4; ++m)
#pragma unroll
                for (int n = 0; n < 2; ++n) acc[a][b][m][n] = (f32x4){0.f, 0.f, 0.f, 0.f};
    bf16x8 At[4][2], B0[2][2], B1[2][2];
    const char* cA = (const char*)g.A + (size_t)cur.pm * tstep; const char* cB = (const char*)g.Bt + (size_t)cur.pn * tstep;
    PG8_STAGE(PG8_SB(0, 0), cB, voffB); PG8_STAGE(PG8_SB(0, 1), cB + hstep, voffB); PG8_STAGE(PG8_SA(0, 0), cA, voffA); PG8_STAGE(PG8_SA(0, 1), cA + hstep, voffA);
    if (wr == 1) PG8_BAR;
    PG8_WAIT_V(2); PG8_BAR;
    PG8_STAGE(PG8_SB(1, 0), cB + kstep, voffB); PG8_STAGE(PG8_SA(1, 0), cA + kstep, voffA); PG8_STAGE(PG8_SB(1, 1), cB + hstep + kstep, voffB);
    PG8_WAIT_V(6); PG8_BAR;
    for (;;) {
        const bool has_next = S.next(ui + 1, nxt);
        const char* nA = has_next ? (const char*)g.A + (size_t)nxt.pm * tstep : cA; const char* nB = has_next ? (const char*)g.Bt + (size_t)nxt.pn * tstep : cB;
        for (int t = 0; t < nt; t += 2) {
            const bool last = (t == nt - 2);
            const char* a1 = cA + (size_t)(t + 1) * kstep;
            const char* a2 = last ? nA : cA + (size_t)(t + 2) * kstep; const char* b2 = last ? nB : cB + (size_t)(t + 2) * kstep;
            const char* a3 = a2 + kstep; const char* b3 = b2 + kstep;
            PG8_LDB(B0, 0, 0); PG8_LDB(B1, 0, 1); PG8_SCHED; PG8_LDA(At, 0, 0); PG8_STAGE(PG8_SA(1, 1), a1 + hstep, voffA);
            PG8_WAIT_V(8); PG8_WAIT_L(0); PG8_BAR; PG8_MMA(0, 0, At, B0); PG8_MMA(0, 1, At, B1); PG8_BAR; PG8_SCHED;
            PG8_LDA(At, 0, 1); PG8_STAGE(PG8_SB(0, 0), b2, voffB); PG8_STAGE(PG8_SB(0, 1), b2 + hstep, voffB); PG8_STAGE(PG8_SA(0, 0), a2, voffA);
            PG8_WAIT_V(8); PG8_WAIT_L(0); PG8_BAR; PG8_MMA(1, 0, At, B0); PG8_MMA(1, 1, At, B1); PG8_BAR; PG8_SCHED;
            PG8_LDB(B0, 1, 0); PG8_LDB(B1, 1, 1); PG8_SCHED; PG8_LDA(At, 1, 0); PG8_STAGE(PG8_SA(0, 1), a2 + hstep, voffA);
            PG8_WAIT_V(8); PG8_WAIT_L(0); PG8_BAR; PG8_MMA(0, 0, At, B0); PG8_MMA(0, 1, At, B1); PG8_BAR; PG8_SCHED;
            PG8_LDA(At, 1, 1); PG8_STAGE(PG8_SB(1, 0), b3, voffB); PG8_STAGE(PG8_SB(1, 1), b3 + hstep, voffB); PG8_STAGE(PG8_SA(1, 0), a3, voffA);
            PG8_WAIT_V(8); PG8_WAIT_L(0); PG8_BAR; PG8_MMA(1, 0, At, B0); PG8_MMA(1, 1, At, B1); PG8_BAR; PG8_SCHED;
        }
        if (wr == 0) PG8_BAR;
        { int fr_ = fr, fq_ = fq; asm volatile("" : "+v"(fr_), "+v"(fq_)); E(acc, cur, wr, wc, fr_, fq_, xl); }
        if (!has_next) break;
#pragma unroll
        for (int a = 0; a < 2; ++a)
#pragma unroll
            for (int b = 0; b < 2; ++b)
#pragma unroll
                for (int m = 0; m < 4; ++m)
#pragma unroll
                    for (int n = 0; n < 2; ++n) acc[a][b][m][n] = (f32x4){0.f, 0.f, 0.f, 0.f};
        cur = nxt; cA = nA; cB = nB; ++ui;
        if (wr == 1) PG8_BAR;
    }
    PG8_WAIT_V(0);
    PG8_BAR;
#undef PG8_SA
#undef PG8_SB
#undef PG8_STAGE
#undef PG8_LDA
#undef PG8_LDB
#undef PG8_MMA
}
}

__device__ __forceinline__ f32x4 ld4(const float* p) { return *(const f32x4*)p; }
struct EpiGU {
    bf16_t* ACT; const float* RSQ; const float* BIAS;
    __device__ __forceinline__ void operator()(f32x4 (&acc)[2][2][4][2], const pg8::Unit& u, int wr, int wc, int fr, int fq, LAS unsigned char*) const {
        const int row0 = u.pm * 256 + wr * 64 + fr; const int mr = mrow_of(u.pm * 256);
        const float* bb = BIAS + (size_t)mr * (2 * DFF) + u.pn * 256 + wc * 32 + 8 * fq;
        const f32x4 bg0 = ld4(bb), bg1 = ld4(bb + 4), bu0 = ld4(bb + 128), bu1 = ld4(bb + 132);
        bf16_t* ob = ACT + u.pn * 128 + wc * 32 + 8 * fq;
        float rsv[8];
        { f32x4 pq_[8];
#pragma unroll
          for (int q = 0; q < 8; ++q) pq_[q] = ld4(RSQ + (size_t)(row0 + (q >> 2) * 128 + (q & 3) * 16) * 4);
          __builtin_amdgcn_sched_barrier(0);
#pragma unroll
          for (int q = 0; q < 8; ++q) rsv[q] = rsqrtf(((pq_[q][0] + pq_[q][1]) + (pq_[q][2] + pq_[q][3])) * (1.f / DM) + EPS); }
#pragma unroll
        for (int ai = 0; ai < 2; ++ai)
#pragma unroll
            for (int m = 0; m < 4; ++m) { const int row = row0 + ai * 128 + m * 16; const float rs = rsv[ai * 4 + m];
                const f32x4 g0 = acc[ai][0][m][0] * rs + bg0, g1 = acc[ai][0][m][1] * rs + bg1, u0 = acc[ai][1][m][0] * rs + bu0, u1 = acc[ai][1][m][1] * rs + bu1;
                u32x4 w; w.x = cvt_pk_bf16(fast_silu(g0[0]) * u0[0], fast_silu(g0[1]) * u0[1]); w.y = cvt_pk_bf16(fast_silu(g0[2]) * u0[2], fast_silu(g0[3]) * u0[3]);
                w.z = cvt_pk_bf16(fast_silu(g1[0]) * u1[0], fast_silu(g1[1]) * u1[1]); w.w = cvt_pk_bf16(fast_silu(g1[2]) * u1[2], fast_silu(g1[3]) * u1[3]);
                *(u32x4*)(ob + (size_t)row * DFF) = w; }
    }
};
struct EpiRes {
    float* XL; float* XC; const float* XLr; const float* XCr; const float* gate; float* RSQ; bf16_t* XG; const float* ng; const float* nsc; int do_next; int pad;
    float* part = nullptr; unsigned* flag = nullptr;
    __device__ __forceinline__ void operator()(f32x4 (&acc)[2][2][4][2], const pg8::Unit& u, int wr, int wc, int fr, int fq, LAS unsigned char* xl) const {
        if (pad != 0) {
            int tid_ = threadIdx.x; asm volatile("" : "+v"(tid_));
            const int un = (u.pm & 3) + 4 * u.pn;
            float* pp = part + (size_t)un * (32 * 2048) + tid_ * 4; unsigned* fl = flag + un * 16;
            if (pad == 1) {
#pragma unroll
                for (int e = 0; e < 32; ++e) *(f32x4*)(pp + e * 2048) = acc[e >> 4][(e >> 3) & 1][(e >> 1) & 3][e & 1];
                asm volatile("s_waitcnt vmcnt(0)" ::: "memory"); __builtin_amdgcn_s_barrier();
                if (tid_ == 0) { __builtin_amdgcn_fence(__ATOMIC_RELEASE, "agent"); __hip_atomic_store(fl, 1u, __ATOMIC_RELAXED, __HIP_MEMORY_SCOPE_AGENT); }
                return;
            }
            if (tid_ == 0) { unsigned sp = 0; while (__hip_atomic_load(fl, __ATOMIC_RELAXED, __HIP_MEMORY_SCOPE_AGENT) == 0u && ++sp < (1u << 22)) __builtin_amdgcn_s_sleep(1); }
            __builtin_amdgcn_s_barrier(); __builtin_amdgcn_fence(__ATOMIC_ACQUIRE, "agent");
#pragma unroll
            for (int c8 = 0; c8 < 4; ++c8) { f32x4 pv[8];
#pragma unroll
                for (int e = 0; e < 8; ++e) pv[e] = *(const f32x4*)(pp + (c8 * 8 + e) * 2048);
#pragma unroll
                for (int e = 0; e < 8; ++e) { const int q = c8 * 8 + e; acc[q >> 4][(q >> 3) & 1][(q >> 1) & 3][q & 1] += pv[e]; } }
        }
        const int mr = mrow_of(u.pm * 256); const int col0 = u.pn * 256 + wc * 32 + 8 * fq; const int rl0 = wr * 64 + fr;
        float* xbase = u.pm < 64 ? XL + (size_t)(u.pm * 256) * DM : XC + (size_t)(u.pm * 256 - RL) * DM;
        const float* xrbase = u.pm < 64 ? XLr + (size_t)(u.pm * 256) * DM : XCr + (size_t)(u.pm * 256 - RL) * DM;
        LAS float* P = (LAS float*)xl;
        float ss[8];
#pragma unroll
        for (int q = 0; q < 8; ++q) ss[q] = 0.f;
#pragma unroll
        for (int bj = 0; bj < 2; ++bj) {
            f32x4 gt[2], gm[2];
#pragma unroll
            for (int n = 0; n < 2; ++n) { const int c = col0 + bj * 128 + 4 * n; gt[n] = ld4(gate + (size_t)mr * (NMOD * DM) + c);
                if (do_next) gm[n] = ld4(ng + c) * (ld4(nsc + (size_t)mr * (NMOD * DM) + c) + 1.f); else gm[n] = (f32x4){0.f, 0.f, 0.f, 0.f}; }
#pragma unroll
            for (int ai = 0; ai < 2; ++ai) {
                f32x4 xv[4][2];
#pragma unroll
                for (int m = 0; m < 4; ++m) { const unsigned off = (unsigned)((rl0 + ai * 128 + m * 16) * DM + col0 + bj * 128) * 4u;
                    const float* xp = (const float*)((const char*)xrbase + off); xv[m][0] = ld4(xp); xv[m][1] = ld4(xp + 4); }
#pragma unroll
                for (int m = 0; m < 4; ++m) { const int q = ai * 4 + m; const int rl = rl0 + ai * 128 + m * 16; const unsigned off = (unsigned)(rl * DM + col0 + bj * 128) * 4u; float* xp = (float*)((char*)xbase + off);
                    const f32x4 y0 = xv[m][0] + gt[0] * acc[ai][bj][m][0], y1 = xv[m][1] + gt[1] * acc[ai][bj][m][1];
                    *(f32x4*)(xp) = y0; *(f32x4*)(xp + 4) = y1;
                    if (do_next) { ss[q] += (y0[0] * y0[0] + y0[1] * y0[1]) + (y0[2] * y0[2] + y0[3] * y0[3]) + (y1[0] * y1[0] + y1[1] * y1[1]) + (y1[2] * y1[2] + y1[3] * y1[3]);
                        const f32x4 z0 = y0 * gm[0], z1 = y1 * gm[1]; u32x4 w; w.x = cvt_pk_bf16(z0[0], z0[1]); w.y = cvt_pk_bf16(z0[2], z0[3]); w.z = cvt_pk_bf16(z1[0], z1[1]); w.w = cvt_pk_bf16(z1[2], z1[3]);
                        *(u32x4*)((char*)(XG + (size_t)(u.pm * 256) * DM) + (off >> 1)) = w; } }
                asm volatile("" ::: "memory");
            }
        }
        if (do_next) {
#pragma unroll
            for (int q = 0; q < 8; ++q) { float t = ss[q]; t += __shfl_xor(t, 16); t += __shfl_xor(t, 32); if (fq == 0) P[(rl0 + (q >> 2) * 128 + (q & 3) * 16) * 4 + wc] = t; }
        }
        if (do_next) {
            asm volatile("s_waitcnt lgkmcnt(0)" ::: "memory"); __builtin_amdgcn_s_barrier(); asm volatile("" ::: "memory");
            int tid = threadIdx.x; asm volatile("" : "+v"(tid));
            if (tid < 256) { const f32x4 p = *(const LAS f32x4*)(P + tid * 4); RSQ[(size_t)(u.pm * 256 + tid) * 4 + u.pn] = (p[0] + p[1]) + (p[2] + p[3]); }
        }
    }
};


__device__ __forceinline__ float gelu_fast(float v) {
    const float av = fabsf(v), d = av * 0.2316418882f + 1.0f, t = __builtin_amdgcn_rcpf(d);
    float q = t * 0.5307027145f + (-0.7265760135f); q = q * t + 0.7107068705f; q = q * t + (-0.142248368f); q = q * t + 0.127414796f; q = q * t;
    const float e = __builtin_amdgcn_exp2f((v * v) * (-0.72134752044f));
    const float m = v * (q * e), r = v - m; return v < 0.f ? m : r;
}
struct EpiG1 {
    const float* RSQ; const float* BIAS; const float* sgu_g; const float* qa_g; const float* kva_g;
    bf16_t* U; bf16_t* VT; bf16_t* BW; bf16_t* QA; bf16_t* KVA; float* KR;
#define G1_PACK(v0, v1) (u32x4){cvt_pk_bf16((v0)[0], (v0)[1]), cvt_pk_bf16((v0)[2], (v0)[3]), cvt_pk_bf16((v1)[0], (v1)[1]), cvt_pk_bf16((v1)[2], (v1)[3])}
#define G1_SS(v) (((v)[0] * (v)[0] + (v)[1] * (v)[1]) + ((v)[2] * (v)[2] + (v)[3] * (v)[3]))
    __device__ __forceinline__ void operator()(f32x4 (&acc)[2][2][4][2], const pg8::Unit& u, int wr, int wc, int fr, int fq, LAS unsigned char* xl) const {
        const int mr = mrow_of(u.pm * 256); const int cl = wc * 32 + 8 * fq; const int rl0 = wr * 64 + fr; const int pn = u.pn;
        LAS float* P = (LAS float*)xl;
        {   f32x4 bv[2][2];
#pragma unroll
            for (int bj = 0; bj < 2; ++bj)
#pragma unroll
                for (int n = 0; n < 2; ++n) bv[bj][n] = ld4(BIAS + (size_t)mr * 1280 + pn * 256 + bj * 128 + cl + 4 * n);
            const bool act = (pn <= 1);
            float rsv[8];
            { f32x4 pq_[8];
#pragma unroll
              for (int q = 0; q < 8; ++q) pq_[q] = ld4(RSQ + (size_t)(u.pm * 256 + rl0 + (q >> 2) * 128 + (q & 3) * 16) * 4);
              __builtin_amdgcn_sched_barrier(0);
#pragma unroll
              for (int q = 0; q < 8; ++q) rsv[q] = rsqrtf(((pq_[q][0] + pq_[q][1]) + (pq_[q][2] + pq_[q][3])) * (1.f / DM) + EPS); }
#pragma unroll
            for (int ai = 0; ai < 2; ++ai)
#pragma unroll
                for (int m = 0; m < 4; ++m) { const float rs = rsv[ai * 4 + m];
#pragma unroll
                    for (int bj = 0; bj < 2; ++bj)
#pragma unroll
                        for (int n = 0; n < 2; ++n) { f32x4 v = acc[ai][bj][m][n] * rs + bv[bj][n];
                            if (act) v = (f32x4){gelu_fast(v[0]), gelu_fast(v[1]), gelu_fast(v[2]), gelu_fast(v[3])};
                            acc[ai][bj][m][n] = v; }
                    if (m & 1) asm volatile("" ::: "memory"); }
        }
        if (pn == 0) {
#pragma unroll
            for (int ai = 0; ai < 2; ++ai)
#pragma unroll
                for (int m = 0; m < 4; ++m) { const int row = u.pm * 256 + rl0 + ai * 128 + m * 16;
#pragma unroll
                    for (int bj = 0; bj < 2; ++bj) *(u32x4*)(U + (size_t)row * 256 + bj * 128 + cl) = G1_PACK(acc[ai][bj][m][0], acc[ai][bj][m][1]); }
            return;
        }
        if (pn == 2) {
#pragma unroll
            for (int ai = 0; ai < 2; ++ai)
#pragma unroll
                for (int m = 0; m < 4; ++m) { const int row = u.pm * 256 + rl0 + ai * 128 + m * 16;
#pragma unroll
                    for (int bj = 0; bj < 2; ++bj) *(u32x4*)(BW + (size_t)row * 256 + bj * 128 + cl) = G1_PACK(acc[ai][bj][m][0], acc[ai][bj][m][1]); }
            return;
        }
#pragma unroll
        for (int ai = 0; ai < 2; ++ai)
#pragma unroll
            for (int m = 0; m < 4; ++m) { float ss = G1_SS(acc[ai][0][m][0]) + G1_SS(acc[ai][0][m][1]);
                if (pn != 4) ss += G1_SS(acc[ai][1][m][0]) + G1_SS(acc[ai][1][m][1]);
                ss += __shfl_xor(ss, 16); ss += __shfl_xor(ss, 32);
                if (fq == 0) P[(rl0 + ai * 128 + m * 16) * 4 + wc] = ss; }
        asm volatile("s_waitcnt lgkmcnt(0)" ::: "memory"); __builtin_amdgcn_s_barrier(); asm volatile("" ::: "memory");
        if (pn == 1) {
            const int wid_ = wr * 4 + wc; LAS unsigned char* W = xl + (wid_ < 3 ? 4096 + wid_ * 1280 : 8448 + (wid_ - 3) * 1280);
            const int ln = fq * 16 + fr; LAS unsigned char* Ww = W + (fq * 4) * 80 + fr * 2; const LAS unsigned char* Wr = W + (ln >> 2) * 80 + (ln & 3) * 16;
            const int cq = ln >> 2, jg = ln & 3;
#pragma unroll
            for (int ai = 0; ai < 2; ++ai) { float rn[4];
#pragma unroll
                for (int m = 0; m < 4; ++m) { const f32x4 p = *(const LAS f32x4*)(P + (rl0 + ai * 128 + m * 16) * 4); rn[m] = rsqrtf(((p[0] + p[1]) + (p[2] + p[3])) * (1.f / 256.f) + EPS); }
#pragma unroll
                for (int bj = 0; bj < 2; ++bj) { const f32x4 g0 = ld4(sgu_g + bj * 128 + cl), g1 = ld4(sgu_g + bj * 128 + cl + 4);
#pragma unroll
                    for (int mh = 0; mh < 2; ++mh)
#pragma unroll
                        for (int n = 0; n < 2; ++n) {
#pragma unroll
                            for (int mm = 0; mm < 2; ++mm) { const int m = 2 * mh + mm; const f32x4 v = acc[ai][bj][m][n] * rn[m] * (n ? g1 : g0);
#pragma unroll
                                for (int i = 0; i < 4; ++i) *(LAS bf16_t*)(Ww + i * 80 + mm * 32) = (bf16_t)(cvt_pk_bf16(v[i], 0.f) & 0xffffu); }
                            asm volatile("s_waitcnt lgkmcnt(0)" ::: "memory");
                            const u32x4 t = *(const LAS u32x4*)Wr;
                            *(u32x4*)(VT + ((((size_t)(u.pm * 2 + ai) * 8 + bj * 4 + wc) * 8 + wr * 4 + mh * 2 + (jg >> 1)) * 64 + (jg & 1) * 32 + (cq >> 2) * 8 + 4 * n + (cq & 3)) * 8) = t;
                            asm volatile("" ::: "memory"); } } }
        } else if (pn == 3) {
#pragma unroll
            for (int bj = 0; bj < 2; ++bj) { const f32x4 g0 = ld4(qa_g + bj * 128 + cl), g1 = ld4(qa_g + bj * 128 + cl + 4);
#pragma unroll
                for (int ai = 0; ai < 2; ++ai)
#pragma unroll
                    for (int m = 0; m < 4; ++m) { const int rl = rl0 + ai * 128 + m * 16; const int row = u.pm * 256 + rl;
                        const f32x4 p = *(const LAS f32x4*)(P + rl * 4); const float rn = rsqrtf(((p[0] + p[1]) + (p[2] + p[3])) * (1.f / 256.f) + EPS);
                        const f32x4 v0 = acc[ai][bj][m][0] * rn * g0, v1 = acc[ai][bj][m][1] * rn * g1;
                        { const int c8 = bj * 16 + wc * 4 + fq; *(u32x4*)(QA + ((((size_t)(row >> 5) * 16 + (c8 >> 1)) * 64 + (c8 & 1) * 32 + (row & 31)) * 8)) = G1_PACK(v0, v1); } } }
        } else {
            const f32x4 g0 = ld4(kva_g + cl), g1 = ld4(kva_g + cl + 4);
#pragma unroll
            for (int ai = 0; ai < 2; ++ai)
#pragma unroll
                for (int m = 0; m < 4; ++m) { const int rl = rl0 + ai * 128 + m * 16; const int row = u.pm * 256 + rl;
                    const f32x4 p = *(const LAS f32x4*)(P + rl * 4); const float rn = rsqrtf(((p[0] + p[1]) + (p[2] + p[3])) * (1.f / 128.f) + EPS);
                    const f32x4 v0 = acc[ai][0][m][0] * rn * g0, v1 = acc[ai][0][m][1] * rn * g1;
                    { const int c8 = wc * 4 + fq; *(u32x4*)(KVA + ((((size_t)(row >> 5) * 8 + (c8 >> 1)) * 64 + (c8 & 1) * 32 + (row & 31)) * 8)) = G1_PACK(v0, v1); }
                    if (wc == 0) { *(f32x4*)(KR + (size_t)row * 32 + 8 * fq) = acc[ai][1][m][0]; *(f32x4*)(KR + (size_t)row * 32 + 8 * fq + 4) = acc[ai][1][m][1]; } }
        }
    }
#undef G1_PACK
#undef G1_SS
};


namespace att {
using s16x4 = __attribute__((ext_vector_type(4))) short;
using f32x16 = __attribute__((ext_vector_type(16))) float;
constexpr int KROW = 208;
constexpr int NBUF = 3, SHM_V = 64 * 64 * 2, SHM_K = 64 * KROW, OFF_K = NBUF * SHM_V, OFF_WS = OFF_K + NBUF * SHM_K, SHM_ATTN = OFF_WS + 8 * 64 * 4;
#define ASBAR() __builtin_amdgcn_sched_barrier(0)
__device__ __forceinline__ int crow(int r, int hi) { return (r & 3) + 8 * (r >> 2) + 4 * hi; }
__device__ __forceinline__ int v_st(int k, int c) { const int kk = (k & ~0xC) | ((k & 4) << 1) | ((k & 8) >> 1); return ((kk >> 3) * 2 + (c >> 5)) * 512 + ((kk & 7) * 32 + (c & 31)) * 2; }
__device__ __forceinline__ int v_rd_base(int lane) { return ((lane & 3) << 3) | (((lane >> 2) & 3) << 6) | (((lane >> 4) & 1) << 5) | (((lane >> 5) & 1) << 8); }
constexpr int v_rd_off(int d0, int ks, int half) { return d0 * 512 + ks * 2048 + half * 1024; }
template <int OFF> __device__ __forceinline__ s16x4 tr_read(int vb) { s16x4 r; asm volatile("ds_read_b64_tr_b16 %0, %1 offset:%2" : "=&v"(r) : "v"(vb), "i"(OFF) : "memory"); return r; }
__device__ __forceinline__ void partialSM(f32x16& p0, f32x16& p1) {
#pragma unroll
    for (int r = 0; r < 16; ++r) p0[r] = __builtin_amdgcn_exp2f(p0[r]);
}
__device__ __forceinline__ void finishSM(f32x16& p0, f32x16& p1, float& l_reg, bf16x8& pa0, bf16x8& pa1, bf16x8& pa2, bf16x8& pa3) {
#pragma unroll
    for (int r = 0; r < 16; ++r) p1[r] = __builtin_amdgcn_exp2f(p1[r]);
    f32x2 s2a = {p0[0], p0[1]}, s2b = {p1[0], p1[1]};
#pragma unroll
    for (int r = 2; r < 16; r += 2) { s2a += (f32x2){p0[r], p0[r + 1]}; s2b += (f32x2){p1[r], p1[r + 1]}; }
    s2a += s2b; l_reg += s2a[0] + s2a[1];
#define PK4(P, BASE, OUT) do { unsigned a0 = cvt_pk_bf16(P[BASE + 0], P[BASE + 1]), a1 = cvt_pk_bf16(P[BASE + 2], P[BASE + 3]);   \
    unsigned b0 = cvt_pk_bf16(P[BASE + 4], P[BASE + 5]), b1 = cvt_pk_bf16(P[BASE + 6], P[BASE + 7]);                              \
    auto r0 = __builtin_amdgcn_permlane32_swap(a0, b0, false, false); auto r1 = __builtin_amdgcn_permlane32_swap(a1, b1, false, false); \
    u32x4 w = {r0[0], r1[0], r0[1], r1[1]}; OUT = *reinterpret_cast<bf16x8*>(&w); } while (0)
    PK4(p0, 0, pa0); PK4(p0, 8, pa1); PK4(p1, 0, pa2); PK4(p1, 8, pa3);
#undef PK4
}
__device__ __forceinline__ void qkt(f32x16& p0, f32x16& p1, LAS const unsigned char* Ks, const bf16x8 (&qr)[6], int r32, int hi) {
    p0 = f32x16{}; p1 = f32x16{};
#pragma unroll
    for (int d0 = 0; d0 < 6; ++d0) {
        const bf16x8 b0 = *(LAS const bf16x8*)(Ks + r32 * KROW + d0 * 32 + hi * 16);
        const bf16x8 b1 = *(LAS const bf16x8*)(Ks + (32 + r32) * KROW + d0 * 32 + hi * 16);
        p0 = __builtin_amdgcn_mfma_f32_32x32x16_bf16(b0, qr[d0], p0, 0, 0, 0);
        p1 = __builtin_amdgcn_mfma_f32_32x32x16_bf16(b1, qr[d0], p1, 0, 0, 0); }
}
template <int D0> __device__ __forceinline__ void pv_one(f32x16& od, int vb, bf16x8 pa0, bf16x8 pa1, bf16x8 pa2, bf16x8 pa3) {
    const s16x4 l0 = tr_read<v_rd_off(D0, 0, 0)>(vb), h0 = tr_read<v_rd_off(D0, 0, 1)>(vb), l1 = tr_read<v_rd_off(D0, 1, 0)>(vb), h1 = tr_read<v_rd_off(D0, 1, 1)>(vb);
    const s16x4 l2 = tr_read<v_rd_off(D0, 2, 0)>(vb), h2 = tr_read<v_rd_off(D0, 2, 1)>(vb), l3 = tr_read<v_rd_off(D0, 3, 0)>(vb), h3 = tr_read<v_rd_off(D0, 3, 1)>(vb);
    asm volatile("s_waitcnt lgkmcnt(0)" ::: "memory"); ASBAR();
#define PK(L, H) (bf16x8){L[0], L[1], L[2], L[3], H[0], H[1], H[2], H[3]}
    od = __builtin_amdgcn_mfma_f32_32x32x16_bf16(pa0, PK(l0, h0), od, 0, 0, 0);
    od = __builtin_amdgcn_mfma_f32_32x32x16_bf16(pa1, PK(l1, h1), od, 0, 0, 0);
    od = __builtin_amdgcn_mfma_f32_32x32x16_bf16(pa2, PK(l2, h2), od, 0, 0, 0);
    od = __builtin_amdgcn_mfma_f32_32x32x16_bf16(pa3, PK(l3, h3), od, 0, 0, 0);
#undef PK
}
template <int BASE> __device__ __forceinline__ bf16x8 pack8(const f32x16& P) {
    unsigned a0 = cvt_pk_bf16(P[BASE + 0], P[BASE + 1]), a1 = cvt_pk_bf16(P[BASE + 2], P[BASE + 3]), b0 = cvt_pk_bf16(P[BASE + 4], P[BASE + 5]), b1 = cvt_pk_bf16(P[BASE + 6], P[BASE + 7]);
    auto r0 = __builtin_amdgcn_permlane32_swap(a0, b0, false, false); auto r1 = __builtin_amdgcn_permlane32_swap(a1, b1, false, false);
    u32x4 w = {r0[0], r1[0], r0[1], r1[1]}; return *reinterpret_cast<bf16x8*>(&w);
}
__device__ __forceinline__ void arope(const float* __restrict__ ROPE, int t, int pp, float& x1, float& x2) {
    const int pos = pp < 8 ? (t >> 6) : (t & 63); const f32x2 cs = *(const f32x2*)(ROPE + (pos * 8 + (pp & 7)) * 2);
    const float y1 = x1 * cs[0] - x2 * cs[1], y2 = x1 * cs[1] + x2 * cs[0]; x1 = y1; x2 = y2;
}
__device__ __forceinline__ void attn_unit(const bf16_t* __restrict__ QA, const bf16_t* __restrict__ WQh, const float* __restrict__ qn_g, const float* __restrict__ ROPE, int row0, const bf16_t* __restrict__ Kh, const bf16_t* __restrict__ Vh, bf16_t* __restrict__ Ob, int seq, LAS unsigned char* lds) {
    int tid = threadIdx.x; asm volatile("" : "+v"(tid));
    const int wid = __builtin_amdgcn_readfirstlane(tid >> 6), lane = tid & 63, r32 = lane & 31, hi = lane >> 5;
    LAS float* wsf = (LAS float*)(lds + OFF_WS) + wid * 64; LAS float* li_l = wsf;
    float l_reg = 0; f32x16 o[2] = {}; bf16x8 qr[6];
    const bool isK = wid < 4; const int t = tid & 255;
    const unsigned char* gbase = isK ? (const unsigned char*)Kh : (const unsigned char*)Vh; const int tstride = isK ? 64 * 96 * 2 : 64 * 64 * 2;
    int loff0, loff1, loff2;
    { const int c0 = t, c1 = t + 256, c2 = t + 512;
      loff0 = isK ? (c0 / 12) * KROW + (c0 % 12) * 16 : v_st(c0 >> 3, (c0 & 7) * 8);
      loff1 = isK ? (c1 / 12) * KROW + (c1 % 12) * 16 : v_st(c1 >> 3, (c1 & 7) * 8);
      loff2 = (c2 / 12) * KROW + (c2 % 12) * 16; }
    const int vb0 = (int)(uintptr_t)(lds) + v_rd_base(lane);
    bf16x8 sA0, sA1, sA2, sB0, sB1, sB2;
#define SLOAD(S, tile) do { const unsigned char* p_ = gbase + (size_t)(tile) * tstride + t * 16; S##0 = *(const bf16x8*)(p_); S##1 = *(const bf16x8*)(p_ + 4096); if (isK) S##2 = *(const bf16x8*)(p_ + 8192); } while (0)
#define SWRITE(b, S) do { LAS unsigned char* d_ = lds + (isK ? OFF_K + (b) * SHM_K : (b) * SHM_V); *(LAS bf16x8*)(d_ + loff0) = S##0; *(LAS bf16x8*)(d_ + loff1) = S##1; if (isK) *(LAS bf16x8*)(d_ + loff2) = S##2; } while (0)
    f32x16 pA0, pA1, pB0, pB1; bf16x8 pa0, pa1, pa2, pa3; const int NT = seq / 64;
    int b_prev = 0, b_cur = 1, b_next = 2;
#define ROT3() do { b_prev = b_cur; b_cur = b_next; b_next = (b_next == NBUF - 1) ? 0 : b_next + 1; } while (0)
#define STEP(PC0, PC1, PP0, PP1, SW, SL, i) do { \
        ASBAR(); qkt(PC0, PC1, lds + OFF_K + b_cur * SHM_K, qr, r32, hi); \
        finishSM(PP0, PP1, l_reg, pa0, pa1, pa2, pa3); ASBAR(); \
        if ((i) + 1 < NT) SWRITE(b_next, SW); \
        if ((i) + 2 < NT) SLOAD(SL, (i) + 2); ASBAR(); \
        pv_one<0>(o[0], vb0 + b_prev * SHM_V, pa0, pa1, pa2, pa3); pv_one<1>(o[1], vb0 + b_prev * SHM_V, pa0, pa1, pa2, pa3); partialSM(PC0, PC1); \
        __syncthreads(); ROT3(); } while (0)
    SLOAD(sA, 0);
    {
        f32x16 qa_[3];
#pragma unroll
        for (int b = 0; b < 3; ++b) qa_[b] = f32x16{};
        const bf16_t* ap = QA + ((size_t)((row0 >> 5) + wid) * 16 * 64 + lane) * 8; const bf16_t* wp = WQh + (size_t)lane * 8;
        bf16x8 fr[4][2][4];
#define AQLOAD(S, g) do { _Pragma("unroll") for (int kk = 0; kk < 2; ++kk) { const int ks = 2 * (g) + kk; fr[S][kk][0] = *(const bf16x8*)(ap + (size_t)ks * 512); \
            _Pragma("unroll") for (int b = 0; b < 3; ++b) fr[S][kk][1 + b] = *(const bf16x8*)(wp + (size_t)(b * 16 + ks) * 512); } } while (0)
        AQLOAD(0, 0); AQLOAD(1, 1); AQLOAD(2, 2);
#pragma unroll
        for (int g = 0; g < 8; ++g) {
            if (g + 3 < 8) { if (((g + 3) & 3) == 0) AQLOAD(0, g + 3); else if (((g + 3) & 3) == 1) AQLOAD(1, g + 3); else if (((g + 3) & 3) == 2) AQLOAD(2, g + 3); else AQLOAD(3, g + 3); }
            __builtin_amdgcn_sched_barrier(0);
#pragma unroll
            for (int kk = 0; kk < 2; ++kk)
#pragma unroll
                for (int b = 0; b < 3; ++b) qa_[b] = __builtin_amdgcn_mfma_f32_32x32x16_bf16(fr[g & 3][kk][1 + b], fr[g & 3][kk][0], qa_[b], 0, 0, 0);
            __builtin_amdgcn_sched_barrier(0);
        }
#undef AQLOAD
        const int row = row0 + wid * 32 + r32; const bool lat = row < RL; const int tq = row & 4095;
        float ss = 0.f;
#pragma unroll
        for (int b = 0; b < 3; ++b)
#pragma unroll
            for (int r = 0; r < 16; ++r) ss += qa_[b][r] * qa_[b][r];
        { auto rr = __builtin_amdgcn_permlane32_swap(__float_as_uint(ss), __float_as_uint(ss), false, false); ss = __uint_as_float(rr[0]) + __uint_as_float(rr[1]); }
        const float rn = rsqrtf(ss * (1.f / 96.f) + EPS) * QSCALE;
#pragma unroll
        for (int b = 0; b < 3; ++b)
#pragma unroll
            for (int rq = 0; rq < 4; ++rq) { const f32x4 g = ld4(qn_g + 32 * b + 8 * rq + 4 * hi);
                float v0 = qa_[b][4 * rq] * rn * g[0], v1 = qa_[b][4 * rq + 1] * rn * g[1], v2 = qa_[b][4 * rq + 2] * rn * g[2], v3 = qa_[b][4 * rq + 3] * rn * g[3];
                if (b == 2 && lat) { const int pp = 4 * rq + 2 * hi; arope(ROPE, tq, pp, v0, v1); arope(ROPE, tq, pp + 1, v2, v3); }
                qa_[b][4 * rq] = v0; qa_[b][4 * rq + 1] = v1; qa_[b][4 * rq + 2] = v2; qa_[b][4 * rq + 3] = v3; }
        qr[0] = pack8<0>(qa_[0]); qr[1] = pack8<8>(qa_[0]); qr[2] = pack8<0>(qa_[1]); qr[3] = pack8<8>(qa_[1]); qr[4] = pack8<0>(qa_[2]); qr[5] = pack8<8>(qa_[2]);
    }
    SWRITE(0, sA); SLOAD(sB, 1); if (2 < NT) SLOAD(sA, 2); __syncthreads();
    qkt(pA0, pA1, lds + OFF_K, qr, r32, hi); partialSM(pA0, pA1);
    SWRITE(1, sB); __syncthreads();
    for (int i = 1; i + 1 < NT; i += 2) {
        STEP(pB0, pB1, pA0, pA1, sA, sB, i);
        STEP(pA0, pA1, pB0, pB1, sB, sA, i + 1);
    }
    ASBAR(); qkt(pB0, pB1, lds + OFF_K + b_cur * SHM_K, qr, r32, hi);
    finishSM(pA0, pA1, l_reg, pa0, pa1, pa2, pa3); ASBAR();
    pv_one<0>(o[0], vb0 + b_prev * SHM_V, pa0, pa1, pa2, pa3); pv_one<1>(o[1], vb0 + b_prev * SHM_V, pa0, pa1, pa2, pa3); partialSM(pB0, pB1);
    finishSM(pB0, pB1, l_reg, pa0, pa1, pa2, pa3); ASBAR();
    pv_one<0>(o[0], vb0 + b_cur * SHM_V, pa0, pa1, pa2, pa3); pv_one<1>(o[1], vb0 + b_cur * SHM_V, pa0, pa1, pa2, pa3);
    { auto rr = __builtin_amdgcn_permlane32_swap(__float_as_uint(l_reg), __float_as_uint(l_reg), false, false); l_reg = __uint_as_float(rr[0]) + __uint_as_float(rr[1]); }
#undef STEP
#undef ROT3
    if (hi == 0) li_l[r32] = l_reg; asm volatile("s_waitcnt lgkmcnt(0)" ::: "memory");
    int hi_e = hi, r32_e = r32; asm volatile("" : "+v"(hi_e), "+v"(r32_e));
    bf16_t* Ow = Ob + (size_t)(wid * 32 + 4 * hi_e) * DM + r32_e;
#pragma unroll
    for (int r = 0; r < 16; ++r) { const int orow = (r & 3) + 8 * (r >> 2); const float rl = __builtin_amdgcn_rcpf(li_l[orow + 4 * hi_e]);
#pragma unroll
        for (int d0 = 0; d0 < 2; ++d0) Ow[(size_t)orow * DM + d0 * 32] = (bf16_t)(cvt_pk_bf16(o[d0][r] * rl, 0.f) & 0xffffu); }
    __syncthreads();
#undef SLOAD
#undef SWRITE
}
#undef ASBAR
}


namespace g2 {
using f32x16 = __attribute__((ext_vector_type(16))) float;
__device__ __forceinline__ int crow(int r, int hi) { return (r & 3) + 8 * (r >> 2) + 4 * hi; }
__device__ __forceinline__ float half_swap_sum(float v) { auto rr = __builtin_amdgcn_permlane32_swap(__float_as_uint(v), __float_as_uint(v), false, false); return __uint_as_float(rr[0]) + __uint_as_float(rr[1]); }
__device__ __forceinline__ void rope_pair(const float* __restrict__ ROPE, int t, int pp, float& x1, float& x2) {
    const int pos = pp < 8 ? (t >> 6) : (t & 63); const f32x2 cs = *(const f32x2*)(ROPE + (pos * 8 + (pp & 7)) * 2);
    const float y1 = x1 * cs[0] - x2 * cs[1], y2 = x1 * cs[1] + x2 * cs[0]; x1 = y1; x2 = y2;
}
template <int NTG>
__device__ __forceinline__ void q_item(const bf16_t* __restrict__ QA, const bf16_t* __restrict__ WQ, const float* __restrict__ qn_g, const float* __restrict__ ROPE, bf16_t* __restrict__ Q, int row0, int h, int lane) {
    const int r32 = lane & 31, hi = lane >> 5;
    f32x16 acc[NTG][3];
#pragma unroll
    for (int tg = 0; tg < NTG; ++tg)
#pragma unroll
        for (int b = 0; b < 3; ++b) acc[tg][b] = f32x16{};
    const bf16_t* wp = WQ + ((size_t)(h * 3) * 16 * 64 + lane) * 8; const bf16_t* ap = QA + ((size_t)(row0 >> 5) * 16 * 64 + lane) * 8;
    bf16x8 fr[2][2][5];
#define G2_QLOAD(S, g) do { _Pragma("unroll") for (int kk = 0; kk < 2; ++kk) { const int ks = 2 * (g) + kk; _Pragma("unroll") for (int tg = 0; tg < NTG; ++tg) fr[S][kk][tg] = *(const bf16x8*)(ap + (size_t)(16 * tg + ks) * 512); \
        _Pragma("unroll") for (int b = 0; b < 3; ++b) fr[S][kk][2 + b] = *(const bf16x8*)(wp + (size_t)(b * 16 + ks) * 512); } } while (0)
    G2_QLOAD(0, 0);
#pragma unroll
    for (int g = 0; g < 8; ++g) {
        if (g + 1 < 8) { if (g & 1) G2_QLOAD(0, g + 1); else G2_QLOAD(1, g + 1); }
        __builtin_amdgcn_sched_barrier(0);
#pragma unroll
        for (int kk = 0; kk < 2; ++kk)
#pragma unroll
            for (int b = 0; b < 3; ++b)
#pragma unroll
                for (int tg = 0; tg < NTG; ++tg) acc[tg][b] = __builtin_amdgcn_mfma_f32_32x32x16_bf16(fr[g & 1][kk][2 + b], fr[g & 1][kk][tg], acc[tg][b], 0, 0, 0);
        __builtin_amdgcn_sched_barrier(0);
    }
#undef G2_QLOAD
#pragma unroll
    for (int tg = 0; tg < NTG; ++tg) { const int row = row0 + tg * 32 + r32; const bool lat = row < RL; const int t = row & 4095;
        float ss = 0.f;
#pragma unroll
        for (int b = 0; b < 3; ++b)
#pragma unroll
            for (int r = 0; r < 16; ++r) ss += acc[tg][b][r] * acc[tg][b][r];
        ss = half_swap_sum(ss); const float rn = rsqrtf(ss * (1.f / 96.f) + EPS) * QSCALE;
        bf16_t* qo = Q + ((size_t)row * NH + h) * QKH + 4 * hi;
#pragma unroll
        for (int b = 0; b < 3; ++b)
#pragma unroll
            for (int rq = 0; rq < 4; ++rq) { const int f0 = 32 * b + 8 * rq + 4 * hi; const f32x4 g = ld4(qn_g + f0);
                float v0 = acc[tg][b][4 * rq] * rn * g[0], v1 = acc[tg][b][4 * rq + 1] * rn * g[1], v2 = acc[tg][b][4 * rq + 2] * rn * g[2], v3 = acc[tg][b][4 * rq + 3] * rn * g[3];
                if (b == 2 && lat) { const int pp = 4 * rq + 2 * hi; rope_pair(ROPE, t, pp, v0, v1); rope_pair(ROPE, t, pp + 1, v2, v3); }
                *(u32x2*)(qo + 32 * b + 8 * rq) = (u32x2){cvt_pk_bf16(v0, v1), cvt_pk_bf16(v2, v3)}; } }
}
__device__ __forceinline__ void kv_item(const bf16_t* __restrict__ KVA, const float* __restrict__ KR, const bf16_t* __restrict__ WKV, const float* __restrict__ kn_g, const float* __restrict__ ROPE,
                                        bf16_t* __restrict__ Kb, bf16_t* __restrict__ Vb, int row0, int h, int lane) {
    const int r32 = lane & 31, hi = lane >> 5;
    f32x16 acc[4];
#pragma unroll
    for (int b = 0; b < 4; ++b) acc[b] = f32x16{};
    const bf16_t* wp = WKV + ((size_t)(h * 4) * 8 * 64 + lane) * 8; const bf16_t* ap = KVA + ((size_t)(row0 >> 5) * 8 * 64 + lane) * 8;
    const int row = row0 + r32; const bool lat = row < RL; const int bb = lat ? (row >> 12) : ((row - RL) >> 8), t = lat ? (row & 4095) : ((row - RL) & 255), key = lat ? CTXL + t : t;
    float kr[16];
    { const float* krp = KR + (size_t)(row0 + r32) * 32 + 16 * hi; f32x4 kv_[4];
#pragma unroll
      for (int q = 0; q < 4; ++q) kv_[q] = ld4(krp + 4 * q);
#pragma unroll
      for (int q = 0; q < 4; ++q) { kr[4 * q] = kv_[q][0]; kr[4 * q + 1] = kv_[q][1]; kr[4 * q + 2] = kv_[q][2]; kr[4 * q + 3] = kv_[q][3]; } }
    bf16x8 fr[3][2][5];
#define G2_KLOAD(S, g) do { _Pragma("unroll") for (int kk = 0; kk < 2; ++kk) { const int ks = 2 * (g) + kk; fr[S][kk][0] = *(const bf16x8*)(ap + (size_t)ks * 512); \
        _Pragma("unroll") for (int b = 0; b < 4; ++b) fr[S][kk][1 + b] = *(const bf16x8*)(wp + (size_t)(b * 8 + ks) * 512); } } while (0)
    G2_KLOAD(0, 0); G2_KLOAD(1, 1); G2_KLOAD(2, 2);
#pragma unroll
    for (int g = 0; g < 4; ++g) {
        __builtin_amdgcn_sched_barrier(0);
#pragma unroll
        for (int kk = 0; kk < 2; ++kk)
#pragma unroll
            for (int b = 0; b < 4; ++b) acc[b] = __builtin_amdgcn_mfma_f32_32x32x16_bf16(fr[g % 3][kk][1 + b], fr[g % 3][kk][0], acc[b], 0, 0, 0);
        __builtin_amdgcn_sched_barrier(0);
        if (g == 0) { G2_KLOAD(0, 3); __builtin_amdgcn_sched_barrier(0); }
    }
#undef G2_KLOAD
    float ss = 0.f;
#pragma unroll
    for (int b = 0; b < 2; ++b)
#pragma unroll
        for (int r = 0; r < 16; ++r) ss += acc[b][r] * acc[b][r];
#pragma unroll
    for (int i = 0; i < 16; ++i) ss += kr[i] * kr[i];
    ss = half_swap_sum(ss); const float rn = rsqrtf(ss * (1.f / 96.f) + EPS);
    bf16_t* ko = Kb + (((size_t)bb * NH + h) * NKEY + key) * QKH; bf16_t* vo = Vb + (((size_t)bb * NH + h) * NKEY + key) * VD;
#pragma unroll
    for (int b = 0; b < 2; ++b)
#pragma unroll
        for (int rq = 0; rq < 4; ++rq) { const int f0 = 32 * b + 8 * rq + 4 * hi; const f32x4 g = ld4(kn_g + f0);
            *(u32x2*)(ko + f0) = (u32x2){cvt_pk_bf16(acc[b][4 * rq] * rn * g[0], acc[b][4 * rq + 1] * rn * g[1]), cvt_pk_bf16(acc[b][4 * rq + 2] * rn * g[2], acc[b][4 * rq + 3] * rn * g[3])};
            *(u32x2*)(vo + f0) = (u32x2){cvt_pk_bf16(acc[2 + b][4 * rq], acc[2 + b][4 * rq + 1]), cvt_pk_bf16(acc[2 + b][4 * rq + 2], acc[2 + b][4 * rq + 3])}; }
    f32x4 kgr[4], rp[4];
    { const int pos = hi == 0 ? (t >> 6) : (t & 63);
#pragma unroll
      for (int q = 0; q < 4; ++q) { kgr[q] = ld4(kn_g + 64 + 16 * hi + 4 * q); rp[q] = ld4(ROPE + pos * 16 + 4 * q); } }
    unsigned pk[8];
#pragma unroll
    for (int q = 0; q < 8; ++q) { float x1 = kr[2 * q] * rn * kgr[q >> 1][(2 * q) & 3], x2 = kr[2 * q + 1] * rn * kgr[q >> 1][(2 * q + 1) & 3];
        if (lat) { const float cs0 = rp[q >> 1][(q & 1) * 2], cs1 = rp[q >> 1][(q & 1) * 2 + 1]; const float y1 = x1 * cs0 - x2 * cs1, y2 = x1 * cs1 + x2 * cs0; x1 = y1; x2 = y2; }
        pk[q] = cvt_pk_bf16(x1, x2); }
    *(u32x4*)(ko + 64 + 16 * hi) = (u32x4){pk[0], pk[1], pk[2], pk[3]}; *(u32x4*)(ko + 72 + 16 * hi) = (u32x4){pk[4], pk[5], pk[6], pk[7]};
}
__device__ __forceinline__ void sp_item(const bf16_t* __restrict__ VT, const bf16_t* __restrict__ WSP, const float* __restrict__ bsp, const bf16_t* __restrict__ U, bf16_t* __restrict__ MIX, int chunk, int h, int ih, int lane) {
    const int r32 = lane & 31, hi = lane >> 5;
    f32x16 acc[2][2];
#pragma unroll
    for (int cb = 0; cb < 2; ++cb)
#pragma unroll
        for (int ib = 0; ib < 2; ++ib) acc[cb][ib] = f32x16{};
    const bf16_t* vp = VT + (((size_t)chunk * 8 + 2 * h) * 8 * 64 + lane) * 8;     const bf16_t* wp = WSP + ((size_t)(h * 4 + 2 * ih) * 8 * 64 + lane) * 8;
    u32x2 uu_[2][2][4]; float bias_[2];
#pragma unroll
    for (int ib = 0; ib < 2; ++ib) { const int i = 64 * ih + 32 * ib + r32; bias_[ib] = bsp[h * 128 + i]; const size_t row = (size_t)chunk * 128 + i;
#pragma unroll
        for (int cb = 0; cb < 2; ++cb)
#pragma unroll
            for (int rq = 0; rq < 4; ++rq) uu_[ib][cb][rq] = *(const u32x2*)(U + row * 256 + 64 * h + 32 * cb + 8 * rq + 4 * hi); }
    bf16x8 fr[3][2][4];
#define G2_SLOAD(S, g) do { _Pragma("unroll") for (int kk = 0; kk < 2; ++kk) { const int ks = 2 * (g) + kk; fr[S][kk][0] = *(const bf16x8*)(vp + (size_t)ks * 512); fr[S][kk][1] = *(const bf16x8*)(vp + (size_t)(8 + ks) * 512); \
        fr[S][kk][2] = *(const bf16x8*)(wp + (size_t)ks * 512); fr[S][kk][3] = *(const bf16x8*)(wp + (size_t)(8 + ks) * 512); } } while (0)
    G2_SLOAD(0, 0); G2_SLOAD(1, 1); G2_SLOAD(2, 2);
#pragma unroll
    for (int g = 0; g < 4; ++g) {
        __builtin_amdgcn_sched_barrier(0);
#pragma unroll
        for (int kk = 0; kk < 2; ++kk) {
            acc[0][0] = __builtin_amdgcn_mfma_f32_32x32x16_bf16(fr[g % 3][kk][0], fr[g % 3][kk][2], acc[0][0], 0, 0, 0); acc[0][1] = __builtin_amdgcn_mfma_f32_32x32x16_bf16(fr[g % 3][kk][0], fr[g % 3][kk][3], acc[0][1], 0, 0, 0);
            acc[1][0] = __builtin_amdgcn_mfma_f32_32x32x16_bf16(fr[g % 3][kk][1], fr[g % 3][kk][2], acc[1][0], 0, 0, 0); acc[1][1] = __builtin_amdgcn_mfma_f32_32x32x16_bf16(fr[g % 3][kk][1], fr[g % 3][kk][3], acc[1][1], 0, 0, 0); }
        __builtin_amdgcn_sched_barrier(0);
        if (g == 0) { G2_SLOAD(0, 3); __builtin_amdgcn_sched_barrier(0); }
    }
#undef G2_SLOAD
#pragma unroll
    for (int ib = 0; ib < 2; ++ib) { const int i = 64 * ih + 32 * ib + r32; const float bias = bias_[ib]; const size_t row = (size_t)chunk * 128 + i;
#pragma unroll
        for (int cb = 0; cb < 2; ++cb)
#pragma unroll
            for (int rq = 0; rq < 4; ++rq) { const int c = 64 * h + 32 * cb + 8 * rq + 4 * hi; const u32x2 uu = uu_[ib][cb][rq];
                const float u0 = __uint_as_float(uu[0] << 16), u1 = __uint_as_float(uu[0] & 0xffff0000u), u2 = __uint_as_float(uu[1] << 16), u3 = __uint_as_float(uu[1] & 0xffff0000u);
                *(u32x2*)(MIX + row * DM + c) = (u32x2){cvt_pk_bf16(u0 * (acc[cb][ib][4 * rq] + bias), u1 * (acc[cb][ib][4 * rq + 1] + bias)), cvt_pk_bf16(u2 * (acc[cb][ib][4 * rq + 2] + bias), u3 * (acc[cb][ib][4 * rq + 3] + bias))}; } }
}
__device__ __forceinline__ void pool_block(const bf16_t* __restrict__ BW, const float* __restrict__ pscale, bf16_t* __restrict__ MIX, int row0, LAS unsigned char* lds, int tid) {
    int t0, ntok; if (row0 < RL) { t0 = row0 & 4095; ntok = SEQ; } else { t0 = (row0 - RL) & 255; ntok = CTXL; }
    const int base = row0 - t0;
    __syncthreads();
#pragma unroll
    for (int j = 0; j < 5; ++j) { const int idx = tid + 512 * j; const int rr = idx >> 5, ch = idx & 31; const int t = t0 - 8 + rr;
        u32x4 v = (u32x4){0u, 0u, 0u, 0u}; if (t >= 0 && t < ntok) v = *(const u32x4*)(BW + (size_t)(base + t) * 256 + ch * 8);
        *(LAS u32x4*)(lds + rr * 512 + ch * 16) = v; }
    __syncthreads();
#pragma unroll
    for (int j = 0; j < 4; ++j) { const int idx = tid + 512 * j; const int rr = idx >> 5, ch = idx & 31, n0 = ch * 8, g = n0 >> 6, hw = 1 << g; const int t = t0 + rr;
        const int lo = max(t - hw, 0), hi = min(t + hw, ntok);
        float sm[8];
#pragma unroll
        for (int q = 0; q < 8; ++q) sm[q] = 0.f;
#pragma unroll
        for (int d = -8; d < 8; ++d) { if (d >= -hw && d < hw) { const u32x4 v = *(const LAS u32x4*)(lds + (rr + 8 + d) * 512 + ch * 16);
#pragma unroll
                for (int q = 0; q < 4; ++q) { sm[2 * q] += __uint_as_float(v[q] << 16); sm[2 * q + 1] += __uint_as_float(v[q] & 0xffff0000u); } } }
        const float inv = 1.f / (float)(hi - lo); const u32x4 v = *(const LAS u32x4*)(lds + (rr + 8) * 512 + ch * 16); const f32x4 p0 = ld4(pscale + n0), p1 = ld4(pscale + n0 + 4);
        float z[8];
#pragma unroll
        for (int q = 0; q < 4; ++q) { z[2 * q] = sm[2 * q] * inv - __uint_as_float(v[q] << 16); z[2 * q + 1] = sm[2 * q + 1] * inv - __uint_as_float(v[q] & 0xffff0000u); }
        *(u32x4*)(MIX + (size_t)(row0 + rr) * DM + 256 + n0) = (u32x4){cvt_pk_bf16(z[0] * p0[0], z[1] * p0[1]), cvt_pk_bf16(z[2] * p0[2], z[3] * p0[3]), cvt_pk_bf16(z[4] * p1[0], z[5] * p1[1]), cvt_pk_bf16(z[6] * p1[2], z[7] * p1[3])}; }
}
}

__device__ __forceinline__ void transpose_item(const float* W, int ldw, int K, bf16_t* WT, int k0, int n0, int dst_row0, LAS float* scr, int lane) {
    float tv[32];
#pragma unroll
    for (int i = 0; i < 32; ++i) tv[i] = W[(size_t)(k0 + 2 * i + (lane >> 5)) * ldw + n0 + (lane & 31)];
#pragma unroll
    for (int i = 0; i < 32; ++i) scr[(2 * i + (lane >> 5)) * 33 + (lane & 31)] = tv[i];
    asm volatile("s_waitcnt lgkmcnt(0)" ::: "memory");
    const int c = lane & 7;
#pragma unroll
    for (int j = 0; j < 4; ++j) { const int n = (lane >> 3) + 8 * j; const LAS float* sp = scr + (8 * c) * 33 + n;
        u32x4 o; o.x = cvt_pk_bf16(sp[0 * 33], sp[1 * 33]); o.y = cvt_pk_bf16(sp[2 * 33], sp[3 * 33]); o.z = cvt_pk_bf16(sp[4 * 33], sp[5 * 33]); o.w = cvt_pk_bf16(sp[6 * 33], sp[7 * 33]);
        *(u32x4*)(WT + (size_t)(dst_row0 + n) * K + k0 + 8 * c) = o; }
    asm volatile("s_waitcnt lgkmcnt(0)" ::: "memory");
}


__device__ __forceinline__ void fold_item(const float* w_in_l, const float* w_pool_l, bf16_t* WT, int k0, int g, int dh, LAS float* scr, int lane) {
    {   f32x4 av[8], wv[8];
#pragma unroll
        for (int i = 0; i < 8; ++i) av[i] = ld4(w_in_l + (size_t)(k0 + i * 4 + (lane >> 4)) * DIN + 512 + 64 * g + (lane & 15) * 4);
#pragma unroll
        for (int i = 0; i < 8; ++i) wv[i] = ld4(w_pool_l + (size_t)g * 64 * 64 + (size_t)(i * 8 + (lane >> 3)) * 64 + 32 * dh + (lane & 7) * 4);
#pragma unroll
        for (int i = 0; i < 8; ++i) { *(LAS f32x4*)(scr + (i * 4 + (lane >> 4)) * 64 + (lane & 15) * 4) = av[i]; *(LAS f32x4*)(scr + 2048 + (i * 8 + (lane >> 3)) * 32 + (lane & 7) * 4) = wv[i]; }
    }
    asm volatile("s_waitcnt lgkmcnt(0)" ::: "memory");
    const int ch = lane >> 5, d = lane & 31;
    float acc[32];
#pragma unroll
    for (int j = 0; j < 32; ++j) acc[j] = 0.f;
#pragma unroll 2
    for (int cc = 0; cc < 32; ++cc) { const float wvv = scr[2048 + (ch * 32 + cc) * 32 + d];
#pragma unroll
        for (int j = 0; j < 32; ++j) acc[j] += scr[j * 64 + ch * 32 + cc] * wvv; }
    asm volatile("s_waitcnt lgkmcnt(0)" ::: "memory");
#pragma unroll
    for (int j = 0; j < 32; ++j) { auto rr = __builtin_amdgcn_permlane32_swap(__float_as_uint(acc[j]), __float_as_uint(acc[j]), false, false); acc[j] = __uint_as_float(rr[0]) + __uint_as_float(rr[1]); }
    if (ch == 0) {
#pragma unroll
        for (int j = 0; j < 32; ++j) scr[j * 33 + d] = acc[j]; }
    asm volatile("s_waitcnt lgkmcnt(0)" ::: "memory");
    const int c = lane & 3;
#pragma unroll
    for (int jj = 0; jj < 2; ++jj) { const int n = (lane >> 2) + 16 * jj; const LAS float* sp = scr + (8 * c) * 33 + n;
        u32x4 o; o.x = cvt_pk_bf16(sp[0 * 33], sp[1 * 33]); o.y = cvt_pk_bf16(sp[2 * 33], sp[3 * 33]); o.z = cvt_pk_bf16(sp[4 * 33], sp[5 * 33]); o.w = cvt_pk_bf16(sp[6 * 33], sp[7 * 33]);
        *(u32x4*)(WT + (size_t)(512 + 64 * g + 32 * dh + n) * DM + k0 + 8 * c) = o; }
    asm volatile("s_waitcnt lgkmcnt(0)" ::: "memory");
}

template <bool GU>
__device__ __forceinline__ void transpose_block(const float* __restrict__ W, int ldw, int Kdim, bf16_t* __restrict__ WT, int k0, int n0, int width, LAS float* tile, int tid) {
    const int wave = tid >> 6, lane = tid & 63;
    __syncthreads();
    { const int col4 = lane * 4; f32x4 v[8];
      if (col4 < width) {
#pragma unroll
        for (int i = 0; i < 8; ++i) v[i] = ld4(W + (size_t)(k0 + 8 * i + wave) * ldw + n0 + col4);
#pragma unroll
        for (int i = 0; i < 8; ++i) { LAS float* t_ = tile + (8 * i + wave) * 257 + col4; t_[0] = v[i][0]; t_[1] = v[i][1]; t_[2] = v[i][2]; t_[3] = v[i][3]; } } }
    __syncthreads();
    const int c = lane & 7;
#pragma unroll
    for (int jj = 0; jj < 4; ++jj) { const int nl = 32 * wave + (lane >> 3) + 8 * jj;
        if (nl < width) { const LAS float* sp = tile + (8 * c) * 257 + nl;
            u32x4 o; o.x = cvt_pk_bf16(sp[0 * 257], sp[1 * 257]); o.y = cvt_pk_bf16(sp[2 * 257], sp[3 * 257]); o.z = cvt_pk_bf16(sp[4 * 257], sp[5 * 257]); o.w = cvt_pk_bf16(sp[6 * 257], sp[7 * 257]);
            const int n = n0 + nl; int dst = n; if (GU) { const int f = n % DFF, isup = n / DFF; dst = 256 * (f / 128) + 128 * isup + (f % 128); }
            *(u32x4*)(WT + (size_t)dst * Kdim + k0 + 8 * c) = o; } }
}

#define XB_TMO      128
#define XB_XCNT(j)  (256  + 64 * (j))
#define XB_XSUB(j)  (1280 + 64 * (j))
#define XB_XGEN(j)  (2304 + 64 * (j))
#define XB_TOP      3328
#define XB_TOPGEN   3392
#define XCD_BAR_WORDS 3456
#define XB_SPIN_CAP (1u << 18)
#define XB_MISM     160
#define XB_LSUB(j)  (4096 + 64 * (j))
#define XB_CTL(k)   (5632 + 64 * (k))
__device__ __forceinline__ unsigned xb_ld(unsigned* p)              { return __hip_atomic_load(p, __ATOMIC_RELAXED, __HIP_MEMORY_SCOPE_AGENT); }
__device__ __forceinline__ unsigned xb_add(unsigned* p, unsigned v) { return __hip_atomic_fetch_add(p, v, __ATOMIC_RELAXED, __HIP_MEMORY_SCOPE_AGENT); }
__device__ __forceinline__ unsigned xb_xcc_id() { return (unsigned)__builtin_amdgcn_s_getreg((3 << 11) | 20) & 0xFu; }
#define XB_SPIN(cond, bar) do { unsigned _sp = 0; while (cond) { __builtin_amdgcn_s_sleep(1); \
    if ((++_sp & 255u) == 0u) { if (xb_ld(&(bar)[XB_TMO])) break; if (_sp > XB_SPIN_CAP) { atomicAdd(&(bar)[XB_TMO], 1u); break; } } } } while (0)
struct XcdBarrier { unsigned* bar; unsigned x; volatile LAS unsigned* st; };
__device__ __forceinline__ XcdBarrier xcd_barrier_post(unsigned* bar, volatile LAS unsigned* st) {
    XcdBarrier b; b.bar = bar; b.x = xb_xcc_id(); b.st = st;
    if (threadIdx.x == 0) {
        if (b.x != (blockIdx.x & 7u)) { const unsigned o = xb_add(&bar[XB_MISM], 1u); asm volatile("s_waitcnt vmcnt(0)" :: "v"(o) : "memory"); }
        (void)xb_add(&bar[XB_XCNT(b.x)], 1u);
    }
    return b;
}
__device__ __forceinline__ void xcd_barrier_complete(unsigned* bar, unsigned x, unsigned& nloc, unsigned& nx) {
    const unsigned G = gridDim.x * gridDim.y * gridDim.z;
    unsigned sum, cnt, mine, sp = 0u;
    for (;;) {
        sum = 0u; cnt = 0u; mine = 0u;
#pragma unroll
        for (unsigned j = 0; j < 16; ++j) { const unsigned c = xb_ld(&bar[XB_XCNT(j)]); sum += c; cnt += (c > 0u) ? 1u : 0u; mine = (j == x) ? c : mine; }
        if (sum == G) break;
        __builtin_amdgcn_s_sleep(1);
        if ((++sp & 255u) == 0u) { if (xb_ld(&bar[XB_TMO])) break; if (sp > XB_SPIN_CAP) { atomicAdd(&bar[XB_TMO], 1u); break; } }
    }
    nloc = mine > 0u ? mine : 1u; nx = cnt > 0u ? cnt : 1u;
}
__device__ __forceinline__ void xcd_barrier(const XcdBarrier& b) {
    asm volatile("s_waitcnt vmcnt(0)" ::: "memory");
    __syncthreads();
    if (threadIdx.x == 0) {
        unsigned* bar = b.bar;
        __builtin_amdgcn_s_waitcnt(0);
        unsigned nloc = b.st[0], nx = b.st[1];
        if (nloc == 0u) { xcd_barrier_complete(bar, b.x, nloc, nx); b.st[0] = nloc; b.st[1] = nx; }
        const unsigned old = xb_add(&bar[XB_XSUB(b.x)], 1u);
        const unsigned gen = old / nloc;
        if (old + 1u == (gen + 1u) * nloc) {
            __builtin_amdgcn_fence(__ATOMIC_RELEASE, "agent");
            asm volatile("s_waitcnt vmcnt(0)" ::: "memory");
            const unsigned og = xb_add(&bar[XB_TOP], 1u);
            const unsigned tg = og / nx;
            if (og + 1u == (tg + 1u) * nx) xb_add(&bar[XB_TOPGEN], 1u);
            else XB_SPIN(xb_ld(&bar[XB_TOPGEN]) == tg, bar);
            __builtin_amdgcn_fence(__ATOMIC_ACQUIRE, "agent");
            xb_add(&bar[XB_XGEN(b.x)], 1u);
            asm volatile("s_waitcnt vmcnt(0)" ::: "memory");
        } else {
            XB_SPIN(xb_ld(&bar[XB_XGEN(b.x)]) == gen, bar);
            __builtin_amdgcn_fence(__ATOMIC_ACQUIRE, "agent");
            asm volatile("s_waitcnt vmcnt(0)" ::: "memory");
        }
    }
    __syncthreads();
}

__device__ __forceinline__ void xcd_barrier_local(const XcdBarrier& b, int sig = -1, int wt = -1) {
    asm volatile("s_waitcnt vmcnt(0)" ::: "memory");
    __syncthreads();
    if (threadIdx.x == 0) { unsigned ul = b.st[2]; if (ul == 0u) { ul = (xb_ld(&b.bar[XB_MISM]) == 0u && gridDim.x == 256u) ? 2u : 1u; b.st[2] = ul; } }
    __syncthreads();
    if (b.st[2] != 2u) { xcd_barrier(b); return; }
    if (threadIdx.x == 0) {
        unsigned* bar = b.bar; const unsigned nloc = b.st[0] > 0u ? b.st[0] : 1u;
        const unsigned old = xb_add(&bar[XB_LSUB(b.x)], 1u); const unsigned target = (old / nloc + 1u) * nloc;
        if (sig >= 0 && old + 1u == target) (void)xb_add(&bar[XB_CTL(sig)], 1u);
        XB_SPIN(xb_ld(&bar[XB_LSUB(b.x)]) < target, bar);
        if (wt >= 0) { const unsigned nx = b.st[1] > 0u ? b.st[1] : 1u; XB_SPIN(xb_ld(&bar[XB_CTL(wt)]) < nx, bar); }
        __builtin_amdgcn_fence(__ATOMIC_ACQUIRE, "agent");
        asm volatile("s_waitcnt vmcnt(0)" ::: "memory");
    }
    __syncthreads();
}

struct MkArgs { const float* in[23]; float* out; unsigned char* ws; int ph_lo, ph_hi; int dry, pad; };
constexpr int MK_LDS = 147456;
constexpr int MK_XL_OFF = 131072;
enum { PH_P0A = 0, PH_P0B = 1, PH_L0 = 2, PH_PER_LAYER = 6, PH_G1 = 0, PH_G2 = 1, PH_G3 = 2, PH_G4 = 3, PH_G5 = 4, PH_G6 = 5, PH_END = 14 };

typedef const __attribute__((address_space(4))) MkArgs* KargPtr;
#define KARG() ({ KargPtr p_ = (KargPtr)__builtin_amdgcn_kernarg_segment_ptr(); asm volatile("" : "+s"(p_)); p_; })
#define WSP(kp, off) ((kp)->ws + (off))
#define BLK() ({ int b_ = (int)blockIdx.x; asm volatile("" : "+s"(b_)); b_; })

__device__ __forceinline__ void weight_prep(KargPtr kp, unsigned char* ws, int l, int bi, int nb, LAS unsigned char* lds, int tid, int parts) {
    const int lane = tid & 63, wave = __builtin_amdgcn_readfirstlane(tid >> 6);
    bf16_t* WB = (bf16_t*)(ws + WS_WB + (size_t)l * 22 * MiB);
    {   LAS float* tile = (LAS float*)lds;
        constexpr int B_IN = 16 * 4, B_OUT = 16 * 4, B_GU = 16 * 22, B_DN = 44 * 4, B_L = B_IN + B_OUT + B_GU + B_DN;
        for (int it = bi; it < B_L; it += nb) { int r = it; const int part = (r >= B_GU + B_DN && r < B_GU + B_DN + B_IN) ? 1 : 2; if (!(parts & part)) continue;
            if (r < B_GU) { transpose_block<true>(kp->in[21] + (size_t)l * DM * 2 * DFF, 2 * DFF, DM, WB + WL_GU, (r / 22) * 64, (r % 22) * 256, 256, tile, tid); continue; } r -= B_GU;
            if (r < B_DN) { transpose_block<false>(kp->in[22] + (size_t)l * DFF * DM, DM, DFF, WB + WL_DN, (r / 4) * 64, (r % 4) * 256, 256, tile, tid); continue; } r -= B_DN;
            if (r < B_IN) { const int nq = r % 4, n0 = (nq < 2 ? nq : nq + 1) * 256; transpose_block<false>(kp->in[8] + (size_t)l * DM * DIN, DIN, DM, WB + WL_IN, (r / 4) * 64, n0, n0 == 1024 ? 160 : 256, tile, tid); continue; } r -= B_IN;
            transpose_block<false>(kp->in[20] + (size_t)l * DM * DM, DM, DM, WB + WL_OUT, (r / 4) * 64, (r % 4) * 256, 256, tile, tid);
        }
        __syncthreads();
    }
    LAS float* scr = (LAS float*)(lds + wave * 16384);
    constexpr int I_FOLD = 32 * 8, I_Z = 96 * DM / 512, I_SP = 4 * 4 * 8, I_QF = 8 * 3 * 16, I_KF = 8 * 4 * 8, I_ALL = I_FOLD + I_Z + I_SP + I_QF + I_KF;
    if (parts & 1)
    for (int it = bi * 8 + wave; it < I_ALL; it += nb * 8) { int r = it;
        if (r < I_FOLD) { const int kb = r >> 3, g = (r >> 1) & 3, dh = r & 1; fold_item(kp->in[8] + (size_t)l * DM * DIN, kp->in[12] + (size_t)l * 4 * 64 * 64, WB + WL_IN, kb * 32, g, dh, scr, lane); continue; } r -= I_FOLD;
        if (r < I_SP) {
            const int h = r >> 5, ib = (r >> 3) & 3, ks = r & 7; const float* sp_ = kp->in[10] + (size_t)l * 4 * 128 * 128 + ((size_t)h * 128 + 32 * ib + (lane & 31)) * 128 + 16 * ks + 8 * (lane >> 5); const f32x4 x0 = ld4(sp_), x1 = ld4(sp_ + 4);
            *(u32x4*)(WB + WL_SP + ((size_t)r * 64 + lane) * 8) = (u32x4){cvt_pk_bf16(x0[0], x0[1]), cvt_pk_bf16(x0[2], x0[3]), cvt_pk_bf16(x1[0], x1[1]), cvt_pk_bf16(x1[2], x1[3])}; continue; } r -= I_SP;
        if (r < I_QF) {
            const int h = r / 48, b = (r / 16) % 3, ks = r & 15; const float* src = kp->in[15] + (size_t)l * 256 * 768 + (size_t)(16 * ks + 8 * (lane >> 5)) * 768 + 96 * h + 32 * b + (lane & 31); float e_[8];
#pragma unroll
            for (int e = 0; e < 8; ++e) e_[e] = src[(size_t)e * 768];
            *(u32x4*)(WB + WL_QB + ((size_t)r * 64 + lane) * 8) = (u32x4){cvt_pk_bf16(e_[0], e_[1]), cvt_pk_bf16(e_[2], e_[3]), cvt_pk_bf16(e_[4], e_[5]), cvt_pk_bf16(e_[6], e_[7])}; continue; } r -= I_QF;
        if (r < I_KF) {
            const int h = r >> 5, b = (r >> 3) & 3, ks = r & 7; const float* src = kp->in[17] + (size_t)l * 128 * 1024 + (size_t)(16 * ks + 8 * (lane >> 5)) * 1024 + 128 * h + 32 * b + (lane & 31); float e_[8];
#pragma unroll
            for (int e = 0; e < 8; ++e) e_[e] = src[(size_t)e * 1024];
            *(u32x4*)(WB + WL_KVB + ((size_t)r * 64 + lane) * 8) = (u32x4){cvt_pk_bf16(e_[0], e_[1]), cvt_pk_bf16(e_[2], e_[3]), cvt_pk_bf16(e_[4], e_[5]), cvt_pk_bf16(e_[6], e_[7])}; continue; } r -= I_KF;
        { unsigned z_ = 0u; asm volatile("" : "+v"(z_)); *(u32x4*)(WB + WL_IN + (size_t)DIN * DM + (size_t)r * 512 + lane * 8) = (u32x4){z_, z_, z_, z_}; }
    }
}
__device__ __forceinline__ void bias_items(unsigned char* ws, int l, int bi, int nb, int tid, int which) {
    const int lane = tid & 63, wave = __builtin_amdgcn_readfirstlane(tid >> 6);
    const float* MOD = (const float*)(ws + WS_MOD); float* BIAS1P = (float*)(ws + WS_BIAS1P); float* BIAS2P = (float*)(ws + WS_BIAS2P);
    constexpr int NB_ROWS = 2 * DFF + 1280;
    const int r_lo = (which & 2) ? 0 : 2 * DFF, r_hi = (which & 1) ? NB_ROWS : 2 * DFF;
    for (int it0 = r_lo + (bi * 8 + wave) * 2; it0 < r_hi; it0 += nb * 8 * 2) {
        u32x4 q0[2], q1[2]; const float* shp[2]; float* outp[2]; int ldo[2];
#pragma unroll
        for (int e = 0; e < 2; ++e) { int n = it0 + e; const bool isgu = n < 2 * DFF; if (!isgu) n -= 2 * DFF;
            const bf16_t* wrow = (const bf16_t*)(ws + WS_WB + (size_t)l * 22 * MiB) + (isgu ? WL_GU : WL_IN) + (size_t)n * DM; shp[e] = MOD + (size_t)l * 5 * NMOD * DM + (isgu ? 3 : 0) * DM;
            outp[e] = isgu ? BIAS2P + (size_t)l * 5 * 2 * DFF + n : BIAS1P + (size_t)l * 5 * 1280 + n; ldo[e] = isgu ? 2 * DFF : 1280;
            q0[e] = *(const u32x4*)(wrow + lane * 16); q1[e] = *(const u32x4*)(wrow + lane * 16 + 8); }
        float accr[2][5];
#pragma unroll
        for (int e = 0; e < 2; ++e) { float w[16];
#pragma unroll
            for (int j = 0; j < 4; ++j) { w[2 * j] = __uint_as_float(q0[e][j] << 16); w[2 * j + 1] = __uint_as_float(q0[e][j] & 0xffff0000u); w[8 + 2 * j] = __uint_as_float(q1[e][j] << 16); w[9 + 2 * j] = __uint_as_float(q1[e][j] & 0xffff0000u); }
#pragma unroll
            for (int r = 0; r < 5; ++r) { const float* sv = shp[e] + (size_t)r * NMOD * DM + lane * 16; float acc = 0.f;
#pragma unroll
                for (int j = 0; j < 4; ++j) { const f32x4 s4 = ld4(sv + 4 * j); acc += (s4[0] * w[4 * j] + s4[1] * w[4 * j + 1]) + (s4[2] * w[4 * j + 2] + s4[3] * w[4 * j + 3]); }
                accr[e][r] = acc; } }
#pragma unroll
        for (int e = 0; e < 2; ++e)
#pragma unroll
            for (int r = 0; r < 5; ++r) { const float t = wave_sum(accr[e][r]); if (lane == 0) outp[e][(size_t)r * ldo[e]] = t; }
    }
}

__device__ __forceinline__ void mod_strips(KargPtr kp, unsigned char* ws, LAS unsigned char* lds, int tid, int l, int G) {
    LAS float* sl = (LAS float*)lds; LAS float* part = (LAS float*)(lds + 20480);
    float* MOD = (float*)(ws + WS_MOD); const float* cc = kp->in[1]; const float* cctx = kp->in[3]; const float* w_ada = kp->in[6]; const float* b_ada = kp->in[7];
    __syncthreads();
    for (int i = tid; i < 5 * DM; i += 512) { const int mr = i >> 10, k = i & 1023; const float v = mr < 4 ? cc[mr * DM + k] : cctx[k]; sl[i] = silu_f(v); }
    __syncthreads();
    for (int strip = blockIdx.x; strip < 128; strip += G) { const int n0 = strip * 48;
        const int kg = tid / 12, c4 = tid % 12;
        if (tid < 504) { f32x4 acc[5];
#pragma unroll
            for (int r = 0; r < 5; ++r) acc[r] = (f32x4){0.f, 0.f, 0.f, 0.f};
            const float* wp = w_ada + (size_t)l * DM * (NMOD * DM) + n0 + c4 * 4;
#pragma unroll 13
            for (int k = kg; k < DM; k += 42) { const f32x4 w = ld4(wp + (size_t)k * (NMOD * DM));
#pragma unroll
                for (int r = 0; r < 5; ++r) acc[r] += w * sl[r * DM + k]; }
#pragma unroll
            for (int r = 0; r < 5; ++r) *(LAS f32x4*)(part + (kg * 5 + r) * 48 + c4 * 4) = acc[r]; }
        __syncthreads();
        if (tid < 240) { const int r = tid / 48, c = tid % 48; float sum = 0.f;
#pragma unroll 6
            for (int q = 0; q < 42; ++q) sum += part[(q * 5 + r) * 48 + c];
            MOD[((size_t)l * 5 + r) * (NMOD * DM) + n0 + c] = sum + b_ada[l * NMOD * DM + n0 + c]; }
        __syncthreads(); }
}

__global__ void __launch_bounds__(512, 2) mk_fwd(MkArgs a) {
    extern __shared__ __attribute__((aligned(16))) unsigned char lds_raw[];
    LAS unsigned char* lds = (LAS unsigned char*)lds_raw; LAS unsigned char* xl = lds + MK_XL_OFF;
    const int ph_lo = a.ph_lo, ph_hi = a.ph_hi;
#define IN(k) (ph_lo <= (k) && (k) < ph_hi)
    volatile LAS unsigned* bst = (volatile LAS unsigned*)(lds + MK_XL_OFF + 8192);
    if (threadIdx.x < 4) bst[threadIdx.x] = 0u;
    __syncthreads();
    XcdBarrier gbar; gbar.bar = (unsigned*)a.ws; gbar.x = 0; gbar.st = bst;
    if (ph_hi - ph_lo > 1) gbar = xcd_barrier_post((unsigned*)a.ws, bst);
#define GRID_BAR(k) do { if (IN(k) && IN((k) + 1)) xcd_barrier(gbar); } while (0)
#define GRID_BAR_L(k) do { if (IN(k) && IN((k) + 1)) xcd_barrier_local(gbar); } while (0)
#define GRID_BAR_LC(k, sig, wt) do { if (IN(k) && IN((k) + 1)) xcd_barrier_local(gbar, sig, wt); } while (0)
#define LANE_IDS() int tid = threadIdx.x; asm volatile("" : "+v"(tid)); const int lane = tid & 63, wave = __builtin_amdgcn_readfirstlane(tid >> 6); const int G = gridDim.x; const int gw = blockIdx.x * 8 + wave, NGW = G * 8; (void)lane; (void)gw; (void)NGW
    if (IN(PH_P0A)) {
        LANE_IDS(); KargPtr kp = KARG(); unsigned char* ws = kp->ws;
        if ((int)blockIdx.x < 128) mod_strips(kp, ws, lds, tid, 0, G);
        if (blockIdx.x == 0) { float* ROPE = (float*)(ws + WS_ROPE); const int pos = tid >> 3, i = tid & 7;
            const float inv = (float)exp2(-(double)i / 8.0 * 13.287712379549449); const float ang = (float)pos * inv;
            double sn, cs; sincos_d((double)ang, sn, cs); ROPE[tid * 2] = (float)cs; ROPE[tid * 2 + 1] = (float)sn; }
        __syncthreads();
        weight_prep(kp, ws, 0, ((int)blockIdx.x + G - (G >= 256 ? 128 : 0)) % G, G, lds, tid, 1);
    }
    GRID_BAR(PH_P0A);
    if (IN(PH_P0B)) {
        LANE_IDS(); KargPtr kp = KARG(); unsigned char* ws = kp->ws;
        const float* MOD = (const float*)(ws + WS_MOD);
        bias_items(ws, 0, ((int)blockIdx.x + G - (G >= 256 ? 128 : 0)) % G, G, tid, 1);
        if ((int)blockIdx.x < 128) { int tid_ = threadIdx.x; asm volatile("" : "+v"(tid_)); mod_strips(kp, ws, lds, tid_, 1, G); }
        float* RSQ1 = (float*)(ws + WS_RSQ1); bf16_t* XG = (bf16_t*)(ws + WS_XG);
        const float* xin = kp->in[0]; const float* cin = kp->in[2]; const float* norm1_g = kp->in[4]; const float* sc = MOD + 1 * DM;
        const int nlow = (G >= 256) ? 128 : 0, nvw = nlow * 8 + (G - nlow) * 16; const int bq = (int)blockIdx.x;
#pragma unroll 1
        for (int qv = 0; qv < (bq < nlow ? 1 : 2); ++qv)
#pragma unroll 1
        for (int r0 = (bq < nlow ? bq * 8 + wave : nlow * 8 + ((bq - nlow) * 8 + wave) * 2 + qv) * 4; r0 < R; r0 += nvw * 4) {
            f32x4 v[4][4], gg[4], s4[4];
            const float* scr_ = sc + (size_t)mrow_of(r0) * (NMOD * DM);
#pragma unroll
            for (int j = 0; j < 4; ++j) { gg[j] = ld4(norm1_g + j * 256 + lane * 4); s4[j] = ld4(scr_ + j * 256 + lane * 4); }
#pragma unroll
            for (int e = 0; e < 4; ++e) { const int r = r0 + e; const float* xr = r < RL ? xin + (size_t)r * DM : cin + (size_t)(r - RL) * DM;
#pragma unroll
                for (int j = 0; j < 4; ++j) v[e][j] = ld4(xr + j * 256 + lane * 4); }
#pragma unroll
            for (int j = 0; j < 4; ++j) gg[j] = gg[j] * (s4[j] + 1.f);
            float ssv[4][4];
#pragma unroll
            for (int e = 0; e < 4; ++e) { const int r = r0 + e;
#pragma unroll
                for (int j = 0; j < 4; ++j) { const int k = j * 256 + lane * 4;
                    ssv[e][j] = (v[e][j][0] * v[e][j][0] + v[e][j][1] * v[e][j][1]) + (v[e][j][2] * v[e][j][2] + v[e][j][3] * v[e][j][3]);
                    const f32x4 z = v[e][j] * gg[j]; *(u32x2*)(XG + (size_t)r * DM + k) = (u32x2){cvt_pk_bf16(z[0], z[1]), cvt_pk_bf16(z[2], z[3])}; } }
#pragma unroll
            for (int e = 0; e < 4; ++e) {
#pragma unroll
                for (int j = 0; j < 4; ++j) ssv[e][j] = wave_sum(ssv[e][j]);
                if (lane == 0) *(f32x4*)(RSQ1 + (size_t)(r0 + e) * 4) = (f32x4){ssv[e][0], ssv[e][1], ssv[e][2], ssv[e][3]}; }
        }
    }
    GRID_BAR(PH_P0B);
    constexpr int NCTXU = 16;
#pragma unroll 1
    for (int l = 0; l < DEPTH; ++l) {
        const int pb = PH_L0 + l * PH_PER_LAYER; const int Mrows = (l == 0) ? R : RL;
        if (IN(pb + PH_G1)) {
            KargPtr kp = KARG(); unsigned char* ws = kp->ws; const bf16_t* WB = (const bf16_t*)(ws + WS_WB + (size_t)l * 22 * MiB); const int G = gridDim.x;
            EpiG1 E{(const float*)(ws + WS_RSQ1), (const float*)(ws + WS_BIAS1P) + (size_t)l * 5 * 1280, kp->in[9] + l * 256, kp->in[14] + l * 256, kp->in[16] + l * 128,
                    (bf16_t*)(ws + WS_U), (bf16_t*)(ws + WS_VT), (bf16_t*)(ws + WS_BW), (bf16_t*)(ws + WS_QA), (bf16_t*)(ws + WS_KVA), (float*)(ws + WS_KR)};
            if (l == 0) {
                pg8::Gemm g{(const bf16_t*)(ws + WS_XG), WB + WL_IN, R, 1280, DM}; pg8::StaticOrder S; S.init(R, 1280, G, BLK());
                pg8::gemm_phase(lds, xl, g, S, E);
                const int busy2 = (R / 256) * 5 > G ? (R / 256) * 5 - G : 0;
                if ((int)blockIdx.x >= busy2) { int tid_ = threadIdx.x; asm volatile("" : "+v"(tid_)); weight_prep(kp, ws, 0, (int)blockIdx.x - busy2, G - busy2, lds, tid_, 2); }
            } else {
                constexpr int NC6 = 2 * NCTXU;
                pg8::Gemm g{(const bf16_t*)(ws + WS_XG), WB + WL_IN, RL, 1280, DM}; pg8::StaticOrder S; S.init(RL, 1280, G - NC6, BLK() - NC6);
                pg8::gemm_phase(lds, xl, g, S, E);
                const bf16_t* WBp = (const bf16_t*)(ws + WS_WB + (size_t)(l - 1) * 22 * MiB); const float* MOD = (const float*)(ws + WS_MOD); const float* modp = MOD + (size_t)(l - 1) * 5 * NMOD * DM;
                const int role = ((int)blockIdx.x >> 4) & 1;
                pg8::Gemm g6{(const bf16_t*)(ws + WS_ACT) + role * (DFF / 2), WBp + WL_DN + role * (DFF / 2), R, DM, DFF / 2, DFF}; pg8::ListOrder S6{role * NCTXU, NCTXU, 16, 64, 4, 0};
                EpiRes E6{kp->out, (float*)(ws + WS_XC), (const float*)kp->out, (const float*)(ws + WS_XC), modp + 5 * DM, (float*)(ws + WS_RSQ1), (bf16_t*)(ws + WS_XG), kp->in[4] + l * DM, MOD + (size_t)l * 5 * NMOD * DM + 1 * DM, 1, role ? 1 : 2,
                          (float*)(ws + WS_Q), (unsigned*)(ws + 32768)};
                pg8::gemm_phase(lds, xl, g6, S6, E6);
            }
        }
        GRID_BAR(pb + PH_G1);
        if (IN(pb + PH_G2)) {
            LANE_IDS(); KargPtr kp = KARG(); unsigned char* ws = kp->ws; const bf16_t* WB = (const bf16_t*)(ws + WS_WB + (size_t)l * 22 * MiB);
            const bf16_t* Uq = (const bf16_t*)(ws + WS_U); const bf16_t* VTq = (const bf16_t*)(ws + WS_VT); const bf16_t* BWq = (const bf16_t*)(ws + WS_BW); const bf16_t* QAq = (const bf16_t*)(ws + WS_QA);
            const bf16_t* KVAq = (const bf16_t*)(ws + WS_KVA); const float* KRq = (const float*)(ws + WS_KR); const float* ROPEq = (const float*)(ws + WS_ROPE);
            bf16_t* Qo = (bf16_t*)(ws + WS_Q); bf16_t* Ko = (bf16_t*)(ws + WS_K); bf16_t* Vo = (bf16_t*)(ws + WS_V); bf16_t* MIX = (bf16_t*)(ws + WS_MIX);
            const int nc7 = (l > 0) ? 32 : 0;
            if ((int)blockIdx.x < nc7) {
                pg8::Gemm g{(const bf16_t*)(ws + WS_XG), WB + WL_IN, R, 1280, DM}; pg8::ListOrder S7{(int)blockIdx.x & ~3, 4, 4, 64, 4, 4};
                EpiG1 E7{(const float*)(ws + WS_RSQ1), (const float*)(ws + WS_BIAS1P) + (size_t)l * 5 * 1280, kp->in[9] + l * 256, kp->in[14] + l * 256, kp->in[16] + l * 128,
                         (bf16_t*)(ws + WS_U), (bf16_t*)(ws + WS_VT), (bf16_t*)(ws + WS_BW), (bf16_t*)(ws + WS_QA), (bf16_t*)(ws + WS_KVA), (float*)(ws + WS_KR)};
                pg8::gemm_phase(lds, xl, g, S7, E7);
                asm volatile("s_waitcnt vmcnt(0)" ::: "memory"); __syncthreads();
                __builtin_amdgcn_fence(__ATOMIC_ACQUIRE, "agent"); asm volatile("s_waitcnt vmcnt(0)" ::: "memory"); __syncthreads();
                { int ln = lane; asm volatile("" : "+v"(ln)); g2::kv_item(KVAq, KRq, WB + WL_KVB, kp->in[19] + l * QKH, ROPEq, Ko, Vo, RL + ((int)blockIdx.x & 3) * 256 + ((int)blockIdx.x >> 2) * 32, wave, ln); }
            } else {
            const int bi2 = (int)blockIdx.x - nc7, nb2 = G - nc7;
            for (int pi = bi2; pi < Mrows / 64; pi += nb2) g2::pool_block(BWq, kp->in[13] + l * 256, MIX, pi * 64, lds, tid);
            const int nQ = 0  , nKV = (Mrows / 32) * NH, nSP = (Mrows / 128) * 8, nAll = nQ + nKV + nSP;
            for (int it = bi2 * 8 + wave; it < nAll; it += nb2 * 8) { int r = it; int ln = lane; asm volatile("" : "+v"(ln));
                if (r < nQ) { g2::q_item<1>(QAq, WB + WL_QB, kp->in[18] + l * QKH, ROPEq, Qo, (r >> 3) * 32, r & 7, ln); continue; } r -= nQ;
                if (r < nKV) { g2::kv_item(KVAq, KRq, WB + WL_KVB, kp->in[19] + l * QKH, ROPEq, Ko, Vo, (r >> 3) * 32, r & 7, ln); continue; } r -= nKV;
                g2::sp_item(VTq, WB + WL_SP, kp->in[11] + l * 4 * 128, Uq, MIX, r >> 3, (r >> 1) & 3, r & 1, ln);
            }
            }
        }
        GRID_BAR(pb + PH_G2);
        if (IN(pb + PH_G3)) {
            KargPtr kp = KARG(); unsigned char* ws = kp->ws; const int G = gridDim.x;
            const bf16_t* WBq = (const bf16_t*)(ws + WS_WB + (size_t)l * 22 * MiB) + WL_QB; const bf16_t* Kp = (const bf16_t*)(ws + WS_K); const bf16_t* Vp = (const bf16_t*)(ws + WS_V); bf16_t* MIX = (bf16_t*)(ws + WS_MIX);
            const int vcu = (G % 8 == 0) ? ((int)blockIdx.x % 8) * (G / 8) + (int)blockIdx.x / 8 : (int)blockIdx.x;
            const int nun = NB * NH * 16 + (l == 0 ? NB * NH : 0);
            for (int un = vcu; un < nun; un += G) {
                int bh, row0, seq;
                if (un < NB * NH * 16) { int v;
                    if (G == 256) { const int c_ = un % G, st = un / G, x_ = c_ >> 5; v = ((((x_ >> 1) << 3) + 4 * st + ((c_ & 31) >> 3)) << 4) | (8 * (x_ & 1) + (c_ & 7)); }
                    else { const int per = ((NB * NH * 16) % G == 0) ? (NB * NH * 16) / G : 0; v = per ? (un % G) * per + un / G : un; }
                    bh = v >> 4; row0 = (bh >> 3) * SEQ + (v & 15) * 256; seq = NKEY; }
                else { bh = un - NB * NH * 16; row0 = RL + (bh >> 3) * CTXL; seq = CTXL; }
                const int h = bh & 7;
                att::attn_unit((const bf16_t*)(ws + WS_QA), WBq + ((size_t)(h * 3) * 16 * 64) * 8, kp->in[18] + l * QKH, (const float*)(ws + WS_ROPE), row0, Kp + (size_t)bh * NKEY * QKH, Vp + (size_t)bh * NKEY * VD, MIX + (size_t)row0 * DM + 512 + h * 64, seq, lds);
            }
            if (l == 0 && vcu >= NB * NH && G > NB * NH) { int tid_ = threadIdx.x; asm volatile("" : "+v"(tid_)); bias_items(ws, 0, vcu - NB * NH, G - NB * NH, tid_, 2); }
        }
        if (l == 0) GRID_BAR(pb + PH_G3); else GRID_BAR_LC(pb + PH_G3, 0, -1);
        if (IN(pb + PH_G4)) {
            KargPtr kp = KARG(); unsigned char* ws = kp->ws; const bf16_t* WB = (const bf16_t*)(ws + WS_WB + (size_t)l * 22 * MiB); const int G = gridDim.x;
            const float* modl = (const float*)(ws + WS_MOD) + (size_t)l * 5 * NMOD * DM;
            pg8::Gemm g{(const bf16_t*)(ws + WS_MIX), WB + WL_OUT, RL, DM, DM}; pg8::StaticOrder S; S.init(RL, DM, G, BLK());
            EpiRes E{kp->out, (float*)(ws + WS_XC), l == 0 ? kp->in[0] : (const float*)kp->out, l == 0 ? kp->in[2] : (const float*)(ws + WS_XC), modl + 2 * DM, (float*)(ws + WS_RSQ2), (bf16_t*)(ws + WS_XG), kp->in[5] + l * DM, modl + 4 * DM, 1, 0};
            pg8::gemm_phase(lds, xl, g, S, E);
        }
        if (l == 0) GRID_BAR_L(pb + PH_G4); else GRID_BAR_LC(pb + PH_G4, -1, 0);
        if (IN(pb + PH_G5)) {
            KargPtr kp = KARG(); unsigned char* ws = kp->ws; const bf16_t* WB = (const bf16_t*)(ws + WS_WB + (size_t)l * 22 * MiB); const int G = gridDim.x;
            pg8::Gemm g{(const bf16_t*)(ws + WS_XG), WB + WL_GU, RL, 2 * DFF, DM}; pg8::StaticOrder S; S.init(RL, 2 * DFF, G, BLK());
            EpiGU E{(bf16_t*)(ws + WS_ACT), (const float*)(ws + WS_RSQ2), (const float*)(ws + WS_BIAS2P) + (size_t)l * 5 * 2 * DFF};
            pg8::gemm_phase(lds, xl, g, S, E);
            if (l == 0) {
                const float* modl = (const float*)(ws + WS_MOD) + (size_t)l * 5 * NMOD * DM;
                pg8::Gemm g4{(const bf16_t*)(ws + WS_MIX), WB + WL_OUT, R, DM, DM}; pg8::ListOrder S4{G - NCTXU, NCTXU, 16, 64, 4, 0};
                EpiRes E4{kp->out, (float*)(ws + WS_XC), kp->in[0], kp->in[2], modl + 2 * DM, (float*)(ws + WS_RSQ2), (bf16_t*)(ws + WS_XG), kp->in[5] + l * DM, modl + 4 * DM, 1, 0};
                pg8::gemm_phase(lds, xl, g4, S4, E4);
                const int nun5 = (RL / 256) * 22, rem = nun5 % G; const int lo = (rem > 0 && rem < G - NCTXU) ? rem : 0;
                if ((int)blockIdx.x >= lo && (int)blockIdx.x < G - NCTXU) { int tid_ = threadIdx.x; asm volatile("" : "+v"(tid_)); weight_prep(kp, ws, l + 1, (int)blockIdx.x - lo, G - NCTXU - lo, lds, tid_, 3); }
            }
        }
        if (l == 0) GRID_BAR(pb + PH_G5); else GRID_BAR_L(pb + PH_G5);
        if (IN(pb + PH_G6)) {
            KargPtr kp = KARG(); unsigned char* ws = kp->ws; const bf16_t* WB = (const bf16_t*)(ws + WS_WB + (size_t)l * 22 * MiB); const int G = gridDim.x;
            const float* MOD = (const float*)(ws + WS_MOD); const float* modl = MOD + (size_t)l * 5 * NMOD * DM;
            pg8::Gemm g{(const bf16_t*)(ws + WS_ACT), WB + WL_DN, RL, DM, DFF}; pg8::StaticOrder S; S.init(RL, DM, G, BLK());
            const int nx = l + 1 < DEPTH;
            EpiRes E{kp->out, (float*)(ws + WS_XC), (const float*)kp->out, (const float*)(ws + WS_XC), modl + 5 * DM, (float*)(ws + WS_RSQ1), (bf16_t*)(ws + WS_XG), kp->in[4] + (nx ? (l + 1) * DM : 0), MOD + (size_t)(nx ? l + 1 : 0) * 5 * NMOD * DM + 1 * DM, nx, 0};
            pg8::gemm_phase(lds, xl, g, S, E);
            if (nx) {
                const int n5 = 88 < G ? 88 : G;
                pg8::Gemm g5{(const bf16_t*)(ws + WS_XG), WB + WL_GU, R, 2 * DFF, DM}; pg8::ListOrder S5{0, n5, 88, 64, 4, 0};
                EpiGU E5{(bf16_t*)(ws + WS_ACT), (const float*)(ws + WS_RSQ2), (const float*)(ws + WS_BIAS2P) + (size_t)l * 5 * 2 * DFF};
                pg8::gemm_phase(lds, xl, g5, S5, E5);
                const int lo = n5 < G ? n5 : 0;
                if ((int)blockIdx.x >= lo) { int tid_ = threadIdx.x; asm volatile("" : "+v"(tid_)); bias_items(ws, l + 1, (int)blockIdx.x - lo, G - lo, tid_, 3); }
            }
        }
        GRID_BAR(pb + PH_G6);
    }
#undef IN
}

extern "C" void kernel_launch(void* const* d_in, const int* in_sizes, int n_in, void* d_out, int out_size, void* d_ws, size_t ws_size, hipStream_t stream) {
    if (n_in != 23 || ws_size < 256 * MiB || out_size != RL * DM) { fprintf(stderr, "kernel_launch: unexpected shapes (n_in %d, out %d, ws %zu)\n", n_in, out_size, ws_size); return; }
    unsigned char* ws = (unsigned char*)d_ws;
    static int grid = 0;
    if (grid == 0) {
        int dev = 0, cus = 0, per_cu = 0;
        if (hipGetDevice(&dev) != hipSuccess || hipDeviceGetAttribute(&cus, hipDeviceAttributeMultiprocessorCount, dev) != hipSuccess) { fprintf(stderr, "device query failed\n"); return; }
        if (hipFuncSetAttribute((const void*)mk_fwd, hipFuncAttributeMaxDynamicSharedMemorySize, MK_LDS) != hipSuccess) { fprintf(stderr, "hipFuncSetAttribute failed\n"); return; }
        if (hipOccupancyMaxActiveBlocksPerMultiprocessor(&per_cu, (const void*)mk_fwd, 512, MK_LDS) != hipSuccess || per_cu < 1) { fprintf(stderr, "occupancy query: %d\n", per_cu); (void)hipGetLastError(); return; }
        if (cus < 64) { fprintf(stderr, "kernel_launch: %d CUs: the phase program needs at least 64 workgroups\n", cus); return; }
        grid = cus;
    }
    MkArgs ma{}; for (int i = 0; i < 23; ++i) ma.in[i] = (const float*)d_in[i]; ma.out = (float*)d_out; ma.ws = ws;
#define MK(lo, hi) do { ma.ph_lo = (lo); ma.ph_hi = (hi); hipLaunchKernelGGL(mk_fwd, dim3(grid), dim3(512), MK_LDS, stream, ma); } while (0)
    if (hipMemsetAsync(ws, 0, 65536, stream) != hipSuccess) { fprintf(stderr, "memset failed\n"); return; }
    MK(0, PH_END);
}
```
